# Optimizing an MI355X kernel written in HIP

```python
import math
import jax, jax.numpy as jnp
from jax import lax
import numpy as np


D_MODEL = 2048
BATCH = 1
SEQ = 8192
DEPTH = 2

CHUNK = 64
MIX_WIDTH = D_MODEL
EPS = 1e-6

HEAD_DIM_A = 64
N_HEADS_A = (MIX_WIDTH // 2) // HEAD_DIM_A
N_KV_A = 4
GROUP_A = N_HEADS_A // N_KV_A
WINDOW = 128
WINDOW_CHUNKS = WINDOW // CHUNK
Q_BLOCK = 128
HIST = WINDOW_CHUNKS * CHUNK
KEY_SPAN = Q_BLOCK + HIST

NUM_BUCKETS = 32
MAX_DISTANCE = 128

LRU_WIDTH = MIX_WIDTH // 2
LRU_BLOCKS = 16
LRU_BLOCK_DIM = LRU_WIDTH // LRU_BLOCKS
CONV_WIDTH = 4
LRU_C = 8.0

HEAD_DIM_C = 128
N_HEADS_C = MIX_WIDTH // HEAD_DIM_C
SB_BLOCK = 128

D_FF = 4 * D_MODEL

Q_COLS = N_HEADS_A * HEAD_DIM_A
KV_COLS = N_KV_A * HEAD_DIM_A
OFF_K = Q_COLS
OFF_V = OFF_K + KV_COLS
OFF_X = OFF_V + KV_COLS
OFF_G = OFF_X + LRU_WIDTH
EVEN_IN = OFF_G + LRU_WIDTH
ODD_IN = 3 * MIX_WIDTH
N_EVEN = (DEPTH + 1) // 2
N_ODD = DEPTH // 2

kernel_name = "chunk_causal_hybrid_swa_rglru_stickbreak"


def rms_norm(x, g):
    x32 = x.astype(jnp.float32)
    y = x32 * lax.rsqrt(jnp.mean(x32 * x32, axis=-1, keepdims=True) + EPS)
    return (y * g.astype(jnp.float32)).astype(x.dtype)


def t5_bucket(rel):
    half = NUM_BUCKETS // 2
    ret = jnp.where(rel > 0, half, 0)
    n = jnp.abs(rel)
    max_exact = half // 2
    nf = jnp.maximum(n, 1).astype(jnp.float32)
    large = max_exact + (jnp.log(nf / max_exact) / math.log(MAX_DISTANCE / max_exact)
                         * (half - max_exact)).astype(jnp.int32)
    large = jnp.minimum(large, half - 1)
    return ret + jnp.where(n < max_exact, n, large)


def swa_sink_attention(q, k, v, sinks, rel_bias):
    B, S = q.shape[0], q.shape[1]
    nb = S // Q_BLOCK
    qb = q.reshape(B, nb, Q_BLOCK, N_KV_A, GROUP_A, HEAD_DIM_A)
    kidx = jnp.arange(nb)[:, None] * Q_BLOCK + jnp.arange(KEY_SPAN)[None, :]
    kp = jnp.pad(k, ((0, 0), (HIST, 0), (0, 0), (0, 0)))
    vp = jnp.pad(v, ((0, 0), (HIST, 0), (0, 0), (0, 0)))
    kb = jnp.take(kp, kidx, axis=1)
    vb = jnp.take(vp, kidx, axis=1)
    logits = jnp.einsum('bnqhgd,bnshd->bnhgqs', qb, kb,
                        preferred_element_type=jnp.float32) * (HEAD_DIM_A ** -0.5)
    qi = jnp.arange(Q_BLOCK)
    sj = jnp.arange(KEY_SPAN)
    rel = (sj[None, :] - HIST) - qi[:, None]
    bias = rel_bias[t5_bucket(rel)].astype(jnp.float32)
    bias = bias.transpose(2, 0, 1).reshape(N_KV_A, GROUP_A, Q_BLOCK, KEY_SPAN)
    q_chunk = qi // CHUNK
    k_chunk = (sj - HIST) // CHUNK
    in_window = (k_chunk[None, :] <= q_chunk[:, None]) & \
                (k_chunk[None, :] >= q_chunk[:, None] - WINDOW_CHUNKS)
    valid = in_window[None] & ((kidx - HIST) >= 0)[:, None, :]
    logits = jnp.where(valid[None, :, None, None], logits + bias, -jnp.inf)
    sink = sinks.astype(jnp.float32).reshape(N_KV_A, GROUP_A)[None, None, :, :, None, None]
    m = jnp.maximum(jnp.max(logits, axis=-1, keepdims=True), sink)
    p = jnp.exp(logits - m)
    denom = jnp.sum(p, axis=-1, keepdims=True) + jnp.exp(sink - m)
    w = (p / denom).astype(v.dtype)
    out = jnp.einsum('bnhgqs,bnshd->bnqhgd', w, vb)
    return out.reshape(B, S, N_HEADS_A * HEAD_DIM_A)


def rg_lru_branch(xb, gb, conv_w, conv_b, gate_a_w, gate_a_b, gate_x_w, gate_x_b, lru_lambda):
    B, S, C = xb.shape
    xc = lax.conv_general_dilated(xb, conv_w[:, None, :], window_strides=(1,),
                                  padding=[(CONV_WIDTH - 1, 0)],
                                  dimension_numbers=('NWC', 'WIO', 'NWC'),
                                  feature_group_count=C) + conv_b
    xh = xc.reshape(B, S, LRU_BLOCKS, LRU_BLOCK_DIM)
    r = jax.nn.sigmoid((jnp.einsum('bshi,hij->bshj', xh, gate_a_w).reshape(B, S, C)
                        + gate_a_b).astype(jnp.float32))
    i = jax.nn.sigmoid((jnp.einsum('bshi,hij->bshj', xh, gate_x_w).reshape(B, S, C)
                        + gate_x_b).astype(jnp.float32))
    log_a = -LRU_C * r * jax.nn.softplus(-lru_lambda.astype(jnp.float32))
    a = jnp.exp(log_a)
    u = jnp.sqrt(-jnp.expm1(2.0 * log_a)) * (i * xc.astype(jnp.float32))

    def combine(left, right):
        a1, b1 = left
        a2, b2 = right
        return a1 * a2, a2 * b1 + b2

    _, h = lax.associative_scan(combine, (a, u), axis=1)
    y = jax.nn.gelu(gb.astype(jnp.float32), approximate=True) * h
    return y.astype(xb.dtype)


def stick_breaking_attention(q, k, v):
    B, S, H, D = q.shape
    nb = S // SB_BLOCK
    kpos = jnp.arange(S)
    qblocks = q.reshape(B, nb, SB_BLOCK, H, D).transpose(1, 0, 3, 2, 4)

    def one_block(args):
        bi, qb = args
        z = jnp.einsum('bhqd,bshd->bhqs', qb, k,
                       preferred_element_type=jnp.float32) * (HEAD_DIM_C ** -0.5)
        qpos = bi * SB_BLOCK + jnp.arange(SB_BLOCK)
        before = kpos[None, :] < qpos[:, None]
        log_keep = jnp.where(before, jax.nn.log_sigmoid(-z), 0.0)
        stick = lax.cumsum(log_keep, axis=3, reverse=True) - log_keep
        w = jnp.where(before, jnp.exp(jax.nn.log_sigmoid(z) + stick), 0.0)
        return jnp.einsum('bhqs,bshd->bqhd', w.astype(v.dtype), v)

    out = lax.map(one_block, (jnp.arange(nb), qblocks))
    return out.transpose(1, 0, 2, 3, 4).reshape(B, S, H * D)


def even_mixer(hn, w_in, conv_w, conv_b, gate_a_w, gate_a_b, gate_x_w, gate_x_b,
               lru_lambda, sinks, w_out, rel_bias):
    B, S, _ = hn.shape
    proj = hn @ w_in
    q = proj[..., :OFF_K].reshape(B, S, N_HEADS_A, HEAD_DIM_A)
    k = proj[..., OFF_K:OFF_V].reshape(B, S, N_KV_A, HEAD_DIM_A)
    v = proj[..., OFF_V:OFF_X].reshape(B, S, N_KV_A, HEAD_DIM_A)
    xb = proj[..., OFF_X:OFF_G]
    gb = proj[..., OFF_G:]
    y_a = swa_sink_attention(q, k, v, sinks, rel_bias)
    y_b = rg_lru_branch(xb, gb, conv_w, conv_b, gate_a_w, gate_a_b, gate_x_w, gate_x_b, lru_lambda)
    return jnp.concatenate([y_a, y_b], axis=-1) @ w_out


def odd_mixer(hn, w_in, w_out):
    B, S, _ = hn.shape
    proj = (hn @ w_in).reshape(B, S, 3, N_HEADS_C, HEAD_DIM_C)
    y = stick_breaking_attention(proj[:, :, 0], proj[:, :, 1], proj[:, :, 2])
    return y @ w_out


def squared_relu_mlp(hn, w_up, w_down):
    return jnp.square(jax.nn.relu(hn @ w_up)) @ w_down


def setup_inputs(seed: int = 0) -> dict:
    key = jax.random.key(seed)
    ks = jax.random.split(key, 20)
    f = jnp.float32

    def nrm(k, shape, scale):
        return jax.random.normal(k, shape, f) * scale

    x = nrm(ks[0], (BATCH, SEQ, D_MODEL), 1.0)
    rel_bias = nrm(ks[1], (NUM_BUCKETS, N_HEADS_A), 0.5)
    norm_mix = 1.0 + nrm(ks[2], (DEPTH, D_MODEL), 0.02)
    even_w_in = nrm(ks[3], (N_EVEN, D_MODEL, EVEN_IN), D_MODEL ** -0.5)
    even_conv_w = nrm(ks[4], (N_EVEN, CONV_WIDTH, LRU_WIDTH), CONV_WIDTH ** -0.5)
    even_conv_b = nrm(ks[5], (N_EVEN, LRU_WIDTH), 0.02)
    even_gate_a_w = nrm(ks[6], (N_EVEN, LRU_BLOCKS, LRU_BLOCK_DIM, LRU_BLOCK_DIM), LRU_BLOCK_DIM ** -0.5)
    even_gate_a_b = nrm(ks[7], (N_EVEN, LRU_WIDTH), 0.02)
    even_gate_x_w = nrm(ks[8], (N_EVEN, LRU_BLOCKS, LRU_BLOCK_DIM, LRU_BLOCK_DIM), LRU_BLOCK_DIM ** -0.5)
    even_gate_x_b = nrm(ks[9], (N_EVEN, LRU_WIDTH), 0.02)
    a_c = jax.random.uniform(ks[10], (N_EVEN, LRU_WIDTH), f, 0.9, 0.999)
    a0 = a_c ** (1.0 / LRU_C)
    even_lru_lambda = jnp.log(a0) - jnp.log1p(-a0)
    even_sinks = nrm(ks[11], (N_EVEN, N_HEADS_A), 0.5)
    even_w_out = nrm(ks[12], (N_EVEN, MIX_WIDTH, D_MODEL), MIX_WIDTH ** -0.5)
    odd_w_in = nrm(ks[13], (N_ODD, D_MODEL, ODD_IN), D_MODEL ** -0.5)
    odd_w_out = nrm(ks[14], (N_ODD, MIX_WIDTH, D_MODEL), MIX_WIDTH ** -0.5)
    norm_mlp = 1.0 + nrm(ks[15], (DEPTH, D_MODEL), 0.02)
    w_up = nrm(ks[16], (DEPTH, D_MODEL, D_FF), D_MODEL ** -0.5)
    w_down = nrm(ks[17], (DEPTH, D_FF, D_MODEL), D_FF ** -0.5)
    final_norm = 1.0 + nrm(ks[18], (D_MODEL,), 0.02)
    return {"x": x, "rel_bias": rel_bias, "norm_mix": norm_mix,
            "even_w_in": even_w_in, "even_conv_w": even_conv_w, "even_conv_b": even_conv_b,
            "even_gate_a_w": even_gate_a_w, "even_gate_a_b": even_gate_a_b,
            "even_gate_x_w": even_gate_x_w, "even_gate_x_b": even_gate_x_b,
            "even_lru_lambda": even_lru_lambda, "even_sinks": even_sinks,
            "even_w_out": even_w_out, "odd_w_in": odd_w_in, "odd_w_out": odd_w_out,
            "norm_mlp": norm_mlp, "w_up": w_up, "w_down": w_down, "final_norm": final_norm}


def reference(x, rel_bias, norm_mix, even_w_in, even_conv_w, even_conv_b,
              even_gate_a_w, even_gate_a_b, even_gate_x_w, even_gate_x_b,
              even_lru_lambda, even_sinks, even_w_out, odd_w_in, odd_w_out,
              norm_mlp, w_up, w_down, final_norm):
    h = x
    for layer in range(DEPTH):
        j = layer // 2
        hn = rms_norm(h, norm_mix[layer])
        if layer % 2 == 0:
            mix = even_mixer(hn, even_w_in[j], even_conv_w[j], even_conv_b[j],
                             even_gate_a_w[j], even_gate_a_b[j], even_gate_x_w[j],
                             even_gate_x_b[j], even_lru_lambda[j], even_sinks[j],
                             even_w_out[j], rel_bias)
        else:
            mix = odd_mixer(hn, odd_w_in[j], odd_w_out[j])
        h = h + mix
        h = h + squared_relu_mlp(rms_norm(h, norm_mlp[layer]), w_up[layer], w_down[layer])
    return rms_norm(h, final_norm)
```

```cpp
#include <hip/hip_runtime.h>
#include <cstdio>
#include <cstdint>
namespace pg8 {
#define PG8_LAS __attribute__((address_space(3)))
typedef unsigned short bf16_t;
typedef short bf16x8 __attribute__((ext_vector_type(8)));
typedef float f32x4 __attribute__((ext_vector_type(4)));
typedef unsigned u32x4 __attribute__((ext_vector_type(4)));
constexpr int BM = 256, BK = 64, HALF = 128, HTB = HALF * BK * 2  , STAGE_BYTES = 8 * HTB, NXCD = 8, WGM = 8;

__host__ __device__ __forceinline__ int lds_byte(int r, int c) { const int st = (r >> 4) * 2 + (c >> 5), rr = r & 15, cc = c & 31, ob = rr * 64 + cc * 2; return st * 1024 + (ob ^ (((ob >> 9) & 1) << 5)); }
__host__ __device__ __forceinline__ void stage_rc(int b, int& R, int& C) { const int st = b / 1024, sb = b % 1024, swz = sb ^ (((sb >> 9) & 1) << 5); R = (st >> 1) * 16 + swz / 64; C = (st & 1) * 32 + (swz % 64) / 2; }
__host__ __device__ __forceinline__ int perm32(int rho) { const int n = rho >> 4, i = rho & 15; return 8 * (i >> 2) + 4 * n + (i & 3); }

struct Unit { int pm, pn; };
struct Gemm { const bf16_t* A; const bf16_t* Bt; int M, N, K; };

struct StaticOrder {
    int nM, nN, nwg, G, c;
    __host__ __device__ void init(int M, int N, int G_, int c_) { nM = M / BM; nN = N / BM; nwg = nM * nN; G = G_; c = c_; }
    __host__ __device__ bool next(int i, Unit& u) const {
        const long L = (long)i * G + c; if (L >= nwg) return false;
        int wgid = (int)L; { const int q = nwg / NXCD, r = nwg % NXCD, xcd = wgid % NXCD, off = wgid / NXCD; wgid = (xcd < r ? xcd * (q + 1) : r * (q + 1) + (xcd - r) * q) + off; }
        const int nig = WGM * nN, gid = wgid / nig, fm = gid * WGM, gsz = (nM - fm) < WGM ? (nM - fm) : WGM;
        u.pm = fm + ((wgid % nig) % gsz); u.pn = (wgid % nig) / gsz; return true;
    }
    __device__ __forceinline__ void a_ready(const Unit&) const {}
    __device__ __forceinline__ void done(const Unit&) const {}
};

__device__ __forceinline__ unsigned cvt_pk_bf16(float lo, float hi) { unsigned r; asm volatile("v_cvt_pk_bf16_f32 %0, %1, %2" : "=v"(r) : "v"(lo), "v"(hi)); return r; }
constexpr float RMS_EPS = 1e-6f;
__device__ __forceinline__ float row_rstd(const float* ss, int r) {
    const f32x4 a = *(const f32x4*)(ss + (size_t)r * 8), b = *(const f32x4*)(ss + (size_t)r * 8 + 4);
    const float s = ((a[0] + a[1]) + (a[2] + a[3])) + ((b[0] + b[1]) + (b[2] + b[3]));
    return 1.0f / sqrtf(s * (1.0f / 2048.0f) + RMS_EPS);
}
template <int ACT> struct EpiBf16 {
    static constexpr bool PERM = true, AFTER_DRAIN = false;
    bf16_t* O; int ldc; const float* ss;
    __device__ __forceinline__ void operator()(const f32x4 (&acc)[2][2][4][2], const Unit& u, int wr, int wc, int fr, int fq) const {
        const int row0 = u.pm * BM + wr * 64 + fr, col0 = u.pn * BM + wc * 32 + 8 * fq;
#pragma unroll
        for (int ai = 0; ai < 2; ++ai)
#pragma unroll
            for (int m = 0; m < 4; ++m) { const int r = row0 + ai * HALF + m * 16; const float rs = ss ? row_rstd(ss, r) : 1.0f;
                bf16_t* rowp = O + (size_t)r * ldc + col0;
#pragma unroll
                for (int bj = 0; bj < 2; ++bj) { f32x4 v0 = acc[ai][bj][m][0] * rs, v1 = acc[ai][bj][m][1] * rs;
                    if (ACT == 1) {
#pragma unroll
                        for (int j = 0; j < 4; ++j) { const float a = fmaxf(v0[j], 0.f), b = fmaxf(v1[j], 0.f); v0[j] = a * a; v1[j] = b * b; } }
                    u32x4 w; w.x = cvt_pk_bf16(v0[0], v0[1]); w.y = cvt_pk_bf16(v0[2], v0[3]); w.z = cvt_pk_bf16(v1[0], v1[1]); w.w = cvt_pk_bf16(v1[2], v1[3]);
                    *(u32x4*)(rowp + bj * HALF) = w; } }
    }
};
struct EpiRes {
    static constexpr bool PERM = true, AFTER_DRAIN = true;
    const float* base; float* out; bf16_t* xn; float* ss; int ldc;
    __device__ __forceinline__ void operator()(const f32x4 (&)[2][2][4][2], const Unit&, int, int, int, int) const {}
    __device__ __forceinline__ void fused(f32x4 (&acc)[2][2][4][2], const Unit& u, int wr, int wc, int fr, int fq, PG8_LAS unsigned char* lds, int wid, int lane) const {
        PG8_LAS float* P = (PG8_LAS float*)lds;
#pragma unroll
        for (int ai = 0; ai < 2; ++ai)
#pragma unroll
            for (int m = 0; m < 4; ++m) { const int rl = ai * HALF + wr * 64 + m * 16 + fr; const size_t off = (size_t)(u.pm * BM + rl) * ldc + u.pn * BM + wc * 32 + 8 * fq; float s = 0.f;
#pragma unroll
                for (int bj = 0; bj < 2; ++bj) { const f32x4 b0 = *(const f32x4*)(base + off + bj * HALF), b1 = *(const f32x4*)(base + off + bj * HALF + 4);
                    const f32x4 v0 = acc[ai][bj][m][0] + b0, v1 = acc[ai][bj][m][1] + b1;
                    *(f32x4*)(out + off + bj * HALF) = v0; *(f32x4*)(out + off + bj * HALF + 4) = v1;
                    u32x4 w; w.x = cvt_pk_bf16(v0[0], v0[1]); w.y = cvt_pk_bf16(v0[2], v0[3]); w.z = cvt_pk_bf16(v1[0], v1[1]); w.w = cvt_pk_bf16(v1[2], v1[3]);
                    *(u32x4*)(xn + off + bj * HALF) = w;
                    s += ((v0[0] * v0[0] + v0[1] * v0[1]) + (v0[2] * v0[2] + v0[3] * v0[3])) + ((v1[0] * v1[0] + v1[1] * v1[1]) + (v1[2] * v1[2] + v1[3] * v1[3])); }
                s += __shfl_xor(s, 16); s += __shfl_xor(s, 32);
                if (fq == 0) P[rl * 4 + wc] = s;
                asm volatile("" ::: "memory"); }
        asm volatile("s_waitcnt lgkmcnt(0)" ::: "memory"); __builtin_amdgcn_s_barrier(); asm volatile("" ::: "memory");
        const int t = wid * 64 + lane;
        if (t < 256) { const f32x4 p = *(const PG8_LAS f32x4*)(P + t * 4); ss[(size_t)(u.pm * BM + t) * 8 + u.pn] = (p[0] + p[1]) + (p[2] + p[3]); }
        asm volatile("s_waitcnt lgkmcnt(0)" ::: "memory"); __builtin_amdgcn_s_barrier(); asm volatile("" ::: "memory");
    }
};

template <class Epi, class Sched, bool ALIGN_EPI = false, bool SP2 = false>
__device__ __forceinline__ void gemm_phase(PG8_LAS unsigned char* lds, const Gemm g, const Sched& S, const Epi& E) {
    const int tid = threadIdx.x, wid = __builtin_amdgcn_readfirstlane(tid >> 6), lane = tid & 63, wr = wid >> 2, wc = wid & 3, fr = lane & 15, fq = lane >> 4;
    const int K = g.K, nt = K / BK;
    unsigned voffA[2], voffB[2];
#pragma unroll
    for (int i = 0; i < 2; ++i) { int R, C; stage_rc(tid * 16 + i * 8192, R, C); const int Rb = Epi::PERM ? ((R & ~31) + perm32(R & 31)) : R;
        voffA[i] = (unsigned)(R * K + C) * 2u; voffB[i] = (unsigned)(Rb * K + C) * 2u; }
    const size_t kstep = (size_t)(BK * 2);
    const size_t hstep = (size_t)HALF * K * 2;
    const size_t tstep = 2 * hstep;
    const unsigned ldsw = (unsigned)wid * 1024u;
    const int aoff = lds_byte(wr * 64 + fr, fq * 8), boff = lds_byte(wc * 32 + fr, fq * 8);
#define PG8_SA(b, h) (((b) * 2 + (h)) * HTB)
#define PG8_SB(b, h) ((4 + (b) * 2 + (h)) * HTB)
#define PG8_STAGE(bufoff, gbase, voff) do { _Pragma("unroll") for (int _i = 0; _i < 2; ++_i) \
        __builtin_amdgcn_global_load_lds((const unsigned*)((const char*)(gbase) + (voff)[_i]), (PG8_LAS unsigned*)(lds + (bufoff) + ldsw + _i * 8192), 16, 0, 0); } while (0)
#define PG8_LDA(dst, b, h) do { _Pragma("unroll") for (int m = 0; m < 4; ++m) _Pragma("unroll") for (int k = 0; k < 2; ++k) dst[m][k] = *(const PG8_LAS bf16x8*)(lds + PG8_SA(b, h) + aoff + m * 2048 + k * 1024); } while (0)
#define PG8_LDB(dst, b, h) do { _Pragma("unroll") for (int n = 0; n < 2; ++n) _Pragma("unroll") for (int k = 0; k < 2; ++k) dst[n][k] = *(const PG8_LAS bf16x8*)(lds + PG8_SB(b, h) + boff + n * 2048 + k * 1024); } while (0)
#define PG8_MMA(ai, bj, At, Bt) do { __builtin_amdgcn_s_setprio(1); _Pragma("unroll") for (int m = 0; m < 4; ++m) _Pragma("unroll") for (int n = 0; n < 2; ++n) _Pragma("unroll") for (int k = 0; k < 2; ++k) \
        acc[ai][bj][m][n] = __builtin_amdgcn_mfma_f32_16x16x32_bf16(Bt[n][k], At[m][k], acc[ai][bj][m][n], 0, 0, 0); __builtin_amdgcn_s_setprio(0); } while (0)
#define PG8_WAIT_V(n) asm volatile("s_waitcnt vmcnt(" #n ")" ::: "memory")
#define PG8_WAIT_L(n) asm volatile("s_waitcnt lgkmcnt(" #n ")" ::: "memory")
#define PG8_BAR __builtin_amdgcn_s_barrier()
#define PG8_SCHED __builtin_amdgcn_sched_barrier(0)
    Unit cur, nxt; int ui = 0;
    if (!S.next(0, cur)) return;
    f32x4 acc[2][2][4][2];
#pragma unroll
    for (int a = 0; a < 2; ++a)
#pragma unroll
        for (int b = 0; b < 2; ++b)
#pragma unroll
            for (int m = 0; m < 4; ++m)
#pragma unroll
                for (int n = 0; n < 2; ++n) acc[a][b][m][n] = (f32x4){0.f, 0.f, 0.f, 0.f};
    bf16x8 At[4][2], B0[2][2], B1[2][2];
    const char* cA = (const char*)g.A + (size_t)cur.pm * tstep; const char* cB = (const char*)g.Bt + (size_t)cur.pn * tstep;
    S.a_ready(cur);
    if constexpr (SP2) {
        PG8_STAGE(PG8_SB(0, 0), cB, voffB); PG8_STAGE(PG8_SB(0, 1), cB + hstep, voffB); PG8_STAGE(PG8_SA(0, 0), cA, voffA); PG8_STAGE(PG8_SA(0, 1), cA + hstep, voffA);
        if (wr == 1) PG8_BAR;
        PG8_WAIT_V(2); PG8_BAR;
        PG8_STAGE(PG8_SB(1, 0), cB + kstep, voffB); PG8_STAGE(PG8_SA(1, 0), cA + kstep, voffA); PG8_STAGE(PG8_SB(1, 1), cB + hstep + kstep, voffB);
        PG8_WAIT_V(6); PG8_BAR;
    } else {
        PG8_STAGE(PG8_SB(0, 0), cB, voffB); PG8_STAGE(PG8_SA(0, 0), cA, voffA); PG8_STAGE(PG8_SB(0, 1), cB + hstep, voffB); PG8_STAGE(PG8_SA(0, 1), cA + hstep, voffA);
        if (wr == 1) PG8_BAR;
        PG8_WAIT_V(4); PG8_BAR;
        PG8_STAGE(PG8_SB(1, 0), cB + kstep, voffB); PG8_STAGE(PG8_SA(1, 0), cA + kstep, voffA); PG8_STAGE(PG8_SB(1, 1), cB + hstep + kstep, voffB);
        PG8_WAIT_V(6); PG8_BAR;
    }
    for (;;) {
        const bool has_next = S.next(ui + 1, nxt);
        const char* nA = has_next ? (const char*)g.A + (size_t)nxt.pm * tstep : cA; const char* nB = has_next ? (const char*)g.Bt + (size_t)nxt.pn * tstep : cB;
        for (int t = 0; t < nt; t += 2) {
            const bool last = (t == nt - 2);
            const char* a1 = cA + (size_t)(t + 1) * kstep;
            const char* a2 = last ? nA : cA + (size_t)(t + 2) * kstep; const char* b2 = last ? nB : cB + (size_t)(t + 2) * kstep;
            const char* a3 = a2 + kstep; const char* b3 = b2 + kstep;
            if (last && has_next) S.a_ready(nxt);
            if constexpr (SP2) {
            PG8_LDB(B0, 0, 0); PG8_LDB(B1, 0, 1); PG8_SCHED; PG8_LDA(At, 0, 0); PG8_STAGE(PG8_SA(1, 1), a1 + hstep, voffA);
            PG8_WAIT_V(8); PG8_WAIT_L(0); PG8_BAR; PG8_MMA(0, 0, At, B0); PG8_MMA(0, 1, At, B1); PG8_BAR; PG8_SCHED;
            PG8_LDA(At, 0, 1); PG8_STAGE(PG8_SB(0, 0), b2, voffB); PG8_STAGE(PG8_SB(0, 1), b2 + hstep, voffB); PG8_STAGE(PG8_SA(0, 0), a2, voffA);
            PG8_WAIT_V(8); PG8_WAIT_L(0); PG8_BAR; PG8_MMA(1, 0, At, B0); PG8_MMA(1, 1, At, B1); PG8_BAR; PG8_SCHED;
            PG8_LDB(B0, 1, 0); PG8_LDB(B1, 1, 1); PG8_SCHED; PG8_LDA(At, 1, 0); PG8_STAGE(PG8_SA(0, 1), a2 + hstep, voffA);
            PG8_WAIT_V(8); PG8_WAIT_L(0); PG8_BAR; PG8_MMA(0, 0, At, B0); PG8_MMA(0, 1, At, B1); PG8_BAR; PG8_SCHED;
            PG8_LDA(At, 1, 1); PG8_STAGE(PG8_SB(1, 0), b3, voffB); PG8_STAGE(PG8_SB(1, 1), b3 + hstep, voffB); PG8_STAGE(PG8_SA(1, 0), a3, voffA);
            PG8_WAIT_V(8); PG8_WAIT_L(0); PG8_BAR; PG8_MMA(1, 0, At, B0); PG8_MMA(1, 1, At, B1); PG8_BAR; PG8_SCHED;
            } else {
            PG8_LDB(B0, 0, 0); PG8_SCHED; PG8_LDA(At, 0, 0); PG8_STAGE(PG8_SA(1, 1), a1 + hstep, voffA);
            PG8_WAIT_L(8); PG8_BAR; PG8_WAIT_L(0); PG8_MMA(0, 0, At, B0); PG8_BAR; PG8_SCHED;
            PG8_LDB(B1, 0, 1); PG8_STAGE(PG8_SB(0, 0), b2, voffB);
            PG8_BAR; PG8_WAIT_L(0); PG8_MMA(0, 1, At, B1); PG8_BAR;
            PG8_LDA(At, 0, 1); PG8_STAGE(PG8_SA(0, 0), a2, voffA);
            PG8_BAR; PG8_WAIT_L(0); PG8_MMA(1, 0, At, B0); PG8_BAR; PG8_SCHED;
            PG8_STAGE(PG8_SB(0, 1), b2 + hstep, voffB);
            PG8_WAIT_V(6); PG8_BAR; PG8_MMA(1, 1, At, B1); PG8_BAR;
            PG8_LDB(B0, 1, 0); PG8_SCHED; PG8_LDA(At, 1, 0); PG8_STAGE(PG8_SA(0, 1), a2 + hstep, voffA);
            PG8_WAIT_L(8); PG8_BAR; PG8_WAIT_L(0); PG8_MMA(0, 0, At, B0); PG8_BAR; PG8_SCHED;
            PG8_LDB(B1, 1, 1); PG8_STAGE(PG8_SB(1, 0), b3, voffB);
            PG8_BAR; PG8_WAIT_L(0); PG8_MMA(0, 1, At, B1); PG8_BAR;
            PG8_LDA(At, 1, 1); PG8_STAGE(PG8_SA(1, 0), a3, voffA);
            PG8_BAR; PG8_WAIT_L(0); PG8_MMA(1, 0, At, B0); PG8_BAR; PG8_SCHED;
            PG8_STAGE(PG8_SB(1, 1), b3 + hstep, voffB);
            PG8_WAIT_V(6); PG8_BAR; PG8_MMA(1, 1, At, B1); PG8_BAR;
            }
        }
        if constexpr (ALIGN_EPI) { if (wr == 0) PG8_BAR; }
        if constexpr (!Epi::AFTER_DRAIN) { E(acc, cur, wr, wc, fr, fq); S.done(cur); }
        if (!has_next) break;
#pragma unroll
        for (int a = 0; a < 2; ++a)
#pragma unroll
            for (int b = 0; b < 2; ++b)
#pragma unroll
                for (int m = 0; m < 4; ++m)
#pragma unroll
                    for (int n = 0; n < 2; ++n) acc[a][b][m][n] = (f32x4){0.f, 0.f, 0.f, 0.f};
        cur = nxt; cA = nA; cB = nB; ++ui;
        if constexpr (ALIGN_EPI) { if (wr == 1) PG8_BAR; }
    }
    PG8_WAIT_V(0);
    if constexpr (!ALIGN_EPI) { if (wr == 0) PG8_BAR; }
    PG8_BAR;
    if constexpr (Epi::AFTER_DRAIN) { E.fused(acc, cur, wr, wc, fr, fq, lds, wid, lane); S.done(cur); }
#undef PG8_SA
#undef PG8_SB
#undef PG8_STAGE
#undef PG8_LDA
#undef PG8_LDB
#undef PG8_MMA
#undef PG8_WAIT_V
#undef PG8_WAIT_L
#undef PG8_BAR
#undef PG8_SCHED
}
}

constexpr int NWAVES = 8;
constexpr int SEQ = 8192, DM = 2048, DFF = 8192, EVEN_IN = 3584, ODD_IN = 6144;
constexpr int OFF_K = 1024, OFF_V = 1280, OFF_X = 1536, OFF_G = 2560;
#ifndef MK_N_LAUNCHES
#define MK_N_LAUNCHES 1
#endif
constexpr int N_PHASES = 13;
constexpr size_t MiB = 1u << 20;
constexpr size_t WS_CTL = 0, CTL_ZERO_BYTES = 64 * 1024;
constexpr size_t WS_SS = 1 * MiB;
constexpr size_t WS_BT = 1 * MiB + 512 * 1024;
constexpr size_t WS_WIN0 = 2 * MiB, WS_WOUT0 = 16 * MiB, WS_WUP0 = 24 * MiB, WS_WDN0 = 56 * MiB, WS_WIN1 = 88 * MiB, WS_WOUT1 = 112 * MiB, WS_WUP1 = 120 * MiB, WS_WDN1 = 152 * MiB;
constexpr size_t WS_XN = 184 * MiB;
constexpr size_t WS_Y = 216 * MiB;
constexpr size_t WS_PROJ = 248 * MiB;
constexpr size_t WS_HL = 344 * MiB, WS_PA = 376 * MiB;
constexpr size_t WS_ACT = 248 * MiB;
constexpr size_t WS_END = 408 * MiB;
constexpr int CW_BAR = 1024;

constexpr int RING_OFF = 0, RING_BYTES = 131072;
constexpr int LDSCTL_OFF = RING_BYTES, MISC_OFF = LDSCTL_OFF + 320;
constexpr int LDS_BYTES = 147456;

#define GAS __attribute__((address_space(1)))
#define LAS __attribute__((address_space(3)))
typedef unsigned short bf16;
typedef unsigned v4u __attribute__((ext_vector_type(4)));
typedef unsigned v2u __attribute__((ext_vector_type(2)));
typedef float f32x4 __attribute__((ext_vector_type(4)));
#define LDS_WAIT() asm volatile("s_waitcnt lgkmcnt(0)" ::: "memory")
#define VM_WAIT() asm volatile("s_waitcnt vmcnt(0)" ::: "memory")
__device__ __forceinline__ unsigned f2bf(float f) { unsigned u = __builtin_bit_cast(unsigned, f); return (u + 0x7fffu + ((u >> 16) & 1u)) >> 16; }
__device__ __forceinline__ unsigned pk2(float lo, float hi) { return f2bf(lo) | (f2bf(hi) << 16); }
__device__ __forceinline__ float bflo(unsigned w) { return __builtin_bit_cast(float, w << 16); }
__device__ __forceinline__ float bfhi(unsigned w) { return __builtin_bit_cast(float, w & 0xffff0000u); }

#define XB_TMO      128
#define XB_XCNT(j)  (256  + 64 * (j))
#define XB_XSUB(j)  (1280 + 64 * (j))
#define XB_XGEN(j)  (2304 + 64 * (j))
#define XB_TOP      3328
#define XB_TOPGEN   3392
#define XCD_BAR_WORDS 3456
#define XB_SPIN_CAP (1u << 24)

__device__ __forceinline__ unsigned xb_ld(unsigned* p)              { return __hip_atomic_load(p, __ATOMIC_RELAXED, __HIP_MEMORY_SCOPE_AGENT); }
__device__ __forceinline__ unsigned xb_add(unsigned* p, unsigned v) { return __hip_atomic_fetch_add(p, v, __ATOMIC_RELAXED, __HIP_MEMORY_SCOPE_AGENT); }
__device__ __forceinline__ unsigned xb_xcc_id() { return (unsigned)__builtin_amdgcn_s_getreg((3 << 11) | 20) & 0xFu; }
#define XB_SPIN(cond, bar) do { unsigned _sp = 0; while (cond) { __builtin_amdgcn_s_sleep(1); \
    if ((++_sp & 255u) == 0u) { if (xb_ld(&(bar)[XB_TMO])) break; if (_sp > XB_SPIN_CAP) { atomicAdd(&(bar)[XB_TMO], 1u); break; } } } } while (0)

struct XcdBarrier {
    unsigned* bar; unsigned x;
    volatile LAS unsigned* st;
};

__device__ __forceinline__ XcdBarrier xcd_barrier_post(unsigned* bar, volatile LAS unsigned* st) {
    XcdBarrier b; b.bar = bar; b.x = xb_xcc_id(); b.st = st;
    if (threadIdx.x == 0) (void)xb_add(&bar[XB_XCNT(b.x)], 1u);
    return b;
}
__device__ __forceinline__ void xcd_barrier_complete(unsigned* bar, unsigned x, unsigned& nloc, unsigned& nx) {
    const unsigned G = gridDim.x * gridDim.y * gridDim.z;
    unsigned sum, cnt, mine, sp = 0u;
    for (;;) {
        sum = 0u; cnt = 0u; mine = 0u;
#pragma unroll
        for (unsigned j = 0; j < 16; ++j) { const unsigned c = xb_ld(&bar[XB_XCNT(j)]); sum += c; cnt += (c > 0u) ? 1u : 0u; mine = (j == x) ? c : mine; }
        if (sum == G) break;
        __builtin_amdgcn_s_sleep(1);
        if ((++sp & 255u) == 0u) { if (xb_ld(&bar[XB_TMO])) break; if (sp > XB_SPIN_CAP) { atomicAdd(&bar[XB_TMO], 1u); break; } }
    }
    nloc = mine > 0u ? mine : 1u; nx = cnt > 0u ? cnt : 1u;
}

__device__ __forceinline__ void xcd_barrier(const XcdBarrier& b) {
    asm volatile("s_waitcnt vmcnt(0)" ::: "memory");
    __syncthreads();
    if (threadIdx.x == 0) {
        unsigned* bar = b.bar;
        __builtin_amdgcn_s_waitcnt(0);
        unsigned nloc = b.st[0], nx = b.st[1];
        if (nloc == 0u) { xcd_barrier_complete(bar, b.x, nloc, nx); b.st[0] = nloc; b.st[1] = nx; }
        const unsigned old = xb_add(&bar[XB_XSUB(b.x)], 1u);
        const unsigned gen = old / nloc;
        if (old + 1u == (gen + 1u) * nloc) {
            __builtin_amdgcn_fence(__ATOMIC_RELEASE, "agent");
            asm volatile("s_waitcnt vmcnt(0)" ::: "memory");
            const unsigned og = xb_add(&bar[XB_TOP], 1u);
            const unsigned tg = og / nx;
            if (og + 1u == (tg + 1u) * nx) xb_add(&bar[XB_TOPGEN], 1u);
            else XB_SPIN(xb_ld(&bar[XB_TOPGEN]) == tg, bar);
            __builtin_amdgcn_fence(__ATOMIC_ACQUIRE, "agent");
            xb_add(&bar[XB_XGEN(b.x)], 1u);
            asm volatile("s_waitcnt vmcnt(0)" ::: "memory");
        } else {
            XB_SPIN(xb_ld(&bar[XB_XGEN(b.x)]) == gen, bar);
            __builtin_amdgcn_fence(__ATOMIC_ACQUIRE, "agent");
            asm volatile("s_waitcnt vmcnt(0)" ::: "memory");
        }
    }
    __syncthreads();
}
struct Frame {
    LAS unsigned char* lds;
    int tid, lane, wave, G;
    const float* in[19]; float* out; unsigned char* ws;
};
#define IN_X 0
#define IN_RELB 1
#define IN_NMIX 2
#define IN_EWIN 3
#define IN_CONVW 4
#define IN_CONVB 5
#define IN_GAW 6
#define IN_GAB 7
#define IN_GXW 8
#define IN_GXB 9
#define IN_LAMBDA 10
#define IN_SINKS 11
#define IN_EWOUT 12
#define IN_OWIN 13
#define IN_OWOUT 14
#define IN_NMLP 15
#define IN_WUP 16
#define IN_WDOWN 17
#define IN_FNORM 18

__device__ __forceinline__ float wave_sum(float v) {
#pragma unroll
    for (int o = 1; o < 64; o <<= 1) v += __shfl_xor(v, o);
    return v;
}
__device__ __forceinline__ void p0_transpose_item(const float* W, int K, int N, const float* gain, bf16* WT, LAS float* scr, int item, int lane) {
    const int nblk = N / 32, kb = item / nblk, nb = item % nblk, k0 = 64 * kb, n0 = 32 * nb;
#pragma unroll 8
    for (int i = 0; i < 32; ++i) { const int kk = 2 * i + (lane >> 5); const float g = gain ? gain[k0 + kk] : 1.0f; scr[kk * 33 + (lane & 31)] = W[(size_t)(k0 + kk) * N + n0 + (lane & 31)] * g; }
    LDS_WAIT(); asm volatile("" ::: "memory");
    const int c = lane & 7;
#pragma unroll
    for (int j = 0; j < 4; ++j) { const int n = (lane >> 3) + 8 * j; const LAS float* s = scr + (8 * c) * 33 + n;
        v4u o; o.x = pk2(s[0 * 33], s[1 * 33]); o.y = pk2(s[2 * 33], s[3 * 33]); o.z = pk2(s[4 * 33], s[5 * 33]); o.w = pk2(s[6 * 33], s[7 * 33]);
        *(GAS v4u*)(WT + (size_t)(n0 + n) * K + k0 + 8 * c) = o; }
    LDS_WAIT(); asm volatile("" ::: "memory");
}
__device__ __forceinline__ int t5_bucket(int rel) {
    const int ret = rel > 0 ? 16 : 0, n = rel < 0 ? -rel : rel;
    if (n < 8) return ret + n;
    int large = 8 + (31 - __builtin_clz((unsigned)(n * n))) - 6; if (large > 15) large = 15;
    return ret + large;
}
__device__ __forceinline__ void p0_prologue(Frame& F) {
    LAS float* scr = (LAS float*)(F.lds + RING_OFF + F.wave * 16384);
    const int gw = blockIdx.x * NWAVES + F.wave, NGW = F.G * NWAVES;
    constexpr int I_IN0 = (DM / 64) * (EVEN_IN / 32), I_OUT = (DM / 64) * (DM / 32), I_UP = (DM / 64) * (DFF / 32), I_DN = (DFF / 64) * (DM / 32), I_IN1 = (DM / 64) * (ODD_IN / 32);
    constexpr int NITEMS = I_IN0 + I_IN1 + 2 * I_OUT + 2 * I_UP + 2 * I_DN;
    unsigned char* ws = F.ws;
    for (int it = gw; it < NITEMS; it += NGW) {
        int r = it;
        if (r < I_IN0) { p0_transpose_item(F.in[IN_EWIN], DM, EVEN_IN, F.in[IN_NMIX], (bf16*)(ws + WS_WIN0), scr, r, F.lane); continue; } r -= I_IN0;
        if (r < I_OUT) { p0_transpose_item(F.in[IN_EWOUT], DM, DM, nullptr, (bf16*)(ws + WS_WOUT0), scr, r, F.lane); continue; } r -= I_OUT;
        if (r < I_UP) { p0_transpose_item(F.in[IN_WUP], DM, DFF, F.in[IN_NMLP], (bf16*)(ws + WS_WUP0), scr, r, F.lane); continue; } r -= I_UP;
        if (r < I_DN) { p0_transpose_item(F.in[IN_WDOWN], DFF, DM, nullptr, (bf16*)(ws + WS_WDN0), scr, r, F.lane); continue; } r -= I_DN;
        if (r < I_IN1) { p0_transpose_item(F.in[IN_OWIN], DM, ODD_IN, F.in[IN_NMIX] + DM, (bf16*)(ws + WS_WIN1), scr, r, F.lane); continue; } r -= I_IN1;
        if (r < I_OUT) { p0_transpose_item(F.in[IN_OWOUT], DM, DM, nullptr, (bf16*)(ws + WS_WOUT1), scr, r, F.lane); continue; } r -= I_OUT;
        if (r < I_UP) { p0_transpose_item(F.in[IN_WUP] + (size_t)DM * DFF, DM, DFF, F.in[IN_NMLP] + DM, (bf16*)(ws + WS_WUP1), scr, r, F.lane); continue; } r -= I_UP;
        p0_transpose_item(F.in[IN_WDOWN] + (size_t)DFF * DM, DFF, DM, nullptr, (bf16*)(ws + WS_WDN1), scr, r, F.lane);
    }
    bf16* XN = (bf16*)(ws + WS_XN); float* SS = (float*)(ws + WS_SS);
    for (int m = gw; m < SEQ; m += NGW) {
        const GAS f32x4* xr = (const GAS f32x4*)(F.in[IN_X] + (size_t)m * DM) + F.lane;
        f32x4 v[8]; float s = 0.f;
#pragma unroll
        for (int j = 0; j < 8; ++j) { v[j] = xr[64 * j]; s += (v[j].x * v[j].x + v[j].y * v[j].y) + (v[j].z * v[j].z + v[j].w * v[j].w); }
        s = wave_sum(s);
        GAS v2u* o8 = (GAS v2u*)(XN + (size_t)m * DM) + F.lane;
#pragma unroll
        for (int j = 0; j < 8; ++j) { v2u w; w.x = pk2(v[j].x, v[j].y); w.y = pk2(v[j].z, v[j].w); o8[64 * j] = w; }
        if (F.lane < 8) SS[(size_t)m * 8 + F.lane] = F.lane == 0 ? s : 0.f;
    }
    float* BT = (float*)(ws + WS_BT);
    for (int i = blockIdx.x * 512 + F.tid; i < 16 * 256; i += F.G * 512) { const int head = i >> 8, rel = (i & 255) - 191; BT[i] = F.in[IN_RELB][t5_bucket(rel) * 16 + head]; }
}

__device__ __forceinline__ void ld8(const bf16* p, float (&o)[8]) { const v4u w = *(const GAS v4u*)p; o[0] = bflo(w.x); o[1] = bfhi(w.x); o[2] = bflo(w.y); o[3] = bfhi(w.y); o[4] = bflo(w.z); o[5] = bfhi(w.z); o[6] = bflo(w.w); o[7] = bfhi(w.w); }
__device__ __forceinline__ void swa_naive(Frame& F) {
    const bf16* PROJ = (const bf16*)(F.ws + WS_PROJ); bf16* Y = (bf16*)(F.ws + WS_Y); const float* BT = (const float*)(F.ws + WS_BT);
    for (int idx = blockIdx.x * 512 + F.tid; idx < SEQ * 16; idx += F.G * 512) {
        const int head = idx >> 13, tok = idx & (SEQ - 1), kvh = head >> 2, c = tok >> 6;
        float q[64], acc[64];
#pragma unroll
        for (int i = 0; i < 8; ++i) { float t[8]; ld8(PROJ + (size_t)tok * EVEN_IN + head * 64 + 8 * i, t);
#pragma unroll
            for (int j = 0; j < 8; ++j) { q[8 * i + j] = t[j] * 0.125f; acc[8 * i + j] = 0.f; } }
        float m = F.in[IN_SINKS][head], l = 1.0f;
        const int k0 = c >= 2 ? (c - 2) * 64 : 0, k1 = (c + 1) * 64;
        const float* bt = BT + head * 256;
        for (int j = k0; j < k1; ++j) {
            const bf16* kp = PROJ + (size_t)j * EVEN_IN + OFF_K + kvh * 64; float s = 0.f;
#pragma unroll
            for (int i = 0; i < 8; ++i) { float t[8]; ld8(kp + 8 * i, t);
#pragma unroll
                for (int e = 0; e < 8; ++e) s += q[8 * i + e] * t[e]; }
            s += bt[j - tok + 191];
            const float mn = fmaxf(m, s), corr = expf(m - mn), p = expf(s - mn);
            l = l * corr + p; m = mn;
            const bf16* vp = PROJ + (size_t)j * EVEN_IN + OFF_V + kvh * 64;
#pragma unroll
            for (int i = 0; i < 8; ++i) { float t[8]; ld8(vp + 8 * i, t);
#pragma unroll
                for (int e = 0; e < 8; ++e) acc[8 * i + e] = acc[8 * i + e] * corr + p * t[e]; }
        }
        const float inv = 1.0f / l;
#pragma unroll
        for (int i = 0; i < 8; ++i) { v4u w; w.x = pk2(acc[8 * i] * inv, acc[8 * i + 1] * inv); w.y = pk2(acc[8 * i + 2] * inv, acc[8 * i + 3] * inv); w.z = pk2(acc[8 * i + 4] * inv, acc[8 * i + 5] * inv); w.w = pk2(acc[8 * i + 6] * inv, acc[8 * i + 7] * inv);
            *(GAS v4u*)(Y + (size_t)tok * DM + head * 64 + 8 * i) = w; }
    }
}
__device__ __forceinline__ float softplusf(float z) { return fmaxf(z, 0.f) + log1pf(expf(-fabsf(z))); }
__device__ __forceinline__ float sigmoidf_(float z) { return 1.0f / (1.0f + expf(-z)); }
__device__ __forceinline__ float gelu_tanh(float x) { const float u = 0.7978845608028654f * (x + 0.044715f * x * x * x); return 0.5f * x * (1.0f + tanhf(u)); }
__device__ __forceinline__ void lru_naive(Frame& F) {
    if (blockIdx.x >= 16 || F.wave != 0) return;
    const bf16* PROJ = (const bf16*)(F.ws + WS_PROJ); bf16* Y = (bf16*)(F.ws + WS_Y);
    const int hb = blockIdx.x, lane = F.lane, c = hb * 64 + lane;
    float Wa[64], Wx[64];
#pragma unroll
    for (int i = 0; i < 64; ++i) { Wa[i] = F.in[IN_GAW][(size_t)(hb * 64 + i) * 64 + lane]; Wx[i] = F.in[IN_GXW][(size_t)(hb * 64 + i) * 64 + lane]; }
    const float ba = F.in[IN_GAB][c], bx = F.in[IN_GXB][c], cb = F.in[IN_CONVB][c];
    const float cw0 = F.in[IN_CONVW][c], cw1 = F.in[IN_CONVW][1024 + c], cw2 = F.in[IN_CONVW][2048 + c], cw3 = F.in[IN_CONVW][3072 + c];
    const float sp8 = 8.0f * softplusf(-F.in[IN_LAMBDA][c]);
    float x1 = 0.f, x2 = 0.f, x3 = 0.f, h = 0.f;
    for (int t0 = 0; t0 < SEQ; t0 += 8) {
        float xb[8], g[8];
#pragma unroll
        for (int u = 0; u < 8; ++u) { xb[u] = bflo((unsigned)PROJ[(size_t)(t0 + u) * EVEN_IN + OFF_X + c]); g[u] = bflo((unsigned)PROJ[(size_t)(t0 + u) * EVEN_IN + OFF_G + c]); }
#pragma unroll
        for (int u = 0; u < 8; ++u) {
            const float xt = xb[u], xc = cb + cw0 * x3 + cw1 * x2 + cw2 * x1 + cw3 * xt; x3 = x2; x2 = x1; x1 = xt;
            float ra = ba, rx = bx; const int xci = __builtin_bit_cast(int, xc);
#pragma unroll
            for (int i = 0; i < 64; ++i) { const float xi = __builtin_bit_cast(float, __builtin_amdgcn_readlane(xci, i)); ra += xi * Wa[i]; rx += xi * Wx[i]; }
            const float r = sigmoidf_(ra), ig = sigmoidf_(rx), log_a = -r * sp8, a = expf(log_a), mult = sqrtf(-expm1f(2.0f * log_a));
            h = a * h + mult * (ig * xc);
            Y[(size_t)(t0 + u) * DM + 1024 + c] = (bf16)f2bf(gelu_tanh(g[u]) * h);
        }
    }
}
__device__ __forceinline__ void sb_naive(Frame& F) {
    const bf16* PROJ = (const bf16*)(F.ws + WS_PROJ); bf16* Y = (bf16*)(F.ws + WS_Y);
    const int gt = blockIdx.x * 512 + F.tid, half = gt & 1;
    for (int pidx = gt >> 1; pidx < SEQ * 16; pidx += (F.G * 512) >> 1) {
        const int head = pidx >> 13, tok = pidx & (SEQ - 1);
        float q[64], acc[64];
#pragma unroll
        for (int i = 0; i < 8; ++i) { float t[8]; ld8(PROJ + (size_t)tok * ODD_IN + head * 128 + half * 64 + 8 * i, t);
#pragma unroll
            for (int j = 0; j < 8; ++j) { q[8 * i + j] = t[j] * 0.08838834764831845f; acc[8 * i + j] = 0.f; } }
        float stick = 0.f;
        for (int j = tok - 1; j >= 0; --j) {
            const bf16* kp = PROJ + (size_t)j * ODD_IN + 2048 + head * 128 + half * 64; float s = 0.f;
#pragma unroll
            for (int i = 0; i < 8; ++i) { float t[8]; ld8(kp + 8 * i, t);
#pragma unroll
                for (int e = 0; e < 8; ++e) s += q[8 * i + e] * t[e]; }
            const float z = s + __shfl_xor(s, 1);
            const float lk = -softplusf(z), w = expf(z + lk + stick);
            const bf16* vp = PROJ + (size_t)j * ODD_IN + 4096 + head * 128 + half * 64;
#pragma unroll
            for (int i = 0; i < 8; ++i) { float t[8]; ld8(vp + 8 * i, t);
#pragma unroll
                for (int e = 0; e < 8; ++e) acc[8 * i + e] += w * t[e]; }
            stick += lk;
            if (stick < -104.0f) break;
        }
#pragma unroll
        for (int i = 0; i < 8; ++i) { v4u w; w.x = pk2(acc[8 * i], acc[8 * i + 1]); w.y = pk2(acc[8 * i + 2], acc[8 * i + 3]); w.z = pk2(acc[8 * i + 4], acc[8 * i + 5]); w.w = pk2(acc[8 * i + 6], acc[8 * i + 7]);
            *(GAS v4u*)(Y + (size_t)tok * DM + head * 128 + half * 64 + 8 * i) = w; }
    }
}
__device__ __forceinline__ void final_norm(Frame& F) {
    const int gw = blockIdx.x * NWAVES + F.wave, NGW = F.G * NWAVES;
    const GAS f32x4* gp = (const GAS f32x4*)F.in[IN_FNORM] + F.lane;
    for (int m = gw; m < SEQ; m += NGW) {
        GAS f32x4* xr = (GAS f32x4*)(F.out + (size_t)m * DM) + F.lane;
        f32x4 v[8]; float s = 0.f;
#pragma unroll
        for (int j = 0; j < 8; ++j) { v[j] = xr[64 * j]; s += (v[j].x * v[j].x + v[j].y * v[j].y) + (v[j].z * v[j].z + v[j].w * v[j].w); }
        const float rstd = 1.0f / sqrtf(wave_sum(s) * (1.0f / DM) + 1e-6f);
#pragma unroll
        for (int j = 0; j < 8; ++j) xr[64 * j] = v[j] * rstd * gp[64 * j];
    }
}

struct Args { const float* in[19]; float* out; unsigned char* ws; int ph_lo, ph_hi; };
__global__ void __launch_bounds__(NWAVES * 64, 2) hybrid_fwd(Args args) {
    extern __shared__ __attribute__((aligned(16))) unsigned char lds[];
    Frame F;
    F.lds = (LAS unsigned char*)lds;
    F.tid = threadIdx.x; F.lane = F.tid & 63; F.wave = __builtin_amdgcn_readfirstlane(F.tid >> 6);
    F.G = gridDim.x;
#pragma unroll
    for (int i = 0; i < 19; ++i) F.in[i] = args.in[i];
    F.out = args.out; F.ws = args.ws;
    unsigned char* ws = args.ws;
    for (int u = F.tid; u < (LDS_BYTES - LDSCTL_OFF) / 4; u += NWAVES * 64) ((LAS unsigned*)(F.lds + LDSCTL_OFF))[u] = 0u;
    __syncthreads();
    const int lo = args.ph_lo, hi = args.ph_hi;
    XcdBarrier bar; bar.bar = (unsigned*)(ws + WS_CTL) + CW_BAR; bar.x = 0; bar.st = nullptr;
    if (hi - lo > 1) bar = xcd_barrier_post((unsigned*)(ws + WS_CTL) + CW_BAR, (volatile LAS unsigned*)(F.lds + MISC_OFF) + 8);
#define IN(k) (lo <= (k) && (k) < hi)
#define SEAM(k) do { if (IN(k) && IN((k) + 1)) xcd_barrier(bar); } while (0)
    bf16* XN = (bf16*)(ws + WS_XN); bf16* Yb = (bf16*)(ws + WS_Y); bf16* PROJ = (bf16*)(ws + WS_PROJ); bf16* ACT = (bf16*)(ws + WS_ACT); float* SS = (float*)(ws + WS_SS);

    if (IN(0)) { p0_prologue(F); } SEAM(0);
    if (IN(1)) { pg8::Gemm g{XN, (const bf16*)(ws + WS_WIN0), SEQ, EVEN_IN, DM}; pg8::StaticOrder S; S.init(SEQ, EVEN_IN, F.G, (int)blockIdx.x);
        pg8::EpiBf16<0> E{PROJ, EVEN_IN, SS}; pg8::gemm_phase<pg8::EpiBf16<0>, pg8::StaticOrder, true, true>(F.lds + RING_OFF, g, S, E); } SEAM(1);
    if (IN(2)) { swa_naive(F); lru_naive(F); } SEAM(2);
    SEAM(3);
    if (IN(4)) { pg8::Gemm g{Yb, (const bf16*)(ws + WS_WOUT0), SEQ, DM, DM}; pg8::StaticOrder S; S.init(SEQ, DM, F.G, (int)blockIdx.x);
        pg8::EpiRes E{F.in[IN_X], F.out, XN, SS, DM}; pg8::gemm_phase<pg8::EpiRes, pg8::StaticOrder, false, true>(F.lds + RING_OFF, g, S, E); } SEAM(4);
    if (IN(5)) { pg8::Gemm g{XN, (const bf16*)(ws + WS_WUP0), SEQ, DFF, DM}; pg8::StaticOrder S; S.init(SEQ, DFF, F.G, (int)blockIdx.x);
        pg8::EpiBf16<1> E{ACT, DFF, SS}; pg8::gemm_phase<pg8::EpiBf16<1>, pg8::StaticOrder, true, true>(F.lds + RING_OFF, g, S, E); } SEAM(5);
    if (IN(6)) { pg8::Gemm g{ACT, (const bf16*)(ws + WS_WDN0), SEQ, DM, DFF}; pg8::StaticOrder S; S.init(SEQ, DM, F.G, (int)blockIdx.x);
        pg8::EpiRes E{F.out, F.out, XN, SS, DM}; pg8::gemm_phase<pg8::EpiRes, pg8::StaticOrder, false, true>(F.lds + RING_OFF, g, S, E); } SEAM(6);
    if (IN(7)) { pg8::Gemm g{XN, (const bf16*)(ws + WS_WIN1), SEQ, ODD_IN, DM}; pg8::StaticOrder S; S.init(SEQ, ODD_IN, F.G, (int)blockIdx.x);
        pg8::EpiBf16<0> E{PROJ, ODD_IN, SS}; pg8::gemm_phase<pg8::EpiBf16<0>, pg8::StaticOrder, true, true>(F.lds + RING_OFF, g, S, E); } SEAM(7);
    if (IN(8)) { sb_naive(F); } SEAM(8);
    if (IN(9)) { pg8::Gemm g{Yb, (const bf16*)(ws + WS_WOUT1), SEQ, DM, DM}; pg8::StaticOrder S; S.init(SEQ, DM, F.G, (int)blockIdx.x);
        pg8::EpiRes E{F.out, F.out, XN, SS, DM}; pg8::gemm_phase<pg8::EpiRes, pg8::StaticOrder, false, true>(F.lds + RING_OFF, g, S, E); } SEAM(9);
    if (IN(10)) { pg8::Gemm g{XN, (const bf16*)(ws + WS_WUP1), SEQ, DFF, DM}; pg8::StaticOrder S; S.init(SEQ, DFF, F.G, (int)blockIdx.x);
        pg8::EpiBf16<1> E{ACT, DFF, SS}; pg8::gemm_phase<pg8::EpiBf16<1>, pg8::StaticOrder, true, true>(F.lds + RING_OFF, g, S, E); } SEAM(10);
    if (IN(11)) { pg8::Gemm g{ACT, (const bf16*)(ws + WS_WDN1), SEQ, DM, DFF}; pg8::StaticOrder S; S.init(SEQ, DM, F.G, (int)blockIdx.x);
        pg8::EpiRes E{F.out, F.out, XN, SS, DM}; pg8::gemm_phase<pg8::EpiRes, pg8::StaticOrder, false, true>(F.lds + RING_OFF, g, S, E); } SEAM(11);
    if (IN(12)) { final_norm(F); }
#undef IN
#undef SEAM
}

extern "C" void kernel_launch(void* const* d_in, const int* in_sizes, int n_in, void* d_out, int out_size, void* d_ws, size_t ws_size, hipStream_t stream) {
    static int grid = 0;
    if (grid == 0) {
        if (n_in != 19 || in_sizes[0] != SEQ * DM || out_size != SEQ * DM || ws_size < WS_END) { fprintf(stderr, "kernel_launch: unexpected shapes (n_in %d, in0 %d, out %d, ws %zu); nothing launched\n", n_in, n_in > 0 ? in_sizes[0] : -1, out_size, ws_size); grid = -1; return; }
        int dev = 0, cus = 0, per_cu = 0;
        if (hipGetDevice(&dev) != hipSuccess || hipDeviceGetAttribute(&cus, hipDeviceAttributeMultiprocessorCount, dev) != hipSuccess) { fprintf(stderr, "kernel_launch: device query failed\n"); grid = -1; return; }
        if (hipFuncSetAttribute((const void*)hybrid_fwd, hipFuncAttributeMaxDynamicSharedMemorySize, LDS_BYTES) != hipSuccess) { fprintf(stderr, "kernel_launch: hipFuncSetAttribute failed\n"); grid = -1; return; }
        if (hipOccupancyMaxActiveBlocksPerMultiprocessor(&per_cu, (const void*)hybrid_fwd, NWAVES * 64, LDS_BYTES) != hipSuccess || per_cu < 1) { fprintf(stderr, "kernel_launch: occupancy query reports %d workgroups per CU\n", per_cu); per_cu = 1; }
        (void)hipGetLastError();
        grid = cus;
        if (grid != 256) fprintf(stderr, "kernel_launch: %d CUs; the residual GEMM phases need exactly 256 workgroups\n", grid);
    }
    if (grid < 0) return;
    (void)hipMemsetAsync((char*)d_ws + WS_CTL, 0, CTL_ZERO_BYTES, stream);
    Args a{};
    for (int i = 0; i < 19; ++i) a.in[i] = (const float*)d_in[i];
    a.out = (float*)d_out; a.ws = (unsigned char*)d_ws;
#if MK_N_LAUNCHES == 1
    a.ph_lo = 0; a.ph_hi = N_PHASES;
    hipLaunchKernelGGL(hybrid_fwd, dim3(grid), dim3(NWAVES * 64), LDS_BYTES, stream, a);
#else
    for (int p = 0; p < N_PHASES; ++p) { if (p == 3) continue; a.ph_lo = p; a.ph_hi = p + 1; hipLaunchKernelGGL(hybrid_fwd, dim3(grid), dim3(NWAVES * 64), LDS_BYTES, stream, a); }
#endif
}
```

```cpp
#include <hip/hip_runtime.h>
#include <cstdio>
#include <cstdint>
namespace pg8 {
#define PG8_LAS __attribute__((address_space(3)))
typedef unsigned short bf16_t;
typedef short bf16x8 __attribute__((ext_vector_type(8)));
typedef float f32x4 __attribute__((ext_vector_type(4)));
typedef unsigned u32x4 __attribute__((ext_vector_type(4)));
constexpr int BM = 256, BK = 64, HALF = 128, HTB = HALF * BK * 2  , STAGE_BYTES = 8 * HTB, NXCD = 8, WGM = 8;

__host__ __device__ __forceinline__ int lds_byte(int r, int c) { const int st = (r >> 4) * 2 + (c >> 5), rr = r & 15, cc = c & 31, ob = rr * 64 + cc * 2; return st * 1024 + (ob ^ (((ob >> 9) & 1) << 5)); }
__host__ __device__ __forceinline__ void stage_rc(int b, int& R, int& C) { const int st = b / 1024, sb = b % 1024, swz = sb ^ (((sb >> 9) & 1) << 5); R = (st >> 1) * 16 + swz / 64; C = (st & 1) * 32 + (swz % 64) / 2; }
__host__ __device__ __forceinline__ int perm32(int rho) { const int n = rho >> 4, i = rho & 15; return 8 * (i >> 2) + 4 * n + (i & 3); }

struct Unit { int pm, pn; };
struct Gemm { const bf16_t* A; const bf16_t* Bt; int M, N, K; };

struct StaticOrder {
    int nM, nN, nwg, G, c;
    __host__ __device__ void init(int M, int N, int G_, int c_) { nM = M / BM; nN = N / BM; nwg = nM * nN; G = G_; c = c_; }
    __host__ __device__ bool next(int i, Unit& u) const {
        const long L = (long)i * G + c; if (L >= nwg) return false;
        int wgid = (int)L; { const int q = nwg / NXCD, r = nwg % NXCD, xcd = wgid % NXCD, off = wgid / NXCD; wgid = (xcd < r ? xcd * (q + 1) : r * (q + 1) + (xcd - r) * q) + off; }
        const int nig = WGM * nN, gid = wgid / nig, fm = gid * WGM, gsz = (nM - fm) < WGM ? (nM - fm) : WGM;
        u.pm = fm + ((wgid % nig) % gsz); u.pn = (wgid % nig) / gsz; return true;
    }
    __device__ __forceinline__ void a_ready(const Unit&) const {}
    __device__ __forceinline__ void done(const Unit&) const {}
};

__device__ __forceinline__ unsigned cvt_pk_bf16(float lo, float hi) { unsigned r; asm volatile("v_cvt_pk_bf16_f32 %0, %1, %2" : "=v"(r) : "v"(lo), "v"(hi)); return r; }
constexpr float RMS_EPS = 1e-6f;
__device__ __forceinline__ float row_rstd(const float* ss, int r) {
    const f32x4 a = *(const f32x4*)(ss + (size_t)r * 8), b = *(const f32x4*)(ss + (size_t)r * 8 + 4);
    const float s = ((a[0] + a[1]) + (a[2] + a[3])) + ((b[0] + b[1]) + (b[2] + b[3]));
    return 1.0f / sqrtf(s * (1.0f / 2048.0f) + RMS_EPS);
}
template <int ACT> struct EpiBf16 {
    static constexpr bool PERM = true, AFTER_DRAIN = false;
    bf16_t* O; int ldc; const float* ss;
    __device__ __forceinline__ void operator()(const f32x4 (&acc)[2][2][4][2], const Unit& u, int wr, int wc, int fr, int fq) const {
        const int row0 = u.pm * BM + wr * 64 + fr, col0 = u.pn * BM + wc * 32 + 8 * fq;
#pragma unroll
        for (int ai = 0; ai < 2; ++ai)
#pragma unroll
            for (int m = 0; m < 4; ++m) { const int r = row0 + ai * HALF + m * 16; const float rs = ss ? row_rstd(ss, r) : 1.0f;
                bf16_t* rowp = O + (size_t)r * ldc + col0;
#pragma unroll
                for (int bj = 0; bj < 2; ++bj) { f32x4 v0 = acc[ai][bj][m][0] * rs, v1 = acc[ai][bj][m][1] * rs;
                    if (ACT == 1) {
#pragma unroll
                        for (int j = 0; j < 4; ++j) { const float a = fmaxf(v0[j], 0.f), b = fmaxf(v1[j], 0.f); v0[j] = a * a; v1[j] = b * b; } }
                    u32x4 w; w.x = cvt_pk_bf16(v0[0], v0[1]); w.y = cvt_pk_bf16(v0[2], v0[3]); w.z = cvt_pk_bf16(v1[0], v1[1]); w.w = cvt_pk_bf16(v1[2], v1[3]);
                    *(u32x4*)(rowp + bj * HALF) = w; } }
    }
};
struct EpiRes {
    static constexpr bool PERM = true, AFTER_DRAIN = true;
    const float* base; float* out; bf16_t* xn; float* ss; int ldc;
    __device__ __forceinline__ void operator()(const f32x4 (&)[2][2][4][2], const Unit&, int, int, int, int) const {}
    __device__ __forceinline__ void fused(f32x4 (&acc)[2][2][4][2], const Unit& u, int wr, int wc, int fr, int fq, PG8_LAS unsigned char* lds, int wid, int lane) const {
        PG8_LAS float* P = (PG8_LAS float*)lds;
#pragma unroll
        for (int ai = 0; ai < 2; ++ai)
#pragma unroll
            for (int m = 0; m < 4; ++m) { const int rl = ai * HALF + wr * 64 + m * 16 + fr; const size_t off = (size_t)(u.pm * BM + rl) * ldc + u.pn * BM + wc * 32 + 8 * fq; float s = 0.f;
#pragma unroll
                for (int bj = 0; bj < 2; ++bj) { const f32x4 b0 = *(const f32x4*)(base + off + bj * HALF), b1 = *(const f32x4*)(base + off + bj * HALF + 4);
                    const f32x4 v0 = acc[ai][bj][m][0] + b0, v1 = acc[ai][bj][m][1] + b1;
                    *(f32x4*)(out + off + bj * HALF) = v0; *(f32x4*)(out + off + bj * HALF + 4) = v1;
                    u32x4 w; w.x = cvt_pk_bf16(v0[0], v0[1]); w.y = cvt_pk_bf16(v0[2], v0[3]); w.z = cvt_pk_bf16(v1[0], v1[1]); w.w = cvt_pk_bf16(v1[2], v1[3]);
                    *(u32x4*)(xn + off + bj * HALF) = w;
                    s += ((v0[0] * v0[0] + v0[1] * v0[1]) + (v0[2] * v0[2] + v0[3] * v0[3])) + ((v1[0] * v1[0] + v1[1] * v1[1]) + (v1[2] * v1[2] + v1[3] * v1[3])); }
                s += __shfl_xor(s, 16); s += __shfl_xor(s, 32);
                if (fq == 0) P[rl * 4 + wc] = s;
                asm volatile("" ::: "memory"); }
        asm volatile("s_waitcnt lgkmcnt(0)" ::: "memory"); __builtin_amdgcn_s_barrier(); asm volatile("" ::: "memory");
        const int t = wid * 64 + lane;
        if (t < 256) { const f32x4 p = *(const PG8_LAS f32x4*)(P + t * 4); ss[(size_t)(u.pm * BM + t) * 8 + u.pn] = (p[0] + p[1]) + (p[2] + p[3]); }
        asm volatile("s_waitcnt lgkmcnt(0)" ::: "memory"); __builtin_amdgcn_s_barrier(); asm volatile("" ::: "memory");
    }
};

template <class Epi, class Sched, bool ALIGN_EPI = false, bool SP2 = false>
__device__ __forceinline__ void gemm_phase(PG8_LAS unsigned char* lds, const Gemm g, const Sched& S, const Epi& E) {
    const int tid = threadIdx.x, wid = __builtin_amdgcn_readfirstlane(tid >> 6), lane = tid & 63, wr = wid >> 2, wc = wid & 3, fr = lane & 15, fq = lane >> 4;
    const int K = g.K, nt = K / BK;
    unsigned voffA[2], voffB[2];
#pragma unroll
    for (int i = 0; i < 2; ++i) { int R, C; stage_rc(tid * 16 + i * 8192, R, C); const int Rb = Epi::PERM ? ((R & ~31) + perm32(R & 31)) : R;
        voffA[i] = (unsigned)(R * K + C) * 2u; voffB[i] = (unsigned)(Rb * K + C) * 2u; }
    const size_t kstep = (size_t)(BK * 2);
    const size_t hstep = (size_t)HALF * K * 2;
    const size_t tstep = 2 * hstep;
    const unsigned ldsw = (unsigned)wid * 1024u;
    const int aoff = lds_byte(wr * 64 + fr, fq * 8), boff = lds_byte(wc * 32 + fr, fq * 8);
#define PG8_SA(b, h) (((b) * 2 + (h)) * HTB)
#define PG8_SB(b, h) ((4 + (b) * 2 + (h)) * HTB)
#define PG8_STAGE(bufoff, gbase, voff) do { _Pragma("unroll") for (int _i = 0; _i < 2; ++_i) \
        __builtin_amdgcn_global_load_lds((const unsigned*)((const char*)(gbase) + (voff)[_i]), (PG8_LAS unsigned*)(lds + (bufoff) + ldsw + _i * 8192), 16, 0, 0); } while (0)
#define PG8_LDA(dst, b, h) do { _Pragma("unroll") for (int m = 0; m < 4; ++m) _Pragma("unroll") for (int k = 0; k < 2; ++k) dst[m][k] = *(const PG8_LAS bf16x8*)(lds + PG8_SA(b, h) + aoff + m * 2048 + k * 1024); } while (0)
#define PG8_LDB(dst, b, h) do { _Pragma("unroll") for (int n = 0; n < 2; ++n) _Pragma("unroll") for (int k = 0; k < 2; ++k) dst[n][k] = *(const PG8_LAS bf16x8*)(lds + PG8_SB(b, h) + boff + n * 2048 + k * 1024); } while (0)
#define PG8_MMA(ai, bj, At, Bt) do { __builtin_amdgcn_s_setprio(1); _Pragma("unroll") for (int m = 0; m < 4; ++m) _Pragma("unroll") for (int n = 0; n < 2; ++n) _Pragma("unroll") for (int k = 0; k < 2; ++k) \
        acc[ai][bj][m][n] = __builtin_amdgcn_mfma_f32_16x16x32_bf16(Bt[n][k], At[m][k], acc[ai][bj][m][n], 0, 0, 0); __builtin_amdgcn_s_setprio(0); } while (0)
#define PG8_WAIT_V(n) asm volatile("s_waitcnt vmcnt(" #n ")" ::: "memory")
#define PG8_WAIT_L(n) asm volatile("s_waitcnt lgkmcnt(" #n ")" ::: "memory")
#define PG8_BAR __builtin_amdgcn_s_barrier()
#define PG8_SCHED __builtin_amdgcn_sched_barrier(0)
    Unit cur, nxt; int ui = 0;
    if (!S.next(0, cur)) return;
    f32x4 acc[2][2][4][2];
#pragma unroll
    for (int a = 0; a < 2; ++a)
#pragma unroll
        for (int b = 0; b < 2; ++b)
#pragma unroll
            for (int m = 0; m < 4; ++m)
#pragma unroll
                for (int n = 0; n < 2; ++n) acc[a][b][m][n] = (f32x4){0.f, 0.f, 0.f, 0.f};
    bf16x8 At[4][2], B0[2][2], B1[2][2];
    const char* cA = (const char*)g.A + (size_t)cur.pm * tstep; const char* cB = (const char*)g.Bt + (size_t)cur.pn * tstep;
    S.a_ready(cur);
    if constexpr (SP2) {
        PG8_STAGE(PG8_SB(0, 0), cB, voffB); PG8_STAGE(PG8_SB(0, 1), cB + hstep, voffB); PG8_STAGE(PG8_SA(0, 0), cA, voffA); PG8_STAGE(PG8_SA(0, 1), cA + hstep, voffA);
        if (wr == 1) PG8_BAR;
        PG8_WAIT_V(2); PG8_BAR;
        PG8_STAGE(PG8_SB(1, 0), cB + kstep, voffB); PG8_STAGE(PG8_SA(1, 0), cA + kstep, voffA); PG8_STAGE(PG8_SB(1, 1), cB + hstep + kstep, voffB);
        PG8_WAIT_V(6); PG8_BAR;
    } else {
        PG8_STAGE(PG8_SB(0, 0), cB, voffB); PG8_STAGE(PG8_SA(0, 0), cA, voffA); PG8_STAGE(PG8_SB(0, 1), cB + hstep, voffB); PG8_STAGE(PG8_SA(0, 1), cA + hstep, voffA);
        if (wr == 1) PG8_BAR;
        PG8_WAIT_V(4); PG8_BAR;
        PG8_STAGE(PG8_SB(1, 0), cB + kstep, voffB); PG8_STAGE(PG8_SA(1, 0), cA + kstep, voffA); PG8_STAGE(PG8_SB(1, 1), cB + hstep + kstep, voffB);
        PG8_WAIT_V(6); PG8_BAR;
    }
    for (;;) {
        const bool has_next = S.next(ui + 1, nxt);
        const char* nA = has_next ? (const char*)g.A + (size_t)nxt.pm * tstep : cA; const char* nB = has_next ? (const char*)g.Bt + (size_t)nxt.pn * tstep : cB;
        for (int t = 0; t < nt; t += 2) {
            const bool last = (t == nt - 2);
            const char* a1 = cA + (size_t)(t + 1) * kstep;
            const char* a2 = last ? nA : cA + (size_t)(t + 2) * kstep; const char* b2 = last ? nB : cB + (size_t)(t + 2) * kstep;
            const char* a3 = a2 + kstep; const char* b3 = b2 + kstep;
            if (last && has_next) S.a_ready(nxt);
            if constexpr (SP2) {
            PG8_LDB(B0, 0, 0); PG8_LDB(B1, 0, 1); PG8_SCHED; PG8_LDA(At, 0, 0); PG8_STAGE(PG8_SA(1, 1), a1 + hstep, voffA);
            PG8_WAIT_V(8); PG8_WAIT_L(0); PG8_BAR; PG8_MMA(0, 0, At, B0); PG8_MMA(0, 1, At, B1); PG8_BAR; PG8_SCHED;
            PG8_LDA(At, 0, 1); PG8_STAGE(PG8_SB(0, 0), b2, voffB); PG8_STAGE(PG8_SB(0, 1), b2 + hstep, voffB); PG8_STAGE(PG8_SA(0, 0), a2, voffA);
            PG8_WAIT_V(8); PG8_WAIT_L(0); PG8_BAR; PG8_MMA(1, 0, At, B0); PG8_MMA(1, 1, At, B1); PG8_BAR; PG8_SCHED;
            PG8_LDB(B0, 1, 0); PG8_LDB(B1, 1, 1); PG8_SCHED; PG8_LDA(At, 1, 0); PG8_STAGE(PG8_SA(0, 1), a2 + hstep, voffA);
            PG8_WAIT_V(8); PG8_WAIT_L(0); PG8_BAR; PG8_MMA(0, 0, At, B0); PG8_MMA(0, 1, At, B1); PG8_BAR; PG8_SCHED;
            PG8_LDA(At, 1, 1); PG8_STAGE(PG8_SB(1, 0), b3, voffB); PG8_STAGE(PG8_SB(1, 1), b3 + hstep, voffB); PG8_STAGE(PG8_SA(1, 0), a3, voffA);
            PG8_WAIT_V(8); PG8_WAIT_L(0); PG8_BAR; PG8_MMA(1, 0, At, B0); PG8_MMA(1, 1, At, B1); PG8_BAR; PG8_SCHED;
            } else {
            PG8_LDB(B0, 0, 0); PG8_SCHED; PG8_LDA(At, 0, 0); PG8_STAGE(PG8_SA(1, 1), a1 + hstep, voffA);
            PG8_WAIT_L(8); PG8_BAR; PG8_WAIT_L(0); PG8_MMA(0, 0, At, B0); PG8_BAR; PG8_SCHED;
            PG8_LDB(B1, 0, 1); PG8_STAGE(PG8_SB(0, 0), b2, voffB);
            PG8_BAR; PG8_WAIT_L(0); PG8_MMA(0, 1, At, B1); PG8_BAR;
            PG8_LDA(At, 0, 1); PG8_STAGE(PG8_SA(0, 0), a2, voffA);
            PG8_BAR; PG8_WAIT_L(0); PG8_MMA(1, 0, At, B0); PG8_BAR; PG8_SCHED;
            PG8_STAGE(PG8_SB(0, 1), b2 + hstep, voffB);
            PG8_WAIT_V(6); PG8_BAR; PG8_MMA(1, 1, At, B1); PG8_BAR;
            PG8_LDB(B0, 1, 0); PG8_SCHED; PG8_LDA(At, 1, 0); PG8_STAGE(PG8_SA(0, 1), a2 + hstep, voffA);
            PG8_WAIT_L(8); PG8_BAR; PG8_WAIT_L(0); PG8_MMA(0, 0, At, B0); PG8_BAR; PG8_SCHED;
            PG8_LDB(B1, 1, 1); PG8_STAGE(PG8_SB(1, 0), b3, voffB);
            PG8_BAR; PG8_WAIT_L(0); PG8_MMA(0, 1, At, B1); PG8_BAR;
            PG8_LDA(At, 1, 1); PG8_STAGE(PG8_SA(1, 0), a3, voffA);
            PG8_BAR; PG8_WAIT_L(0); PG8_MMA(1, 0, At, B0); PG8_BAR; PG8_SCHED;
            PG8_STAGE(PG8_SB(1, 1), b3 + hstep, voffB);
            PG8_WAIT_V(6); PG8_BAR; PG8_MMA(1, 1, At, B1); PG8_BAR;
            }
        }
        if constexpr (ALIGN_EPI) { if (wr == 0) PG8_BAR; }
        if constexpr (!Epi::AFTER_DRAIN) { E(acc, cur, wr, wc, fr, fq); S.done(cur); }
        if (!has_next) break;
#pragma unroll
        for (int a = 0; a < 2; ++a)
#pragma unroll
            for (int b = 0; b < 2; ++b)
#pragma unroll
                for (int m = 0; m < 4; ++m)
#pragma unroll
                    for (int n = 0; n < 2; ++n) acc[a][b][m][n] = (f32x4){0.f, 0.f, 0.f, 0.f};
        cur = nxt; cA = nA; cB = nB; ++ui;
        if constexpr (ALIGN_EPI) { if (wr == 1) PG8_BAR; }
    }
    PG8_WAIT_V(0);
    if constexpr (!ALIGN_EPI) { if (wr == 0) PG8_BAR; }
    PG8_BAR;
    if constexpr (Epi::AFTER_DRAIN) { E.fused(acc, cur, wr, wc, fr, fq, lds, wid, lane); S.done(cur); }
#undef PG8_SA
#undef PG8_SB
#undef PG8_STAGE
#undef PG8_LDA
#undef PG8_LDB
#undef PG8_MMA
#undef PG8_WAIT_V
#undef PG8_WAIT_L
#undef PG8_BAR
#undef PG8_SCHED
}
}

constexpr int NWAVES = 8;
constexpr int SEQ = 8192, DM = 2048, DFF = 8192, EVEN_IN = 3584, ODD_IN = 6144;
constexpr int OFF_K = 1024, OFF_V = 1280, OFF_X = 1536, OFF_G = 2560;
#ifndef MK_N_LAUNCHES
#define MK_N_LAUNCHES 1
#endif
constexpr int N_PHASES = 13;
constexpr size_t MiB = 1u << 20;
constexpr size_t WS_CTL = 0, CTL_ZERO_BYTES = 64 * 1024;
constexpr size_t WS_SS = 1 * MiB;
constexpr size_t WS_BT = 1 * MiB + 512 * 1024;
constexpr size_t WS_GWT = 1 * MiB + 768 * 1024;
constexpr size_t WS_WIN0 = 2 * MiB, WS_WOUT0 = 16 * MiB, WS_WUP0 = 24 * MiB, WS_WDN0 = 56 * MiB, WS_WIN1 = 88 * MiB, WS_WOUT1 = 112 * MiB, WS_WUP1 = 120 * MiB, WS_WDN1 = 152 * MiB;
constexpr size_t WS_XN = 184 * MiB;
constexpr size_t WS_Y = 216 * MiB;
constexpr size_t WS_PROJ = 248 * MiB;
constexpr size_t WS_HL = 344 * MiB, WS_PA = 376 * MiB;
constexpr size_t WS_ACT = 248 * MiB;
constexpr size_t WS_END = 408 * MiB;
constexpr int CW_BAR = 1024;

constexpr int RING_OFF = 0, RING_BYTES = 131072;
constexpr int LDSCTL_OFF = RING_BYTES, MISC_OFF = LDSCTL_OFF + 320;
constexpr int LDS_BYTES = 147456;

#define GAS __attribute__((address_space(1)))
#define LAS __attribute__((address_space(3)))
typedef unsigned short bf16;
typedef unsigned v4u __attribute__((ext_vector_type(4)));
typedef unsigned v2u __attribute__((ext_vector_type(2)));
typedef float f32x4 __attribute__((ext_vector_type(4)));
#define LDS_WAIT() asm volatile("s_waitcnt lgkmcnt(0)" ::: "memory")
#define VM_WAIT() asm volatile("s_waitcnt vmcnt(0)" ::: "memory")
__device__ __forceinline__ unsigned f2bf(float f) { unsigned u = __builtin_bit_cast(unsigned, f); return (u + 0x7fffu + ((u >> 16) & 1u)) >> 16; }
__device__ __forceinline__ unsigned pk2(float lo, float hi) { return f2bf(lo) | (f2bf(hi) << 16); }
__device__ __forceinline__ float bflo(unsigned w) { return __builtin_bit_cast(float, w << 16); }
__device__ __forceinline__ float bfhi(unsigned w) { return __builtin_bit_cast(float, w & 0xffff0000u); }

#define XB_TMO      128
#define XB_XCNT(j)  (256  + 64 * (j))
#define XB_XSUB(j)  (1280 + 64 * (j))
#define XB_XGEN(j)  (2304 + 64 * (j))
#define XB_TOP      3328
#define XB_TOPGEN   3392
#define XCD_BAR_WORDS 3456
#define XB_SPIN_CAP (1u << 24)

__device__ __forceinline__ unsigned xb_ld(unsigned* p)              { return __hip_atomic_load(p, __ATOMIC_RELAXED, __HIP_MEMORY_SCOPE_AGENT); }
__device__ __forceinline__ unsigned xb_add(unsigned* p, unsigned v) { return __hip_atomic_fetch_add(p, v, __ATOMIC_RELAXED, __HIP_MEMORY_SCOPE_AGENT); }
__device__ __forceinline__ unsigned xb_xcc_id() { return (unsigned)__builtin_amdgcn_s_getreg((3 << 11) | 20) & 0xFu; }
#define XB_SPIN(cond, bar) do { unsigned _sp = 0; while (cond) { __builtin_amdgcn_s_sleep(1); \
    if ((++_sp & 255u) == 0u) { if (xb_ld(&(bar)[XB_TMO])) break; if (_sp > XB_SPIN_CAP) { atomicAdd(&(bar)[XB_TMO], 1u); break; } } } } while (0)

struct XcdBarrier {
    unsigned* bar; unsigned x;
    volatile LAS unsigned* st;
};

__device__ __forceinline__ XcdBarrier xcd_barrier_post(unsigned* bar, volatile LAS unsigned* st) {
    XcdBarrier b; b.bar = bar; b.x = xb_xcc_id(); b.st = st;
    if (threadIdx.x == 0) (void)xb_add(&bar[XB_XCNT(b.x)], 1u);
    return b;
}
__device__ __forceinline__ void xcd_barrier_complete(unsigned* bar, unsigned x, unsigned& nloc, unsigned& nx) {
    const unsigned G = gridDim.x * gridDim.y * gridDim.z;
    unsigned sum, cnt, mine, sp = 0u;
    for (;;) {
        sum = 0u; cnt = 0u; mine = 0u;
#pragma unroll
        for (unsigned j = 0; j < 16; ++j) { const unsigned c = xb_ld(&bar[XB_XCNT(j)]); sum += c; cnt += (c > 0u) ? 1u : 0u; mine = (j == x) ? c : mine; }
        if (sum == G) break;
        __builtin_amdgcn_s_sleep(1);
        if ((++sp & 255u) == 0u) { if (xb_ld(&bar[XB_TMO])) break; if (sp > XB_SPIN_CAP) { atomicAdd(&bar[XB_TMO], 1u); break; } }
    }
    nloc = mine > 0u ? mine : 1u; nx = cnt > 0u ? cnt : 1u;
}

__device__ __forceinline__ void xcd_barrier(const XcdBarrier& b) {
    asm volatile("s_waitcnt vmcnt(0)" ::: "memory");
    __syncthreads();
    if (threadIdx.x == 0) {
        unsigned* bar = b.bar;
        __builtin_amdgcn_s_waitcnt(0);
        unsigned nloc = b.st[0], nx = b.st[1];
        if (nloc == 0u) { xcd_barrier_complete(bar, b.x, nloc, nx); b.st[0] = nloc; b.st[1] = nx; }
        const unsigned old = xb_add(&bar[XB_XSUB(b.x)], 1u);
        const unsigned gen = old / nloc;
        if (old + 1u == (gen + 1u) * nloc) {
            __builtin_amdgcn_fence(__ATOMIC_RELEASE, "agent");
            asm volatile("s_waitcnt vmcnt(0)" ::: "memory");
            const unsigned og = xb_add(&bar[XB_TOP], 1u);
            const unsigned tg = og / nx;
            if (og + 1u == (tg + 1u) * nx) xb_add(&bar[XB_TOPGEN], 1u);
            else XB_SPIN(xb_ld(&bar[XB_TOPGEN]) == tg, bar);
            __builtin_amdgcn_fence(__ATOMIC_ACQUIRE, "agent");
            xb_add(&bar[XB_XGEN(b.x)], 1u);
            asm volatile("s_waitcnt vmcnt(0)" ::: "memory");
        } else {
            XB_SPIN(xb_ld(&bar[XB_XGEN(b.x)]) == gen, bar);
            __builtin_amdgcn_fence(__ATOMIC_ACQUIRE, "agent");
            asm volatile("s_waitcnt vmcnt(0)" ::: "memory");
        }
    }
    __syncthreads();
}
struct Frame {
    LAS unsigned char* lds;
    int tid, lane, wave, G;
    const float* in[19]; float* out; unsigned char* ws;
};
#define IN_X 0
#define IN_RELB 1
#define IN_NMIX 2
#define IN_EWIN 3
#define IN_CONVW 4
#define IN_CONVB 5
#define IN_GAW 6
#define IN_GAB 7
#define IN_GXW 8
#define IN_GXB 9
#define IN_LAMBDA 10
#define IN_SINKS 11
#define IN_EWOUT 12
#define IN_OWIN 13
#define IN_OWOUT 14
#define IN_NMLP 15
#define IN_WUP 16
#define IN_WDOWN 17
#define IN_FNORM 18

__device__ __forceinline__ float wave_sum(float v) {
#pragma unroll
    for (int o = 1; o < 64; o <<= 1) v += __shfl_xor(v, o);
    return v;
}
__device__ __forceinline__ void p0_transpose_item(const float* W, int K, int N, const float* gain, bf16* WT, LAS float* scr, int item, int lane) {
    const int nblk = N / 32, kb = item / nblk, nb = item % nblk, k0 = 64 * kb, n0 = 32 * nb;
#pragma unroll 8
    for (int i = 0; i < 32; ++i) { const int kk = 2 * i + (lane >> 5); const float g = gain ? gain[k0 + kk] : 1.0f; scr[kk * 33 + (lane & 31)] = W[(size_t)(k0 + kk) * N + n0 + (lane & 31)] * g; }
    LDS_WAIT(); asm volatile("" ::: "memory");
    const int c = lane & 7;
#pragma unroll
    for (int j = 0; j < 4; ++j) { const int n = (lane >> 3) + 8 * j; const LAS float* s = scr + (8 * c) * 33 + n;
        v4u o; o.x = pk2(s[0 * 33], s[1 * 33]); o.y = pk2(s[2 * 33], s[3 * 33]); o.z = pk2(s[4 * 33], s[5 * 33]); o.w = pk2(s[6 * 33], s[7 * 33]);
        *(GAS v4u*)(WT + (size_t)(n0 + n) * K + k0 + 8 * c) = o; }
    LDS_WAIT(); asm volatile("" ::: "memory");
}
__device__ __forceinline__ int t5_bucket(int rel) {
    const int ret = rel > 0 ? 16 : 0, n = rel < 0 ? -rel : rel;
    if (n < 8) return ret + n;
    int large = 8 + (31 - __builtin_clz((unsigned)(n * n))) - 6; if (large > 15) large = 15;
    return ret + large;
}
__device__ __forceinline__ void p0_prologue(Frame& F) {
    LAS float* scr = (LAS float*)(F.lds + RING_OFF + F.wave * 16384);
    const int gw = blockIdx.x * NWAVES + F.wave, NGW = F.G * NWAVES;
    constexpr int I_IN0 = (DM / 64) * (EVEN_IN / 32), I_OUT = (DM / 64) * (DM / 32), I_UP = (DM / 64) * (DFF / 32), I_DN = (DFF / 64) * (DM / 32), I_IN1 = (DM / 64) * (ODD_IN / 32);
    constexpr int NITEMS = I_IN0 + I_IN1 + 2 * I_OUT + 2 * I_UP + 2 * I_DN;
    unsigned char* ws = F.ws;
    for (int it = gw; it < NITEMS; it += NGW) {
        int r = it;
        if (r < I_IN0) { p0_transpose_item(F.in[IN_EWIN], DM, EVEN_IN, F.in[IN_NMIX], (bf16*)(ws + WS_WIN0), scr, r, F.lane); continue; } r -= I_IN0;
        if (r < I_OUT) { p0_transpose_item(F.in[IN_EWOUT], DM, DM, nullptr, (bf16*)(ws + WS_WOUT0), scr, r, F.lane); continue; } r -= I_OUT;
        if (r < I_UP) { p0_transpose_item(F.in[IN_WUP], DM, DFF, F.in[IN_NMLP], (bf16*)(ws + WS_WUP0), scr, r, F.lane); continue; } r -= I_UP;
        if (r < I_DN) { p0_transpose_item(F.in[IN_WDOWN], DFF, DM, nullptr, (bf16*)(ws + WS_WDN0), scr, r, F.lane); continue; } r -= I_DN;
        if (r < I_IN1) { p0_transpose_item(F.in[IN_OWIN], DM, ODD_IN, F.in[IN_NMIX] + DM, (bf16*)(ws + WS_WIN1), scr, r, F.lane); continue; } r -= I_IN1;
        if (r < I_OUT) { p0_transpose_item(F.in[IN_OWOUT], DM, DM, nullptr, (bf16*)(ws + WS_WOUT1), scr, r, F.lane); continue; } r -= I_OUT;
        if (r < I_UP) { p0_transpose_item(F.in[IN_WUP] + (size_t)DM * DFF, DM, DFF, F.in[IN_NMLP] + DM, (bf16*)(ws + WS_WUP1), scr, r, F.lane); continue; } r -= I_UP;
        p0_transpose_item(F.in[IN_WDOWN] + (size_t)DFF * DM, DFF, DM, nullptr, (bf16*)(ws + WS_WDN1), scr, r, F.lane);
    }
    bf16* XN = (bf16*)(ws + WS_XN); float* SS = (float*)(ws + WS_SS);
    for (int m = gw; m < SEQ; m += NGW) {
        const GAS f32x4* xr = (const GAS f32x4*)(F.in[IN_X] + (size_t)m * DM) + F.lane;
        f32x4 v[8]; float s = 0.f;
#pragma unroll
        for (int j = 0; j < 8; ++j) { v[j] = xr[64 * j]; s += (v[j].x * v[j].x + v[j].y * v[j].y) + (v[j].z * v[j].z + v[j].w * v[j].w); }
        s = wave_sum(s);
        GAS v2u* o8 = (GAS v2u*)(XN + (size_t)m * DM) + F.lane;
#pragma unroll
        for (int j = 0; j < 8; ++j) { v2u w; w.x = pk2(v[j].x, v[j].y); w.y = pk2(v[j].z, v[j].w); o8[64 * j] = w; }
        if (F.lane < 8) SS[(size_t)m * 8 + F.lane] = F.lane == 0 ? s : 0.f;
    }
    float* BT = (float*)(ws + WS_BT);
    for (int i = blockIdx.x * 512 + F.tid; i < 16 * 256; i += F.G * 512) { const int head = i >> 8, rel = (i & 255) - 191; BT[i] = F.in[IN_RELB][t5_bucket(rel) * 16 + head]; }
    bf16* GWT = (bf16*)(ws + WS_GWT);
    for (int i = blockIdx.x * 512 + F.tid; i < 2 * 16 * 64 * 64; i += F.G * 512) { const int gate = i >> 16, hb = (i >> 12) & 15, jo = (i >> 6) & 63, ii = i & 63;
        GWT[i] = (bf16)f2bf(F.in[gate ? IN_GXW : IN_GAW][(size_t)(hb * 64 + ii) * 64 + jo]); }
}

__device__ __forceinline__ void ld8(const bf16* p, float (&o)[8]) { const v4u w = *(const GAS v4u*)p; o[0] = bflo(w.x); o[1] = bfhi(w.x); o[2] = bflo(w.y); o[3] = bfhi(w.y); o[4] = bflo(w.z); o[5] = bfhi(w.z); o[6] = bflo(w.w); o[7] = bfhi(w.w); }
__device__ __forceinline__ void swa_naive(Frame& F) {
    const bf16* PROJ = (const bf16*)(F.ws + WS_PROJ); bf16* Y = (bf16*)(F.ws + WS_Y); const float* BT = (const float*)(F.ws + WS_BT);
    for (int idx = blockIdx.x * 512 + F.tid; idx < SEQ * 16; idx += F.G * 512) {
        const int head = idx >> 13, tok = idx & (SEQ - 1), kvh = head >> 2, c = tok >> 6;
        float q[64], acc[64];
#pragma unroll
        for (int i = 0; i < 8; ++i) { float t[8]; ld8(PROJ + (size_t)tok * EVEN_IN + head * 64 + 8 * i, t);
#pragma unroll
            for (int j = 0; j < 8; ++j) { q[8 * i + j] = t[j] * 0.125f; acc[8 * i + j] = 0.f; } }
        float m = F.in[IN_SINKS][head], l = 1.0f;
        const int k0 = c >= 2 ? (c - 2) * 64 : 0, k1 = (c + 1) * 64;
        const float* bt = BT + head * 256;
        for (int j = k0; j < k1; ++j) {
            const bf16* kp = PROJ + (size_t)j * EVEN_IN + OFF_K + kvh * 64; float s = 0.f;
#pragma unroll
            for (int i = 0; i < 8; ++i) { float t[8]; ld8(kp + 8 * i, t);
#pragma unroll
                for (int e = 0; e < 8; ++e) s += q[8 * i + e] * t[e]; }
            s += bt[j - tok + 191];
            const float mn = fmaxf(m, s), corr = expf(m - mn), p = expf(s - mn);
            l = l * corr + p; m = mn;
            const bf16* vp = PROJ + (size_t)j * EVEN_IN + OFF_V + kvh * 64;
#pragma unroll
            for (int i = 0; i < 8; ++i) { float t[8]; ld8(vp + 8 * i, t);
#pragma unroll
                for (int e = 0; e < 8; ++e) acc[8 * i + e] = acc[8 * i + e] * corr + p * t[e]; }
        }
        const float inv = 1.0f / l;
#pragma unroll
        for (int i = 0; i < 8; ++i) { v4u w; w.x = pk2(acc[8 * i] * inv, acc[8 * i + 1] * inv); w.y = pk2(acc[8 * i + 2] * inv, acc[8 * i + 3] * inv); w.z = pk2(acc[8 * i + 4] * inv, acc[8 * i + 5] * inv); w.w = pk2(acc[8 * i + 6] * inv, acc[8 * i + 7] * inv);
            *(GAS v4u*)(Y + (size_t)tok * DM + head * 64 + 8 * i) = w; }
    }
}
__device__ __forceinline__ float softplusf(float z) { return fmaxf(z, 0.f) + log1pf(expf(-fabsf(z))); }
__device__ __forceinline__ float sigmoidf_(float z) { return 1.0f / (1.0f + expf(-z)); }
__device__ __forceinline__ float gelu_tanh(float x) { const float u = 0.7978845608028654f * (x + 0.044715f * x * x * x); return 0.5f * x * (1.0f + tanhf(u)); }
__device__ __forceinline__ void lru_naive(Frame& F) {
    if (blockIdx.x >= 16 || F.wave != 0) return;
    const bf16* PROJ = (const bf16*)(F.ws + WS_PROJ); bf16* Y = (bf16*)(F.ws + WS_Y);
    const int hb = blockIdx.x, lane = F.lane, c = hb * 64 + lane;
    float Wa[64], Wx[64];
#pragma unroll
    for (int i = 0; i < 64; ++i) { Wa[i] = F.in[IN_GAW][(size_t)(hb * 64 + i) * 64 + lane]; Wx[i] = F.in[IN_GXW][(size_t)(hb * 64 + i) * 64 + lane]; }
    const float ba = F.in[IN_GAB][c], bx = F.in[IN_GXB][c], cb = F.in[IN_CONVB][c];
    const float cw0 = F.in[IN_CONVW][c], cw1 = F.in[IN_CONVW][1024 + c], cw2 = F.in[IN_CONVW][2048 + c], cw3 = F.in[IN_CONVW][3072 + c];
    const float sp8 = 8.0f * softplusf(-F.in[IN_LAMBDA][c]);
    float x1 = 0.f, x2 = 0.f, x3 = 0.f, h = 0.f;
    for (int t0 = 0; t0 < SEQ; t0 += 8) {
        float xb[8], g[8];
#pragma unroll
        for (int u = 0; u < 8; ++u) { xb[u] = bflo((unsigned)PROJ[(size_t)(t0 + u) * EVEN_IN + OFF_X + c]); g[u] = bflo((unsigned)PROJ[(size_t)(t0 + u) * EVEN_IN + OFF_G + c]); }
#pragma unroll
        for (int u = 0; u < 8; ++u) {
            const float xt = xb[u], xc = cb + cw0 * x3 + cw1 * x2 + cw2 * x1 + cw3 * xt; x3 = x2; x2 = x1; x1 = xt;
            float ra = ba, rx = bx; const int xci = __builtin_bit_cast(int, xc);
#pragma unroll
            for (int i = 0; i < 64; ++i) { const float xi = __builtin_bit_cast(float, __builtin_amdgcn_readlane(xci, i)); ra += xi * Wa[i]; rx += xi * Wx[i]; }
            const float r = sigmoidf_(ra), ig = sigmoidf_(rx), log_a = -r * sp8, a = expf(log_a), mult = sqrtf(-expm1f(2.0f * log_a));
            h = a * h + mult * (ig * xc);
            Y[(size_t)(t0 + u) * DM + 1024 + c] = (bf16)f2bf(gelu_tanh(g[u]) * h);
        }
    }
}
__device__ __forceinline__ void sb_naive(Frame& F) {
    const bf16* PROJ = (const bf16*)(F.ws + WS_PROJ); bf16* Y = (bf16*)(F.ws + WS_Y);
    const int gt = blockIdx.x * 512 + F.tid, half = gt & 1;
    for (int pidx = gt >> 1; pidx < SEQ * 16; pidx += (F.G * 512) >> 1) {
        const int head = pidx >> 13, tok = pidx & (SEQ - 1);
        float q[64], acc[64];
#pragma unroll
        for (int i = 0; i < 8; ++i) { float t[8]; ld8(PROJ + (size_t)tok * ODD_IN + head * 128 + half * 64 + 8 * i, t);
#pragma unroll
            for (int j = 0; j < 8; ++j) { q[8 * i + j] = t[j] * 0.08838834764831845f; acc[8 * i + j] = 0.f; } }
        float stick = 0.f;
        for (int j = tok - 1; j >= 0; --j) {
            const bf16* kp = PROJ + (size_t)j * ODD_IN + 2048 + head * 128 + half * 64; float s = 0.f;
#pragma unroll
            for (int i = 0; i < 8; ++i) { float t[8]; ld8(kp + 8 * i, t);
#pragma unroll
                for (int e = 0; e < 8; ++e) s += q[8 * i + e] * t[e]; }
            const float z = s + __shfl_xor(s, 1);
            const float lk = -softplusf(z), w = expf(z + lk + stick);
            const bf16* vp = PROJ + (size_t)j * ODD_IN + 4096 + head * 128 + half * 64;
#pragma unroll
            for (int i = 0; i < 8; ++i) { float t[8]; ld8(vp + 8 * i, t);
#pragma unroll
                for (int e = 0; e < 8; ++e) acc[8 * i + e] += w * t[e]; }
            stick += lk;
            if (stick < -104.0f) break;
        }
#pragma unroll
        for (int i = 0; i < 8; ++i) { v4u w; w.x = pk2(acc[8 * i], acc[8 * i + 1]); w.y = pk2(acc[8 * i + 2], acc[8 * i + 3]); w.z = pk2(acc[8 * i + 4], acc[8 * i + 5]); w.w = pk2(acc[8 * i + 6], acc[8 * i + 7]);
            *(GAS v4u*)(Y + (size_t)tok * DM + head * 128 + half * 64 + 8 * i) = w; }
    }
}
__device__ __forceinline__ void final_norm(Frame& F) {
    const int gw = blockIdx.x * NWAVES + F.wave, NGW = F.G * NWAVES;
    const GAS f32x4* gp = (const GAS f32x4*)F.in[IN_FNORM] + F.lane;
    for (int m = gw; m < SEQ; m += NGW) {
        GAS f32x4* xr = (GAS f32x4*)(F.out + (size_t)m * DM) + F.lane;
        f32x4 v[8]; float s = 0.f;
#pragma unroll
        for (int j = 0; j < 8; ++j) { v[j] = xr[64 * j]; s += (v[j].x * v[j].x + v[j].y * v[j].y) + (v[j].z * v[j].z + v[j].w * v[j].w); }
        const float rstd = 1.0f / sqrtf(wave_sum(s) * (1.0f / DM) + 1e-6f);
#pragma unroll
        for (int j = 0; j < 8; ++j) xr[64 * j] = v[j] * rstd * gp[64 * j];
    }
}
typedef float f32x16 __attribute__((ext_vector_type(16)));
typedef short s16x8 __attribute__((ext_vector_type(8)));
typedef short s16x4 __attribute__((ext_vector_type(4)));
typedef __bf16 bf16x2v __attribute__((ext_vector_type(2)));
#define MFMA32(a, b, c) __builtin_amdgcn_mfma_f32_32x32x16_bf16((a), (b), (c), 0, 0, 0)
__device__ __forceinline__ int crow(int i, int h) { return (i & 3) + 8 * (i >> 2) + 4 * h; }
__device__ __forceinline__ unsigned pkbf(float a, float b) { bf16x2v v; v.x = (__bf16)a; v.y = (__bf16)b; return __builtin_bit_cast(unsigned, v); }
__device__ __forceinline__ s16x8 pack8(const float (&p)[16], int s) {
    v4u w; w.x = pkbf(p[8 * s], p[8 * s + 1]); w.y = pkbf(p[8 * s + 2], p[8 * s + 3]); w.z = pkbf(p[8 * s + 4], p[8 * s + 5]); w.w = pkbf(p[8 * s + 6], p[8 * s + 7]);
    return __builtin_bit_cast(s16x8, w);
}
__device__ __forceinline__ s16x8 tr_frag(const LAS unsigned char* p0, const LAS unsigned char* p1) {
    const s16x4 lo = __builtin_amdgcn_ds_read_tr16_b64_v4i16((LAS s16x4*)p0), hi = __builtin_amdgcn_ds_read_tr16_b64_v4i16((LAS s16x4*)p1);
    return __builtin_shufflevector(lo, hi, 0, 1, 2, 3, 4, 5, 6, 7);
}
__device__ __forceinline__ float fast_softplus(float z) { return fmaxf(z, 0.f) + __logf(1.0f + __expf(-fabsf(z))); }
__device__ __forceinline__ float fast_sigmoid(float z) { return __builtin_amdgcn_rcpf(1.0f + __expf(-z)); }

__device__ __forceinline__ void lru_local(Frame& F) {
    const bf16* PROJ = (const bf16*)(F.ws + WS_PROJ); float* HL = (float*)(F.ws + WS_HL); float* PA = (float*)(F.ws + WS_PA); const bf16* GWT = (const bf16*)(F.ws + WS_GWT);
    LAS unsigned char* xc16 = F.lds;
    LAS float* xc32 = (LAS float*)(F.lds + 18432);
    LAS float* comp = (LAS float*)(F.lds + 18432 + 34816);
    const int tid = F.tid, lane = F.lane, w = F.wave, ts = w & 3, ch = w >> 2, r = lane & 31, h = lane >> 5;
    for (int u = blockIdx.x; u < 1024; u += F.G) {
        const int hb = u & 15, k = u >> 4, t0 = k * 128;
        {
            const int tt = tid >> 2, cg = tid & 3, cbase = hb * 64 + cg * 16, t = t0 + tt;
            float xc[16];
            { const GAS f32x4* cbp = (const GAS f32x4*)(F.in[IN_CONVB] + cbase);
#pragma unroll
              for (int q4 = 0; q4 < 4; ++q4) { const f32x4 b = cbp[q4]; xc[4 * q4] = b[0]; xc[4 * q4 + 1] = b[1]; xc[4 * q4 + 2] = b[2]; xc[4 * q4 + 3] = b[3]; } }
#pragma unroll
            for (int d = 0; d < 4; ++d) { const int row = t - 3 + d;
                float xv[16];
                if (row >= 0) { float a8[8], b8[8]; ld8(PROJ + (size_t)row * EVEN_IN + OFF_X + cbase, a8); ld8(PROJ + (size_t)row * EVEN_IN + OFF_X + cbase + 8, b8);
#pragma unroll
                    for (int e = 0; e < 8; ++e) { xv[e] = a8[e]; xv[8 + e] = b8[e]; } }
                else {
#pragma unroll
                    for (int e = 0; e < 16; ++e) xv[e] = 0.f; }
                const GAS f32x4* cwp = (const GAS f32x4*)(F.in[IN_CONVW] + d * 1024 + cbase);
#pragma unroll
                for (int q4 = 0; q4 < 4; ++q4) { const f32x4 cw = cwp[q4];
#pragma unroll
                    for (int e = 0; e < 4; ++e) xc[4 * q4 + e] += cw[e] * xv[4 * q4 + e]; } }
#pragma unroll
            for (int q4 = 0; q4 < 4; ++q4) *(LAS f32x4*)(xc32 + tt * 68 + cg * 16 + 4 * q4) = (f32x4){xc[4 * q4], xc[4 * q4 + 1], xc[4 * q4 + 2], xc[4 * q4 + 3]};
#pragma unroll
            for (int q8 = 0; q8 < 2; ++q8) { v4u o; o.x = pkbf(xc[8 * q8], xc[8 * q8 + 1]); o.y = pkbf(xc[8 * q8 + 2], xc[8 * q8 + 3]); o.z = pkbf(xc[8 * q8 + 4], xc[8 * q8 + 5]); o.w = pkbf(xc[8 * q8 + 6], xc[8 * q8 + 7]);
                *(LAS v4u*)(xc16 + tt * 144 + cg * 32 + q8 * 16) = o; }
        }
        __syncthreads();
        f32x16 acc_a, acc_x;
#pragma unroll
        for (int i = 0; i < 16; ++i) { acc_a[i] = 0.f; acc_x[i] = 0.f; }
#pragma unroll
        for (int s = 0; s < 4; ++s) {
            const s16x8 af = *(const LAS s16x8*)(xc16 + (ts * 32 + r) * 144 + (16 * s + 8 * h) * 2);
            const s16x8 ba = *(const GAS s16x8*)(GWT + (size_t)((0 * 16 + hb) * 64 + ch * 32 + r) * 64 + 16 * s + 8 * h);
            const s16x8 bx = *(const GAS s16x8*)(GWT + (size_t)((1 * 16 + hb) * 64 + ch * 32 + r) * 64 + 16 * s + 8 * h);
            acc_a = MFMA32(af, ba, acc_a); acc_x = MFMA32(af, bx, acc_x);
        }
        const int c = hb * 64 + ch * 32 + r;
        const float gab = F.in[IN_GAB][c], gxb = F.in[IN_GXB][c], sp8 = 8.0f * softplusf(-F.in[IN_LAMBDA][c]);
        float pa[16], hl[16], gA[4], gU[4];
#pragma unroll
        for (int g = 0; g < 4; ++g) { float A = 1.f, U = 0.f;
#pragma unroll
            for (int e = 0; e < 4; ++e) { const int i = 4 * g + e; const float xcv = xc32[(ts * 32 + crow(i, h)) * 68 + ch * 32 + r];
                const float rg = fast_sigmoid(acc_a[i] + gab), ig = fast_sigmoid(acc_x[i] + gxb), log_a = -rg * sp8, a = __expf(log_a), mult = sqrtf(-expm1f(2.0f * log_a));
                U = a * U + mult * (ig * xcv); A *= a; pa[i] = A; hl[i] = U; }
            gA[g] = A; gU[g] = U; }
        float PAc = 1.f, Hc = 0.f;
#pragma unroll
        for (int g = 0; g < 4; ++g) { const float oA = __shfl_xor(gA[g], 32), oU = __shfl_xor(gU[g], 32);
            const float fA = h ? oA : gA[g], fU = h ? oU : gU[g], sA = h ? gA[g] : oA, sU = h ? gU[g] : oU;
            const float c0P = PAc, c0H = Hc; Hc = fA * Hc + fU; PAc *= fA; const float c1P = PAc, c1H = Hc; Hc = sA * Hc + sU; PAc *= sA;
            const float ciP = h ? c1P : c0P, ciH = h ? c1H : c0H;
#pragma unroll
            for (int e = 0; e < 4; ++e) { const int i = 4 * g + e; hl[i] += pa[i] * ciH; pa[i] *= ciP; } }
        if (h == 0) { comp[(ts * 64 + ch * 32 + r) * 2] = PAc; comp[(ts * 64 + ch * 32 + r) * 2 + 1] = Hc; }
        __syncthreads();
        float PAin = 1.f, Hin = 0.f;
        for (int t2 = 0; t2 < ts; ++t2) { const float A2 = comp[(t2 * 64 + ch * 32 + r) * 2], U2 = comp[(t2 * 64 + ch * 32 + r) * 2 + 1]; Hin = A2 * Hin + U2; PAin *= A2; }
#pragma unroll
        for (int i = 0; i < 16; ++i) { const size_t o = (size_t)(t0 + ts * 32 + crow(i, h)) * 1024 + c; HL[o] = hl[i] + pa[i] * Hin; PA[o] = pa[i] * PAin; }
        __syncthreads();
    }
}
__device__ __forceinline__ void lru_fix(Frame& F) {
    const bf16* PROJ = (const bf16*)(F.ws + WS_PROJ); const float* HL = (const float*)(F.ws + WS_HL); const float* PA = (const float*)(F.ws + WS_PA); bf16* Y = (bf16*)(F.ws + WS_Y);
    const int gw = blockIdx.x * NWAVES + F.wave, NGW = F.G * NWAVES;
    for (int it = gw; it < 4096; it += NGW) {
        const int cgp = it & 15, sub = (it >> 4) & 3, k = it >> 6, c = cgp * 64 + F.lane;
        float H = 0.f;
#pragma unroll 8
        for (int kk = 0; kk < k; ++kk) { const size_t row = (size_t)(kk * 128 + 127) * 1024 + c; H = PA[row] * H + HL[row]; }
#pragma unroll 8
        for (int tt = 0; tt < 32; ++tt) { const int t = k * 128 + sub * 32 + tt;
            const float hv = HL[(size_t)t * 1024 + c] + PA[(size_t)t * 1024 + c] * H, g = bflo((unsigned)PROJ[(size_t)t * EVEN_IN + OFF_G + c]);
            const float u2 = 1.5957691216057308f * (g + 0.044715f * g * g * g), ge = g * fast_sigmoid(u2);
            Y[(size_t)t * DM + 1024 + c] = (bf16)f2bf(ge * hv); }
    }
}

struct Args { const float* in[19]; float* out; unsigned char* ws; int ph_lo, ph_hi; };
__global__ void __launch_bounds__(NWAVES * 64, 2) hybrid_fwd(Args args) {
    extern __shared__ __attribute__((aligned(16))) unsigned char lds[];
    Frame F;
    F.lds = (LAS unsigned char*)lds;
    F.tid = threadIdx.x; F.lane = F.tid & 63; F.wave = __builtin_amdgcn_readfirstlane(F.tid >> 6);
    F.G = gridDim.x;
#pragma unroll
    for (int i = 0; i < 19; ++i) F.in[i] = args.in[i];
    F.out = args.out; F.ws = args.ws;
    unsigned char* ws = args.ws;
    for (int u = F.tid; u < (LDS_BYTES - LDSCTL_OFF) / 4; u += NWAVES * 64) ((LAS unsigned*)(F.lds + LDSCTL_OFF))[u] = 0u;
    __syncthreads();
    const int lo = args.ph_lo, hi = args.ph_hi;
    XcdBarrier bar; bar.bar = (unsigned*)(ws + WS_CTL) + CW_BAR; bar.x = 0; bar.st = nullptr;
    if (hi - lo > 1) bar = xcd_barrier_post((unsigned*)(ws + WS_CTL) + CW_BAR, (volatile LAS unsigned*)(F.lds + MISC_OFF) + 8);
#define IN(k) (lo <= (k) && (k) < hi)
#define SEAM(k) do { if (IN(k) && IN((k) + 1)) xcd_barrier(bar); } while (0)
    bf16* XN = (bf16*)(ws + WS_XN); bf16* Yb = (bf16*)(ws + WS_Y); bf16* PROJ = (bf16*)(ws + WS_PROJ); bf16* ACT = (bf16*)(ws + WS_ACT); float* SS = (float*)(ws + WS_SS);

    if (IN(0)) { p0_prologue(F); } SEAM(0);
    if (IN(1)) { pg8::Gemm g{XN, (const bf16*)(ws + WS_WIN0), SEQ, EVEN_IN, DM}; pg8::StaticOrder S; S.init(SEQ, EVEN_IN, F.G, (int)blockIdx.x);
        pg8::EpiBf16<0> E{PROJ, EVEN_IN, SS}; pg8::gemm_phase<pg8::EpiBf16<0>, pg8::StaticOrder, true, true>(F.lds + RING_OFF, g, S, E); } SEAM(1);
    if (IN(2)) { lru_local(F); swa_naive(F); } SEAM(2);
    if (IN(3)) { lru_fix(F); } SEAM(3);
    if (IN(4)) { pg8::Gemm g{Yb, (const bf16*)(ws + WS_WOUT0), SEQ, DM, DM}; pg8::StaticOrder S; S.init(SEQ, DM, F.G, (int)blockIdx.x);
        pg8::EpiRes E{F.in[IN_X], F.out, XN, SS, DM}; pg8::gemm_phase<pg8::EpiRes, pg8::StaticOrder, false, true>(F.lds + RING_OFF, g, S, E); } SEAM(4);
    if (IN(5)) { pg8::Gemm g{XN, (const bf16*)(ws + WS_WUP0), SEQ, DFF, DM}; pg8::StaticOrder S; S.init(SEQ, DFF, F.G, (int)blockIdx.x);
        pg8::EpiBf16<1> E{ACT, DFF, SS}; pg8::gemm_phase<pg8::EpiBf16<1>, pg8::StaticOrder, true, true>(F.lds + RING_OFF, g, S, E); } SEAM(5);
    if (IN(6)) { pg8::Gemm g{ACT, (const bf16*)(ws + WS_WDN0), SEQ, DM, DFF}; pg8::StaticOrder S; S.init(SEQ, DM, F.G, (int)blockIdx.x);
        pg8::EpiRes E{F.out, F.out, XN, SS, DM}; pg8::gemm_phase<pg8::EpiRes, pg8::StaticOrder, false, true>(F.lds + RING_OFF, g, S, E); } SEAM(6);
    if (IN(7)) { pg8::Gemm g{XN, (const bf16*)(ws + WS_WIN1), SEQ, ODD_IN, DM}; pg8::StaticOrder S; S.init(SEQ, ODD_IN, F.G, (int)blockIdx.x);
        pg8::EpiBf16<0> E{PROJ, ODD_IN, SS}; pg8::gemm_phase<pg8::EpiBf16<0>, pg8::StaticOrder, true, true>(F.lds + RING_OFF, g, S, E); } SEAM(7);
    if (IN(8)) { sb_naive(F); } SEAM(8);
    if (IN(9)) { pg8::Gemm g{Yb, (const bf16*)(ws + WS_WOUT1), SEQ, DM, DM}; pg8::StaticOrder S; S.init(SEQ, DM, F.G, (int)blockIdx.x);
        pg8::EpiRes E{F.out, F.out, XN, SS, DM}; pg8::gemm_phase<pg8::EpiRes, pg8::StaticOrder, false, true>(F.lds + RING_OFF, g, S, E); } SEAM(9);
    if (IN(10)) { pg8::Gemm g{XN, (const bf16*)(ws + WS_WUP1), SEQ, DFF, DM}; pg8::StaticOrder S; S.init(SEQ, DFF, F.G, (int)blockIdx.x);
        pg8::EpiBf16<1> E{ACT, DFF, SS}; pg8::gemm_phase<pg8::EpiBf16<1>, pg8::StaticOrder, true, true>(F.lds + RING_OFF, g, S, E); } SEAM(10);
    if (IN(11)) { pg8::Gemm g{ACT, (const bf16*)(ws + WS_WDN1), SEQ, DM, DFF}; pg8::StaticOrder S; S.init(SEQ, DM, F.G, (int)blockIdx.x);
        pg8::EpiRes E{F.out, F.out, XN, SS, DM}; pg8::gemm_phase<pg8::EpiRes, pg8::StaticOrder, false, true>(F.lds + RING_OFF, g, S, E); } SEAM(11);
    if (IN(12)) { final_norm(F); }
#undef IN
#undef SEAM
}

extern "C" void kernel_launch(void* const* d_in, const int* in_sizes, int n_in, void* d_out, int out_size, void* d_ws, size_t ws_size, hipStream_t stream) {
    static int grid = 0;
    if (grid == 0) {
        if (n_in != 19 || in_sizes[0] != SEQ * DM || out_size != SEQ * DM || ws_size < WS_END) { fprintf(stderr, "kernel_launch: unexpected shapes (n_in %d, in0 %d, out %d, ws %zu); nothing launched\n", n_in, n_in > 0 ? in_sizes[0] : -1, out_size, ws_size); grid = -1; return; }
        int dev = 0, cus = 0, per_cu = 0;
        if (hipGetDevice(&dev) != hipSuccess || hipDeviceGetAttribute(&cus, hipDeviceAttributeMultiprocessorCount, dev) != hipSuccess) { fprintf(stderr, "kernel_launch: device query failed\n"); grid = -1; return; }
        if (hipFuncSetAttribute((const void*)hybrid_fwd, hipFuncAttributeMaxDynamicSharedMemorySize, LDS_BYTES) != hipSuccess) { fprintf(stderr, "kernel_launch: hipFuncSetAttribute failed\n"); grid = -1; return; }
        if (hipOccupancyMaxActiveBlocksPerMultiprocessor(&per_cu, (const void*)hybrid_fwd, NWAVES * 64, LDS_BYTES) != hipSuccess || per_cu < 1) { fprintf(stderr, "kernel_launch: occupancy query reports %d workgroups per CU\n", per_cu); per_cu = 1; }
        (void)hipGetLastError();
        grid = cus;
        if (grid != 256) fprintf(stderr, "kernel_launch: %d CUs; the residual GEMM phases need exactly 256 workgroups\n", grid);
    }
    if (grid < 0) return;
    (void)hipMemsetAsync((char*)d_ws + WS_CTL, 0, CTL_ZERO_BYTES, stream);
    Args a{};
    for (int i = 0; i < 19; ++i) a.in[i] = (const float*)d_in[i];
    a.out = (float*)d_out; a.ws = (unsigned char*)d_ws;
#if MK_N_LAUNCHES == 1
    a.ph_lo = 0; a.ph_hi = N_PHASES;
    hipLaunchKernelGGL(hybrid_fwd, dim3(grid), dim3(NWAVES * 64), LDS_BYTES, stream, a);
#else
    for (int p = 0; p < N_PHASES; ++p) { a.ph_lo = p; a.ph_hi = p + 1; hipLaunchKernelGGL(hybrid_fwd, dim3(grid), dim3(NWAVES * 64), LDS_BYTES, stream, a); }
#endif
}
```

```cpp
#include <hip/hip_runtime.h>
#include <cstdio>
#include <cstdint>
namespace pg8 {
#define PG8_LAS __attribute__((address_space(3)))
typedef unsigned short bf16_t;
typedef short bf16x8 __attribute__((ext_vector_type(8)));
typedef float f32x4 __attribute__((ext_vector_type(4)));
typedef unsigned u32x4 __attribute__((ext_vector_type(4)));
constexpr int BM = 256, BK = 64, HALF = 128, HTB = HALF * BK * 2  , STAGE_BYTES = 8 * HTB, NXCD = 8, WGM = 8;

__host__ __device__ __forceinline__ int lds_byte(int r, int c) { const int st = (r >> 4) * 2 + (c >> 5), rr = r & 15, cc = c & 31, ob = rr * 64 + cc * 2; return st * 1024 + (ob ^ (((ob >> 9) & 1) << 5)); }
__host__ __device__ __forceinline__ void stage_rc(int b, int& R, int& C) { const int st = b / 1024, sb = b % 1024, swz = sb ^ (((sb >> 9) & 1) << 5); R = (st >> 1) * 16 + swz / 64; C = (st & 1) * 32 + (swz % 64) / 2; }
__host__ __device__ __forceinline__ int perm32(int rho) { const int n = rho >> 4, i = rho & 15; return 8 * (i >> 2) + 4 * n + (i & 3); }

struct Unit { int pm, pn; };
struct Gemm { const bf16_t* A; const bf16_t* Bt; int M, N, K; };

struct StaticOrder {
    int nM, nN, nwg, G, c;
    __host__ __device__ void init(int M, int N, int G_, int c_) { nM = M / BM; nN = N / BM; nwg = nM * nN; G = G_; c = c_; }
    __host__ __device__ bool next(int i, Unit& u) const {
        const long L = (long)i * G + c; if (L >= nwg) return false;
        int wgid = (int)L; { const int q = nwg / NXCD, r = nwg % NXCD, xcd = wgid % NXCD, off = wgid / NXCD; wgid = (xcd < r ? xcd * (q + 1) : r * (q + 1) + (xcd - r) * q) + off; }
        const int nig = WGM * nN, gid = wgid / nig, fm = gid * WGM, gsz = (nM - fm) < WGM ? (nM - fm) : WGM;
        u.pm = fm + ((wgid % nig) % gsz); u.pn = (wgid % nig) / gsz; return true;
    }
    __device__ __forceinline__ void a_ready(const Unit&) const {}
    __device__ __forceinline__ void done(const Unit&) const {}
};

__device__ __forceinline__ unsigned cvt_pk_bf16(float lo, float hi) { unsigned r; asm volatile("v_cvt_pk_bf16_f32 %0, %1, %2" : "=v"(r) : "v"(lo), "v"(hi)); return r; }
constexpr float RMS_EPS = 1e-6f;
__device__ __forceinline__ float row_rstd(const float* ss, int r) {
    const f32x4 a = *(const f32x4*)(ss + (size_t)r * 8), b = *(const f32x4*)(ss + (size_t)r * 8 + 4);
    const float s = ((a[0] + a[1]) + (a[2] + a[3])) + ((b[0] + b[1]) + (b[2] + b[3]));
    return 1.0f / sqrtf(s * (1.0f / 2048.0f) + RMS_EPS);
}
template <int ACT> struct EpiBf16 {
    static constexpr bool PERM = true, AFTER_DRAIN = false;
    bf16_t* O; int ldc; const float* ss;
    __device__ __forceinline__ void operator()(const f32x4 (&acc)[2][2][4][2], const Unit& u, int wr, int wc, int fr, int fq) const {
        const int row0 = u.pm * BM + wr * 64 + fr, col0 = u.pn * BM + wc * 32 + 8 * fq;
#pragma unroll
        for (int ai = 0; ai < 2; ++ai)
#pragma unroll
            for (int m = 0; m < 4; ++m) { const int r = row0 + ai * HALF + m * 16; const float rs = ss ? row_rstd(ss, r) : 1.0f;
                bf16_t* rowp = O + (size_t)r * ldc + col0;
#pragma unroll
                for (int bj = 0; bj < 2; ++bj) { f32x4 v0 = acc[ai][bj][m][0] * rs, v1 = acc[ai][bj][m][1] * rs;
                    if (ACT == 1) {
#pragma unroll
                        for (int j = 0; j < 4; ++j) { const float a = fmaxf(v0[j], 0.f), b = fmaxf(v1[j], 0.f); v0[j] = a * a; v1[j] = b * b; } }
                    u32x4 w; w.x = cvt_pk_bf16(v0[0], v0[1]); w.y = cvt_pk_bf16(v0[2], v0[3]); w.z = cvt_pk_bf16(v1[0], v1[1]); w.w = cvt_pk_bf16(v1[2], v1[3]);
                    *(u32x4*)(rowp + bj * HALF) = w; } }
    }
};
struct EpiRes {
    static constexpr bool PERM = true, AFTER_DRAIN = true;
    const float* base; float* out; bf16_t* xn; float* ss; int ldc;
    __device__ __forceinline__ void operator()(const f32x4 (&)[2][2][4][2], const Unit&, int, int, int, int) const {}
    __device__ __forceinline__ void fused(f32x4 (&acc)[2][2][4][2], const Unit& u, int wr, int wc, int fr, int fq, PG8_LAS unsigned char* lds, int wid, int lane) const {
        PG8_LAS float* P = (PG8_LAS float*)lds;
#pragma unroll
        for (int ai = 0; ai < 2; ++ai)
#pragma unroll
            for (int m = 0; m < 4; ++m) { const int rl = ai * HALF + wr * 64 + m * 16 + fr; const size_t off = (size_t)(u.pm * BM + rl) * ldc + u.pn * BM + wc * 32 + 8 * fq; float s = 0.f;
#pragma unroll
                for (int bj = 0; bj < 2; ++bj) { const f32x4 b0 = *(const f32x4*)(base + off + bj * HALF), b1 = *(const f32x4*)(base + off + bj * HALF + 4);
                    const f32x4 v0 = acc[ai][bj][m][0] + b0, v1 = acc[ai][bj][m][1] + b1;
                    *(f32x4*)(out + off + bj * HALF) = v0; *(f32x4*)(out + off + bj * HALF + 4) = v1;
                    u32x4 w; w.x = cvt_pk_bf16(v0[0], v0[1]); w.y = cvt_pk_bf16(v0[2], v0[3]); w.z = cvt_pk_bf16(v1[0], v1[1]); w.w = cvt_pk_bf16(v1[2], v1[3]);
                    *(u32x4*)(xn + off + bj * HALF) = w;
                    s += ((v0[0] * v0[0] + v0[1] * v0[1]) + (v0[2] * v0[2] + v0[3] * v0[3])) + ((v1[0] * v1[0] + v1[1] * v1[1]) + (v1[2] * v1[2] + v1[3] * v1[3])); }
                s += __shfl_xor(s, 16); s += __shfl_xor(s, 32);
                if (fq == 0) P[rl * 4 + wc] = s;
                asm volatile("" ::: "memory"); }
        asm volatile("s_waitcnt lgkmcnt(0)" ::: "memory"); __builtin_amdgcn_s_barrier(); asm volatile("" ::: "memory");
        const int t = wid * 64 + lane;
        if (t < 256) { const f32x4 p = *(const PG8_LAS f32x4*)(P + t * 4); ss[(size_t)(u.pm * BM + t) * 8 + u.pn] = (p[0] + p[1]) + (p[2] + p[3]); }
        asm volatile("s_waitcnt lgkmcnt(0)" ::: "memory"); __builtin_amdgcn_s_barrier(); asm volatile("" ::: "memory");
    }
};

template <class Epi, class Sched, bool ALIGN_EPI = false, bool SP2 = false>
__device__ __forceinline__ void gemm_phase(PG8_LAS unsigned char* lds, const Gemm g, const Sched& S, const Epi& E) {
    const int tid = threadIdx.x, wid = __builtin_amdgcn_readfirstlane(tid >> 6), lane = tid & 63, wr = wid >> 2, wc = wid & 3, fr = lane & 15, fq = lane >> 4;
    const int K = g.K, nt = K / BK;
    unsigned voffA[2], voffB[2];
#pragma unroll
    for (int i = 0; i < 2; ++i) { int R, C; stage_rc(tid * 16 + i * 8192, R, C); const int Rb = Epi::PERM ? ((R & ~31) + perm32(R & 31)) : R;
        voffA[i] = (unsigned)(R * K + C) * 2u; voffB[i] = (unsigned)(Rb * K + C) * 2u; }
    const size_t kstep = (size_t)(BK * 2);
    const size_t hstep = (size_t)HALF * K * 2;
    const size_t tstep = 2 * hstep;
    const unsigned ldsw = (unsigned)wid * 1024u;
    const int aoff = lds_byte(wr * 64 + fr, fq * 8), boff = lds_byte(wc * 32 + fr, fq * 8);
#define PG8_SA(b, h) (((b) * 2 + (h)) * HTB)
#define PG8_SB(b, h) ((4 + (b) * 2 + (h)) * HTB)
#define PG8_STAGE(bufoff, gbase, voff) do { _Pragma("unroll") for (int _i = 0; _i < 2; ++_i) \
        __builtin_amdgcn_global_load_lds((const unsigned*)((const char*)(gbase) + (voff)[_i]), (PG8_LAS unsigned*)(lds + (bufoff) + ldsw + _i * 8192), 16, 0, 0); } while (0)
#define PG8_LDA(dst, b, h) do { _Pragma("unroll") for (int m = 0; m < 4; ++m) _Pragma("unroll") for (int k = 0; k < 2; ++k) dst[m][k] = *(const PG8_LAS bf16x8*)(lds + PG8_SA(b, h) + aoff + m * 2048 + k * 1024); } while (0)
#define PG8_LDB(dst, b, h) do { _Pragma("unroll") for (int n = 0; n < 2; ++n) _Pragma("unroll") for (int k = 0; k < 2; ++k) dst[n][k] = *(const PG8_LAS bf16x8*)(lds + PG8_SB(b, h) + boff + n * 2048 + k * 1024); } while (0)
#define PG8_MMA(ai, bj, At, Bt) do { __builtin_amdgcn_s_setprio(1); _Pragma("unroll") for (int m = 0; m < 4; ++m) _Pragma("unroll") for (int n = 0; n < 2; ++n) _Pragma("unroll") for (int k = 0; k < 2; ++k) \
        acc[ai][bj][m][n] = __builtin_amdgcn_mfma_f32_16x16x32_bf16(Bt[n][k], At[m][k], acc[ai][bj][m][n], 0, 0, 0); __builtin_amdgcn_s_setprio(0); } while (0)
#define PG8_WAIT_V(n) asm volatile("s_waitcnt vmcnt(" #n ")" ::: "memory")
#define PG8_WAIT_L(n) asm volatile("s_waitcnt lgkmcnt(" #n ")" ::: "memory")
#define PG8_BAR __builtin_amdgcn_s_barrier()
#define PG8_SCHED __builtin_amdgcn_sched_barrier(0)
    Unit cur, nxt; int ui = 0;
    if (!S.next(0, cur)) return;
    f32x4 acc[2][2][4][2];
#pragma unroll
    for (int a = 0; a < 2; ++a)
#pragma unroll
        for (int b = 0; b < 2; ++b)
#pragma unroll
            for (int m = 0; m < 4; ++m)
#pragma unroll
                for (int n = 0; n < 2; ++n) acc[a][b][m][n] = (f32x4){0.f, 0.f, 0.f, 0.f};
    bf16x8 At[4][2], B0[2][2], B1[2][2];
    const char* cA = (const char*)g.A + (size_t)cur.pm * tstep; const char* cB = (const char*)g.Bt + (size_t)cur.pn * tstep;
    S.a_ready(cur);
    if constexpr (SP2) {
        PG8_STAGE(PG8_SB(0, 0), cB, voffB); PG8_STAGE(PG8_SB(0, 1), cB + hstep, voffB); PG8_STAGE(PG8_SA(0, 0), cA, voffA); PG8_STAGE(PG8_SA(0, 1), cA + hstep, voffA);
        if (wr == 1) PG8_BAR;
        PG8_WAIT_V(2); PG8_BAR;
        PG8_STAGE(PG8_SB(1, 0), cB + kstep, voffB); PG8_STAGE(PG8_SA(1, 0), cA + kstep, voffA); PG8_STAGE(PG8_SB(1, 1), cB + hstep + kstep, voffB);
        PG8_WAIT_V(6); PG8_BAR;
    } else {
        PG8_STAGE(PG8_SB(0, 0), cB, voffB); PG8_STAGE(PG8_SA(0, 0), cA, voffA); PG8_STAGE(PG8_SB(0, 1), cB + hstep, voffB); PG8_STAGE(PG8_SA(0, 1), cA + hstep, voffA);
        if (wr == 1) PG8_BAR;
        PG8_WAIT_V(4); PG8_BAR;
        PG8_STAGE(PG8_SB(1, 0), cB + kstep, voffB); PG8_STAGE(PG8_SA(1, 0), cA + kstep, voffA); PG8_STAGE(PG8_SB(1, 1), cB + hstep + kstep, voffB);
        PG8_WAIT_V(6); PG8_BAR;
    }
    for (;;) {
        const bool has_next = S.next(ui + 1, nxt);
        const char* nA = has_next ? (const char*)g.A + (size_t)nxt.pm * tstep : cA; const char* nB = has_next ? (const char*)g.Bt + (size_t)nxt.pn * tstep : cB;
        for (int t = 0; t < nt; t += 2) {
            const bool last = (t == nt - 2);
            const char* a1 = cA + (size_t)(t + 1) * kstep;
            const char* a2 = last ? nA : cA + (size_t)(t + 2) * kstep; const char* b2 = last ? nB : cB + (size_t)(t + 2) * kstep;
            const char* a3 = a2 + kstep; const char* b3 = b2 + kstep;
            if (last && has_next) S.a_ready(nxt);
            if constexpr (SP2) {
            PG8_LDB(B0, 0, 0); PG8_LDB(B1, 0, 1); PG8_SCHED; PG8_LDA(At, 0, 0); PG8_STAGE(PG8_SA(1, 1), a1 + hstep, voffA);
            PG8_WAIT_V(8); PG8_WAIT_L(0); PG8_BAR; PG8_MMA(0, 0, At, B0); PG8_MMA(0, 1, At, B1); PG8_BAR; PG8_SCHED;
            PG8_LDA(At, 0, 1); PG8_STAGE(PG8_SB(0, 0), b2, voffB); PG8_STAGE(PG8_SB(0, 1), b2 + hstep, voffB); PG8_STAGE(PG8_SA(0, 0), a2, voffA);
            PG8_WAIT_V(8); PG8_WAIT_L(0); PG8_BAR; PG8_MMA(1, 0, At, B0); PG8_MMA(1, 1, At, B1); PG8_BAR; PG8_SCHED;
            PG8_LDB(B0, 1, 0); PG8_LDB(B1, 1, 1); PG8_SCHED; PG8_LDA(At, 1, 0); PG8_STAGE(PG8_SA(0, 1), a2 + hstep, voffA);
            PG8_WAIT_V(8); PG8_WAIT_L(0); PG8_BAR; PG8_MMA(0, 0, At, B0); PG8_MMA(0, 1, At, B1); PG8_BAR; PG8_SCHED;
            PG8_LDA(At, 1, 1); PG8_STAGE(PG8_SB(1, 0), b3, voffB); PG8_STAGE(PG8_SB(1, 1), b3 + hstep, voffB); PG8_STAGE(PG8_SA(1, 0), a3, voffA);
            PG8_WAIT_V(8); PG8_WAIT_L(0); PG8_BAR; PG8_MMA(1, 0, At, B0); PG8_MMA(1, 1, At, B1); PG8_BAR; PG8_SCHED;
            } else {
            PG8_LDB(B0, 0, 0); PG8_SCHED; PG8_LDA(At, 0, 0); PG8_STAGE(PG8_SA(1, 1), a1 + hstep, voffA);
            PG8_WAIT_L(8); PG8_BAR; PG8_WAIT_L(0); PG8_MMA(0, 0, At, B0); PG8_BAR; PG8_SCHED;
            PG8_LDB(B1, 0, 1); PG8_STAGE(PG8_SB(0, 0), b2, voffB);
            PG8_BAR; PG8_WAIT_L(0); PG8_MMA(0, 1, At, B1); PG8_BAR;
            PG8_LDA(At, 0, 1); PG8_STAGE(PG8_SA(0, 0), a2, voffA);
            PG8_BAR; PG8_WAIT_L(0); PG8_MMA(1, 0, At, B0); PG8_BAR; PG8_SCHED;
            PG8_STAGE(PG8_SB(0, 1), b2 + hstep, voffB);
            PG8_WAIT_V(6); PG8_BAR; PG8_MMA(1, 1, At, B1); PG8_BAR;
            PG8_LDB(B0, 1, 0); PG8_SCHED; PG8_LDA(At, 1, 0); PG8_STAGE(PG8_SA(0, 1), a2 + hstep, voffA);
            PG8_WAIT_L(8); PG8_BAR; PG8_WAIT_L(0); PG8_MMA(0, 0, At, B0); PG8_BAR; PG8_SCHED;
            PG8_LDB(B1, 1, 1); PG8_STAGE(PG8_SB(1, 0), b3, voffB);
            PG8_BAR; PG8_WAIT_L(0); PG8_MMA(0, 1, At, B1); PG8_BAR;
            PG8_LDA(At, 1, 1); PG8_STAGE(PG8_SA(1, 0), a3, voffA);
            PG8_BAR; PG8_WAIT_L(0); PG8_MMA(1, 0, At, B0); PG8_BAR; PG8_SCHED;
            PG8_STAGE(PG8_SB(1, 1), b3 + hstep, voffB);
            PG8_WAIT_V(6); PG8_BAR; PG8_MMA(1, 1, At, B1); PG8_BAR;
            }
        }
        if constexpr (ALIGN_EPI) { if (wr == 0) PG8_BAR; }
        if constexpr (!Epi::AFTER_DRAIN) { E(acc, cur, wr, wc, fr, fq); S.done(cur); }
        if (!has_next) break;
#pragma unroll
        for (int a = 0; a < 2; ++a)
#pragma unroll
            for (int b = 0; b < 2; ++b)
#pragma unroll
                for (int m = 0; m < 4; ++m)
#pragma unroll
                    for (int n = 0; n < 2; ++n) acc[a][b][m][n] = (f32x4){0.f, 0.f, 0.f, 0.f};
        cur = nxt; cA = nA; cB = nB; ++ui;
        if constexpr (ALIGN_EPI) { if (wr == 1) PG8_BAR; }
    }
    PG8_WAIT_V(0);
    if constexpr (!ALIGN_EPI) { if (wr == 0) PG8_BAR; }
    PG8_BAR;
    if constexpr (Epi::AFTER_DRAIN) { E.fused(acc, cur, wr, wc, fr, fq, lds, wid, lane); S.done(cur); }
#undef PG8_SA
#undef PG8_SB
#undef PG8_STAGE
#undef PG8_LDA
#undef PG8_LDB
#undef PG8_MMA
#undef PG8_WAIT_V
#undef PG8_WAIT_L
#undef PG8_BAR
#undef PG8_SCHED
}
}

constexpr int NWAVES = 8;
constexpr int SEQ = 8192, DM = 2048, DFF = 8192, EVEN_IN = 3584, ODD_IN = 6144;
constexpr int OFF_K = 1024, OFF_V = 1280, OFF_X = 1536, OFF_G = 2560;
#ifndef MK_N_LAUNCHES
#define MK_N_LAUNCHES 1
#endif
constexpr int N_PHASES = 13;
constexpr size_t MiB = 1u << 20;
constexpr size_t WS_CTL = 0, CTL_ZERO_BYTES = 64 * 1024;
constexpr size_t WS_SS = 1 * MiB;
constexpr size_t WS_BT = 1 * MiB + 512 * 1024;
constexpr size_t WS_GWT = 1 * MiB + 768 * 1024;
constexpr size_t WS_WIN0 = 2 * MiB, WS_WOUT0 = 16 * MiB, WS_WUP0 = 24 * MiB, WS_WDN0 = 56 * MiB, WS_WIN1 = 88 * MiB, WS_WOUT1 = 112 * MiB, WS_WUP1 = 120 * MiB, WS_WDN1 = 152 * MiB;
constexpr size_t WS_XN = 184 * MiB;
constexpr size_t WS_Y = 216 * MiB;
constexpr size_t WS_PROJ = 248 * MiB;
constexpr size_t WS_HL = 344 * MiB, WS_PA = 376 * MiB;
constexpr size_t WS_ACT = 248 * MiB;
constexpr size_t WS_END = 408 * MiB;
constexpr int CW_BAR = 1024;

constexpr int RING_OFF = 0, RING_BYTES = 131072;
constexpr int LDSCTL_OFF = RING_BYTES, MISC_OFF = LDSCTL_OFF + 320;
constexpr int LDS_BYTES = 147456;

#define GAS __attribute__((address_space(1)))
#define LAS __attribute__((address_space(3)))
typedef unsigned short bf16;
typedef unsigned v4u __attribute__((ext_vector_type(4)));
typedef unsigned v2u __attribute__((ext_vector_type(2)));
typedef float f32x4 __attribute__((ext_vector_type(4)));
#define LDS_WAIT() asm volatile("s_waitcnt lgkmcnt(0)" ::: "memory")
#define VM_WAIT() asm volatile("s_waitcnt vmcnt(0)" ::: "memory")
__device__ __forceinline__ unsigned f2bf(float f) { unsigned u = __builtin_bit_cast(unsigned, f); return (u + 0x7fffu + ((u >> 16) & 1u)) >> 16; }
__device__ __forceinline__ unsigned pk2(float lo, float hi) { return f2bf(lo) | (f2bf(hi) << 16); }
__device__ __forceinline__ float bflo(unsigned w) { return __builtin_bit_cast(float, w << 16); }
__device__ __forceinline__ float bfhi(unsigned w) { return __builtin_bit_cast(float, w & 0xffff0000u); }

#define XB_TMO      128
#define XB_XCNT(j)  (256  + 64 * (j))
#define XB_XSUB(j)  (1280 + 64 * (j))
#define XB_XGEN(j)  (2304 + 64 * (j))
#define XB_TOP      3328
#define XB_TOPGEN   3392
#define XCD_BAR_WORDS 3456
#define XB_SPIN_CAP (1u << 24)

__device__ __forceinline__ unsigned xb_ld(unsigned* p)              { return __hip_atomic_load(p, __ATOMIC_RELAXED, __HIP_MEMORY_SCOPE_AGENT); }
__device__ __forceinline__ unsigned xb_add(unsigned* p, unsigned v) { return __hip_atomic_fetch_add(p, v, __ATOMIC_RELAXED, __HIP_MEMORY_SCOPE_AGENT); }
__device__ __forceinline__ unsigned xb_xcc_id() { return (unsigned)__builtin_amdgcn_s_getreg((3 << 11) | 20) & 0xFu; }
#define XB_SPIN(cond, bar) do { unsigned _sp = 0; while (cond) { __builtin_amdgcn_s_sleep(1); \
    if ((++_sp & 255u) == 0u) { if (xb_ld(&(bar)[XB_TMO])) break; if (_sp > XB_SPIN_CAP) { atomicAdd(&(bar)[XB_TMO], 1u); break; } } } } while (0)

struct XcdBarrier {
    unsigned* bar; unsigned x;
    volatile LAS unsigned* st;
};

__device__ __forceinline__ XcdBarrier xcd_barrier_post(unsigned* bar, volatile LAS unsigned* st) {
    XcdBarrier b; b.bar = bar; b.x = xb_xcc_id(); b.st = st;
    if (threadIdx.x == 0) (void)xb_add(&bar[XB_XCNT(b.x)], 1u);
    return b;
}
__device__ __forceinline__ void xcd_barrier_complete(unsigned* bar, unsigned x, unsigned& nloc, unsigned& nx) {
    const unsigned G = gridDim.x * gridDim.y * gridDim.z;
    unsigned sum, cnt, mine, sp = 0u;
    for (;;) {
        sum = 0u; cnt = 0u; mine = 0u;
#pragma unroll
        for (unsigned j = 0; j < 16; ++j) { const unsigned c = xb_ld(&bar[XB_XCNT(j)]); sum += c; cnt += (c > 0u) ? 1u : 0u; mine = (j == x) ? c : mine; }
        if (sum == G) break;
        __builtin_amdgcn_s_sleep(1);
        if ((++sp & 255u) == 0u) { if (xb_ld(&bar[XB_TMO])) break; if (sp > XB_SPIN_CAP) { atomicAdd(&bar[XB_TMO], 1u); break; } }
    }
    nloc = mine > 0u ? mine : 1u; nx = cnt > 0u ? cnt : 1u;
}

__device__ __forceinline__ void xcd_barrier(const XcdBarrier& b) {
    asm volatile("s_waitcnt vmcnt(0)" ::: "memory");
    __syncthreads();
    if (threadIdx.x == 0) {
        unsigned* bar = b.bar;
        __builtin_amdgcn_s_waitcnt(0);
        unsigned nloc = b.st[0], nx = b.st[1];
        if (nloc == 0u) { xcd_barrier_complete(bar, b.x, nloc, nx); b.st[0] = nloc; b.st[1] = nx; }
        const unsigned old = xb_add(&bar[XB_XSUB(b.x)], 1u);
        const unsigned gen = old / nloc;
        if (old + 1u == (gen + 1u) * nloc) {
            __builtin_amdgcn_fence(__ATOMIC_RELEASE, "agent");
            asm volatile("s_waitcnt vmcnt(0)" ::: "memory");
            const unsigned og = xb_add(&bar[XB_TOP], 1u);
            const unsigned tg = og / nx;
            if (og + 1u == (tg + 1u) * nx) xb_add(&bar[XB_TOPGEN], 1u);
            else XB_SPIN(xb_ld(&bar[XB_TOPGEN]) == tg, bar);
            __builtin_amdgcn_fence(__ATOMIC_ACQUIRE, "agent");
            xb_add(&bar[XB_XGEN(b.x)], 1u);
            asm volatile("s_waitcnt vmcnt(0)" ::: "memory");
        } else {
            XB_SPIN(xb_ld(&bar[XB_XGEN(b.x)]) == gen, bar);
            __builtin_amdgcn_fence(__ATOMIC_ACQUIRE, "agent");
            asm volatile("s_waitcnt vmcnt(0)" ::: "memory");
        }
    }
    __syncthreads();
}
struct Frame {
    LAS unsigned char* lds;
    int tid, lane, wave, G;
    const float* in[19]; float* out; unsigned char* ws;
};
#define IN_X 0
#define IN_RELB 1
#define IN_NMIX 2
#define IN_EWIN 3
#define IN_CONVW 4
#define IN_CONVB 5
#define IN_GAW 6
#define IN_GAB 7
#define IN_GXW 8
#define IN_GXB 9
#define IN_LAMBDA 10
#define IN_SINKS 11
#define IN_EWOUT 12
#define IN_OWIN 13
#define IN_OWOUT 14
#define IN_NMLP 15
#define IN_WUP 16
#define IN_WDOWN 17
#define IN_FNORM 18

__device__ __forceinline__ float wave_sum(float v) {
#pragma unroll
    for (int o = 1; o < 64; o <<= 1) v += __shfl_xor(v, o);
    return v;
}
__device__ __forceinline__ void p0_transpose_item(const float* W, int K, int N, const float* gain, bf16* WT, LAS float* scr, int item, int lane) {
    const int nblk = N / 32, kb = item / nblk, nb = item % nblk, k0 = 64 * kb, n0 = 32 * nb;
#pragma unroll 8
    for (int i = 0; i < 32; ++i) { const int kk = 2 * i + (lane >> 5); const float g = gain ? gain[k0 + kk] : 1.0f; scr[kk * 33 + (lane & 31)] = W[(size_t)(k0 + kk) * N + n0 + (lane & 31)] * g; }
    LDS_WAIT(); asm volatile("" ::: "memory");
    const int c = lane & 7;
#pragma unroll
    for (int j = 0; j < 4; ++j) { const int n = (lane >> 3) + 8 * j; const LAS float* s = scr + (8 * c) * 33 + n;
        v4u o; o.x = pk2(s[0 * 33], s[1 * 33]); o.y = pk2(s[2 * 33], s[3 * 33]); o.z = pk2(s[4 * 33], s[5 * 33]); o.w = pk2(s[6 * 33], s[7 * 33]);
        *(GAS v4u*)(WT + (size_t)(n0 + n) * K + k0 + 8 * c) = o; }
    LDS_WAIT(); asm volatile("" ::: "memory");
}
__device__ __forceinline__ int t5_bucket(int rel) {
    const int ret = rel > 0 ? 16 : 0, n = rel < 0 ? -rel : rel;
    if (n < 8) return ret + n;
    int large = 8 + (31 - __builtin_clz((unsigned)(n * n))) - 6; if (large > 15) large = 15;
    return ret + large;
}
__device__ __forceinline__ void p0_prologue(Frame& F) {
    LAS float* scr = (LAS float*)(F.lds + RING_OFF + F.wave * 16384);
    const int gw = blockIdx.x * NWAVES + F.wave, NGW = F.G * NWAVES;
    constexpr int I_IN0 = (DM / 64) * (EVEN_IN / 32), I_OUT = (DM / 64) * (DM / 32), I_UP = (DM / 64) * (DFF / 32), I_DN = (DFF / 64) * (DM / 32), I_IN1 = (DM / 64) * (ODD_IN / 32);
    constexpr int NITEMS = I_IN0 + I_IN1 + 2 * I_OUT + 2 * I_UP + 2 * I_DN;
    unsigned char* ws = F.ws;
    for (int it = gw; it < NITEMS; it += NGW) {
        int r = it;
        if (r < I_IN0) { p0_transpose_item(F.in[IN_EWIN], DM, EVEN_IN, F.in[IN_NMIX], (bf16*)(ws + WS_WIN0), scr, r, F.lane); continue; } r -= I_IN0;
        if (r < I_OUT) { p0_transpose_item(F.in[IN_EWOUT], DM, DM, nullptr, (bf16*)(ws + WS_WOUT0), scr, r, F.lane); continue; } r -= I_OUT;
        if (r < I_UP) { p0_transpose_item(F.in[IN_WUP], DM, DFF, F.in[IN_NMLP], (bf16*)(ws + WS_WUP0), scr, r, F.lane); continue; } r -= I_UP;
        if (r < I_DN) { p0_transpose_item(F.in[IN_WDOWN], DFF, DM, nullptr, (bf16*)(ws + WS_WDN0), scr, r, F.lane); continue; } r -= I_DN;
        if (r < I_IN1) { p0_transpose_item(F.in[IN_OWIN], DM, ODD_IN, F.in[IN_NMIX] + DM, (bf16*)(ws + WS_WIN1), scr, r, F.lane); continue; } r -= I_IN1;
        if (r < I_OUT) { p0_transpose_item(F.in[IN_OWOUT], DM, DM, nullptr, (bf16*)(ws + WS_WOUT1), scr, r, F.lane); continue; } r -= I_OUT;
        if (r < I_UP) { p0_transpose_item(F.in[IN_WUP] + (size_t)DM * DFF, DM, DFF, F.in[IN_NMLP] + DM, (bf16*)(ws + WS_WUP1), scr, r, F.lane); continue; } r -= I_UP;
        p0_transpose_item(F.in[IN_WDOWN] + (size_t)DFF * DM, DFF, DM, nullptr, (bf16*)(ws + WS_WDN1), scr, r, F.lane);
    }
    bf16* XN = (bf16*)(ws + WS_XN); float* SS = (float*)(ws + WS_SS);
    for (int m = gw; m < SEQ; m += NGW) {
        const GAS f32x4* xr = (const GAS f32x4*)(F.in[IN_X] + (size_t)m * DM) + F.lane;
        f32x4 v[8]; float s = 0.f;
#pragma unroll
        for (int j = 0; j < 8; ++j) { v[j] = xr[64 * j]; s += (v[j].x * v[j].x + v[j].y * v[j].y) + (v[j].z * v[j].z + v[j].w * v[j].w); }
        s = wave_sum(s);
        GAS v2u* o8 = (GAS v2u*)(XN + (size_t)m * DM) + F.lane;
#pragma unroll
        for (int j = 0; j < 8; ++j) { v2u w; w.x = pk2(v[j].x, v[j].y); w.y = pk2(v[j].z, v[j].w); o8[64 * j] = w; }
        if (F.lane < 8) SS[(size_t)m * 8 + F.lane] = F.lane == 0 ? s : 0.f;
    }
    float* BT = (float*)(ws + WS_BT);
    for (int i = blockIdx.x * 512 + F.tid; i < 16 * 256; i += F.G * 512) { const int head = i >> 8, rel = (i & 255) - 191; BT[i] = F.in[IN_RELB][t5_bucket(rel) * 16 + head]; }
    bf16* GWT = (bf16*)(ws + WS_GWT);
    for (int i = blockIdx.x * 512 + F.tid; i < 2 * 16 * 64 * 64; i += F.G * 512) { const int gate = i >> 16, hb = (i >> 12) & 15, jo = (i >> 6) & 63, ii = i & 63;
        GWT[i] = (bf16)f2bf(F.in[gate ? IN_GXW : IN_GAW][(size_t)(hb * 64 + ii) * 64 + jo]); }
}

__device__ __forceinline__ void ld8(const bf16* p, float (&o)[8]) { const v4u w = *(const GAS v4u*)p; o[0] = bflo(w.x); o[1] = bfhi(w.x); o[2] = bflo(w.y); o[3] = bfhi(w.y); o[4] = bflo(w.z); o[5] = bfhi(w.z); o[6] = bflo(w.w); o[7] = bfhi(w.w); }
__device__ __forceinline__ void swa_naive(Frame& F) {
    const bf16* PROJ = (const bf16*)(F.ws + WS_PROJ); bf16* Y = (bf16*)(F.ws + WS_Y); const float* BT = (const float*)(F.ws + WS_BT);
    for (int idx = blockIdx.x * 512 + F.tid; idx < SEQ * 16; idx += F.G * 512) {
        const int head = idx >> 13, tok = idx & (SEQ - 1), kvh = head >> 2, c = tok >> 6;
        float q[64], acc[64];
#pragma unroll
        for (int i = 0; i < 8; ++i) { float t[8]; ld8(PROJ + (size_t)tok * EVEN_IN + head * 64 + 8 * i, t);
#pragma unroll
            for (int j = 0; j < 8; ++j) { q[8 * i + j] = t[j] * 0.125f; acc[8 * i + j] = 0.f; } }
        float m = F.in[IN_SINKS][head], l = 1.0f;
        const int k0 = c >= 2 ? (c - 2) * 64 : 0, k1 = (c + 1) * 64;
        const float* bt = BT + head * 256;
        for (int j = k0; j < k1; ++j) {
            const bf16* kp = PROJ + (size_t)j * EVEN_IN + OFF_K + kvh * 64; float s = 0.f;
#pragma unroll
            for (int i = 0; i < 8; ++i) { float t[8]; ld8(kp + 8 * i, t);
#pragma unroll
                for (int e = 0; e < 8; ++e) s += q[8 * i + e] * t[e]; }
            s += bt[j - tok + 191];
            const float mn = fmaxf(m, s), corr = expf(m - mn), p = expf(s - mn);
            l = l * corr + p; m = mn;
            const bf16* vp = PROJ + (size_t)j * EVEN_IN + OFF_V + kvh * 64;
#pragma unroll
            for (int i = 0; i < 8; ++i) { float t[8]; ld8(vp + 8 * i, t);
#pragma unroll
                for (int e = 0; e < 8; ++e) acc[8 * i + e] = acc[8 * i + e] * corr + p * t[e]; }
        }
        const float inv = 1.0f / l;
#pragma unroll
        for (int i = 0; i < 8; ++i) { v4u w; w.x = pk2(acc[8 * i] * inv, acc[8 * i + 1] * inv); w.y = pk2(acc[8 * i + 2] * inv, acc[8 * i + 3] * inv); w.z = pk2(acc[8 * i + 4] * inv, acc[8 * i + 5] * inv); w.w = pk2(acc[8 * i + 6] * inv, acc[8 * i + 7] * inv);
            *(GAS v4u*)(Y + (size_t)tok * DM + head * 64 + 8 * i) = w; }
    }
}
__device__ __forceinline__ float softplusf(float z) { return fmaxf(z, 0.f) + log1pf(expf(-fabsf(z))); }
__device__ __forceinline__ float sigmoidf_(float z) { return 1.0f / (1.0f + expf(-z)); }
__device__ __forceinline__ float gelu_tanh(float x) { const float u = 0.7978845608028654f * (x + 0.044715f * x * x * x); return 0.5f * x * (1.0f + tanhf(u)); }
__device__ __forceinline__ void lru_naive(Frame& F) {
    if (blockIdx.x >= 16 || F.wave != 0) return;
    const bf16* PROJ = (const bf16*)(F.ws + WS_PROJ); bf16* Y = (bf16*)(F.ws + WS_Y);
    const int hb = blockIdx.x, lane = F.lane, c = hb * 64 + lane;
    float Wa[64], Wx[64];
#pragma unroll
    for (int i = 0; i < 64; ++i) { Wa[i] = F.in[IN_GAW][(size_t)(hb * 64 + i) * 64 + lane]; Wx[i] = F.in[IN_GXW][(size_t)(hb * 64 + i) * 64 + lane]; }
    const float ba = F.in[IN_GAB][c], bx = F.in[IN_GXB][c], cb = F.in[IN_CONVB][c];
    const float cw0 = F.in[IN_CONVW][c], cw1 = F.in[IN_CONVW][1024 + c], cw2 = F.in[IN_CONVW][2048 + c], cw3 = F.in[IN_CONVW][3072 + c];
    const float sp8 = 8.0f * softplusf(-F.in[IN_LAMBDA][c]);
    float x1 = 0.f, x2 = 0.f, x3 = 0.f, h = 0.f;
    for (int t0 = 0; t0 < SEQ; t0 += 8) {
        float xb[8], g[8];
#pragma unroll
        for (int u = 0; u < 8; ++u) { xb[u] = bflo((unsigned)PROJ[(size_t)(t0 + u) * EVEN_IN + OFF_X + c]); g[u] = bflo((unsigned)PROJ[(size_t)(t0 + u) * EVEN_IN + OFF_G + c]); }
#pragma unroll
        for (int u = 0; u < 8; ++u) {
            const float xt = xb[u], xc = cb + cw0 * x3 + cw1 * x2 + cw2 * x1 + cw3 * xt; x3 = x2; x2 = x1; x1 = xt;
            float ra = ba, rx = bx; const int xci = __builtin_bit_cast(int, xc);
#pragma unroll
            for (int i = 0; i < 64; ++i) { const float xi = __builtin_bit_cast(float, __builtin_amdgcn_readlane(xci, i)); ra += xi * Wa[i]; rx += xi * Wx[i]; }
            const float r = sigmoidf_(ra), ig = sigmoidf_(rx), log_a = -r * sp8, a = expf(log_a), mult = sqrtf(-expm1f(2.0f * log_a));
            h = a * h + mult * (ig * xc);
            Y[(size_t)(t0 + u) * DM + 1024 + c] = (bf16)f2bf(gelu_tanh(g[u]) * h);
        }
    }
}
__device__ __forceinline__ void sb_naive(Frame& F) {
    const bf16* PROJ = (const bf16*)(F.ws + WS_PROJ); bf16* Y = (bf16*)(F.ws + WS_Y);
    const int gt = blockIdx.x * 512 + F.tid, half = gt & 1;
    for (int pidx = gt >> 1; pidx < SEQ * 16; pidx += (F.G * 512) >> 1) {
        const int head = pidx >> 13, tok = pidx & (SEQ - 1);
        float q[64], acc[64];
#pragma unroll
        for (int i = 0; i < 8; ++i) { float t[8]; ld8(PROJ + (size_t)tok * ODD_IN + head * 128 + half * 64 + 8 * i, t);
#pragma unroll
            for (int j = 0; j < 8; ++j) { q[8 * i + j] = t[j] * 0.08838834764831845f; acc[8 * i + j] = 0.f; } }
        float stick = 0.f;
        for (int j = tok - 1; j >= 0; --j) {
            const bf16* kp = PROJ + (size_t)j * ODD_IN + 2048 + head * 128 + half * 64; float s = 0.f;
#pragma unroll
            for (int i = 0; i < 8; ++i) { float t[8]; ld8(kp + 8 * i, t);
#pragma unroll
                for (int e = 0; e < 8; ++e) s += q[8 * i + e] * t[e]; }
            const float z = s + __shfl_xor(s, 1);
            const float lk = -softplusf(z), w = expf(z + lk + stick);
            const bf16* vp = PROJ + (size_t)j * ODD_IN + 4096 + head * 128 + half * 64;
#pragma unroll
            for (int i = 0; i < 8; ++i) { float t[8]; ld8(vp + 8 * i, t);
#pragma unroll
                for (int e = 0; e < 8; ++e) acc[8 * i + e] += w * t[e]; }
            stick += lk;
            if (stick < -104.0f) break;
        }
#pragma unroll
        for (int i = 0; i < 8; ++i) { v4u w; w.x = pk2(acc[8 * i], acc[8 * i + 1]); w.y = pk2(acc[8 * i + 2], acc[8 * i + 3]); w.z = pk2(acc[8 * i + 4], acc[8 * i + 5]); w.w = pk2(acc[8 * i + 6], acc[8 * i + 7]);
            *(GAS v4u*)(Y + (size_t)tok * DM + head * 128 + half * 64 + 8 * i) = w; }
    }
}
__device__ __forceinline__ void final_norm(Frame& F) {
    const int gw = blockIdx.x * NWAVES + F.wave, NGW = F.G * NWAVES;
    const GAS f32x4* gp = (const GAS f32x4*)F.in[IN_FNORM] + F.lane;
    for (int m = gw; m < SEQ; m += NGW) {
        GAS f32x4* xr = (GAS f32x4*)(F.out + (size_t)m * DM) + F.lane;
        f32x4 v[8]; float s = 0.f;
#pragma unroll
        for (int j = 0; j < 8; ++j) { v[j] = xr[64 * j]; s += (v[j].x * v[j].x + v[j].y * v[j].y) + (v[j].z * v[j].z + v[j].w * v[j].w); }
        const float rstd = 1.0f / sqrtf(wave_sum(s) * (1.0f / DM) + 1e-6f);
#pragma unroll
        for (int j = 0; j < 8; ++j) xr[64 * j] = v[j] * rstd * gp[64 * j];
    }
}
typedef float f32x16 __attribute__((ext_vector_type(16)));
typedef short s16x8 __attribute__((ext_vector_type(8)));
typedef short s16x4 __attribute__((ext_vector_type(4)));
typedef __bf16 bf16x2v __attribute__((ext_vector_type(2)));
#define MFMA32(a, b, c) __builtin_amdgcn_mfma_f32_32x32x16_bf16((a), (b), (c), 0, 0, 0)
__device__ __forceinline__ int crow(int i, int h) { return (i & 3) + 8 * (i >> 2) + 4 * h; }
__device__ __forceinline__ unsigned pkbf(float a, float b) { bf16x2v v; v.x = (__bf16)a; v.y = (__bf16)b; return __builtin_bit_cast(unsigned, v); }
__device__ __forceinline__ s16x8 pack8(const float (&p)[16], int s) {
    v4u w; w.x = pkbf(p[8 * s], p[8 * s + 1]); w.y = pkbf(p[8 * s + 2], p[8 * s + 3]); w.z = pkbf(p[8 * s + 4], p[8 * s + 5]); w.w = pkbf(p[8 * s + 6], p[8 * s + 7]);
    return __builtin_bit_cast(s16x8, w);
}
__device__ __forceinline__ s16x8 tr_frag(const LAS unsigned char* p0, const LAS unsigned char* p1) {
    const s16x4 lo = __builtin_amdgcn_ds_read_tr16_b64_v4i16((LAS s16x4*)p0), hi = __builtin_amdgcn_ds_read_tr16_b64_v4i16((LAS s16x4*)p1);
    return __builtin_shufflevector(lo, hi, 0, 1, 2, 3, 4, 5, 6, 7);
}
__device__ __forceinline__ float fast_softplus(float z) { return fmaxf(z, 0.f) + __logf(1.0f + __expf(-fabsf(z))); }
__device__ __forceinline__ float fast_sigmoid(float z) { return __builtin_amdgcn_rcpf(1.0f + __expf(-z)); }

__device__ __forceinline__ void lru_local(Frame& F) {
    const bf16* PROJ = (const bf16*)(F.ws + WS_PROJ); float* HL = (float*)(F.ws + WS_HL); float* PA = (float*)(F.ws + WS_PA); const bf16* GWT = (const bf16*)(F.ws + WS_GWT);
    LAS unsigned char* xc16 = F.lds;
    LAS float* xc32 = (LAS float*)(F.lds + 18432);
    LAS float* comp = (LAS float*)(F.lds + 18432 + 34816);
    const int tid = F.tid, lane = F.lane, w = F.wave, ts = w & 3, ch = w >> 2, r = lane & 31, h = lane >> 5;
    for (int u = blockIdx.x; u < 1024; u += F.G) {
        const int hb = u & 15, k = u >> 4, t0 = k * 128;
        {
            const int tt = tid >> 2, cg = tid & 3, cbase = hb * 64 + cg * 16, t = t0 + tt;
            float xc[16];
            { const GAS f32x4* cbp = (const GAS f32x4*)(F.in[IN_CONVB] + cbase);
#pragma unroll
              for (int q4 = 0; q4 < 4; ++q4) { const f32x4 b = cbp[q4]; xc[4 * q4] = b[0]; xc[4 * q4 + 1] = b[1]; xc[4 * q4 + 2] = b[2]; xc[4 * q4 + 3] = b[3]; } }
#pragma unroll
            for (int d = 0; d < 4; ++d) { const int row = t - 3 + d;
                float xv[16];
                if (row >= 0) { float a8[8], b8[8]; ld8(PROJ + (size_t)row * EVEN_IN + OFF_X + cbase, a8); ld8(PROJ + (size_t)row * EVEN_IN + OFF_X + cbase + 8, b8);
#pragma unroll
                    for (int e = 0; e < 8; ++e) { xv[e] = a8[e]; xv[8 + e] = b8[e]; } }
                else {
#pragma unroll
                    for (int e = 0; e < 16; ++e) xv[e] = 0.f; }
                const GAS f32x4* cwp = (const GAS f32x4*)(F.in[IN_CONVW] + d * 1024 + cbase);
#pragma unroll
                for (int q4 = 0; q4 < 4; ++q4) { const f32x4 cw = cwp[q4];
#pragma unroll
                    for (int e = 0; e < 4; ++e) xc[4 * q4 + e] += cw[e] * xv[4 * q4 + e]; } }
#pragma unroll
            for (int q4 = 0; q4 < 4; ++q4) *(LAS f32x4*)(xc32 + tt * 68 + cg * 16 + 4 * q4) = (f32x4){xc[4 * q4], xc[4 * q4 + 1], xc[4 * q4 + 2], xc[4 * q4 + 3]};
#pragma unroll
            for (int q8 = 0; q8 < 2; ++q8) { v4u o; o.x = pkbf(xc[8 * q8], xc[8 * q8 + 1]); o.y = pkbf(xc[8 * q8 + 2], xc[8 * q8 + 3]); o.z = pkbf(xc[8 * q8 + 4], xc[8 * q8 + 5]); o.w = pkbf(xc[8 * q8 + 6], xc[8 * q8 + 7]);
                *(LAS v4u*)(xc16 + tt * 144 + cg * 32 + q8 * 16) = o; }
        }
        __syncthreads();
        f32x16 acc_a, acc_x;
#pragma unroll
        for (int i = 0; i < 16; ++i) { acc_a[i] = 0.f; acc_x[i] = 0.f; }
#pragma unroll
        for (int s = 0; s < 4; ++s) {
            const s16x8 af = *(const LAS s16x8*)(xc16 + (ts * 32 + r) * 144 + (16 * s + 8 * h) * 2);
            const s16x8 ba = *(const GAS s16x8*)(GWT + (size_t)((0 * 16 + hb) * 64 + ch * 32 + r) * 64 + 16 * s + 8 * h);
            const s16x8 bx = *(const GAS s16x8*)(GWT + (size_t)((1 * 16 + hb) * 64 + ch * 32 + r) * 64 + 16 * s + 8 * h);
            acc_a = MFMA32(af, ba, acc_a); acc_x = MFMA32(af, bx, acc_x);
        }
        const int c = hb * 64 + ch * 32 + r;
        const float gab = F.in[IN_GAB][c], gxb = F.in[IN_GXB][c], sp8 = 8.0f * softplusf(-F.in[IN_LAMBDA][c]);
        float pa[16], hl[16], gA[4], gU[4];
#pragma unroll
        for (int g = 0; g < 4; ++g) { float A = 1.f, U = 0.f;
#pragma unroll
            for (int e = 0; e < 4; ++e) { const int i = 4 * g + e; const float xcv = xc32[(ts * 32 + crow(i, h)) * 68 + ch * 32 + r];
                const float rg = fast_sigmoid(acc_a[i] + gab), ig = fast_sigmoid(acc_x[i] + gxb), log_a = -rg * sp8, a = __expf(log_a), mult = sqrtf(-expm1f(2.0f * log_a));
                U = a * U + mult * (ig * xcv); A *= a; pa[i] = A; hl[i] = U; }
            gA[g] = A; gU[g] = U; }
        float PAc = 1.f, Hc = 0.f;
#pragma unroll
        for (int g = 0; g < 4; ++g) { const float oA = __shfl_xor(gA[g], 32), oU = __shfl_xor(gU[g], 32);
            const float fA = h ? oA : gA[g], fU = h ? oU : gU[g], sA = h ? gA[g] : oA, sU = h ? gU[g] : oU;
            const float c0P = PAc, c0H = Hc; Hc = fA * Hc + fU; PAc *= fA; const float c1P = PAc, c1H = Hc; Hc = sA * Hc + sU; PAc *= sA;
            const float ciP = h ? c1P : c0P, ciH = h ? c1H : c0H;
#pragma unroll
            for (int e = 0; e < 4; ++e) { const int i = 4 * g + e; hl[i] += pa[i] * ciH; pa[i] *= ciP; } }
        if (h == 0) { comp[(ts * 64 + ch * 32 + r) * 2] = PAc; comp[(ts * 64 + ch * 32 + r) * 2 + 1] = Hc; }
        __syncthreads();
        float PAin = 1.f, Hin = 0.f;
        for (int t2 = 0; t2 < ts; ++t2) { const float A2 = comp[(t2 * 64 + ch * 32 + r) * 2], U2 = comp[(t2 * 64 + ch * 32 + r) * 2 + 1]; Hin = A2 * Hin + U2; PAin *= A2; }
#pragma unroll
        for (int i = 0; i < 16; ++i) { const size_t o = (size_t)(t0 + ts * 32 + crow(i, h)) * 1024 + c; HL[o] = hl[i] + pa[i] * Hin; PA[o] = pa[i] * PAin; }
        __syncthreads();
    }
}
__device__ __forceinline__ void lru_fix(Frame& F) {
    const bf16* PROJ = (const bf16*)(F.ws + WS_PROJ); const float* HL = (const float*)(F.ws + WS_HL); const float* PA = (const float*)(F.ws + WS_PA); bf16* Y = (bf16*)(F.ws + WS_Y);
    const int gw = blockIdx.x * NWAVES + F.wave, NGW = F.G * NWAVES;
    for (int it = gw; it < 4096; it += NGW) {
        const int cgp = it & 15, sub = (it >> 4) & 3, k = it >> 6, c = cgp * 64 + F.lane;
        float H = 0.f;
#pragma unroll 8
        for (int kk = 0; kk < k; ++kk) { const size_t row = (size_t)(kk * 128 + 127) * 1024 + c; H = PA[row] * H + HL[row]; }
#pragma unroll 8
        for (int tt = 0; tt < 32; ++tt) { const int t = k * 128 + sub * 32 + tt;
            const float hv = HL[(size_t)t * 1024 + c] + PA[(size_t)t * 1024 + c] * H, g = bflo((unsigned)PROJ[(size_t)t * EVEN_IN + OFF_G + c]);
            const float u2 = 1.5957691216057308f * (g + 0.044715f * g * g * g), ge = g * fast_sigmoid(u2);
            Y[(size_t)t * DM + 1024 + c] = (bf16)f2bf(ge * hv); }
    }
}
__device__ __forceinline__ void sb_attn(Frame& F) {
    const bf16* PROJ = (const bf16*)(F.ws + WS_PROJ); bf16* Y = (bf16*)(F.ws + WS_Y);
    LAS unsigned char* vt = F.lds + F.wave * 16384;
    const int lane = F.lane, r = lane & 31, h = lane >> 5;
    const int gw = blockIdx.x * NWAVES + F.wave, NGW = F.G * NWAVES;
    const LAS unsigned char* trb = vt + (4 * h + ((lane & 15) >> 2)) * 320 + (16 * ((lane >> 4) & 1) + 4 * (lane & 3)) * 2;
    for (int it = gw; it < 4096; it += NGW) {
        const int head = it & 15, qb = it >> 4, q0 = qb * 32;
        s16x8 qf[8];
#pragma unroll
        for (int s = 0; s < 8; ++s) qf[s] = *(const GAS s16x8*)(PROJ + (size_t)(q0 + r) * ODD_IN + head * 128 + 16 * s + 8 * h);
        f32x16 o[4];
#pragma unroll
        for (int db = 0; db < 4; ++db)
#pragma unroll
            for (int i = 0; i < 16; ++i) o[db][i] = 0.f;
        float carry = 0.f;
        for (int kt = qb; kt >= 0; --kt) {
            const int kb = kt * 32;
            v4u vreg[8];
#pragma unroll
            for (int i = 0; i < 8; ++i) { const int p = lane + 64 * i; vreg[i] = *(const GAS v4u*)(PROJ + (size_t)(kb + (p >> 4)) * ODD_IN + 4096 + head * 128 + (p & 15) * 8); }
            f32x16 sacc;
#pragma unroll
            for (int i = 0; i < 16; ++i) sacc[i] = 0.f;
#pragma unroll
            for (int s = 0; s < 8; ++s) { const s16x8 kf = *(const GAS s16x8*)(PROJ + (size_t)(kb + r) * ODD_IN + 2048 + head * 128 + 16 * s + 8 * h); sacc = MFMA32(kf, qf[s], sacc); }
#pragma unroll
            for (int i = 0; i < 8; ++i) { const int p = lane + 64 * i; *(LAS v4u*)(vt + (p >> 4) * 320 + (p & 15) * 16) = vreg[i]; }
            LDS_WAIT();
            const bool diag = (kt == qb);
            float z[16], lk[16], G[4];
#pragma unroll
            for (int g = 0; g < 4; ++g) { float gs = 0.f;
#pragma unroll
                for (int e = 0; e < 4; ++e) { const int i = 4 * g + e; z[i] = sacc[i] * 0.08838834764831845f; const bool valid = !diag || (crow(i, h) < r);
                    lk[i] = valid ? -fast_softplus(z[i]) : 0.f; z[i] = valid ? z[i] : -1e30f; gs += lk[i]; }
                G[g] = gs; }
            float run = carry, pw[16];
#pragma unroll
            for (int g = 3; g >= 0; --g) { const float og = __shfl_xor(G[g], 32);
                const float s1 = run; run += h ? G[g] : og;
                const float s0 = run; run += h ? og : G[g];
                float ex = h ? s1 : s0;
#pragma unroll
                for (int e = 3; e >= 0; --e) { const int i = 4 * g + e; pw[i] = __expf(z[i] + lk[i] + ex); ex += lk[i]; } }
            carry = run;
            const s16x8 p0 = pack8(pw, 0), p1 = pack8(pw, 1);
#pragma unroll
            for (int db = 0; db < 4; ++db) {
                const s16x8 v0 = tr_frag(trb + db * 64, trb + 8 * 320 + db * 64);
                const s16x8 v1 = tr_frag(trb + 16 * 320 + db * 64, trb + 24 * 320 + db * 64);
                o[db] = MFMA32(v0, p0, o[db]); o[db] = MFMA32(v1, p1, o[db]); }
            if (__all(carry < -104.0f)) break;
        }
#pragma unroll
        for (int db = 0; db < 4; ++db)
#pragma unroll
            for (int g = 0; g < 4; ++g) { v2u w; w.x = pkbf(o[db][4 * g], o[db][4 * g + 1]); w.y = pkbf(o[db][4 * g + 2], o[db][4 * g + 3]);
                *(GAS v2u*)(Y + (size_t)(q0 + r) * DM + head * 128 + db * 32 + 8 * g + 4 * h) = w; }
    }
}
__device__ __forceinline__ void swa_attn(Frame& F) {
    const bf16* PROJ = (const bf16*)(F.ws + WS_PROJ); bf16* Y = (bf16*)(F.ws + WS_Y); const float* BT = (const float*)(F.ws + WS_BT);
    LAS unsigned char* vt = F.lds + 65536 + F.wave * 8192;
    LAS float* btl = (LAS float*)(vt + 6144);
    const int lane = F.lane, r = lane & 31, h = lane >> 5;
    const int gw = blockIdx.x * NWAVES + F.wave, NGW = F.G * NWAVES;
    const LAS unsigned char* trb = vt + (4 * h + ((lane & 15) >> 2)) * 192 + (16 * ((lane >> 4) & 1) + 4 * (lane & 3)) * 2;
    for (int it = gw; it < 4096; it += NGW) {
        const int head = it & 15, qb = it >> 4, q0 = qb * 32, c = q0 >> 6, kvh = head >> 2, kbase = (c - 2) * 64, kt0 = c >= 2 ? 0 : (2 - c) * 2;
#pragma unroll
        for (int i = 0; i < 4; ++i) btl[lane + 64 * i] = BT[head * 256 + lane + 64 * i];
        LDS_WAIT();
        s16x8 qf[4];
#pragma unroll
        for (int s = 0; s < 4; ++s) qf[s] = *(const GAS s16x8*)(PROJ + (size_t)(q0 + r) * EVEN_IN + head * 64 + 16 * s + 8 * h);
        const float sink = F.in[IN_SINKS][head];
        float sc[6][16]; float m = sink;
#pragma unroll
        for (int kt = 0; kt < 6; ++kt) {
            if (kt >= kt0) {
                const int kb = kbase + kt * 32;
                f32x16 sacc;
#pragma unroll
                for (int i = 0; i < 16; ++i) sacc[i] = 0.f;
#pragma unroll
                for (int s = 0; s < 4; ++s) { const s16x8 kf = *(const GAS s16x8*)(PROJ + (size_t)(kb + r) * EVEN_IN + OFF_K + kvh * 64 + 16 * s + 8 * h); sacc = MFMA32(kf, qf[s], sacc); }
#pragma unroll
                for (int i = 0; i < 16; ++i) { const float v = sacc[i] * 0.125f + btl[kb + crow(i, h) - (q0 + r) + 191]; sc[kt][i] = v; m = fmaxf(m, v); }
            } else {
#pragma unroll
                for (int i = 0; i < 16; ++i) sc[kt][i] = -1e30f;
            }
        }
        m = fmaxf(m, __shfl_xor(m, 32));
        float l = 0.f;
#pragma unroll
        for (int kt = 0; kt < 6; ++kt)
#pragma unroll
            for (int i = 0; i < 16; ++i) { const float p = __expf(sc[kt][i] - m); sc[kt][i] = p; l += p; }
        l += __shfl_xor(l, 32); l += __expf(sink - m);
        f32x16 o[2];
#pragma unroll
        for (int db = 0; db < 2; ++db)
#pragma unroll
            for (int i = 0; i < 16; ++i) o[db][i] = 0.f;
#pragma unroll
        for (int kt = 0; kt < 6; ++kt) {
            if (kt >= kt0) {
                const int kb = kbase + kt * 32;
#pragma unroll
                for (int i = 0; i < 4; ++i) { const int p = lane + 64 * i; const v4u v = *(const GAS v4u*)(PROJ + (size_t)(kb + (p >> 3)) * EVEN_IN + OFF_V + kvh * 64 + (p & 7) * 8); *(LAS v4u*)(vt + (p >> 3) * 192 + (p & 7) * 16) = v; }
                LDS_WAIT();
                const s16x8 p0 = pack8(sc[kt], 0), p1 = pack8(sc[kt], 1);
#pragma unroll
                for (int db = 0; db < 2; ++db) {
                    const s16x8 v0 = tr_frag(trb + db * 64, trb + 8 * 192 + db * 64);
                    const s16x8 v1 = tr_frag(trb + 16 * 192 + db * 64, trb + 24 * 192 + db * 64);
                    o[db] = MFMA32(v0, p0, o[db]); o[db] = MFMA32(v1, p1, o[db]); }
            }
        }
        const float inv = 1.0f / l;
#pragma unroll
        for (int db = 0; db < 2; ++db)
#pragma unroll
            for (int g = 0; g < 4; ++g) { v2u w; w.x = pkbf(o[db][4 * g] * inv, o[db][4 * g + 1] * inv); w.y = pkbf(o[db][4 * g + 2] * inv, o[db][4 * g + 3] * inv);
                *(GAS v2u*)(Y + (size_t)(q0 + r) * DM + head * 64 + db * 32 + 8 * g + 4 * h) = w; }
    }
}

struct Args { const float* in[19]; float* out; unsigned char* ws; int ph_lo, ph_hi; };
__global__ void __launch_bounds__(NWAVES * 64, 2) hybrid_fwd(Args args) {
    extern __shared__ __attribute__((aligned(16))) unsigned char lds[];
    Frame F;
    F.lds = (LAS unsigned char*)lds;
    F.tid = threadIdx.x; F.lane = F.tid & 63; F.wave = __builtin_amdgcn_readfirstlane(F.tid >> 6);
    F.G = gridDim.x;
#pragma unroll
    for (int i = 0; i < 19; ++i) F.in[i] = args.in[i];
    F.out = args.out; F.ws = args.ws;
    unsigned char* ws = args.ws;
    for (int u = F.tid; u < (LDS_BYTES - LDSCTL_OFF) / 4; u += NWAVES * 64) ((LAS unsigned*)(F.lds + LDSCTL_OFF))[u] = 0u;
    __syncthreads();
    const int lo = args.ph_lo, hi = args.ph_hi;
    XcdBarrier bar; bar.bar = (unsigned*)(ws + WS_CTL) + CW_BAR; bar.x = 0; bar.st = nullptr;
    if (hi - lo > 1) bar = xcd_barrier_post((unsigned*)(ws + WS_CTL) + CW_BAR, (volatile LAS unsigned*)(F.lds + MISC_OFF) + 8);
#define IN(k) (lo <= (k) && (k) < hi)
#define SEAM(k) do { if (IN(k) && IN((k) + 1)) xcd_barrier(bar); } while (0)
    bf16* XN = (bf16*)(ws + WS_XN); bf16* Yb = (bf16*)(ws + WS_Y); bf16* PROJ = (bf16*)(ws + WS_PROJ); bf16* ACT = (bf16*)(ws + WS_ACT); float* SS = (float*)(ws + WS_SS);

    if (IN(0)) { p0_prologue(F); } SEAM(0);
    if (IN(1)) { pg8::Gemm g{XN, (const bf16*)(ws + WS_WIN0), SEQ, EVEN_IN, DM}; pg8::StaticOrder S; S.init(SEQ, EVEN_IN, F.G, (int)blockIdx.x);
        pg8::EpiBf16<0> E{PROJ, EVEN_IN, SS}; pg8::gemm_phase<pg8::EpiBf16<0>, pg8::StaticOrder, true, true>(F.lds + RING_OFF, g, S, E); } SEAM(1);
    if (IN(2)) { lru_local(F); swa_attn(F); } SEAM(2);
    if (IN(3)) { lru_fix(F); } SEAM(3);
    if (IN(4)) { pg8::Gemm g{Yb, (const bf16*)(ws + WS_WOUT0), SEQ, DM, DM}; pg8::StaticOrder S; S.init(SEQ, DM, F.G, (int)blockIdx.x);
        pg8::EpiRes E{F.in[IN_X], F.out, XN, SS, DM}; pg8::gemm_phase<pg8::EpiRes, pg8::StaticOrder, false, true>(F.lds + RING_OFF, g, S, E); } SEAM(4);
    if (IN(5)) { pg8::Gemm g{XN, (const bf16*)(ws + WS_WUP0), SEQ, DFF, DM}; pg8::StaticOrder S; S.init(SEQ, DFF, F.G, (int)blockIdx.x);
        pg8::EpiBf16<1> E{ACT, DFF, SS}; pg8::gemm_phase<pg8::EpiBf16<1>, pg8::StaticOrder, true, true>(F.lds + RING_OFF, g, S, E); } SEAM(5);
    if (IN(6)) { pg8::Gemm g{ACT, (const bf16*)(ws + WS_WDN0), SEQ, DM, DFF}; pg8::StaticOrder S; S.init(SEQ, DM, F.G, (int)blockIdx.x);
        pg8::EpiRes E{F.out, F.out, XN, SS, DM}; pg8::gemm_phase<pg8::EpiRes, pg8::StaticOrder, false, true>(F.lds + RING_OFF, g, S, E); } SEAM(6);
    if (IN(7)) { pg8::Gemm g{XN, (const bf16*)(ws + WS_WIN1), SEQ, ODD_IN, DM}; pg8::StaticOrder S; S.init(SEQ, ODD_IN, F.G, (int)blockIdx.x);
        pg8::EpiBf16<0> E{PROJ, ODD_IN, SS}; pg8::gemm_phase<pg8::EpiBf16<0>, pg8::StaticOrder, true, true>(F.lds + RING_OFF, g, S, E); } SEAM(7);
    if (IN(8)) { sb_attn(F); } SEAM(8);
    if (IN(9)) { pg8::Gemm g{Yb, (const bf16*)(ws + WS_WOUT1), SEQ, DM, DM}; pg8::StaticOrder S; S.init(SEQ, DM, F.G, (int)blockIdx.x);
        pg8::EpiRes E{F.out, F.out, XN, SS, DM}; pg8::gemm_phase<pg8::EpiRes, pg8::StaticOrder, false, true>(F.lds + RING_OFF, g, S, E); } SEAM(9);
    if (IN(10)) { pg8::Gemm g{XN, (const bf16*)(ws + WS_WUP1), SEQ, DFF, DM}; pg8::StaticOrder S; S.init(SEQ, DFF, F.G, (int)blockIdx.x);
        pg8::EpiBf16<1> E{ACT, DFF, SS}; pg8::gemm_phase<pg8::EpiBf16<1>, pg8::StaticOrder, true, true>(F.lds + RING_OFF, g, S, E); } SEAM(10);
    if (IN(11)) { pg8::Gemm g{ACT, (const bf16*)(ws + WS_WDN1), SEQ, DM, DFF}; pg8::StaticOrder S; S.init(SEQ, DM, F.G, (int)blockIdx.x);
        pg8::EpiRes E{F.out, F.out, XN, SS, DM}; pg8::gemm_phase<pg8::EpiRes, pg8::StaticOrder, false, true>(F.lds + RING_OFF, g, S, E); } SEAM(11);
    if (IN(12)) { final_norm(F); }
#undef IN
#undef SEAM
}

extern "C" void kernel_launch(void* const* d_in, const int* in_sizes, int n_in, void* d_out, int out_size, void* d_ws, size_t ws_size, hipStream_t stream) {
    static int grid = 0;
    if (grid == 0) {
        if (n_in != 19 || in_sizes[0] != SEQ * DM || out_size != SEQ * DM || ws_size < WS_END) { fprintf(stderr, "kernel_launch: unexpected shapes (n_in %d, in0 %d, out %d, ws %zu); nothing launched\n", n_in, n_in > 0 ? in_sizes[0] : -1, out_size, ws_size); grid = -1; return; }
        int dev = 0, cus = 0, per_cu = 0;
        if (hipGetDevice(&dev) != hipSuccess || hipDeviceGetAttribute(&cus, hipDeviceAttributeMultiprocessorCount, dev) != hipSuccess) { fprintf(stderr, "kernel_launch: device query failed\n"); grid = -1; return; }
        if (hipFuncSetAttribute((const void*)hybrid_fwd, hipFuncAttributeMaxDynamicSharedMemorySize, LDS_BYTES) != hipSuccess) { fprintf(stderr, "kernel_launch: hipFuncSetAttribute failed\n"); grid = -1; return; }
        if (hipOccupancyMaxActiveBlocksPerMultiprocessor(&per_cu, (const void*)hybrid_fwd, NWAVES * 64, LDS_BYTES) != hipSuccess || per_cu < 1) { fprintf(stderr, "kernel_launch: occupancy query reports %d workgroups per CU\n", per_cu); per_cu = 1; }
        (void)hipGetLastError();
        grid = cus;
        if (grid != 256) fprintf(stderr, "kernel_launch: %d CUs; the residual GEMM phases need exactly 256 workgroups\n", grid);
    }
    if (grid < 0) return;
    (void)hipMemsetAsync((char*)d_ws + WS_CTL, 0, CTL_ZERO_BYTES, stream);
    Args a{};
    for (int i = 0; i < 19; ++i) a.in[i] = (const float*)d_in[i];
    a.out = (float*)d_out; a.ws = (unsigned char*)d_ws;
#if MK_N_LAUNCHES == 1
    a.ph_lo = 0; a.ph_hi = N_PHASES;
    hipLaunchKernelGGL(hybrid_fwd, dim3(grid), dim3(NWAVES * 64), LDS_BYTES, stream, a);
#else
    for (int p = 0; p < N_PHASES; ++p) { a.ph_lo = p; a.ph_hi = p + 1; hipLaunchKernelGGL(hybrid_fwd, dim3(grid), dim3(NWAVES * 64), LDS_BYTES, stream, a); }
#endif
}
```

```cpp
#include <hip/hip_runtime.h>
#include <cstdio>
#include <cstdint>
namespace pg8 {
#define PG8_LAS __attribute__((address_space(3)))
typedef unsigned short bf16_t;
typedef short bf16x8 __attribute__((ext_vector_type(8)));
typedef float f32x4 __attribute__((ext_vector_type(4)));
typedef unsigned u32x4 __attribute__((ext_vector_type(4)));
constexpr int BM = 256, BK = 64, HALF = 128, HTB = HALF * BK * 2  , STAGE_BYTES = 8 * HTB, NXCD = 8, WGM = 8;

__host__ __device__ __forceinline__ int lds_byte(int r, int c) { const int st = (r >> 4) * 2 + (c >> 5), rr = r & 15, cc = c & 31, ob = rr * 64 + cc * 2; return st * 1024 + (ob ^ (((ob >> 9) & 1) << 5)); }
__host__ __device__ __forceinline__ void stage_rc(int b, int& R, int& C) { const int st = b / 1024, sb = b % 1024, swz = sb ^ (((sb >> 9) & 1) << 5); R = (st >> 1) * 16 + swz / 64; C = (st & 1) * 32 + (swz % 64) / 2; }
__host__ __device__ __forceinline__ int perm32(int rho) { const int n = rho >> 4, i = rho & 15; return 8 * (i >> 2) + 4 * n + (i & 3); }

struct Unit { int pm, pn; };
struct Gemm { const bf16_t* A; const bf16_t* Bt; int M, N, K; };

struct StaticOrder {
    int nM, nN, nwg, G, c;
    __host__ __device__ void init(int M, int N, int G_, int c_) { nM = M / BM; nN = N / BM; nwg = nM * nN; G = G_; c = c_; }
    __host__ __device__ bool next(int i, Unit& u) const {
        const long L = (long)i * G + c; if (L >= nwg) return false;
        int wgid = (int)L; { const int q = nwg / NXCD, r = nwg % NXCD, xcd = wgid % NXCD, off = wgid / NXCD; wgid = (xcd < r ? xcd * (q + 1) : r * (q + 1) + (xcd - r) * q) + off; }
        const int nig = WGM * nN, gid = wgid / nig, fm = gid * WGM, gsz = (nM - fm) < WGM ? (nM - fm) : WGM;
        u.pm = fm + ((wgid % nig) % gsz); u.pn = (wgid % nig) / gsz; return true;
    }
    __device__ __forceinline__ void a_ready(const Unit&) const {}
    __device__ __forceinline__ void done(const Unit&) const {}
};

__device__ __forceinline__ unsigned cvt_pk_bf16(float lo, float hi) { unsigned r; asm volatile("v_cvt_pk_bf16_f32 %0, %1, %2" : "=v"(r) : "v"(lo), "v"(hi)); return r; }
constexpr float RMS_EPS = 1e-6f;
__device__ __forceinline__ float row_rstd(const float* ss, int r) {
    const f32x4 a = *(const f32x4*)(ss + (size_t)r * 8), b = *(const f32x4*)(ss + (size_t)r * 8 + 4);
    const float s = ((a[0] + a[1]) + (a[2] + a[3])) + ((b[0] + b[1]) + (b[2] + b[3]));
    return 1.0f / sqrtf(s * (1.0f / 2048.0f) + RMS_EPS);
}
template <int ACT> struct EpiBf16 {
    static constexpr bool PERM = true, AFTER_DRAIN = false;
    bf16_t* O; int ldc; const float* ss;
    __device__ __forceinline__ void operator()(const f32x4 (&acc)[2][2][4][2], const Unit& u, int wr, int wc, int fr, int fq) const {
        const int row0 = u.pm * BM + wr * 64 + fr, col0 = u.pn * BM + wc * 32 + 8 * fq;
#pragma unroll
        for (int ai = 0; ai < 2; ++ai)
#pragma unroll
            for (int m = 0; m < 4; ++m) { const int r = row0 + ai * HALF + m * 16; const float rs = ss ? row_rstd(ss, r) : 1.0f;
                bf16_t* rowp = O + (size_t)r * ldc + col0;
#pragma unroll
                for (int bj = 0; bj < 2; ++bj) { f32x4 v0 = acc[ai][bj][m][0] * rs, v1 = acc[ai][bj][m][1] * rs;
                    if (ACT == 1) {
#pragma unroll
                        for (int j = 0; j < 4; ++j) { const float a = fmaxf(v0[j], 0.f), b = fmaxf(v1[j], 0.f); v0[j] = a * a; v1[j] = b * b; } }
                    u32x4 w; w.x = cvt_pk_bf16(v0[0], v0[1]); w.y = cvt_pk_bf16(v0[2], v0[3]); w.z = cvt_pk_bf16(v1[0], v1[1]); w.w = cvt_pk_bf16(v1[2], v1[3]);
                    *(u32x4*)(rowp + bj * HALF) = w; } }
    }
};
struct EpiRes {
    static constexpr bool PERM = true, AFTER_DRAIN = true;
    const float* base; float* out; bf16_t* xn; float* ss; int ldc;
    __device__ __forceinline__ void operator()(const f32x4 (&)[2][2][4][2], const Unit&, int, int, int, int) const {}
    __device__ __forceinline__ void fused(f32x4 (&acc)[2][2][4][2], const Unit& u, int wr, int wc, int fr, int fq, PG8_LAS unsigned char* lds, int wid, int lane) const {
        PG8_LAS float* P = (PG8_LAS float*)lds;
#pragma unroll
        for (int ai = 0; ai < 2; ++ai)
#pragma unroll
            for (int m = 0; m < 4; ++m) { const int rl = ai * HALF + wr * 64 + m * 16 + fr; const size_t off = (size_t)(u.pm * BM + rl) * ldc + u.pn * BM + wc * 32 + 8 * fq; float s = 0.f;
#pragma unroll
                for (int bj = 0; bj < 2; ++bj) { const f32x4 b0 = *(const f32x4*)(base + off + bj * HALF), b1 = *(const f32x4*)(base + off + bj * HALF + 4);
                    const f32x4 v0 = acc[ai][bj][m][0] + b0, v1 = acc[ai][bj][m][1] + b1;
                    *(f32x4*)(out + off + bj * HALF) = v0; *(f32x4*)(out + off + bj * HALF + 4) = v1;
                    u32x4 w; w.x = cvt_pk_bf16(v0[0], v0[1]); w.y = cvt_pk_bf16(v0[2], v0[3]); w.z = cvt_pk_bf16(v1[0], v1[1]); w.w = cvt_pk_bf16(v1[2], v1[3]);
                    *(u32x4*)(xn + off + bj * HALF) = w;
                    s += ((v0[0] * v0[0] + v0[1] * v0[1]) + (v0[2] * v0[2] + v0[3] * v0[3])) + ((v1[0] * v1[0] + v1[1] * v1[1]) + (v1[2] * v1[2] + v1[3] * v1[3])); }
                s += __shfl_xor(s, 16); s += __shfl_xor(s, 32);
                if (fq == 0) P[rl * 4 + wc] = s;
                asm volatile("" ::: "memory"); }
        asm volatile("s_waitcnt lgkmcnt(0)" ::: "memory"); __builtin_amdgcn_s_barrier(); asm volatile("" ::: "memory");
        const int t = wid * 64 + lane;
        if (t < 256) { const f32x4 p = *(const PG8_LAS f32x4*)(P + t * 4); ss[(size_t)(u.pm * BM + t) * 8 + u.pn] = (p[0] + p[1]) + (p[2] + p[3]); }
        asm volatile("s_waitcnt lgkmcnt(0)" ::: "memory"); __builtin_amdgcn_s_barrier(); asm volatile("" ::: "memory");
    }
};

template <class Epi, class Sched, bool ALIGN_EPI = false, bool SP2 = false>
__device__ __forceinline__ void gemm_phase(PG8_LAS unsigned char* lds, const Gemm g, const Sched& S, const Epi& E) {
    const int tid = threadIdx.x, wid = __builtin_amdgcn_readfirstlane(tid >> 6), lane = tid & 63, wr = wid >> 2, wc = wid & 3, fr = lane & 15, fq = lane >> 4;
    const int K = g.K, nt = K / BK;
    unsigned voffA[2], voffB[2];
#pragma unroll
    for (int i = 0; i < 2; ++i) { int R, C; stage_rc(tid * 16 + i * 8192, R, C); const int Rb = Epi::PERM ? ((R & ~31) + perm32(R & 31)) : R;
        voffA[i] = (unsigned)(R * K + C) * 2u; voffB[i] = (unsigned)(Rb * K + C) * 2u; }
    const size_t kstep = (size_t)(BK * 2);
    const size_t hstep = (size_t)HALF * K * 2;
    const size_t tstep = 2 * hstep;
    const unsigned ldsw = (unsigned)wid * 1024u;
    const int aoff = lds_byte(wr * 64 + fr, fq * 8), boff = lds_byte(wc * 32 + fr, fq * 8);
#define PG8_SA(b, h) (((b) * 2 + (h)) * HTB)
#define PG8_SB(b, h) ((4 + (b) * 2 + (h)) * HTB)
#define PG8_STAGE(bufoff, gbase, voff) do { _Pragma("unroll") for (int _i = 0; _i < 2; ++_i) \
        __builtin_amdgcn_global_load_lds((const unsigned*)((const char*)(gbase) + (voff)[_i]), (PG8_LAS unsigned*)(lds + (bufoff) + ldsw + _i * 8192), 16, 0, 0); } while (0)
#define PG8_LDA(dst, b, h) do { _Pragma("unroll") for (int m = 0; m < 4; ++m) _Pragma("unroll") for (int k = 0; k < 2; ++k) dst[m][k] = *(const PG8_LAS bf16x8*)(lds + PG8_SA(b, h) + aoff + m * 2048 + k * 1024); } while (0)
#define PG8_LDB(dst, b, h) do { _Pragma("unroll") for (int n = 0; n < 2; ++n) _Pragma("unroll") for (int k = 0; k < 2; ++k) dst[n][k] = *(const PG8_LAS bf16x8*)(lds + PG8_SB(b, h) + boff + n * 2048 + k * 1024); } while (0)
#define PG8_MMA(ai, bj, At, Bt) do { __builtin_amdgcn_s_setprio(1); _Pragma("unroll") for (int m = 0; m < 4; ++m) _Pragma("unroll") for (int n = 0; n < 2; ++n) _Pragma("unroll") for (int k = 0; k < 2; ++k) \
        acc[ai][bj][m][n] = __builtin_amdgcn_mfma_f32_16x16x32_bf16(Bt[n][k], At[m][k], acc[ai][bj][m][n], 0, 0, 0); __builtin_amdgcn_s_setprio(0); } while (0)
#define PG8_WAIT_V(n) asm volatile("s_waitcnt vmcnt(" #n ")" ::: "memory")
#define PG8_WAIT_L(n) asm volatile("s_waitcnt lgkmcnt(" #n ")" ::: "memory")
#define PG8_BAR __builtin_amdgcn_s_barrier()
#define PG8_SCHED __builtin_amdgcn_sched_barrier(0)
    Unit cur, nxt; int ui = 0;
    if (!S.next(0, cur)) return;
    f32x4 acc[2][2][4][2];
#pragma unroll
    for (int a = 0; a < 2; ++a)
#pragma unroll
        for (int b = 0; b < 2; ++b)
#pragma unroll
            for (int m = 0; m < 4; ++m)
#pragma unroll
                for (int n = 0; n < 2; ++n) acc[a][b][m][n] = (f32x4){0.f, 0.f, 0.f, 0.f};
    bf16x8 At[4][2], B0[2][2], B1[2][2];
    const char* cA = (const char*)g.A + (size_t)cur.pm * tstep; const char* cB = (const char*)g.Bt + (size_t)cur.pn * tstep;
    S.a_ready(cur);
    if constexpr (SP2) {
        PG8_STAGE(PG8_SB(0, 0), cB, voffB); PG8_STAGE(PG8_SB(0, 1), cB + hstep, voffB); PG8_STAGE(PG8_SA(0, 0), cA, voffA); PG8_STAGE(PG8_SA(0, 1), cA + hstep, voffA);
        if (wr == 1) PG8_BAR;
        PG8_WAIT_V(2); PG8_BAR;
        PG8_STAGE(PG8_SB(1, 0), cB + kstep, voffB); PG8_STAGE(PG8_SA(1, 0), cA + kstep, voffA); PG8_STAGE(PG8_SB(1, 1), cB + hstep + kstep, voffB);
        PG8_WAIT_V(6); PG8_BAR;
    } else {
        PG8_STAGE(PG8_SB(0, 0), cB, voffB); PG8_STAGE(PG8_SA(0, 0), cA, voffA); PG8_STAGE(PG8_SB(0, 1), cB + hstep, voffB); PG8_STAGE(PG8_SA(0, 1), cA + hstep, voffA);
        if (wr == 1) PG8_BAR;
        PG8_WAIT_V(4); PG8_BAR;
        PG8_STAGE(PG8_SB(1, 0), cB + kstep, voffB); PG8_STAGE(PG8_SA(1, 0), cA + kstep, voffA); PG8_STAGE(PG8_SB(1, 1), cB + hstep + kstep, voffB);
        PG8_WAIT_V(6); PG8_BAR;
    }
    for (;;) {
        const bool has_next = S.next(ui + 1, nxt);
        const char* nA = has_next ? (const char*)g.A + (size_t)nxt.pm * tstep : cA; const char* nB = has_next ? (const char*)g.Bt + (size_t)nxt.pn * tstep : cB;
        for (int t = 0; t < nt; t += 2) {
            const bool last = (t == nt - 2);
            const char* a1 = cA + (size_t)(t + 1) * kstep;
            const char* a2 = last ? nA : cA + (size_t)(t + 2) * kstep; const char* b2 = last ? nB : cB + (size_t)(t + 2) * kstep;
            const char* a3 = a2 + kstep; const char* b3 = b2 + kstep;
            if (last && has_next) S.a_ready(nxt);
            if constexpr (SP2) {
            PG8_LDB(B0, 0, 0); PG8_LDB(B1, 0, 1); PG8_SCHED; PG8_LDA(At, 0, 0); PG8_STAGE(PG8_SA(1, 1), a1 + hstep, voffA);
            PG8_WAIT_V(8); PG8_WAIT_L(0); PG8_BAR; PG8_MMA(0, 0, At, B0); PG8_MMA(0, 1, At, B1); PG8_BAR; PG8_SCHED;
            PG8_LDA(At, 0, 1); PG8_STAGE(PG8_SB(0, 0), b2, voffB); PG8_STAGE(PG8_SB(0, 1), b2 + hstep, voffB); PG8_STAGE(PG8_SA(0, 0), a2, voffA);
            PG8_WAIT_V(8); PG8_WAIT_L(0); PG8_BAR; PG8_MMA(1, 0, At, B0); PG8_MMA(1, 1, At, B1); PG8_BAR; PG8_SCHED;
            PG8_LDB(B0, 1, 0); PG8_LDB(B1, 1, 1); PG8_SCHED; PG8_LDA(At, 1, 0); PG8_STAGE(PG8_SA(0, 1), a2 + hstep, voffA);
            PG8_WAIT_V(8); PG8_WAIT_L(0); PG8_BAR; PG8_MMA(0, 0, At, B0); PG8_MMA(0, 1, At, B1); PG8_BAR; PG8_SCHED;
            PG8_LDA(At, 1, 1); PG8_STAGE(PG8_SB(1, 0), b3, voffB); PG8_STAGE(PG8_SB(1, 1), b3 + hstep, voffB); PG8_STAGE(PG8_SA(1, 0), a3, voffA);
            PG8_WAIT_V(8); PG8_WAIT_L(0); PG8_BAR; PG8_MMA(1, 0, At, B0); PG8_MMA(1, 1, At, B1); PG8_BAR; PG8_SCHED;
            } else {
            PG8_LDB(B0, 0, 0); PG8_SCHED; PG8_LDA(At, 0, 0); PG8_STAGE(PG8_SA(1, 1), a1 + hstep, voffA);
            PG8_WAIT_L(8); PG8_BAR; PG8_WAIT_L(0); PG8_MMA(0, 0, At, B0); PG8_BAR; PG8_SCHED;
            PG8_LDB(B1, 0, 1); PG8_STAGE(PG8_SB(0, 0), b2, voffB);
            PG8_BAR; PG8_WAIT_L(0); PG8_MMA(0, 1, At, B1); PG8_BAR;
            PG8_LDA(At, 0, 1); PG8_STAGE(PG8_SA(0, 0), a2, voffA);
            PG8_BAR; PG8_WAIT_L(0); PG8_MMA(1, 0, At, B0); PG8_BAR; PG8_SCHED;
            PG8_STAGE(PG8_SB(0, 1), b2 + hstep, voffB);
            PG8_WAIT_V(6); PG8_BAR; PG8_MMA(1, 1, At, B1); PG8_BAR;
            PG8_LDB(B0, 1, 0); PG8_SCHED; PG8_LDA(At, 1, 0); PG8_STAGE(PG8_SA(0, 1), a2 + hstep, voffA);
            PG8_WAIT_L(8); PG8_BAR; PG8_WAIT_L(0); PG8_MMA(0, 0, At, B0); PG8_BAR; PG8_SCHED;
            PG8_LDB(B1, 1, 1); PG8_STAGE(PG8_SB(1, 0), b3, voffB);
            PG8_BAR; PG8_WAIT_L(0); PG8_MMA(0, 1, At, B1); PG8_BAR;
            PG8_LDA(At, 1, 1); PG8_STAGE(PG8_SA(1, 0), a3, voffA);
            PG8_BAR; PG8_WAIT_L(0); PG8_MMA(1, 0, At, B0); PG8_BAR; PG8_SCHED;
            PG8_STAGE(PG8_SB(1, 1), b3 + hstep, voffB);
            PG8_WAIT_V(6); PG8_BAR; PG8_MMA(1, 1, At, B1); PG8_BAR;
            }
        }
        if constexpr (ALIGN_EPI) { if (wr == 0) PG8_BAR; }
        if constexpr (!Epi::AFTER_DRAIN) { E(acc, cur, wr, wc, fr, fq); S.done(cur); }
        if (!has_next) break;
#pragma unroll
        for (int a = 0; a < 2; ++a)
#pragma unroll
            for (int b = 0; b < 2; ++b)
#pragma unroll
                for (int m = 0; m < 4; ++m)
#pragma unroll
                    for (int n = 0; n < 2; ++n) acc[a][b][m][n] = (f32x4){0.f, 0.f, 0.f, 0.f};
        cur = nxt; cA = nA; cB = nB; ++ui;
        if constexpr (ALIGN_EPI) { if (wr == 1) PG8_BAR; }
    }
    PG8_WAIT_V(0);
    if constexpr (!ALIGN_EPI) { if (wr == 0) PG8_BAR; }
    PG8_BAR;
    if constexpr (Epi::AFTER_DRAIN) { E.fused(acc, cur, wr, wc, fr, fq, lds, wid, lane); S.done(cur); }
#undef PG8_SA
#undef PG8_SB
#undef PG8_STAGE
#undef PG8_LDA
#undef PG8_LDB
#undef PG8_MMA
#undef PG8_WAIT_V
#undef PG8_WAIT_L
#undef PG8_BAR
#undef PG8_SCHED
}
}

constexpr int NWAVES = 8;
constexpr int SEQ = 8192, DM = 2048, DFF = 8192, EVEN_IN = 3584, ODD_IN = 6144;
constexpr int OFF_K = 1024, OFF_V = 1280, OFF_X = 1536, OFF_G = 2560;
#ifndef MK_N_LAUNCHES
#define MK_N_LAUNCHES 1
#endif
constexpr int N_PHASES = 13;
constexpr size_t MiB = 1u << 20;
constexpr size_t WS_CTL = 0, CTL_ZERO_BYTES = 64 * 1024;
constexpr size_t WS_SS = 1 * MiB;
constexpr size_t WS_BT = 1 * MiB + 512 * 1024;
constexpr size_t WS_GWT = 1 * MiB + 768 * 1024;
constexpr size_t WS_WIN0 = 2 * MiB, WS_WOUT0 = 16 * MiB, WS_WUP0 = 24 * MiB, WS_WDN0 = 56 * MiB, WS_WIN1 = 88 * MiB, WS_WOUT1 = 112 * MiB, WS_WUP1 = 120 * MiB, WS_WDN1 = 152 * MiB;
constexpr size_t WS_XN = 184 * MiB;
constexpr size_t WS_Y = 216 * MiB;
constexpr size_t WS_PROJ = 248 * MiB;
constexpr size_t WS_HL = 344 * MiB, WS_PA = 376 * MiB;
constexpr size_t WS_ACT = 248 * MiB;
constexpr size_t WS_END = 408 * MiB;
constexpr int CW_BAR = 1024;

constexpr int RING_OFF = 0, RING_BYTES = 131072;
constexpr int LDSCTL_OFF = RING_BYTES, MISC_OFF = LDSCTL_OFF + 320;
constexpr int LDS_BYTES = 147456;

#define GAS __attribute__((address_space(1)))
#define LAS __attribute__((address_space(3)))
typedef unsigned short bf16;
typedef unsigned v4u __attribute__((ext_vector_type(4)));
typedef unsigned v2u __attribute__((ext_vector_type(2)));
typedef float f32x4 __attribute__((ext_vector_type(4)));
#define LDS_WAIT() asm volatile("s_waitcnt lgkmcnt(0)" ::: "memory")
#define VM_WAIT() asm volatile("s_waitcnt vmcnt(0)" ::: "memory")
__device__ __forceinline__ unsigned f2bf(float f) { unsigned u = __builtin_bit_cast(unsigned, f); return (u + 0x7fffu + ((u >> 16) & 1u)) >> 16; }
__device__ __forceinline__ unsigned pk2(float lo, float hi) { return f2bf(lo) | (f2bf(hi) << 16); }
__device__ __forceinline__ float bflo(unsigned w) { return __builtin_bit_cast(float, w << 16); }
__device__ __forceinline__ float bfhi(unsigned w) { return __builtin_bit_cast(float, w & 0xffff0000u); }

#define XB_TMO      128
#define XB_XCNT(j)  (256  + 64 * (j))
#define XB_XSUB(j)  (1280 + 64 * (j))
#define XB_XGEN(j)  (2304 + 64 * (j))
#define XB_TOP      3328
#define XB_TOPGEN   3392
#define XCD_BAR_WORDS 3456
#define XB_SPIN_CAP (1u << 22)

__device__ __forceinline__ unsigned xb_ld(unsigned* p)              { return __hip_atomic_load(p, __ATOMIC_RELAXED, __HIP_MEMORY_SCOPE_AGENT); }
__device__ __forceinline__ unsigned xb_add(unsigned* p, unsigned v) { return __hip_atomic_fetch_add(p, v, __ATOMIC_RELAXED, __HIP_MEMORY_SCOPE_AGENT); }
__device__ __forceinline__ unsigned xb_xcc_id() { return (unsigned)__builtin_amdgcn_s_getreg((3 << 11) | 20) & 0xFu; }
#define XB_SPIN(cond, bar) do { unsigned _sp = 0; while (cond) { __builtin_amdgcn_s_sleep(1); \
    if ((++_sp & 255u) == 0u) { if (xb_ld(&(bar)[XB_TMO])) break; if (_sp > XB_SPIN_CAP) { atomicAdd(&(bar)[XB_TMO], 1u); break; } } } } while (0)

struct XcdBarrier {
    unsigned* bar; unsigned x;
    volatile LAS unsigned* st;
};

__device__ __forceinline__ XcdBarrier xcd_barrier_post(unsigned* bar, volatile LAS unsigned* st) {
    XcdBarrier b; b.bar = bar; b.x = xb_xcc_id(); b.st = st;
    if (threadIdx.x == 0) (void)xb_add(&bar[XB_XCNT(b.x)], 1u);
    return b;
}
__device__ __forceinline__ void xcd_barrier_complete(unsigned* bar, unsigned x, unsigned& nloc, unsigned& nx) {
    const unsigned G = gridDim.x * gridDim.y * gridDim.z;
    unsigned sum, cnt, mine, sp = 0u;
    for (;;) {
        sum = 0u; cnt = 0u; mine = 0u;
#pragma unroll
        for (unsigned j = 0; j < 16; ++j) { const unsigned c = xb_ld(&bar[XB_XCNT(j)]); sum += c; cnt += (c > 0u) ? 1u : 0u; mine = (j == x) ? c : mine; }
        if (sum == G) break;
        __builtin_amdgcn_s_sleep(1);
        if ((++sp & 255u) == 0u) { if (xb_ld(&bar[XB_TMO])) break; if (sp > XB_SPIN_CAP) { atomicAdd(&bar[XB_TMO], 1u); break; } }
    }
    nloc = mine > 0u ? mine : 1u; nx = cnt > 0u ? cnt : 1u;
}

__device__ __forceinline__ void xcd_barrier(const XcdBarrier& b) {
    asm volatile("s_waitcnt vmcnt(0)" ::: "memory");
    __syncthreads();
    if (threadIdx.x == 0) {
        unsigned* bar = b.bar;
        __builtin_amdgcn_s_waitcnt(0);
        unsigned nloc = b.st[0], nx = b.st[1];
        if (nloc == 0u) { xcd_barrier_complete(bar, b.x, nloc, nx); b.st[0] = nloc; b.st[1] = nx; }
        const unsigned old = xb_add(&bar[XB_XSUB(b.x)], 1u);
        const unsigned gen = old / nloc;
        if (old + 1u == (gen + 1u) * nloc) {
            __builtin_amdgcn_fence(__ATOMIC_RELEASE, "agent");
            asm volatile("s_waitcnt vmcnt(0)" ::: "memory");
            const unsigned og = xb_add(&bar[XB_TOP], 1u);
            const unsigned tg = og / nx;
            if (og + 1u == (tg + 1u) * nx) xb_add(&bar[XB_TOPGEN], 1u);
            else XB_SPIN(xb_ld(&bar[XB_TOPGEN]) == tg, bar);
            __builtin_amdgcn_fence(__ATOMIC_ACQUIRE, "agent");
            xb_add(&bar[XB_XGEN(b.x)], 1u);
            asm volatile("s_waitcnt vmcnt(0)" ::: "memory");
        } else {
            XB_SPIN(xb_ld(&bar[XB_XGEN(b.x)]) == gen, bar);
            __builtin_amdgcn_fence(__ATOMIC_ACQUIRE, "agent");
            asm volatile("s_waitcnt vmcnt(0)" ::: "memory");
        }
    }
    __syncthreads();
}
struct Frame {
    LAS unsigned char* lds;
    int tid, lane, wave, G;
    const float* in[19]; float* out; unsigned char* ws;
};
#define IN_X 0
#define IN_RELB 1
#define IN_NMIX 2
#define IN_EWIN 3
#define IN_CONVW 4
#define IN_CONVB 5
#define IN_GAW 6
#define IN_GAB 7
#define IN_GXW 8
#define IN_GXB 9
#define IN_LAMBDA 10
#define IN_SINKS 11
#define IN_EWOUT 12
#define IN_OWIN 13
#define IN_OWOUT 14
#define IN_NMLP 15
#define IN_WUP 16
#define IN_WDOWN 17
#define IN_FNORM 18

__device__ __forceinline__ float wave_sum(float v) {
#pragma unroll
    for (int o = 1; o < 64; o <<= 1) v += __shfl_xor(v, o);
    return v;
}
struct P0Tile { const float* W; const float* gain; bf16* WT; int K, N, k0, n0; };
__device__ __forceinline__ void p0_tile_load(const P0Tile& t, int lane, f32x4 (&v)[16]) {
    const GAS f32x4* p = (const GAS f32x4*)(t.W + (size_t)(t.k0 + (lane >> 4)) * t.N + t.n0 + 4 * (lane & 15));
#pragma unroll
    for (int i = 0; i < 16; ++i) v[i] = p[(size_t)i * t.N];
}
__device__ __forceinline__ void p0_tile_store(const P0Tile& t, int lane, const f32x4 (&v)[16], LAS float* scr) {
#pragma unroll
    for (int i = 0; i < 16; ++i) { const int kk = (lane >> 4) + 4 * i; *(LAS f32x4*)(scr + kk * 64 + ((4 * (lane & 15)) ^ (4 * ((kk >> 3) & 7)))) = v[i]; }
    LDS_WAIT(); asm volatile("" ::: "memory");
    const int kc = lane & 7;
    float g[8];
    if (t.gain) { const f32x4 a = *(const GAS f32x4*)(t.gain + t.k0 + 8 * kc), b = *(const GAS f32x4*)(t.gain + t.k0 + 8 * kc + 4); g[0] = a[0]; g[1] = a[1]; g[2] = a[2]; g[3] = a[3]; g[4] = b[0]; g[5] = b[1]; g[6] = b[2]; g[7] = b[3]; }
    else {
#pragma unroll
        for (int e = 0; e < 8; ++e) g[e] = 1.0f; }
#pragma unroll
    for (int j = 0; j < 8; ++j) { const int n = (lane >> 3) + 8 * j; const LAS float* s = scr + (8 * kc) * 64 + (n ^ (4 * kc));
        v4u o; o.x = pk2(s[0] * g[0], s[64] * g[1]); o.y = pk2(s[128] * g[2], s[192] * g[3]); o.z = pk2(s[256] * g[4], s[320] * g[5]); o.w = pk2(s[384] * g[6], s[448] * g[7]);
        *(GAS v4u*)(t.WT + (size_t)(t.n0 + n) * t.K + t.k0 + 8 * kc) = o; }
    LDS_WAIT(); asm volatile("" ::: "memory");
}
__device__ __forceinline__ int t5_bucket(int rel) {
    const int ret = rel > 0 ? 16 : 0, n = rel < 0 ? -rel : rel;
    if (n < 8) return ret + n;
    int large = 8 + (31 - __builtin_clz((unsigned)(n * n))) - 6; if (large > 15) large = 15;
    return ret + large;
}
__device__ __forceinline__ void p0_prologue(Frame& F) {
    LAS float* scr = (LAS float*)(F.lds + RING_OFF + F.wave * 16384);
    const int gw = blockIdx.x * NWAVES + F.wave, NGW = F.G * NWAVES;
    unsigned char* ws = F.ws;
    constexpr int T_IN0 = (DM / 64) * (EVEN_IN / 64), T_OUT = (DM / 64) * (DM / 64), T_UP = (DM / 64) * (DFF / 64), T_DN = (DFF / 64) * (DM / 64), T_IN1 = (DM / 64) * (ODD_IN / 64);
    constexpr int NTILES = T_IN0 + T_IN1 + 2 * T_OUT + 2 * T_UP + 2 * T_DN;
#define P0_DESC(it, t) do { int r_ = (it); \
        if (r_ < T_IN0) { t.W = F.in[IN_EWIN]; t.gain = F.in[IN_NMIX]; t.WT = (bf16*)(ws + WS_WIN0); t.K = DM; t.N = EVEN_IN; } else { r_ -= T_IN0; \
        if (r_ < T_OUT) { t.W = F.in[IN_EWOUT]; t.gain = nullptr; t.WT = (bf16*)(ws + WS_WOUT0); t.K = DM; t.N = DM; } else { r_ -= T_OUT; \
        if (r_ < T_UP) { t.W = F.in[IN_WUP]; t.gain = F.in[IN_NMLP]; t.WT = (bf16*)(ws + WS_WUP0); t.K = DM; t.N = DFF; } else { r_ -= T_UP; \
        if (r_ < T_DN) { t.W = F.in[IN_WDOWN]; t.gain = nullptr; t.WT = (bf16*)(ws + WS_WDN0); t.K = DFF; t.N = DM; } else { r_ -= T_DN; \
        if (r_ < T_IN1) { t.W = F.in[IN_OWIN]; t.gain = F.in[IN_NMIX] + DM; t.WT = (bf16*)(ws + WS_WIN1); t.K = DM; t.N = ODD_IN; } else { r_ -= T_IN1; \
        if (r_ < T_OUT) { t.W = F.in[IN_OWOUT]; t.gain = nullptr; t.WT = (bf16*)(ws + WS_WOUT1); t.K = DM; t.N = DM; } else { r_ -= T_OUT; \
        if (r_ < T_UP) { t.W = F.in[IN_WUP] + (size_t)DM * DFF; t.gain = F.in[IN_NMLP] + DM; t.WT = (bf16*)(ws + WS_WUP1); t.K = DM; t.N = DFF; } else { r_ -= T_UP; \
        t.W = F.in[IN_WDOWN] + (size_t)DFF * DM; t.gain = nullptr; t.WT = (bf16*)(ws + WS_WDN1); t.K = DFF; t.N = DM; } } } } } } } \
        const int nb_ = t.N / 64; t.k0 = 64 * (r_ / nb_); t.n0 = 64 * (r_ % nb_); } while (0)
    {
        f32x4 va[16], vb[16]; P0Tile ta, tb;
        int it = gw;
        if (it < NTILES) { P0_DESC(it, ta); p0_tile_load(ta, F.lane, va); }
        while (it < NTILES) {
            const int itn = it + NGW; const bool more = itn < NTILES;
            if (more) { P0_DESC(itn, tb); p0_tile_load(tb, F.lane, vb); }
            p0_tile_store(ta, F.lane, va, scr);
            if (more) { ta = tb;
#pragma unroll
                for (int i = 0; i < 16; ++i) va[i] = vb[i]; }
            it = itn;
        }
    }
#undef P0_DESC
    bf16* XN = (bf16*)(ws + WS_XN); float* SS = (float*)(ws + WS_SS);
    for (int m = gw; m < SEQ; m += NGW) {
        const GAS f32x4* xr = (const GAS f32x4*)(F.in[IN_X] + (size_t)m * DM) + F.lane;
        f32x4 v[8]; float s = 0.f;
#pragma unroll
        for (int j = 0; j < 8; ++j) { v[j] = xr[64 * j]; s += (v[j].x * v[j].x + v[j].y * v[j].y) + (v[j].z * v[j].z + v[j].w * v[j].w); }
        s = wave_sum(s);
        GAS v2u* o8 = (GAS v2u*)(XN + (size_t)m * DM) + F.lane;
#pragma unroll
        for (int j = 0; j < 8; ++j) { v2u w; w.x = pk2(v[j].x, v[j].y); w.y = pk2(v[j].z, v[j].w); o8[64 * j] = w; }
        if (F.lane < 8) SS[(size_t)m * 8 + F.lane] = F.lane == 0 ? s : 0.f;
    }
    float* BT = (float*)(ws + WS_BT);
    for (int i = blockIdx.x * 512 + F.tid; i < 16 * 256; i += F.G * 512) { const int head = i >> 8, rel = (i & 255) - 191; BT[i] = F.in[IN_RELB][t5_bucket(rel) * 16 + head]; }
    bf16* GWT = (bf16*)(ws + WS_GWT);
    for (int i = blockIdx.x * 512 + F.tid; i < 2 * 16 * 64 * 64; i += F.G * 512) { const int gate = i >> 16, hb = (i >> 12) & 15, jo = (i >> 6) & 63, ii = i & 63;
        GWT[i] = (bf16)f2bf(F.in[gate ? IN_GXW : IN_GAW][(size_t)(hb * 64 + ii) * 64 + jo]); }
}

__device__ __forceinline__ void ld8(const bf16* p, float (&o)[8]) { const v4u w = *(const GAS v4u*)p; o[0] = bflo(w.x); o[1] = bfhi(w.x); o[2] = bflo(w.y); o[3] = bfhi(w.y); o[4] = bflo(w.z); o[5] = bfhi(w.z); o[6] = bflo(w.w); o[7] = bfhi(w.w); }
__device__ __forceinline__ void swa_naive(Frame& F) {
    const bf16* PROJ = (const bf16*)(F.ws + WS_PROJ); bf16* Y = (bf16*)(F.ws + WS_Y); const float* BT = (const float*)(F.ws + WS_BT);
    for (int idx = blockIdx.x * 512 + F.tid; idx < SEQ * 16; idx += F.G * 512) {
        const int head = idx >> 13, tok = idx & (SEQ - 1), kvh = head >> 2, c = tok >> 6;
        float q[64], acc[64];
#pragma unroll
        for (int i = 0; i < 8; ++i) { float t[8]; ld8(PROJ + (size_t)tok * EVEN_IN + head * 64 + 8 * i, t);
#pragma unroll
            for (int j = 0; j < 8; ++j) { q[8 * i + j] = t[j] * 0.125f; acc[8 * i + j] = 0.f; } }
        float m = F.in[IN_SINKS][head], l = 1.0f;
        const int k0 = c >= 2 ? (c - 2) * 64 : 0, k1 = (c + 1) * 64;
        const float* bt = BT + head * 256;
        for (int j = k0; j < k1; ++j) {
            const bf16* kp = PROJ + (size_t)j * EVEN_IN + OFF_K + kvh * 64; float s = 0.f;
#pragma unroll
            for (int i = 0; i < 8; ++i) { float t[8]; ld8(kp + 8 * i, t);
#pragma unroll
                for (int e = 0; e < 8; ++e) s += q[8 * i + e] * t[e]; }
            s += bt[j - tok + 191];
            const float mn = fmaxf(m, s), corr = expf(m - mn), p = expf(s - mn);
            l = l * corr + p; m = mn;
            const bf16* vp = PROJ + (size_t)j * EVEN_IN + OFF_V + kvh * 64;
#pragma unroll
            for (int i = 0; i < 8; ++i) { float t[8]; ld8(vp + 8 * i, t);
#pragma unroll
                for (int e = 0; e < 8; ++e) acc[8 * i + e] = acc[8 * i + e] * corr + p * t[e]; }
        }
        const float inv = 1.0f / l;
#pragma unroll
        for (int i = 0; i < 8; ++i) { v4u w; w.x = pk2(acc[8 * i] * inv, acc[8 * i + 1] * inv); w.y = pk2(acc[8 * i + 2] * inv, acc[8 * i + 3] * inv); w.z = pk2(acc[8 * i + 4] * inv, acc[8 * i + 5] * inv); w.w = pk2(acc[8 * i + 6] * inv, acc[8 * i + 7] * inv);
            *(GAS v4u*)(Y + (size_t)tok * DM + head * 64 + 8 * i) = w; }
    }
}
__device__ __forceinline__ float softplusf(float z) { return fmaxf(z, 0.f) + log1pf(expf(-fabsf(z))); }
__device__ __forceinline__ float sigmoidf_(float z) { return 1.0f / (1.0f + expf(-z)); }
__device__ __forceinline__ float gelu_tanh(float x) { const float u = 0.7978845608028654f * (x + 0.044715f * x * x * x); return 0.5f * x * (1.0f + tanhf(u)); }
__device__ __forceinline__ void lru_naive(Frame& F) {
    if (blockIdx.x >= 16 || F.wave != 0) return;
    const bf16* PROJ = (const bf16*)(F.ws + WS_PROJ); bf16* Y = (bf16*)(F.ws + WS_Y);
    const int hb = blockIdx.x, lane = F.lane, c = hb * 64 + lane;
    float Wa[64], Wx[64];
#pragma unroll
    for (int i = 0; i < 64; ++i) { Wa[i] = F.in[IN_GAW][(size_t)(hb * 64 + i) * 64 + lane]; Wx[i] = F.in[IN_GXW][(size_t)(hb * 64 + i) * 64 + lane]; }
    const float ba = F.in[IN_GAB][c], bx = F.in[IN_GXB][c], cb = F.in[IN_CONVB][c];
    const float cw0 = F.in[IN_CONVW][c], cw1 = F.in[IN_CONVW][1024 + c], cw2 = F.in[IN_CONVW][2048 + c], cw3 = F.in[IN_CONVW][3072 + c];
    const float sp8 = 8.0f * softplusf(-F.in[IN_LAMBDA][c]);
    float x1 = 0.f, x2 = 0.f, x3 = 0.f, h = 0.f;
    for (int t0 = 0; t0 < SEQ; t0 += 8) {
        float xb[8], g[8];
#pragma unroll
        for (int u = 0; u < 8; ++u) { xb[u] = bflo((unsigned)PROJ[(size_t)(t0 + u) * EVEN_IN + OFF_X + c]); g[u] = bflo((unsigned)PROJ[(size_t)(t0 + u) * EVEN_IN + OFF_G + c]); }
#pragma unroll
        for (int u = 0; u < 8; ++u) {
            const float xt = xb[u], xc = cb + cw0 * x3 + cw1 * x2 + cw2 * x1 + cw3 * xt; x3 = x2; x2 = x1; x1 = xt;
            float ra = ba, rx = bx; const int xci = __builtin_bit_cast(int, xc);
#pragma unroll
            for (int i = 0; i < 64; ++i) { const float xi = __builtin_bit_cast(float, __builtin_amdgcn_readlane(xci, i)); ra += xi * Wa[i]; rx += xi * Wx[i]; }
            const float r = sigmoidf_(ra), ig = sigmoidf_(rx), log_a = -r * sp8, a = expf(log_a), mult = sqrtf(-expm1f(2.0f * log_a));
            h = a * h + mult * (ig * xc);
            Y[(size_t)(t0 + u) * DM + 1024 + c] = (bf16)f2bf(gelu_tanh(g[u]) * h);
        }
    }
}
__device__ __forceinline__ void sb_naive(Frame& F) {
    const bf16* PROJ = (const bf16*)(F.ws + WS_PROJ); bf16* Y = (bf16*)(F.ws + WS_Y);
    const int gt = blockIdx.x * 512 + F.tid, half = gt & 1;
    for (int pidx = gt >> 1; pidx < SEQ * 16; pidx += (F.G * 512) >> 1) {
        const int head = pidx >> 13, tok = pidx & (SEQ - 1);
        float q[64], acc[64];
#pragma unroll
        for (int i = 0; i < 8; ++i) { float t[8]; ld8(PROJ + (size_t)tok * ODD_IN + head * 128 + half * 64 + 8 * i, t);
#pragma unroll
            for (int j = 0; j < 8; ++j) { q[8 * i + j] = t[j] * 0.08838834764831845f; acc[8 * i + j] = 0.f; } }
        float stick = 0.f;
        for (int j = tok - 1; j >= 0; --j) {
            const bf16* kp = PROJ + (size_t)j * ODD_IN + 2048 + head * 128 + half * 64; float s = 0.f;
#pragma unroll
            for (int i = 0; i < 8; ++i) { float t[8]; ld8(kp + 8 * i, t);
#pragma unroll
                for (int e = 0; e < 8; ++e) s += q[8 * i + e] * t[e]; }
            const float z = s + __shfl_xor(s, 1);
            const float lk = -softplusf(z), w = expf(z + lk + stick);
            const bf16* vp = PROJ + (size_t)j * ODD_IN + 4096 + head * 128 + half * 64;
#pragma unroll
            for (int i = 0; i < 8; ++i) { float t[8]; ld8(vp + 8 * i, t);
#pragma unroll
                for (int e = 0; e < 8; ++e) acc[8 * i + e] += w * t[e]; }
            stick += lk;
            if (stick < -104.0f) break;
        }
#pragma unroll
        for (int i = 0; i < 8; ++i) { v4u w; w.x = pk2(acc[8 * i], acc[8 * i + 1]); w.y = pk2(acc[8 * i + 2], acc[8 * i + 3]); w.z = pk2(acc[8 * i + 4], acc[8 * i + 5]); w.w = pk2(acc[8 * i + 6], acc[8 * i + 7]);
            *(GAS v4u*)(Y + (size_t)tok * DM + head * 128 + half * 64 + 8 * i) = w; }
    }
}
__device__ __forceinline__ void final_norm(Frame& F) {
    const int gw = blockIdx.x * NWAVES + F.wave, NGW = F.G * NWAVES;
    const GAS f32x4* gp = (const GAS f32x4*)F.in[IN_FNORM] + F.lane;
    for (int m = gw; m < SEQ; m += NGW) {
        GAS f32x4* xr = (GAS f32x4*)(F.out + (size_t)m * DM) + F.lane;
        f32x4 v[8]; float s = 0.f;
#pragma unroll
        for (int j = 0; j < 8; ++j) { v[j] = xr[64 * j]; s += (v[j].x * v[j].x + v[j].y * v[j].y) + (v[j].z * v[j].z + v[j].w * v[j].w); }
        const float rstd = 1.0f / sqrtf(wave_sum(s) * (1.0f / DM) + 1e-6f);
#pragma unroll
        for (int j = 0; j < 8; ++j) xr[64 * j] = v[j] * rstd * gp[64 * j];
    }
}
typedef float f32x16 __attribute__((ext_vector_type(16)));
typedef short s16x8 __attribute__((ext_vector_type(8)));
typedef short s16x4 __attribute__((ext_vector_type(4)));
typedef __bf16 bf16x2v __attribute__((ext_vector_type(2)));
#define MFMA32(a, b, c) __builtin_amdgcn_mfma_f32_32x32x16_bf16((a), (b), (c), 0, 0, 0)
__device__ __forceinline__ int crow(int i, int h) { return (i & 3) + 8 * (i >> 2) + 4 * h; }
__device__ __forceinline__ unsigned pkbf(float a, float b) { bf16x2v v; v.x = (__bf16)a; v.y = (__bf16)b; return __builtin_bit_cast(unsigned, v); }
__device__ __forceinline__ s16x8 pack8(const float (&p)[16], int s) {
    v4u w; w.x = pkbf(p[8 * s], p[8 * s + 1]); w.y = pkbf(p[8 * s + 2], p[8 * s + 3]); w.z = pkbf(p[8 * s + 4], p[8 * s + 5]); w.w = pkbf(p[8 * s + 6], p[8 * s + 7]);
    return __builtin_bit_cast(s16x8, w);
}
__device__ __forceinline__ s16x8 tr_frag(const LAS unsigned char* p0, const LAS unsigned char* p1) {
    const s16x4 lo = __builtin_amdgcn_ds_read_tr16_b64_v4i16((LAS s16x4*)p0), hi = __builtin_amdgcn_ds_read_tr16_b64_v4i16((LAS s16x4*)p1);
    return __builtin_shufflevector(lo, hi, 0, 1, 2, 3, 4, 5, 6, 7);
}
__device__ __forceinline__ float fast_softplus(float z) { return fmaxf(z, 0.f) + __logf(1.0f + __expf(-fabsf(z))); }
__device__ __forceinline__ float fast_sigmoid(float z) { return __builtin_amdgcn_rcpf(1.0f + __expf(-z)); }

__device__ __forceinline__ void lru_local(Frame& F) {
    const bf16* PROJ = (const bf16*)(F.ws + WS_PROJ); float* HL = (float*)(F.ws + WS_HL); float* PA = (float*)(F.ws + WS_PA); const bf16* GWT = (const bf16*)(F.ws + WS_GWT);
    LAS unsigned char* xc16 = F.lds;
    LAS float* xc32 = (LAS float*)(F.lds + 18432);
    LAS float* comp = (LAS float*)(F.lds + 18432 + 34816);
    const int tid = F.tid, lane = F.lane, w = F.wave, ts = w & 3, ch = w >> 2, r = lane & 31, h = lane >> 5;
    for (int u = blockIdx.x; u < 1024; u += F.G) {
        const int hb = u & 15, k = u >> 4, t0 = k * 128;
        {
            const int tt = tid >> 2, cg = tid & 3, cbase = hb * 64 + cg * 16, t = t0 + tt;
            float xc[16];
            { const GAS f32x4* cbp = (const GAS f32x4*)(F.in[IN_CONVB] + cbase);
#pragma unroll
              for (int q4 = 0; q4 < 4; ++q4) { const f32x4 b = cbp[q4]; xc[4 * q4] = b[0]; xc[4 * q4 + 1] = b[1]; xc[4 * q4 + 2] = b[2]; xc[4 * q4 + 3] = b[3]; } }
#pragma unroll
            for (int d = 0; d < 4; ++d) { const int row = t - 3 + d;
                float xv[16];
                if (row >= 0) { float a8[8], b8[8]; ld8(PROJ + (size_t)row * EVEN_IN + OFF_X + cbase, a8); ld8(PROJ + (size_t)row * EVEN_IN + OFF_X + cbase + 8, b8);
#pragma unroll
                    for (int e = 0; e < 8; ++e) { xv[e] = a8[e]; xv[8 + e] = b8[e]; } }
                else {
#pragma unroll
                    for (int e = 0; e < 16; ++e) xv[e] = 0.f; }
                const GAS f32x4* cwp = (const GAS f32x4*)(F.in[IN_CONVW] + d * 1024 + cbase);
#pragma unroll
                for (int q4 = 0; q4 < 4; ++q4) { const f32x4 cw = cwp[q4];
#pragma unroll
                    for (int e = 0; e < 4; ++e) xc[4 * q4 + e] += cw[e] * xv[4 * q4 + e]; } }
#pragma unroll
            for (int q4 = 0; q4 < 4; ++q4) *(LAS f32x4*)(xc32 + tt * 68 + cg * 16 + 4 * q4) = (f32x4){xc[4 * q4], xc[4 * q4 + 1], xc[4 * q4 + 2], xc[4 * q4 + 3]};
#pragma unroll
            for (int q8 = 0; q8 < 2; ++q8) { v4u o; o.x = pkbf(xc[8 * q8], xc[8 * q8 + 1]); o.y = pkbf(xc[8 * q8 + 2], xc[8 * q8 + 3]); o.z = pkbf(xc[8 * q8 + 4], xc[8 * q8 + 5]); o.w = pkbf(xc[8 * q8 + 6], xc[8 * q8 + 7]);
                *(LAS v4u*)(xc16 + tt * 144 + cg * 32 + q8 * 16) = o; }
        }
        __syncthreads();
        f32x16 acc_a, acc_x;
#pragma unroll
        for (int i = 0; i < 16; ++i) { acc_a[i] = 0.f; acc_x[i] = 0.f; }
#pragma unroll
        for (int s = 0; s < 4; ++s) {
            const s16x8 af = *(const LAS s16x8*)(xc16 + (ts * 32 + r) * 144 + (16 * s + 8 * h) * 2);
            const s16x8 ba = *(const GAS s16x8*)(GWT + (size_t)((0 * 16 + hb) * 64 + ch * 32 + r) * 64 + 16 * s + 8 * h);
            const s16x8 bx = *(const GAS s16x8*)(GWT + (size_t)((1 * 16 + hb) * 64 + ch * 32 + r) * 64 + 16 * s + 8 * h);
            acc_a = MFMA32(af, ba, acc_a); acc_x = MFMA32(af, bx, acc_x);
        }
        const int c = hb * 64 + ch * 32 + r;
        const float gab = F.in[IN_GAB][c], gxb = F.in[IN_GXB][c], sp8 = 8.0f * softplusf(-F.in[IN_LAMBDA][c]);
        float pa[16], hl[16], gA[4], gU[4];
#pragma unroll
        for (int g = 0; g < 4; ++g) { float A = 1.f, U = 0.f;
#pragma unroll
            for (int e = 0; e < 4; ++e) { const int i = 4 * g + e; const float xcv = xc32[(ts * 32 + crow(i, h)) * 68 + ch * 32 + r];
                const float rg = fast_sigmoid(acc_a[i] + gab), ig = fast_sigmoid(acc_x[i] + gxb), log_a = -rg * sp8, a = __expf(log_a), mult = sqrtf(-expm1f(2.0f * log_a));
                U = a * U + mult * (ig * xcv); A *= a; pa[i] = A; hl[i] = U; }
            gA[g] = A; gU[g] = U; }
        float PAc = 1.f, Hc = 0.f;
#pragma unroll
        for (int g = 0; g < 4; ++g) { const float oA = __shfl_xor(gA[g], 32), oU = __shfl_xor(gU[g], 32);
            const float fA = h ? oA : gA[g], fU = h ? oU : gU[g], sA = h ? gA[g] : oA, sU = h ? gU[g] : oU;
            const float c0P = PAc, c0H = Hc; Hc = fA * Hc + fU; PAc *= fA; const float c1P = PAc, c1H = Hc; Hc = sA * Hc + sU; PAc *= sA;
            const float ciP = h ? c1P : c0P, ciH = h ? c1H : c0H;
#pragma unroll
            for (int e = 0; e < 4; ++e) { const int i = 4 * g + e; hl[i] += pa[i] * ciH; pa[i] *= ciP; } }
        if (h == 0) { comp[(ts * 64 + ch * 32 + r) * 2] = PAc; comp[(ts * 64 + ch * 32 + r) * 2 + 1] = Hc; }
        __syncthreads();
        float PAin = 1.f, Hin = 0.f;
        for (int t2 = 0; t2 < ts; ++t2) { const float A2 = comp[(t2 * 64 + ch * 32 + r) * 2], U2 = comp[(t2 * 64 + ch * 32 + r) * 2 + 1]; Hin = A2 * Hin + U2; PAin *= A2; }
#pragma unroll
        for (int i = 0; i < 16; ++i) { const size_t o = (size_t)(t0 + ts * 32 + crow(i, h)) * 1024 + c; HL[o] = hl[i] + pa[i] * Hin; PA[o] = pa[i] * PAin; }
        __syncthreads();
    }
}
__device__ __forceinline__ void lru_fix(Frame& F) {
    const bf16* PROJ = (const bf16*)(F.ws + WS_PROJ); const float* HL = (const float*)(F.ws + WS_HL); const float* PA = (const float*)(F.ws + WS_PA); bf16* Y = (bf16*)(F.ws + WS_Y);
    const int gw = blockIdx.x * NWAVES + F.wave, NGW = F.G * NWAVES;
    for (int it = gw; it < 4096; it += NGW) {
        const int cgp = it & 15, sub = (it >> 4) & 3, k = it >> 6, c = cgp * 64 + F.lane;
        float H = 0.f;
#pragma unroll 8
        for (int kk = 0; kk < k; ++kk) { const size_t row = (size_t)(kk * 128 + 127) * 1024 + c; H = PA[row] * H + HL[row]; }
#pragma unroll 8
        for (int tt = 0; tt < 32; ++tt) { const int t = k * 128 + sub * 32 + tt;
            const float hv = HL[(size_t)t * 1024 + c] + PA[(size_t)t * 1024 + c] * H, g = bflo((unsigned)PROJ[(size_t)t * EVEN_IN + OFF_G + c]);
            const float u2 = 1.5957691216057308f * (g + 0.044715f * g * g * g), ge = g * fast_sigmoid(u2);
            Y[(size_t)t * DM + 1024 + c] = (bf16)f2bf(ge * hv); }
    }
}
__device__ __forceinline__ void sb_attn(Frame& F) {
    const bf16* PROJ = (const bf16*)(F.ws + WS_PROJ); bf16* Y = (bf16*)(F.ws + WS_Y);
    LAS unsigned char* vt = F.lds + F.wave * 16384;
    const int lane = F.lane, r = lane & 31, h = lane >> 5;
    const int gw = blockIdx.x * NWAVES + F.wave, NGW = F.G * NWAVES;
    const LAS unsigned char* trb = vt + (4 * h + ((lane & 15) >> 2)) * 320 + (16 * ((lane >> 4) & 1) + 4 * (lane & 3)) * 2;
    for (int it = gw; it < 4096; it += NGW) {
        const int head = it & 15, qb = it >> 4, q0 = qb * 32;
        s16x8 qf[8];
#pragma unroll
        for (int s = 0; s < 8; ++s) qf[s] = *(const GAS s16x8*)(PROJ + (size_t)(q0 + r) * ODD_IN + head * 128 + 16 * s + 8 * h);
        f32x16 o[4];
#pragma unroll
        for (int db = 0; db < 4; ++db)
#pragma unroll
            for (int i = 0; i < 16; ++i) o[db][i] = 0.f;
        float carry = 0.f;
        s16x8 kf[8]; v4u vreg[8];
#pragma unroll
        for (int s = 0; s < 8; ++s) kf[s] = *(const GAS s16x8*)(PROJ + (size_t)(q0 + r) * ODD_IN + 2048 + head * 128 + 16 * s + 8 * h);
#pragma unroll
        for (int i = 0; i < 8; ++i) { const int p = lane + 64 * i; vreg[i] = *(const GAS v4u*)(PROJ + (size_t)(q0 + (p >> 4)) * ODD_IN + 4096 + head * 128 + (p & 15) * 8); }
        for (int kt = qb; kt >= 0; --kt) {
            const int kbn = (kt > 0 ? kt - 1 : 0) * 32;
            f32x16 sacc;
#pragma unroll
            for (int i = 0; i < 16; ++i) sacc[i] = 0.f;
#pragma unroll
            for (int s = 0; s < 8; ++s) sacc = MFMA32(kf[s], qf[s], sacc);
#pragma unroll
            for (int s = 0; s < 8; ++s) kf[s] = *(const GAS s16x8*)(PROJ + (size_t)(kbn + r) * ODD_IN + 2048 + head * 128 + 16 * s + 8 * h);
#pragma unroll
            for (int i = 0; i < 8; ++i) { const int p = lane + 64 * i; *(LAS v4u*)(vt + (p >> 4) * 320 + (p & 15) * 16) = vreg[i]; }
            LDS_WAIT();
#pragma unroll
            for (int i = 0; i < 8; ++i) { const int p = lane + 64 * i; vreg[i] = *(const GAS v4u*)(PROJ + (size_t)(kbn + (p >> 4)) * ODD_IN + 4096 + head * 128 + (p & 15) * 8); }
            const bool diag = (kt == qb);
            float z[16], lk[16], G[4];
#pragma unroll
            for (int g = 0; g < 4; ++g) { float gs = 0.f;
#pragma unroll
                for (int e = 0; e < 4; ++e) { const int i = 4 * g + e; z[i] = sacc[i] * 0.08838834764831845f; const bool valid = !diag || (crow(i, h) < r);
                    lk[i] = valid ? -fast_softplus(z[i]) : 0.f; z[i] = valid ? z[i] : -1e30f; gs += lk[i]; }
                G[g] = gs; }
            float run = carry, pw[16];
#pragma unroll
            for (int g = 3; g >= 0; --g) { const float og = __shfl_xor(G[g], 32);
                const float s1 = run; run += h ? G[g] : og;
                const float s0 = run; run += h ? og : G[g];
                float ex = h ? s1 : s0;
#pragma unroll
                for (int e = 3; e >= 0; --e) { const int i = 4 * g + e; pw[i] = __expf(z[i] + lk[i] + ex); ex += lk[i]; } }
            carry = run;
            const s16x8 p0 = pack8(pw, 0), p1 = pack8(pw, 1);
#pragma unroll
            for (int db = 0; db < 4; ++db) {
                const s16x8 v0 = tr_frag(trb + db * 64, trb + 8 * 320 + db * 64);
                const s16x8 v1 = tr_frag(trb + 16 * 320 + db * 64, trb + 24 * 320 + db * 64);
                o[db] = MFMA32(v0, p0, o[db]); o[db] = MFMA32(v1, p1, o[db]); }
            if (__all(carry < -104.0f)) break;
        }
#pragma unroll
        for (int db = 0; db < 4; ++db)
#pragma unroll
            for (int g = 0; g < 4; ++g) { v2u w; w.x = pkbf(o[db][4 * g], o[db][4 * g + 1]); w.y = pkbf(o[db][4 * g + 2], o[db][4 * g + 3]);
                *(GAS v2u*)(Y + (size_t)(q0 + r) * DM + head * 128 + db * 32 + 8 * g + 4 * h) = w; }
    }
}
__device__ __forceinline__ void swa_attn(Frame& F) {
    const bf16* PROJ = (const bf16*)(F.ws + WS_PROJ); bf16* Y = (bf16*)(F.ws + WS_Y); const float* BT = (const float*)(F.ws + WS_BT);
    LAS unsigned char* vt = F.lds + 65536 + F.wave * 8192;
    LAS float* btl = (LAS float*)(vt + 6144);
    const int lane = F.lane, r = lane & 31, h = lane >> 5;
    const int gw = blockIdx.x * NWAVES + F.wave, NGW = F.G * NWAVES;
    const LAS unsigned char* trb = vt + (4 * h + ((lane & 15) >> 2)) * 192 + (16 * ((lane >> 4) & 1) + 4 * (lane & 3)) * 2;
    for (int it = gw; it < 4096; it += NGW) {
        const int head = it & 15, qb = it >> 4, q0 = qb * 32, c = q0 >> 6, kvh = head >> 2, kbase = (c - 2) * 64, kt0 = c >= 2 ? 0 : (2 - c) * 2;
#pragma unroll
        for (int i = 0; i < 4; ++i) btl[lane + 64 * i] = BT[head * 256 + lane + 64 * i];
        LDS_WAIT();
        s16x8 qf[4];
#pragma unroll
        for (int s = 0; s < 4; ++s) qf[s] = *(const GAS s16x8*)(PROJ + (size_t)(q0 + r) * EVEN_IN + head * 64 + 16 * s + 8 * h);
        const float sink = F.in[IN_SINKS][head];
        float sc[6][16]; float m = sink;
#pragma unroll
        for (int kt = 0; kt < 6; ++kt) {
            if (kt >= kt0) {
                const int kb = kbase + kt * 32;
                f32x16 sacc;
#pragma unroll
                for (int i = 0; i < 16; ++i) sacc[i] = 0.f;
#pragma unroll
                for (int s = 0; s < 4; ++s) { const s16x8 kf = *(const GAS s16x8*)(PROJ + (size_t)(kb + r) * EVEN_IN + OFF_K + kvh * 64 + 16 * s + 8 * h); sacc = MFMA32(kf, qf[s], sacc); }
#pragma unroll
                for (int i = 0; i < 16; ++i) { const float v = sacc[i] * 0.125f + btl[kb + crow(i, h) - (q0 + r) + 191]; sc[kt][i] = v; m = fmaxf(m, v); }
            } else {
#pragma unroll
                for (int i = 0; i < 16; ++i) sc[kt][i] = -1e30f;
            }
        }
        m = fmaxf(m, __shfl_xor(m, 32));
        float l = 0.f;
#pragma unroll
        for (int kt = 0; kt < 6; ++kt)
#pragma unroll
            for (int i = 0; i < 16; ++i) { const float p = __expf(sc[kt][i] - m); sc[kt][i] = p; l += p; }
        l += __shfl_xor(l, 32); l += __expf(sink - m);
        f32x16 o[2];
#pragma unroll
        for (int db = 0; db < 2; ++db)
#pragma unroll
            for (int i = 0; i < 16; ++i) o[db][i] = 0.f;
#pragma unroll
        for (int kt = 0; kt < 6; ++kt) {
            if (kt >= kt0) {
                const int kb = kbase + kt * 32;
#pragma unroll
                for (int i = 0; i < 4; ++i) { const int p = lane + 64 * i; const v4u v = *(const GAS v4u*)(PROJ + (size_t)(kb + (p >> 3)) * EVEN_IN + OFF_V + kvh * 64 + (p & 7) * 8); *(LAS v4u*)(vt + (p >> 3) * 192 + (p & 7) * 16) = v; }
                LDS_WAIT();
                const s16x8 p0 = pack8(sc[kt], 0), p1 = pack8(sc[kt], 1);
#pragma unroll
                for (int db = 0; db < 2; ++db) {
                    const s16x8 v0 = tr_frag(trb + db * 64, trb + 8 * 192 + db * 64);
                    const s16x8 v1 = tr_frag(trb + 16 * 192 + db * 64, trb + 24 * 192 + db * 64);
                    o[db] = MFMA32(v0, p0, o[db]); o[db] = MFMA32(v1, p1, o[db]); }
            }
        }
        const float inv = 1.0f / l;
#pragma unroll
        for (int db = 0; db < 2; ++db)
#pragma unroll
            for (int g = 0; g < 4; ++g) { v2u w; w.x = pkbf(o[db][4 * g] * inv, o[db][4 * g + 1] * inv); w.y = pkbf(o[db][4 * g + 2] * inv, o[db][4 * g + 3] * inv);
                *(GAS v2u*)(Y + (size_t)(q0 + r) * DM + head * 64 + db * 32 + 8 * g + 4 * h) = w; }
    }
}

#ifndef REP_P0
#define REP_P0 1
#endif
#define REP_LRU 1
#define REP_SWA 1
#define REP_FIX 1
#define REP_SB 1
struct Args { const float* in[19]; float* out; unsigned char* ws; int ph_lo, ph_hi; };
__global__ void __launch_bounds__(NWAVES * 64, 2) hybrid_fwd(Args args) {
    extern __shared__ __attribute__((aligned(16))) unsigned char lds[];
    Frame F;
    F.lds = (LAS unsigned char*)lds;
    F.tid = threadIdx.x; F.lane = F.tid & 63; F.wave = __builtin_amdgcn_readfirstlane(F.tid >> 6);
    F.G = gridDim.x;
#pragma unroll
    for (int i = 0; i < 19; ++i) F.in[i] = args.in[i];
    F.out = args.out; F.ws = args.ws;
    unsigned char* ws = args.ws;
    for (int u = F.tid; u < (LDS_BYTES - LDSCTL_OFF) / 4; u += NWAVES * 64) ((LAS unsigned*)(F.lds + LDSCTL_OFF))[u] = 0u;
    __syncthreads();
    const int lo = args.ph_lo, hi = args.ph_hi;
    XcdBarrier bar; bar.bar = (unsigned*)(ws + WS_CTL) + CW_BAR; bar.x = 0; bar.st = nullptr;
    if (hi - lo > 1) bar = xcd_barrier_post((unsigned*)(ws + WS_CTL) + CW_BAR, (volatile LAS unsigned*)(F.lds + MISC_OFF) + 8);
#define IN(k) (lo <= (k) && (k) < hi)
#define SEAM(k) do { if (IN(k) && IN((k) + 1)) xcd_barrier(bar); } while (0)
    bf16* XN = (bf16*)(ws + WS_XN); bf16* Yb = (bf16*)(ws + WS_Y); bf16* PROJ = (bf16*)(ws + WS_PROJ); bf16* ACT = (bf16*)(ws + WS_ACT); float* SS = (float*)(ws + WS_SS);

    if (IN(0)) { for (int rep = 0; rep < REP_P0; ++rep) { p0_prologue(F); if (rep + 1 < REP_P0) xcd_barrier(bar); } } SEAM(0);
    if (IN(1)) { pg8::Gemm g{XN, (const bf16*)(ws + WS_WIN0), SEQ, EVEN_IN, DM}; pg8::StaticOrder S; S.init(SEQ, EVEN_IN, F.G, (int)blockIdx.x);
        pg8::EpiBf16<0> E{PROJ, EVEN_IN, SS}; pg8::gemm_phase<pg8::EpiBf16<0>, pg8::StaticOrder, true, true>(F.lds + RING_OFF, g, S, E); } SEAM(1);
    if (IN(2)) { for (int rep = 0; rep < REP_LRU; ++rep) { lru_local(F); if (rep + 1 < REP_LRU) xcd_barrier(bar); } for (int rep = 0; rep < REP_SWA; ++rep) { swa_attn(F); if (rep + 1 < REP_SWA) xcd_barrier(bar); } } SEAM(2);
    if (IN(3)) { for (int rep = 0; rep < REP_FIX; ++rep) { lru_fix(F); if (rep + 1 < REP_FIX) xcd_barrier(bar); } } SEAM(3);
    if (IN(4)) { pg8::Gemm g{Yb, (const bf16*)(ws + WS_WOUT0), SEQ, DM, DM}; pg8::StaticOrder S; S.init(SEQ, DM, F.G, (int)blockIdx.x);
        pg8::EpiRes E{F.in[IN_X], F.out, XN, SS, DM}; pg8::gemm_phase<pg8::EpiRes, pg8::StaticOrder, false, true>(F.lds + RING_OFF, g, S, E); } SEAM(4);
    if (IN(5)) { pg8::Gemm g{XN, (const bf16*)(ws + WS_WUP0), SEQ, DFF, DM}; pg8::StaticOrder S; S.init(SEQ, DFF, F.G, (int)blockIdx.x);
        pg8::EpiBf16<1> E{ACT, DFF, SS}; pg8::gemm_phase<pg8::EpiBf16<1>, pg8::StaticOrder, true, true>(F.lds + RING_OFF, g, S, E); } SEAM(5);
    if (IN(6)) { pg8::Gemm g{ACT, (const bf16*)(ws + WS_WDN0), SEQ, DM, DFF}; pg8::StaticOrder S; S.init(SEQ, DM, F.G, (int)blockIdx.x);
        pg8::EpiRes E{F.out, F.out, XN, SS, DM}; pg8::gemm_phase<pg8::EpiRes, pg8::StaticOrder, false, true>(F.lds + RING_OFF, g, S, E); } SEAM(6);
    if (IN(7)) { pg8::Gemm g{XN, (const bf16*)(ws + WS_WIN1), SEQ, ODD_IN, DM}; pg8::StaticOrder S; S.init(SEQ, ODD_IN, F.G, (int)blockIdx.x);
        pg8::EpiBf16<0> E{PROJ, ODD_IN, SS}; pg8::gemm_phase<pg8::EpiBf16<0>, pg8::StaticOrder, true, true>(F.lds + RING_OFF, g, S, E); } SEAM(7);
    if (IN(8)) { for (int rep = 0; rep < REP_SB; ++rep) { sb_attn(F); if (rep + 1 < REP_SB) xcd_barrier(bar); } } SEAM(8);
    if (IN(9)) { pg8::Gemm g{Yb, (const bf16*)(ws + WS_WOUT1), SEQ, DM, DM}; pg8::StaticOrder S; S.init(SEQ, DM, F.G, (int)blockIdx.x);
        pg8::EpiRes E{F.out, F.out, XN, SS, DM}; pg8::gemm_phase<pg8::EpiRes, pg8::StaticOrder, false, true>(F.lds + RING_OFF, g, S, E); } SEAM(9);
    if (IN(10)) { pg8::Gemm g{XN, (const bf16*)(ws + WS_WUP1), SEQ, DFF, DM}; pg8::StaticOrder S; S.init(SEQ, DFF, F.G, (int)blockIdx.x);
        pg8::EpiBf16<1> E{ACT, DFF, SS}; pg8::gemm_phase<pg8::EpiBf16<1>, pg8::StaticOrder, true, true>(F.lds + RING_OFF, g, S, E); } SEAM(10);
    if (IN(11)) { pg8::Gemm g{ACT, (const bf16*)(ws + WS_WDN1), SEQ, DM, DFF}; pg8::StaticOrder S; S.init(SEQ, DM, F.G, (int)blockIdx.x);
        pg8::EpiRes E{F.out, F.out, XN, SS, DM}; pg8::gemm_phase<pg8::EpiRes, pg8::StaticOrder, false, true>(F.lds + RING_OFF, g, S, E); } SEAM(11);
    if (IN(12)) { final_norm(F); }
#undef IN
#undef SEAM
}

extern "C" void kernel_launch(void* const* d_in, const int* in_sizes, int n_in, void* d_out, int out_size, void* d_ws, size_t ws_size, hipStream_t stream) {
    static int grid = 0;
    if (grid == 0) {
        if (n_in != 19 || in_sizes[0] != SEQ * DM || out_size != SEQ * DM || ws_size < WS_END) { fprintf(stderr, "kernel_launch: unexpected shapes (n_in %d, in0 %d, out %d, ws %zu); nothing launched\n", n_in, n_in > 0 ? in_sizes[0] : -1, out_size, ws_size); grid = -1; return; }
        int dev = 0, cus = 0, per_cu = 0;
        if (hipGetDevice(&dev) != hipSuccess || hipDeviceGetAttribute(&cus, hipDeviceAttributeMultiprocessorCount, dev) != hipSuccess) { fprintf(stderr, "kernel_launch: device query failed\n"); grid = -1; return; }
        if (hipFuncSetAttribute((const void*)hybrid_fwd, hipFuncAttributeMaxDynamicSharedMemorySize, LDS_BYTES) != hipSuccess) { fprintf(stderr, "kernel_launch: hipFuncSetAttribute failed\n"); grid = -1; return; }
        if (hipOccupancyMaxActiveBlocksPerMultiprocessor(&per_cu, (const void*)hybrid_fwd, NWAVES * 64, LDS_BYTES) != hipSuccess || per_cu < 1) { fprintf(stderr, "kernel_launch: occupancy query reports %d workgroups per CU\n", per_cu); per_cu = 1; }
        (void)hipGetLastError();
        grid = cus;
        if (grid != 256) fprintf(stderr, "kernel_launch: %d CUs; the residual GEMM phases need exactly 256 workgroups\n", grid);
    }
    if (grid < 0) return;
    (void)hipMemsetAsync((char*)d_ws + WS_CTL, 0, CTL_ZERO_BYTES, stream);
    Args a{};
    for (int i = 0; i < 19; ++i) a.in[i] = (const float*)d_in[i];
    a.out = (float*)d_out; a.ws = (unsigned char*)d_ws;
#if MK_N_LAUNCHES == 1
    a.ph_lo = 0; a.ph_hi = N_PHASES;
    hipLaunchKernelGGL(hybrid_fwd, dim3(grid), dim3(NWAVES * 64), LDS_BYTES, stream, a);
#else
    for (int p = 0; p < N_PHASES; ++p) { a.ph_lo = p; a.ph_hi = p + 1; hipLaunchKernelGGL(hybrid_fwd, dim3(grid), dim3(NWAVES * 64), LDS_BYTES, stream, a); }
#endif
}
```

```cpp
#include <hip/hip_runtime.h>
#include <cstdio>
#include <cstdint>
namespace pg8 {
#define PG8_LAS __attribute__((address_space(3)))
typedef unsigned short bf16_t;
typedef short bf16x8 __attribute__((ext_vector_type(8)));
typedef float f32x4 __attribute__((ext_vector_type(4)));
typedef unsigned u32x4 __attribute__((ext_vector_type(4)));
constexpr int BM = 256, BK = 64, HALF = 128, HTB = HALF * BK * 2  , STAGE_BYTES = 8 * HTB, NXCD = 8, WGM = 8;

__host__ __device__ __forceinline__ int lds_byte(int r, int c) { const int st = (r >> 4) * 2 + (c >> 5), rr = r & 15, cc = c & 31, ob = rr * 64 + cc * 2; return st * 1024 + (ob ^ (((ob >> 9) & 1) << 5)); }
__host__ __device__ __forceinline__ void stage_rc(int b, int& R, int& C) { const int st = b / 1024, sb = b % 1024, swz = sb ^ (((sb >> 9) & 1) << 5); R = (st >> 1) * 16 + swz / 64; C = (st & 1) * 32 + (swz % 64) / 2; }
__host__ __device__ __forceinline__ int perm32(int rho) { const int n = rho >> 4, i = rho & 15; return 8 * (i >> 2) + 4 * n + (i & 3); }

struct Unit { int pm, pn; };
struct Gemm { const bf16_t* A; const bf16_t* Bt; int M, N, K; };

struct StaticOrder {
    int nM, nN, nwg, G, c;
    __host__ __device__ void init(int M, int N, int G_, int c_) { nM = M / BM; nN = N / BM; nwg = nM * nN; G = G_; c = c_; }
    __host__ __device__ bool next(int i, Unit& u) const {
        const long L = (long)i * G + c; if (L >= nwg) return false;
        int wgid = (int)L; { const int q = nwg / NXCD, r = nwg % NXCD, xcd = wgid % NXCD, off = wgid / NXCD; wgid = (xcd < r ? xcd * (q + 1) : r * (q + 1) + (xcd - r) * q) + off; }
        const int nig = WGM * nN, gid = wgid / nig, fm = gid * WGM, gsz = (nM - fm) < WGM ? (nM - fm) : WGM;
        u.pm = fm + ((wgid % nig) % gsz); u.pn = (wgid % nig) / gsz; return true;
    }
    __device__ __forceinline__ void a_ready(const Unit&) const {}
    __device__ __forceinline__ void done(const Unit&) const {}
};

__device__ __forceinline__ unsigned cvt_pk_bf16(float lo, float hi) { unsigned r; asm volatile("v_cvt_pk_bf16_f32 %0, %1, %2" : "=v"(r) : "v"(lo), "v"(hi)); return r; }
constexpr float RMS_EPS = 1e-6f;
__device__ __forceinline__ float row_rstd(const float* ss, int r) {
    const f32x4 a = *(const f32x4*)(ss + (size_t)r * 8), b = *(const f32x4*)(ss + (size_t)r * 8 + 4);
    const float s = ((a[0] + a[1]) + (a[2] + a[3])) + ((b[0] + b[1]) + (b[2] + b[3]));
    return 1.0f / sqrtf(s * (1.0f / 2048.0f) + RMS_EPS);
}
template <int ACT> struct EpiBf16 {
    static constexpr bool PERM = true, AFTER_DRAIN = false;
    bf16_t* O; int ldc; const float* ss;
    __device__ __forceinline__ void operator()(const f32x4 (&acc)[2][2][4][2], const Unit& u, int wr, int wc, int fr, int fq) const {
        const int row0 = u.pm * BM + wr * 64 + fr, col0 = u.pn * BM + wc * 32 + 8 * fq;
#pragma unroll
        for (int ai = 0; ai < 2; ++ai)
#pragma unroll
            for (int m = 0; m < 4; ++m) { const int r = row0 + ai * HALF + m * 16; const float rs = ss ? row_rstd(ss, r) : 1.0f;
                bf16_t* rowp = O + (size_t)r * ldc + col0;
#pragma unroll
                for (int bj = 0; bj < 2; ++bj) { f32x4 v0 = acc[ai][bj][m][0] * rs, v1 = acc[ai][bj][m][1] * rs;
                    if (ACT == 1) {
#pragma unroll
                        for (int j = 0; j < 4; ++j) { const float a = fmaxf(v0[j], 0.f), b = fmaxf(v1[j], 0.f); v0[j] = a * a; v1[j] = b * b; } }
                    u32x4 w; w.x = cvt_pk_bf16(v0[0], v0[1]); w.y = cvt_pk_bf16(v0[2], v0[3]); w.z = cvt_pk_bf16(v1[0], v1[1]); w.w = cvt_pk_bf16(v1[2], v1[3]);
                    *(u32x4*)(rowp + bj * HALF) = w; } }
    }
};
struct EpiRes {
    static constexpr bool PERM = true, AFTER_DRAIN = true;
    const float* base; float* out; bf16_t* xn; float* ss; int ldc;
    __device__ __forceinline__ void operator()(const f32x4 (&)[2][2][4][2], const Unit&, int, int, int, int) const {}
    __device__ __forceinline__ void fused(f32x4 (&acc)[2][2][4][2], const Unit& u, int wr, int wc, int fr, int fq, PG8_LAS unsigned char* lds, int wid, int lane) const {
        PG8_LAS float* P = (PG8_LAS float*)lds;
#pragma unroll
        for (int ai = 0; ai < 2; ++ai)
#pragma unroll
            for (int m = 0; m < 4; ++m) { const int rl = ai * HALF + wr * 64 + m * 16 + fr; const size_t off = (size_t)(u.pm * BM + rl) * ldc + u.pn * BM + wc * 32 + 8 * fq; float s = 0.f;
#pragma unroll
                for (int bj = 0; bj < 2; ++bj) { const f32x4 b0 = *(const f32x4*)(base + off + bj * HALF), b1 = *(const f32x4*)(base + off + bj * HALF + 4);
                    const f32x4 v0 = acc[ai][bj][m][0] + b0, v1 = acc[ai][bj][m][1] + b1;
                    *(f32x4*)(out + off + bj * HALF) = v0; *(f32x4*)(out + off + bj * HALF + 4) = v1;
                    u32x4 w; w.x = cvt_pk_bf16(v0[0], v0[1]); w.y = cvt_pk_bf16(v0[2], v0[3]); w.z = cvt_pk_bf16(v1[0], v1[1]); w.w = cvt_pk_bf16(v1[2], v1[3]);
                    *(u32x4*)(xn + off + bj * HALF) = w;
                    s += ((v0[0] * v0[0] + v0[1] * v0[1]) + (v0[2] * v0[2] + v0[3] * v0[3])) + ((v1[0] * v1[0] + v1[1] * v1[1]) + (v1[2] * v1[2] + v1[3] * v1[3])); }
                s += __shfl_xor(s, 16); s += __shfl_xor(s, 32);
                if (fq == 0) P[rl * 4 + wc] = s;
                asm volatile("" ::: "memory"); }
        asm volatile("s_waitcnt lgkmcnt(0)" ::: "memory"); __builtin_amdgcn_s_barrier(); asm volatile("" ::: "memory");
        const int t = wid * 64 + lane;
        if (t < 256) { const f32x4 p = *(const PG8_LAS f32x4*)(P + t * 4); ss[(size_t)(u.pm * BM + t) * 8 + u.pn] = (p[0] + p[1]) + (p[2] + p[3]); }
        asm volatile("s_waitcnt lgkmcnt(0)" ::: "memory"); __builtin_amdgcn_s_barrier(); asm volatile("" ::: "memory");
    }
};

template <class Epi, class Sched, bool ALIGN_EPI = false, bool SP2 = false>
__device__ __forceinline__ void gemm_phase(PG8_LAS unsigned char* lds, const Gemm g, const Sched& S, const Epi& E) {
    const int tid = threadIdx.x, wid = __builtin_amdgcn_readfirstlane(tid >> 6), lane = tid & 63, wr = wid >> 2, wc = wid & 3, fr = lane & 15, fq = lane >> 4;
    const int K = g.K, nt = K / BK;
    unsigned voffA[2], voffB[2];
#pragma unroll
    for (int i = 0; i < 2; ++i) { int R, C; stage_rc(tid * 16 + i * 8192, R, C); const int Rb = Epi::PERM ? ((R & ~31) + perm32(R & 31)) : R;
        voffA[i] = (unsigned)(R * K + C) * 2u; voffB[i] = (unsigned)(Rb * K + C) * 2u; }
    const size_t kstep = (size_t)(BK * 2);
    const size_t hstep = (size_t)HALF * K * 2;
    const size_t tstep = 2 * hstep;
    const unsigned ldsw = (unsigned)wid * 1024u;
    const int aoff = lds_byte(wr * 64 + fr, fq * 8), boff = lds_byte(wc * 32 + fr, fq * 8);
#define PG8_SA(b, h) (((b) * 2 + (h)) * HTB)
#define PG8_SB(b, h) ((4 + (b) * 2 + (h)) * HTB)
#define PG8_STAGE(bufoff, gbase, voff) do { _Pragma("unroll") for (int _i = 0; _i < 2; ++_i) \
        __builtin_amdgcn_global_load_lds((const unsigned*)((const char*)(gbase) + (voff)[_i]), (PG8_LAS unsigned*)(lds + (bufoff) + ldsw + _i * 8192), 16, 0, 0); } while (0)
#define PG8_LDA(dst, b, h) do { _Pragma("unroll") for (int m = 0; m < 4; ++m) _Pragma("unroll") for (int k = 0; k < 2; ++k) dst[m][k] = *(const PG8_LAS bf16x8*)(lds + PG8_SA(b, h) + aoff + m * 2048 + k * 1024); } while (0)
#define PG8_LDB(dst, b, h) do { _Pragma("unroll") for (int n = 0; n < 2; ++n) _Pragma("unroll") for (int k = 0; k < 2; ++k) dst[n][k] = *(const PG8_LAS bf16x8*)(lds + PG8_SB(b, h) + boff + n * 2048 + k * 1024); } while (0)
#define PG8_MMA(ai, bj, At, Bt) do { __builtin_amdgcn_s_setprio(1); _Pragma("unroll") for (int m = 0; m < 4; ++m) _Pragma("unroll") for (int n = 0; n < 2; ++n) _Pragma("unroll") for (int k = 0; k < 2; ++k) \
        acc[ai][bj][m][n] = __builtin_amdgcn_mfma_f32_16x16x32_bf16(Bt[n][k], At[m][k], acc[ai][bj][m][n], 0, 0, 0); __builtin_amdgcn_s_setprio(0); } while (0)
#define PG8_WAIT_V(n) asm volatile("s_waitcnt vmcnt(" #n ")" ::: "memory")
#define PG8_WAIT_L(n) asm volatile("s_waitcnt lgkmcnt(" #n ")" ::: "memory")
#define PG8_BAR __builtin_amdgcn_s_barrier()
#define PG8_SCHED __builtin_amdgcn_sched_barrier(0)
    Unit cur, nxt; int ui = 0;
    if (!S.next(0, cur)) return;
    f32x4 acc[2][2][4][2];
#pragma unroll
    for (int a = 0; a < 2; ++a)
#pragma unroll
        for (int b = 0; b < 2; ++b)
#pragma unroll
            for (int m = 0; m < 4; ++m)
#pragma unroll
                for (int n = 0; n < 2; ++n) acc[a][b][m][n] = (f32x4){0.f, 0.f, 0.f, 0.f};
    bf16x8 At[4][2], B0[2][2], B1[2][2];
    const char* cA = (const char*)g.A + (size_t)cur.pm * tstep; const char* cB = (const char*)g.Bt + (size_t)cur.pn * tstep;
    S.a_ready(cur);
    if constexpr (SP2) {
        PG8_STAGE(PG8_SB(0, 0), cB, voffB); PG8_STAGE(PG8_SB(0, 1), cB + hstep, voffB); PG8_STAGE(PG8_SA(0, 0), cA, voffA); PG8_STAGE(PG8_SA(0, 1), cA + hstep, voffA);
        if (wr == 1) PG8_BAR;
        PG8_WAIT_V(2); PG8_BAR;
        PG8_STAGE(PG8_SB(1, 0), cB + kstep, voffB); PG8_STAGE(PG8_SA(1, 0), cA + kstep, voffA); PG8_STAGE(PG8_SB(1, 1), cB + hstep + kstep, voffB);
        PG8_WAIT_V(6); PG8_BAR;
    } else {
        PG8_STAGE(PG8_SB(0, 0), cB, voffB); PG8_STAGE(PG8_SA(0, 0), cA, voffA); PG8_STAGE(PG8_SB(0, 1), cB + hstep, voffB); PG8_STAGE(PG8_SA(0, 1), cA + hstep, voffA);
        if (wr == 1) PG8_BAR;
        PG8_WAIT_V(4); PG8_BAR;
        PG8_STAGE(PG8_SB(1, 0), cB + kstep, voffB); PG8_STAGE(PG8_SA(1, 0), cA + kstep, voffA); PG8_STAGE(PG8_SB(1, 1), cB + hstep + kstep, voffB);
        PG8_WAIT_V(6); PG8_BAR;
    }
    for (;;) {
        const bool has_next = S.next(ui + 1, nxt);
        const char* nA = has_next ? (const char*)g.A + (size_t)nxt.pm * tstep : cA; const char* nB = has_next ? (const char*)g.Bt + (size_t)nxt.pn * tstep : cB;
        for (int t = 0; t < nt; t += 2) {
            const bool last = (t == nt - 2);
            const char* a1 = cA + (size_t)(t + 1) * kstep;
            const char* a2 = last ? nA : cA + (size_t)(t + 2) * kstep; const char* b2 = last ? nB : cB + (size_t)(t + 2) * kstep;
            const char* a3 = a2 + kstep; const char* b3 = b2 + kstep;
            if (last && has_next) S.a_ready(nxt);
            if constexpr (SP2) {
            PG8_LDB(B0, 0, 0); PG8_LDB(B1, 0, 1); PG8_SCHED; PG8_LDA(At, 0, 0); PG8_STAGE(PG8_SA(1, 1), a1 + hstep, voffA);
            PG8_WAIT_V(8); PG8_WAIT_L(0); PG8_BAR; PG8_MMA(0, 0, At, B0); PG8_MMA(0, 1, At, B1); PG8_BAR; PG8_SCHED;
            PG8_LDA(At, 0, 1); PG8_STAGE(PG8_SB(0, 0), b2, voffB); PG8_STAGE(PG8_SB(0, 1), b2 + hstep, voffB); PG8_STAGE(PG8_SA(0, 0), a2, voffA);
            PG8_WAIT_V(8); PG8_WAIT_L(0); PG8_BAR; PG8_MMA(1, 0, At, B0); PG8_MMA(1, 1, At, B1); PG8_BAR; PG8_SCHED;
            PG8_LDB(B0, 1, 0); PG8_LDB(B1, 1, 1); PG8_SCHED; PG8_LDA(At, 1, 0); PG8_STAGE(PG8_SA(0, 1), a2 + hstep, voffA);
            PG8_WAIT_V(8); PG8_WAIT_L(0); PG8_BAR; PG8_MMA(0, 0, At, B0); PG8_MMA(0, 1, At, B1); PG8_BAR; PG8_SCHED;
            PG8_LDA(At, 1, 1); PG8_STAGE(PG8_SB(1, 0), b3, voffB); PG8_STAGE(PG8_SB(1, 1), b3 + hstep, voffB); PG8_STAGE(PG8_SA(1, 0), a3, voffA);
            PG8_WAIT_V(8); PG8_WAIT_L(0); PG8_BAR; PG8_MMA(1, 0, At, B0); PG8_MMA(1, 1, At, B1); PG8_BAR; PG8_SCHED;
            } else {
            PG8_LDB(B0, 0, 0); PG8_SCHED; PG8_LDA(At, 0, 0); PG8_STAGE(PG8_SA(1, 1), a1 + hstep, voffA);
            PG8_WAIT_L(8); PG8_BAR; PG8_WAIT_L(0); PG8_MMA(0, 0, At, B0); PG8_BAR; PG8_SCHED;
            PG8_LDB(B1, 0, 1); PG8_STAGE(PG8_SB(0, 0), b2, voffB);
            PG8_BAR; PG8_WAIT_L(0); PG8_MMA(0, 1, At, B1); PG8_BAR;
            PG8_LDA(At, 0, 1); PG8_STAGE(PG8_SA(0, 0), a2, voffA);
            PG8_BAR; PG8_WAIT_L(0); PG8_MMA(1, 0, At, B0); PG8_BAR; PG8_SCHED;
            PG8_STAGE(PG8_SB(0, 1), b2 + hstep, voffB);
            PG8_WAIT_V(6); PG8_BAR; PG8_MMA(1, 1, At, B1); PG8_BAR;
            PG8_LDB(B0, 1, 0); PG8_SCHED; PG8_LDA(At, 1, 0); PG8_STAGE(PG8_SA(0, 1), a2 + hstep, voffA);
            PG8_WAIT_L(8); PG8_BAR; PG8_WAIT_L(0); PG8_MMA(0, 0, At, B0); PG8_BAR; PG8_SCHED;
            PG8_LDB(B1, 1, 1); PG8_STAGE(PG8_SB(1, 0), b3, voffB);
            PG8_BAR; PG8_WAIT_L(0); PG8_MMA(0, 1, At, B1); PG8_BAR;
            PG8_LDA(At, 1, 1); PG8_STAGE(PG8_SA(1, 0), a3, voffA);
            PG8_BAR; PG8_WAIT_L(0); PG8_MMA(1, 0, At, B0); PG8_BAR; PG8_SCHED;
            PG8_STAGE(PG8_SB(1, 1), b3 + hstep, voffB);
            PG8_WAIT_V(6); PG8_BAR; PG8_MMA(1, 1, At, B1); PG8_BAR;
            }
        }
        if constexpr (ALIGN_EPI) { if (wr == 0) PG8_BAR; }
        if constexpr (!Epi::AFTER_DRAIN) { E(acc, cur, wr, wc, fr, fq); S.done(cur); }
        if (!has_next) break;
#pragma unroll
        for (int a = 0; a < 2; ++a)
#pragma unroll
            for (int b = 0; b < 2; ++b)
#pragma unroll
                for (int m = 0; m < 4; ++m)
#pragma unroll
                    for (int n = 0; n < 2; ++n) acc[a][b][m][n] = (f32x4){0.f, 0.f, 0.f, 0.f};
        cur = nxt; cA = nA; cB = nB; ++ui;
        if constexpr (ALIGN_EPI) { if (wr == 1) PG8_BAR; }
    }
    PG8_WAIT_V(0);
    if constexpr (!ALIGN_EPI) { if (wr == 0) PG8_BAR; }
    PG8_BAR;
    if constexpr (Epi::AFTER_DRAIN) { E.fused(acc, cur, wr, wc, fr, fq, lds, wid, lane); S.done(cur); }
#undef PG8_SA
#undef PG8_SB
#undef PG8_STAGE
#undef PG8_LDA
#undef PG8_LDB
#undef PG8_MMA
#undef PG8_WAIT_V
#undef PG8_WAIT_L
#undef PG8_BAR
#undef PG8_SCHED
}
}

constexpr int NWAVES = 8;
constexpr int SEQ = 8192, DM = 2048, DFF = 8192, EVEN_IN = 3584, ODD_IN = 6144;
constexpr int OFF_K = 1024, OFF_V = 1280, OFF_X = 1536, OFF_G = 2560;
#ifndef MK_N_LAUNCHES
#define MK_N_LAUNCHES 1
#endif
constexpr int N_PHASES = 13;
constexpr size_t MiB = 1u << 20;
constexpr size_t WS_CTL = 0, CTL_ZERO_BYTES = 64 * 1024;
constexpr size_t WS_SS = 1 * MiB;
constexpr size_t WS_BT = 1 * MiB + 512 * 1024;
constexpr size_t WS_GWT = 1 * MiB + 768 * 1024;
constexpr size_t WS_WIN0 = 2 * MiB, WS_WOUT0 = 16 * MiB, WS_WUP0 = 24 * MiB, WS_WDN0 = 56 * MiB, WS_WIN1 = 88 * MiB, WS_WOUT1 = 112 * MiB, WS_WUP1 = 120 * MiB, WS_WDN1 = 152 * MiB;
constexpr size_t WS_XN = 184 * MiB;
constexpr size_t WS_Y = 216 * MiB;
constexpr size_t WS_PROJ = 248 * MiB;
constexpr size_t WS_HL = 344 * MiB, WS_PA = 376 * MiB;
constexpr size_t WS_ACT = 248 * MiB;
constexpr size_t WS_END = 408 * MiB;
constexpr int CW_BAR = 1024;

constexpr int RING_OFF = 0, RING_BYTES = 131072;
constexpr int LDSCTL_OFF = RING_BYTES, MISC_OFF = LDSCTL_OFF + 320;
constexpr int LDS_BYTES = 147456;

#define GAS __attribute__((address_space(1)))
#define LAS __attribute__((address_space(3)))
typedef unsigned short bf16;
typedef unsigned v4u __attribute__((ext_vector_type(4)));
typedef unsigned v2u __attribute__((ext_vector_type(2)));
typedef float f32x4 __attribute__((ext_vector_type(4)));
#define LDS_WAIT() asm volatile("s_waitcnt lgkmcnt(0)" ::: "memory")
#define VM_WAIT() asm volatile("s_waitcnt vmcnt(0)" ::: "memory")
__device__ __forceinline__ unsigned f2bf(float f) { unsigned u = __builtin_bit_cast(unsigned, f); return (u + 0x7fffu + ((u >> 16) & 1u)) >> 16; }
__device__ __forceinline__ unsigned pk2(float lo, float hi) { return f2bf(lo) | (f2bf(hi) << 16); }
__device__ __forceinline__ float bflo(unsigned w) { return __builtin_bit_cast(float, w << 16); }
__device__ __forceinline__ float bfhi(unsigned w) { return __builtin_bit_cast(float, w & 0xffff0000u); }

#define XB_TMO      128
#define XB_XCNT(j)  (256  + 64 * (j))
#define XB_XSUB(j)  (1280 + 64 * (j))
#define XB_XGEN(j)  (2304 + 64 * (j))
#define XB_TOP      3328
#define XB_TOPGEN   3392
#define XCD_BAR_WORDS 3456
#define XB_SPIN_CAP (1u << 22)

__device__ __forceinline__ unsigned xb_ld(unsigned* p)              { return __hip_atomic_load(p, __ATOMIC_RELAXED, __HIP_MEMORY_SCOPE_AGENT); }
__device__ __forceinline__ unsigned xb_add(unsigned* p, unsigned v) { return __hip_atomic_fetch_add(p, v, __ATOMIC_RELAXED, __HIP_MEMORY_SCOPE_AGENT); }
__device__ __forceinline__ unsigned xb_xcc_id() { return (unsigned)__builtin_amdgcn_s_getreg((3 << 11) | 20) & 0xFu; }
#define XB_SPIN(cond, bar) do { unsigned _sp = 0; while (cond) { __builtin_amdgcn_s_sleep(1); \
    if ((++_sp & 255u) == 0u) { if (xb_ld(&(bar)[XB_TMO])) break; if (_sp > XB_SPIN_CAP) { atomicAdd(&(bar)[XB_TMO], 1u); break; } } } } while (0)

struct XcdBarrier {
    unsigned* bar; unsigned x;
    volatile LAS unsigned* st;
};

__device__ __forceinline__ XcdBarrier xcd_barrier_post(unsigned* bar, volatile LAS unsigned* st) {
    XcdBarrier b; b.bar = bar; b.x = xb_xcc_id(); b.st = st;
    if (threadIdx.x == 0) (void)xb_add(&bar[XB_XCNT(b.x)], 1u);
    return b;
}
__device__ __forceinline__ void xcd_barrier_complete(unsigned* bar, unsigned x, unsigned& nloc, unsigned& nx) {
    const unsigned G = gridDim.x * gridDim.y * gridDim.z;
    unsigned sum, cnt, mine, sp = 0u;
    for (;;) {
        sum = 0u; cnt = 0u; mine = 0u;
#pragma unroll
        for (unsigned j = 0; j < 16; ++j) { const unsigned c = xb_ld(&bar[XB_XCNT(j)]); sum += c; cnt += (c > 0u) ? 1u : 0u; mine = (j == x) ? c : mine; }
        if (sum == G) break;
        __builtin_amdgcn_s_sleep(1);
        if ((++sp & 255u) == 0u) { if (xb_ld(&bar[XB_TMO])) break; if (sp > XB_SPIN_CAP) { atomicAdd(&bar[XB_TMO], 1u); break; } }
    }
    nloc = mine > 0u ? mine : 1u; nx = cnt > 0u ? cnt : 1u;
}

__device__ __forceinline__ void xcd_barrier(const XcdBarrier& b) {
    asm volatile("s_waitcnt vmcnt(0)" ::: "memory");
    __syncthreads();
    if (threadIdx.x == 0) {
        unsigned* bar = b.bar;
        __builtin_amdgcn_s_waitcnt(0);
        unsigned nloc = b.st[0], nx = b.st[1];
        if (nloc == 0u) { xcd_barrier_complete(bar, b.x, nloc, nx); b.st[0] = nloc; b.st[1] = nx; }
        const unsigned old = xb_add(&bar[XB_XSUB(b.x)], 1u);
        const unsigned gen = old / nloc;
        if (old + 1u == (gen + 1u) * nloc) {
            __builtin_amdgcn_fence(__ATOMIC_RELEASE, "agent");
            asm volatile("s_waitcnt vmcnt(0)" ::: "memory");
            const unsigned og = xb_add(&bar[XB_TOP], 1u);
            const unsigned tg = og / nx;
            if (og + 1u == (tg + 1u) * nx) xb_add(&bar[XB_TOPGEN], 1u);
            else XB_SPIN(xb_ld(&bar[XB_TOPGEN]) == tg, bar);
            __builtin_amdgcn_fence(__ATOMIC_ACQUIRE, "agent");
            xb_add(&bar[XB_XGEN(b.x)], 1u);
            asm volatile("s_waitcnt vmcnt(0)" ::: "memory");
        } else {
            XB_SPIN(xb_ld(&bar[XB_XGEN(b.x)]) == gen, bar);
            __builtin_amdgcn_fence(__ATOMIC_ACQUIRE, "agent");
            asm volatile("s_waitcnt vmcnt(0)" ::: "memory");
        }
    }
    __syncthreads();
}
struct Frame {
    LAS unsigned char* lds;
    int tid, lane, wave, G;
    const float* in[19]; float* out; unsigned char* ws;
};
#define IN_X 0
#define IN_RELB 1
#define IN_NMIX 2
#define IN_EWIN 3
#define IN_CONVW 4
#define IN_CONVB 5
#define IN_GAW 6
#define IN_GAB 7
#define IN_GXW 8
#define IN_GXB 9
#define IN_LAMBDA 10
#define IN_SINKS 11
#define IN_EWOUT 12
#define IN_OWIN 13
#define IN_OWOUT 14
#define IN_NMLP 15
#define IN_WUP 16
#define IN_WDOWN 17
#define IN_FNORM 18

__device__ __forceinline__ float wave_sum(float v) {
#pragma unroll
    for (int o = 1; o < 64; o <<= 1) v += __shfl_xor(v, o);
    return v;
}
struct P0Tile { const float* W; const float* gain; bf16* WT; int K, N, k0, n0; };
__device__ __forceinline__ void p0_tile_load(const P0Tile& t, int lane, f32x4 (&v)[16]) {
    const GAS f32x4* p = (const GAS f32x4*)(t.W + (size_t)(t.k0 + (lane >> 4)) * t.N + t.n0 + 4 * (lane & 15));
#pragma unroll
    for (int i = 0; i < 16; ++i) v[i] = p[(size_t)i * t.N];
}
__device__ __forceinline__ void p0_tile_store(const P0Tile& t, int lane, const f32x4 (&v)[16], LAS float* scr) {
#pragma unroll
    for (int i = 0; i < 16; ++i) { const int kk = (lane >> 4) + 4 * i; *(LAS f32x4*)(scr + kk * 64 + ((4 * (lane & 15)) ^ (4 * ((kk >> 3) & 7)))) = v[i]; }
    LDS_WAIT(); asm volatile("" ::: "memory");
    const int kc = lane & 7;
    float g[8];
    if (t.gain) { const f32x4 a = *(const GAS f32x4*)(t.gain + t.k0 + 8 * kc), b = *(const GAS f32x4*)(t.gain + t.k0 + 8 * kc + 4); g[0] = a[0]; g[1] = a[1]; g[2] = a[2]; g[3] = a[3]; g[4] = b[0]; g[5] = b[1]; g[6] = b[2]; g[7] = b[3]; }
    else {
#pragma unroll
        for (int e = 0; e < 8; ++e) g[e] = 1.0f; }
#pragma unroll
    for (int j = 0; j < 8; ++j) { const int n = (lane >> 3) + 8 * j; const LAS float* s = scr + (8 * kc) * 64 + (n ^ (4 * kc));
        v4u o; o.x = pk2(s[0] * g[0], s[64] * g[1]); o.y = pk2(s[128] * g[2], s[192] * g[3]); o.z = pk2(s[256] * g[4], s[320] * g[5]); o.w = pk2(s[384] * g[6], s[448] * g[7]);
        *(GAS v4u*)(t.WT + (size_t)(t.n0 + n) * t.K + t.k0 + 8 * kc) = o; }
    LDS_WAIT(); asm volatile("" ::: "memory");
}
__device__ __forceinline__ int t5_bucket(int rel) {
    const int ret = rel > 0 ? 16 : 0, n = rel < 0 ? -rel : rel;
    if (n < 8) return ret + n;
    int large = 8 + (31 - __builtin_clz((unsigned)(n * n))) - 6; if (large > 15) large = 15;
    return ret + large;
}
__device__ __forceinline__ void p0_prologue(Frame& F) {
    LAS float* scr = (LAS float*)(F.lds + RING_OFF + F.wave * 16384);
    const int gw = blockIdx.x * NWAVES + F.wave, NGW = F.G * NWAVES;
    unsigned char* ws = F.ws;
    constexpr int T_IN0 = (DM / 64) * (EVEN_IN / 64), T_OUT = (DM / 64) * (DM / 64), T_UP = (DM / 64) * (DFF / 64), T_DN = (DFF / 64) * (DM / 64), T_IN1 = (DM / 64) * (ODD_IN / 64);
    constexpr int NTILES = T_IN0 + T_IN1 + 2 * T_OUT + 2 * T_UP + 2 * T_DN;
#define P0_DESC(it, t) do { int r_ = (it); \
        if (r_ < T_IN0) { t.W = F.in[IN_EWIN]; t.gain = F.in[IN_NMIX]; t.WT = (bf16*)(ws + WS_WIN0); t.K = DM; t.N = EVEN_IN; } else { r_ -= T_IN0; \
        if (r_ < T_OUT) { t.W = F.in[IN_EWOUT]; t.gain = nullptr; t.WT = (bf16*)(ws + WS_WOUT0); t.K = DM; t.N = DM; } else { r_ -= T_OUT; \
        if (r_ < T_UP) { t.W = F.in[IN_WUP]; t.gain = F.in[IN_NMLP]; t.WT = (bf16*)(ws + WS_WUP0); t.K = DM; t.N = DFF; } else { r_ -= T_UP; \
        if (r_ < T_DN) { t.W = F.in[IN_WDOWN]; t.gain = nullptr; t.WT = (bf16*)(ws + WS_WDN0); t.K = DFF; t.N = DM; } else { r_ -= T_DN; \
        if (r_ < T_IN1) { t.W = F.in[IN_OWIN]; t.gain = F.in[IN_NMIX] + DM; t.WT = (bf16*)(ws + WS_WIN1); t.K = DM; t.N = ODD_IN; } else { r_ -= T_IN1; \
        if (r_ < T_OUT) { t.W = F.in[IN_OWOUT]; t.gain = nullptr; t.WT = (bf16*)(ws + WS_WOUT1); t.K = DM; t.N = DM; } else { r_ -= T_OUT; \
        if (r_ < T_UP) { t.W = F.in[IN_WUP] + (size_t)DM * DFF; t.gain = F.in[IN_NMLP] + DM; t.WT = (bf16*)(ws + WS_WUP1); t.K = DM; t.N = DFF; } else { r_ -= T_UP; \
        t.W = F.in[IN_WDOWN] + (size_t)DFF * DM; t.gain = nullptr; t.WT = (bf16*)(ws + WS_WDN1); t.K = DFF; t.N = DM; } } } } } } } \
        const int nb_ = t.N / 64; t.k0 = 64 * (r_ / nb_); t.n0 = 64 * (r_ % nb_); } while (0)
    {
        f32x4 va[16], vb[16]; P0Tile ta, tb;
        int it = gw;
        if (it < NTILES) { P0_DESC(it, ta); p0_tile_load(ta, F.lane, va); }
        while (it < NTILES) {
            const int itn = it + NGW; const bool more = itn < NTILES;
            if (more) { P0_DESC(itn, tb); p0_tile_load(tb, F.lane, vb); }
            p0_tile_store(ta, F.lane, va, scr);
            if (more) { ta = tb;
#pragma unroll
                for (int i = 0; i < 16; ++i) va[i] = vb[i]; }
            it = itn;
        }
    }
#undef P0_DESC
    bf16* XN = (bf16*)(ws + WS_XN); float* SS = (float*)(ws + WS_SS);
    for (int m = gw; m < SEQ; m += NGW) {
        const GAS f32x4* xr = (const GAS f32x4*)(F.in[IN_X] + (size_t)m * DM) + F.lane;
        f32x4 v[8]; float s = 0.f;
#pragma unroll
        for (int j = 0; j < 8; ++j) { v[j] = xr[64 * j]; s += (v[j].x * v[j].x + v[j].y * v[j].y) + (v[j].z * v[j].z + v[j].w * v[j].w); }
        s = wave_sum(s);
        GAS v2u* o8 = (GAS v2u*)(XN + (size_t)m * DM) + F.lane;
#pragma unroll
        for (int j = 0; j < 8; ++j) { v2u w; w.x = pk2(v[j].x, v[j].y); w.y = pk2(v[j].z, v[j].w); o8[64 * j] = w; }
        if (F.lane < 8) SS[(size_t)m * 8 + F.lane] = F.lane == 0 ? s : 0.f;
    }
    float* BT = (float*)(ws + WS_BT);
    for (int i = blockIdx.x * 512 + F.tid; i < 16 * 256; i += F.G * 512) { const int head = i >> 8, rel = (i & 255) - 191; BT[i] = F.in[IN_RELB][t5_bucket(rel) * 16 + head]; }
    bf16* GWT = (bf16*)(ws + WS_GWT);
    for (int i = blockIdx.x * 512 + F.tid; i < 2 * 16 * 64 * 64; i += F.G * 512) { const int gate = i >> 16, hb = (i >> 12) & 15, jo = (i >> 6) & 63, ii = i & 63;
        GWT[i] = (bf16)f2bf(F.in[gate ? IN_GXW : IN_GAW][(size_t)(hb * 64 + ii) * 64 + jo]); }
}

__device__ __forceinline__ void ld8(const bf16* p, float (&o)[8]) { const v4u w = *(const GAS v4u*)p; o[0] = bflo(w.x); o[1] = bfhi(w.x); o[2] = bflo(w.y); o[3] = bfhi(w.y); o[4] = bflo(w.z); o[5] = bfhi(w.z); o[6] = bflo(w.w); o[7] = bfhi(w.w); }
__device__ __forceinline__ void swa_naive(Frame& F) {
    const bf16* PROJ = (const bf16*)(F.ws + WS_PROJ); bf16* Y = (bf16*)(F.ws + WS_Y); const float* BT = (const float*)(F.ws + WS_BT);
    for (int idx = blockIdx.x * 512 + F.tid; idx < SEQ * 16; idx += F.G * 512) {
        const int head = idx >> 13, tok = idx & (SEQ - 1), kvh = head >> 2, c = tok >> 6;
        float q[64], acc[64];
#pragma unroll
        for (int i = 0; i < 8; ++i) { float t[8]; ld8(PROJ + (size_t)tok * EVEN_IN + head * 64 + 8 * i, t);
#pragma unroll
            for (int j = 0; j < 8; ++j) { q[8 * i + j] = t[j] * 0.125f; acc[8 * i + j] = 0.f; } }
        float m = F.in[IN_SINKS][head], l = 1.0f;
        const int k0 = c >= 2 ? (c - 2) * 64 : 0, k1 = (c + 1) * 64;
        const float* bt = BT + head * 256;
        for (int j = k0; j < k1; ++j) {
            const bf16* kp = PROJ + (size_t)j * EVEN_IN + OFF_K + kvh * 64; float s = 0.f;
#pragma unroll
            for (int i = 0; i < 8; ++i) { float t[8]; ld8(kp + 8 * i, t);
#pragma unroll
                for (int e = 0; e < 8; ++e) s += q[8 * i + e] * t[e]; }
            s += bt[j - tok + 191];
            const float mn = fmaxf(m, s), corr = expf(m - mn), p = expf(s - mn);
            l = l * corr + p; m = mn;
            const bf16* vp = PROJ + (size_t)j * EVEN_IN + OFF_V + kvh * 64;
#pragma unroll
            for (int i = 0; i < 8; ++i) { float t[8]; ld8(vp + 8 * i, t);
#pragma unroll
                for (int e = 0; e < 8; ++e) acc[8 * i + e] = acc[8 * i + e] * corr + p * t[e]; }
        }
        const float inv = 1.0f / l;
#pragma unroll
        for (int i = 0; i < 8; ++i) { v4u w; w.x = pk2(acc[8 * i] * inv, acc[8 * i + 1] * inv); w.y = pk2(acc[8 * i + 2] * inv, acc[8 * i + 3] * inv); w.z = pk2(acc[8 * i + 4] * inv, acc[8 * i + 5] * inv); w.w = pk2(acc[8 * i + 6] * inv, acc[8 * i + 7] * inv);
            *(GAS v4u*)(Y + (size_t)tok * DM + head * 64 + 8 * i) = w; }
    }
}
__device__ __forceinline__ float softplusf(float z) { return fmaxf(z, 0.f) + log1pf(expf(-fabsf(z))); }
__device__ __forceinline__ float sigmoidf_(float z) { return 1.0f / (1.0f + expf(-z)); }
__device__ __forceinline__ float gelu_tanh(float x) { const float u = 0.7978845608028654f * (x + 0.044715f * x * x * x); return 0.5f * x * (1.0f + tanhf(u)); }
__device__ __forceinline__ void lru_naive(Frame& F) {
    if (blockIdx.x >= 16 || F.wave != 0) return;
    const bf16* PROJ = (const bf16*)(F.ws + WS_PROJ); bf16* Y = (bf16*)(F.ws + WS_Y);
    const int hb = blockIdx.x, lane = F.lane, c = hb * 64 + lane;
    float Wa[64], Wx[64];
#pragma unroll
    for (int i = 0; i < 64; ++i) { Wa[i] = F.in[IN_GAW][(size_t)(hb * 64 + i) * 64 + lane]; Wx[i] = F.in[IN_GXW][(size_t)(hb * 64 + i) * 64 + lane]; }
    const float ba = F.in[IN_GAB][c], bx = F.in[IN_GXB][c], cb = F.in[IN_CONVB][c];
    const float cw0 = F.in[IN_CONVW][c], cw1 = F.in[IN_CONVW][1024 + c], cw2 = F.in[IN_CONVW][2048 + c], cw3 = F.in[IN_CONVW][3072 + c];
    const float sp8 = 8.0f * softplusf(-F.in[IN_LAMBDA][c]);
    float x1 = 0.f, x2 = 0.f, x3 = 0.f, h = 0.f;
    for (int t0 = 0; t0 < SEQ; t0 += 8) {
        float xb[8], g[8];
#pragma unroll
        for (int u = 0; u < 8; ++u) { xb[u] = bflo((unsigned)PROJ[(size_t)(t0 + u) * EVEN_IN + OFF_X + c]); g[u] = bflo((unsigned)PROJ[(size_t)(t0 + u) * EVEN_IN + OFF_G + c]); }
#pragma unroll
        for (int u = 0; u < 8; ++u) {
            const float xt = xb[u], xc = cb + cw0 * x3 + cw1 * x2 + cw2 * x1 + cw3 * xt; x3 = x2; x2 = x1; x1 = xt;
            float ra = ba, rx = bx; const int xci = __builtin_bit_cast(int, xc);
#pragma unroll
            for (int i = 0; i < 64; ++i) { const float xi = __builtin_bit_cast(float, __builtin_amdgcn_readlane(xci, i)); ra += xi * Wa[i]; rx += xi * Wx[i]; }
            const float r = sigmoidf_(ra), ig = sigmoidf_(rx), log_a = -r * sp8, a = expf(log_a), mult = sqrtf(-expm1f(2.0f * log_a));
            h = a * h + mult * (ig * xc);
            Y[(size_t)(t0 + u) * DM + 1024 + c] = (bf16)f2bf(gelu_tanh(g[u]) * h);
        }
    }
}
__device__ __forceinline__ void sb_naive(Frame& F) {
    const bf16* PROJ = (const bf16*)(F.ws + WS_PROJ); bf16* Y = (bf16*)(F.ws + WS_Y);
    const int gt = blockIdx.x * 512 + F.tid, half = gt & 1;
    for (int pidx = gt >> 1; pidx < SEQ * 16; pidx += (F.G * 512) >> 1) {
        const int head = pidx >> 13, tok = pidx & (SEQ - 1);
        float q[64], acc[64];
#pragma unroll
        for (int i = 0; i < 8; ++i) { float t[8]; ld8(PROJ + (size_t)tok * ODD_IN + head * 128 + half * 64 + 8 * i, t);
#pragma unroll
            for (int j = 0; j < 8; ++j) { q[8 * i + j] = t[j] * 0.08838834764831845f; acc[8 * i + j] = 0.f; } }
        float stick = 0.f;
        for (int j = tok - 1; j >= 0; --j) {
            const bf16* kp = PROJ + (size_t)j * ODD_IN + 2048 + head * 128 + half * 64; float s = 0.f;
#pragma unroll
            for (int i = 0; i < 8; ++i) { float t[8]; ld8(kp + 8 * i, t);
#pragma unroll
                for (int e = 0; e < 8; ++e) s += q[8 * i + e] * t[e]; }
            const float z = s + __shfl_xor(s, 1);
            const float lk = -softplusf(z), w = expf(z + lk + stick);
            const bf16* vp = PROJ + (size_t)j * ODD_IN + 4096 + head * 128 + half * 64;
#pragma unroll
            for (int i = 0; i < 8; ++i) { float t[8]; ld8(vp + 8 * i, t);
#pragma unroll
                for (int e = 0; e < 8; ++e) acc[8 * i + e] += w * t[e]; }
            stick += lk;
            if (stick < -104.0f) break;
        }
#pragma unroll
        for (int i = 0; i < 8; ++i) { v4u w; w.x = pk2(acc[8 * i], acc[8 * i + 1]); w.y = pk2(acc[8 * i + 2], acc[8 * i + 3]); w.z = pk2(acc[8 * i + 4], acc[8 * i + 5]); w.w = pk2(acc[8 * i + 6], acc[8 * i + 7]);
            *(GAS v4u*)(Y + (size_t)tok * DM + head * 128 + half * 64 + 8 * i) = w; }
    }
}
__device__ __forceinline__ void final_norm(Frame& F) {
    const int gw = blockIdx.x * NWAVES + F.wave, NGW = F.G * NWAVES;
    const GAS f32x4* gp = (const GAS f32x4*)F.in[IN_FNORM] + F.lane;
    for (int m = gw; m < SEQ; m += NGW) {
        GAS f32x4* xr = (GAS f32x4*)(F.out + (size_t)m * DM) + F.lane;
        f32x4 v[8]; float s = 0.f;
#pragma unroll
        for (int j = 0; j < 8; ++j) { v[j] = xr[64 * j]; s += (v[j].x * v[j].x + v[j].y * v[j].y) + (v[j].z * v[j].z + v[j].w * v[j].w); }
        const float rstd = 1.0f / sqrtf(wave_sum(s) * (1.0f / DM) + 1e-6f);
#pragma unroll
        for (int j = 0; j < 8; ++j) xr[64 * j] = v[j] * rstd * gp[64 * j];
    }
}
typedef float f32x16 __attribute__((ext_vector_type(16)));
typedef short s16x8 __attribute__((ext_vector_type(8)));
typedef short s16x4 __attribute__((ext_vector_type(4)));
typedef __bf16 bf16x2v __attribute__((ext_vector_type(2)));
#define MFMA32(a, b, c) __builtin_amdgcn_mfma_f32_32x32x16_bf16((a), (b), (c), 0, 0, 0)
__device__ __forceinline__ int crow(int i, int h) { return (i & 3) + 8 * (i >> 2) + 4 * h; }
__device__ __forceinline__ unsigned pkbf(float a, float b) { bf16x2v v; v.x = (__bf16)a; v.y = (__bf16)b; return __builtin_bit_cast(unsigned, v); }
__device__ __forceinline__ s16x8 pack8(const float (&p)[16], int s) {
    v4u w; w.x = pkbf(p[8 * s], p[8 * s + 1]); w.y = pkbf(p[8 * s + 2], p[8 * s + 3]); w.z = pkbf(p[8 * s + 4], p[8 * s + 5]); w.w = pkbf(p[8 * s + 6], p[8 * s + 7]);
    return __builtin_bit_cast(s16x8, w);
}
__device__ __forceinline__ s16x8 tr_frag(const LAS unsigned char* p0, const LAS unsigned char* p1) {
    const s16x4 lo = __builtin_amdgcn_ds_read_tr16_b64_v4i16((LAS s16x4*)p0), hi = __builtin_amdgcn_ds_read_tr16_b64_v4i16((LAS s16x4*)p1);
    return __builtin_shufflevector(lo, hi, 0, 1, 2, 3, 4, 5, 6, 7);
}
__device__ __forceinline__ float fast_softplus(float z) { return fmaxf(z, 0.f) + __logf(1.0f + __expf(-fabsf(z))); }
__device__ __forceinline__ float fast_sigmoid(float z) { return __builtin_amdgcn_rcpf(1.0f + __expf(-z)); }

__device__ __forceinline__ void lru_local(Frame& F) {
    const bf16* PROJ = (const bf16*)(F.ws + WS_PROJ); float* HL = (float*)(F.ws + WS_HL); float* PA = (float*)(F.ws + WS_PA); const bf16* GWT = (const bf16*)(F.ws + WS_GWT);
    LAS unsigned char* xc16 = F.lds;
    LAS float* xc32 = (LAS float*)(F.lds + 18432);
    LAS float* comp = (LAS float*)(F.lds + 18432 + 34816);
    const int tid = F.tid, lane = F.lane, w = F.wave, ts = w & 3, ch = w >> 2, r = lane & 31, h = lane >> 5;
    for (int u = blockIdx.x; u < 1024; u += F.G) {
        const int hb = u & 15, k = u >> 4, t0 = k * 128;
        {
            const int tt = tid >> 2, cg = tid & 3, cbase = hb * 64 + cg * 16, t = t0 + tt;
            float xc[16];
            { const GAS f32x4* cbp = (const GAS f32x4*)(F.in[IN_CONVB] + cbase);
#pragma unroll
              for (int q4 = 0; q4 < 4; ++q4) { const f32x4 b = cbp[q4]; xc[4 * q4] = b[0]; xc[4 * q4 + 1] = b[1]; xc[4 * q4 + 2] = b[2]; xc[4 * q4 + 3] = b[3]; } }
#pragma unroll
            for (int d = 0; d < 4; ++d) { const int row = t - 3 + d;
                float xv[16];
                if (row >= 0) { float a8[8], b8[8]; ld8(PROJ + (size_t)row * EVEN_IN + OFF_X + cbase, a8); ld8(PROJ + (size_t)row * EVEN_IN + OFF_X + cbase + 8, b8);
#pragma unroll
                    for (int e = 0; e < 8; ++e) { xv[e] = a8[e]; xv[8 + e] = b8[e]; } }
                else {
#pragma unroll
                    for (int e = 0; e < 16; ++e) xv[e] = 0.f; }
                const GAS f32x4* cwp = (const GAS f32x4*)(F.in[IN_CONVW] + d * 1024 + cbase);
#pragma unroll
                for (int q4 = 0; q4 < 4; ++q4) { const f32x4 cw = cwp[q4];
#pragma unroll
                    for (int e = 0; e < 4; ++e) xc[4 * q4 + e] += cw[e] * xv[4 * q4 + e]; } }
#pragma unroll
            for (int q4 = 0; q4 < 4; ++q4) *(LAS f32x4*)(xc32 + tt * 68 + cg * 16 + 4 * q4) = (f32x4){xc[4 * q4], xc[4 * q4 + 1], xc[4 * q4 + 2], xc[4 * q4 + 3]};
#pragma unroll
            for (int q8 = 0; q8 < 2; ++q8) { v4u o; o.x = pkbf(xc[8 * q8], xc[8 * q8 + 1]); o.y = pkbf(xc[8 * q8 + 2], xc[8 * q8 + 3]); o.z = pkbf(xc[8 * q8 + 4], xc[8 * q8 + 5]); o.w = pkbf(xc[8 * q8 + 6], xc[8 * q8 + 7]);
                *(LAS v4u*)(xc16 + tt * 144 + cg * 32 + q8 * 16) = o; }
        }
        __syncthreads();
        f32x16 acc_a, acc_x;
#pragma unroll
        for (int i = 0; i < 16; ++i) { acc_a[i] = 0.f; acc_x[i] = 0.f; }
#pragma unroll
        for (int s = 0; s < 4; ++s) {
            const s16x8 af = *(const LAS s16x8*)(xc16 + (ts * 32 + r) * 144 + (16 * s + 8 * h) * 2);
            const s16x8 ba = *(const GAS s16x8*)(GWT + (size_t)((0 * 16 + hb) * 64 + ch * 32 + r) * 64 + 16 * s + 8 * h);
            const s16x8 bx = *(const GAS s16x8*)(GWT + (size_t)((1 * 16 + hb) * 64 + ch * 32 + r) * 64 + 16 * s + 8 * h);
            acc_a = MFMA32(af, ba, acc_a); acc_x = MFMA32(af, bx, acc_x);
        }
        const int c = hb * 64 + ch * 32 + r;
        const float gab = F.in[IN_GAB][c], gxb = F.in[IN_GXB][c], sp8 = 8.0f * softplusf(-F.in[IN_LAMBDA][c]);
        float pa[16], hl[16], gA[4], gU[4];
#pragma unroll
        for (int g = 0; g < 4; ++g) { float A = 1.f, U = 0.f;
#pragma unroll
            for (int e = 0; e < 4; ++e) { const int i = 4 * g + e; const float xcv = xc32[(ts * 32 + crow(i, h)) * 68 + ch * 32 + r];
                const float rg = fast_sigmoid(acc_a[i] + gab), ig = fast_sigmoid(acc_x[i] + gxb), log_a = -rg * sp8, a = __expf(log_a), mult = sqrtf(-expm1f(2.0f * log_a));
                U = a * U + mult * (ig * xcv); A *= a; pa[i] = A; hl[i] = U; }
            gA[g] = A; gU[g] = U; }
        float PAc = 1.f, Hc = 0.f;
#pragma unroll
        for (int g = 0; g < 4; ++g) { const float oA = __shfl_xor(gA[g], 32), oU = __shfl_xor(gU[g], 32);
            const float fA = h ? oA : gA[g], fU = h ? oU : gU[g], sA = h ? gA[g] : oA, sU = h ? gU[g] : oU;
            const float c0P = PAc, c0H = Hc; Hc = fA * Hc + fU; PAc *= fA; const float c1P = PAc, c1H = Hc; Hc = sA * Hc + sU; PAc *= sA;
            const float ciP = h ? c1P : c0P, ciH = h ? c1H : c0H;
#pragma unroll
            for (int e = 0; e < 4; ++e) { const int i = 4 * g + e; hl[i] += pa[i] * ciH; pa[i] *= ciP; } }
        if (h == 0) { comp[(ts * 64 + ch * 32 + r) * 2] = PAc; comp[(ts * 64 + ch * 32 + r) * 2 + 1] = Hc; }
        __syncthreads();
        float PAin = 1.f, Hin = 0.f;
        for (int t2 = 0; t2 < ts; ++t2) { const float A2 = comp[(t2 * 64 + ch * 32 + r) * 2], U2 = comp[(t2 * 64 + ch * 32 + r) * 2 + 1]; Hin = A2 * Hin + U2; PAin *= A2; }
#pragma unroll
        for (int i = 0; i < 16; ++i) { const size_t o = (size_t)(t0 + ts * 32 + crow(i, h)) * 1024 + c; HL[o] = hl[i] + pa[i] * Hin; PA[o] = pa[i] * PAin; }
        __syncthreads();
    }
}
__device__ __forceinline__ void lru_fix(Frame& F) {
    const bf16* PROJ = (const bf16*)(F.ws + WS_PROJ); const float* HL = (const float*)(F.ws + WS_HL); const float* PA = (const float*)(F.ws + WS_PA); bf16* Y = (bf16*)(F.ws + WS_Y);
    const int gw = blockIdx.x * NWAVES + F.wave, NGW = F.G * NWAVES;
    for (int it = gw; it < 4096; it += NGW) {
        const int cgp = it & 15, sub = (it >> 4) & 3, k = it >> 6, c = cgp * 64 + F.lane;
        float H = 0.f;
#pragma unroll 8
        for (int kk = 0; kk < k; ++kk) { const size_t row = (size_t)(kk * 128 + 127) * 1024 + c; H = PA[row] * H + HL[row]; }
#pragma unroll 8
        for (int tt = 0; tt < 32; ++tt) { const int t = k * 128 + sub * 32 + tt;
            const float hv = HL[(size_t)t * 1024 + c] + PA[(size_t)t * 1024 + c] * H, g = bflo((unsigned)PROJ[(size_t)t * EVEN_IN + OFF_G + c]);
            const float u2 = 1.5957691216057308f * (g + 0.044715f * g * g * g), ge = g * fast_sigmoid(u2);
            Y[(size_t)t * DM + 1024 + c] = (bf16)f2bf(ge * hv); }
    }
}
__device__ __forceinline__ void sb_attn(Frame& F) {
    const bf16* PROJ = (const bf16*)(F.ws + WS_PROJ); bf16* Y = (bf16*)(F.ws + WS_Y);
    LAS unsigned char* vt = F.lds + F.wave * 16384;
    const int lane = F.lane, r = lane & 31, h = lane >> 5;
    const int gw = blockIdx.x * NWAVES + F.wave, NGW = F.G * NWAVES;
    const LAS unsigned char* trb = vt + (4 * h + ((lane & 15) >> 2)) * 320 + (16 * ((lane >> 4) & 1) + 4 * (lane & 3)) * 2;
    for (int it = gw; it < 4096; it += NGW) {
        const int head = (it >> 3) & 15, qb = ((it >> 7) << 3) + (it & 7), q0 = qb * 32;
        s16x8 qf[8];
#pragma unroll
        for (int s = 0; s < 8; ++s) qf[s] = *(const GAS s16x8*)(PROJ + (size_t)(q0 + r) * ODD_IN + head * 128 + 16 * s + 8 * h);
        f32x16 o[4];
#pragma unroll
        for (int db = 0; db < 4; ++db)
#pragma unroll
            for (int i = 0; i < 16; ++i) o[db][i] = 0.f;
        float carry = 0.f;
        s16x8 kf[8]; v4u vreg[8];
#pragma unroll
        for (int s = 0; s < 8; ++s) kf[s] = *(const GAS s16x8*)(PROJ + (size_t)(q0 + r) * ODD_IN + 2048 + head * 128 + 16 * s + 8 * h);
#pragma unroll
        for (int i = 0; i < 8; ++i) { const int p = lane + 64 * i; vreg[i] = *(const GAS v4u*)(PROJ + (size_t)(q0 + (p >> 4)) * ODD_IN + 4096 + head * 128 + (p & 15) * 8); }
        for (int kt = qb; kt >= 0; --kt) {
            const int kbn = (kt > 0 ? kt - 1 : 0) * 32;
            f32x16 sacc;
#pragma unroll
            for (int i = 0; i < 16; ++i) sacc[i] = 0.f;
#pragma unroll
            for (int s = 0; s < 8; ++s) sacc = MFMA32(kf[s], qf[s], sacc);
#pragma unroll
            for (int s = 0; s < 8; ++s) kf[s] = *(const GAS s16x8*)(PROJ + (size_t)(kbn + r) * ODD_IN + 2048 + head * 128 + 16 * s + 8 * h);
#pragma unroll
            for (int i = 0; i < 8; ++i) { const int p = lane + 64 * i; *(LAS v4u*)(vt + (p >> 4) * 320 + (p & 15) * 16) = vreg[i]; }
            LDS_WAIT();
#pragma unroll
            for (int i = 0; i < 8; ++i) { const int p = lane + 64 * i; vreg[i] = *(const GAS v4u*)(PROJ + (size_t)(kbn + (p >> 4)) * ODD_IN + 4096 + head * 128 + (p & 15) * 8); }
            const bool diag = (kt == qb);
            float z[16], lk[16], G[4];
#pragma unroll
            for (int g = 0; g < 4; ++g) { float gs = 0.f;
#pragma unroll
                for (int e = 0; e < 4; ++e) { const int i = 4 * g + e; z[i] = sacc[i] * 0.08838834764831845f; const bool valid = !diag || (crow(i, h) < r);
                    lk[i] = valid ? -fast_softplus(z[i]) : 0.f; z[i] = valid ? z[i] : -1e30f; gs += lk[i]; }
                G[g] = gs; }
            float run = carry, pw[16];
#pragma unroll
            for (int g = 3; g >= 0; --g) { const float og = __shfl_xor(G[g], 32);
                const float s1 = run; run += h ? G[g] : og;
                const float s0 = run; run += h ? og : G[g];
                float ex = h ? s1 : s0;
#pragma unroll
                for (int e = 3; e >= 0; --e) { const int i = 4 * g + e; pw[i] = __expf(z[i] + lk[i] + ex); ex += lk[i]; } }
            carry = run;
            const s16x8 p0 = pack8(pw, 0), p1 = pack8(pw, 1);
#pragma unroll
            for (int db = 0; db < 4; ++db) {
                const s16x8 v0 = tr_frag(trb + db * 64, trb + 8 * 320 + db * 64);
                const s16x8 v1 = tr_frag(trb + 16 * 320 + db * 64, trb + 24 * 320 + db * 64);
                o[db] = MFMA32(v0, p0, o[db]); o[db] = MFMA32(v1, p1, o[db]); }
            if (__all(carry < -104.0f)) break;
        }
#pragma unroll
        for (int db = 0; db < 4; ++db)
#pragma unroll
            for (int g = 0; g < 4; ++g) { v2u w; w.x = pkbf(o[db][4 * g], o[db][4 * g + 1]); w.y = pkbf(o[db][4 * g + 2], o[db][4 * g + 3]);
                *(GAS v2u*)(Y + (size_t)(q0 + r) * DM + head * 128 + db * 32 + 8 * g + 4 * h) = w; }
    }
}
__device__ __forceinline__ void swa_attn(Frame& F) {
    const bf16* PROJ = (const bf16*)(F.ws + WS_PROJ); bf16* Y = (bf16*)(F.ws + WS_Y); const float* BT = (const float*)(F.ws + WS_BT);
    LAS unsigned char* vt = F.lds + 65536 + F.wave * 8192;
    LAS float* btl = (LAS float*)(vt + 6144);
    const int lane = F.lane, r = lane & 31, h = lane >> 5;
    const int gw = blockIdx.x * NWAVES + F.wave, NGW = F.G * NWAVES;
    const LAS unsigned char* trb = vt + (4 * h + ((lane & 15) >> 2)) * 192 + (16 * ((lane >> 4) & 1) + 4 * (lane & 3)) * 2;
    for (int it = gw; it < 4096; it += NGW) {
        const int wu = it >> 3, kvh = wu & 3, c = wu >> 2, head = kvh * 4 + (it & 3), qb = 2 * c + ((it >> 2) & 1), q0 = qb * 32,
                  kbase = (c - 2) * 64, kt0 = c >= 2 ? 0 : (2 - c) * 2;
#pragma unroll
        for (int i = 0; i < 4; ++i) btl[lane + 64 * i] = BT[head * 256 + lane + 64 * i];
        LDS_WAIT();
        s16x8 qf[4];
#pragma unroll
        for (int s = 0; s < 4; ++s) qf[s] = *(const GAS s16x8*)(PROJ + (size_t)(q0 + r) * EVEN_IN + head * 64 + 16 * s + 8 * h);
        const float sink = F.in[IN_SINKS][head];
        float sc[6][16]; float m = sink;
#pragma unroll
        for (int kt = 0; kt < 6; ++kt) {
            if (kt >= kt0) {
                const int kb = kbase + kt * 32;
                f32x16 sacc;
#pragma unroll
                for (int i = 0; i < 16; ++i) sacc[i] = 0.f;
#pragma unroll
                for (int s = 0; s < 4; ++s) { const s16x8 kf = *(const GAS s16x8*)(PROJ + (size_t)(kb + r) * EVEN_IN + OFF_K + kvh * 64 + 16 * s + 8 * h); sacc = MFMA32(kf, qf[s], sacc); }
#pragma unroll
                for (int i = 0; i < 16; ++i) { const float v = sacc[i] * 0.125f + btl[kb + crow(i, h) - (q0 + r) + 191]; sc[kt][i] = v; m = fmaxf(m, v); }
            } else {
#pragma unroll
                for (int i = 0; i < 16; ++i) sc[kt][i] = -1e30f;
            }
        }
        m = fmaxf(m, __shfl_xor(m, 32));
        float l = 0.f;
#pragma unroll
        for (int kt = 0; kt < 6; ++kt)
#pragma unroll
            for (int i = 0; i < 16; ++i) { const float p = __expf(sc[kt][i] - m); sc[kt][i] = p; l += p; }
        l += __shfl_xor(l, 32); l += __expf(sink - m);
        f32x16 o[2];
#pragma unroll
        for (int db = 0; db < 2; ++db)
#pragma unroll
            for (int i = 0; i < 16; ++i) o[db][i] = 0.f;
#pragma unroll
        for (int kt = 0; kt < 6; ++kt) {
            if (kt >= kt0) {
                const int kb = kbase + kt * 32;
#pragma unroll
                for (int i = 0; i < 4; ++i) { const int p = lane + 64 * i; const v4u v = *(const GAS v4u*)(PROJ + (size_t)(kb + (p >> 3)) * EVEN_IN + OFF_V + kvh * 64 + (p & 7) * 8); *(LAS v4u*)(vt + (p >> 3) * 192 + (p & 7) * 16) = v; }
                LDS_WAIT();
                const s16x8 p0 = pack8(sc[kt], 0), p1 = pack8(sc[kt], 1);
#pragma unroll
                for (int db = 0; db < 2; ++db) {
                    const s16x8 v0 = tr_frag(trb + db * 64, trb + 8 * 192 + db * 64);
                    const s16x8 v1 = tr_frag(trb + 16 * 192 + db * 64, trb + 24 * 192 + db * 64);
                    o[db] = MFMA32(v0, p0, o[db]); o[db] = MFMA32(v1, p1, o[db]); }
            }
        }
        const float inv = 1.0f / l;
#pragma unroll
        for (int db = 0; db < 2; ++db)
#pragma unroll
            for (int g = 0; g < 4; ++g) { v2u w; w.x = pkbf(o[db][4 * g] * inv, o[db][4 * g + 1] * inv); w.y = pkbf(o[db][4 * g + 2] * inv, o[db][4 * g + 3] * inv);
                *(GAS v2u*)(Y + (size_t)(q0 + r) * DM + head * 64 + db * 32 + 8 * g + 4 * h) = w; }
    }
}

#ifndef REP_P0
#define REP_P0 1
#endif
#define REP_LRU 1
#define REP_SWA 1
#define REP_FIX 1
#define REP_SB 1
struct Args { const float* in[19]; float* out; unsigned char* ws; int ph_lo, ph_hi; };
__global__ void __launch_bounds__(NWAVES * 64, 2) hybrid_fwd(Args args) {
    extern __shared__ __attribute__((aligned(16))) unsigned char lds[];
    Frame F;
    F.lds = (LAS unsigned char*)lds;
    F.tid = threadIdx.x; F.lane = F.tid & 63; F.wave = __builtin_amdgcn_readfirstlane(F.tid >> 6);
    F.G = gridDim.x;
#pragma unroll
    for (int i = 0; i < 19; ++i) F.in[i] = args.in[i];
    F.out = args.out; F.ws = args.ws;
    unsigned char* ws = args.ws;
    for (int u = F.tid; u < (LDS_BYTES - LDSCTL_OFF) / 4; u += NWAVES * 64) ((LAS unsigned*)(F.lds + LDSCTL_OFF))[u] = 0u;
    __syncthreads();
    const int lo = args.ph_lo, hi = args.ph_hi;
    XcdBarrier bar; bar.bar = (unsigned*)(ws + WS_CTL) + CW_BAR; bar.x = 0; bar.st = nullptr;
    if (hi - lo > 1) bar = xcd_barrier_post((unsigned*)(ws + WS_CTL) + CW_BAR, (volatile LAS unsigned*)(F.lds + MISC_OFF) + 8);
#define IN(k) (lo <= (k) && (k) < hi)
#define SEAM(k) do { if (IN(k) && IN((k) + 1)) xcd_barrier(bar); } while (0)
    bf16* XN = (bf16*)(ws + WS_XN); bf16* Yb = (bf16*)(ws + WS_Y); bf16* PROJ = (bf16*)(ws + WS_PROJ); bf16* ACT = (bf16*)(ws + WS_ACT); float* SS = (float*)(ws + WS_SS);

    if (IN(0)) { for (int rep = 0; rep < REP_P0; ++rep) { p0_prologue(F); if (rep + 1 < REP_P0) xcd_barrier(bar); } } SEAM(0);
    if (IN(1)) { pg8::Gemm g{XN, (const bf16*)(ws + WS_WIN0), SEQ, EVEN_IN, DM}; pg8::StaticOrder S; S.init(SEQ, EVEN_IN, F.G, (int)blockIdx.x);
        pg8::EpiBf16<0> E{PROJ, EVEN_IN, SS}; pg8::gemm_phase<pg8::EpiBf16<0>, pg8::StaticOrder, true, true>(F.lds + RING_OFF, g, S, E); } SEAM(1);
    if (IN(2)) { for (int rep = 0; rep < REP_LRU; ++rep) { lru_local(F); if (rep + 1 < REP_LRU) xcd_barrier(bar); } for (int rep = 0; rep < REP_SWA; ++rep) { swa_attn(F); if (rep + 1 < REP_SWA) xcd_barrier(bar); } } SEAM(2);
    if (IN(3)) { for (int rep = 0; rep < REP_FIX; ++rep) { lru_fix(F); if (rep + 1 < REP_FIX) xcd_barrier(bar); } } SEAM(3);
    if (IN(4)) { pg8::Gemm g{Yb, (const bf16*)(ws + WS_WOUT0), SEQ, DM, DM}; pg8::StaticOrder S; S.init(SEQ, DM, F.G, (int)blockIdx.x);
        pg8::EpiRes E{F.in[IN_X], F.out, XN, SS, DM}; pg8::gemm_phase<pg8::EpiRes, pg8::StaticOrder, false, true>(F.lds + RING_OFF, g, S, E); } SEAM(4);
    if (IN(5)) { pg8::Gemm g{XN, (const bf16*)(ws + WS_WUP0), SEQ, DFF, DM}; pg8::StaticOrder S; S.init(SEQ, DFF, F.G, (int)blockIdx.x);
        pg8::EpiBf16<1> E{ACT, DFF, SS}; pg8::gemm_phase<pg8::EpiBf16<1>, pg8::StaticOrder, true, true>(F.lds + RING_OFF, g, S, E); } SEAM(5);
    if (IN(6)) { pg8::Gemm g{ACT, (const bf16*)(ws + WS_WDN0), SEQ, DM, DFF}; pg8::StaticOrder S; S.init(SEQ, DM, F.G, (int)blockIdx.x);
        pg8::EpiRes E{F.out, F.out, XN, SS, DM}; pg8::gemm_phase<pg8::EpiRes, pg8::StaticOrder, false, true>(F.lds + RING_OFF, g, S, E); } SEAM(6);
    if (IN(7)) { pg8::Gemm g{XN, (const bf16*)(ws + WS_WIN1), SEQ, ODD_IN, DM}; pg8::StaticOrder S; S.init(SEQ, ODD_IN, F.G, (int)blockIdx.x);
        pg8::EpiBf16<0> E{PROJ, ODD_IN, SS}; pg8::gemm_phase<pg8::EpiBf16<0>, pg8::StaticOrder, true, true>(F.lds + RING_OFF, g, S, E); } SEAM(7);
    if (IN(8)) { for (int rep = 0; rep < REP_SB; ++rep) { sb_attn(F); if (rep + 1 < REP_SB) xcd_barrier(bar); } } SEAM(8);
    if (IN(9)) { pg8::Gemm g{Yb, (const bf16*)(ws + WS_WOUT1), SEQ, DM, DM}; pg8::StaticOrder S; S.init(SEQ, DM, F.G, (int)blockIdx.x);
        pg8::EpiRes E{F.out, F.out, XN, SS, DM}; pg8::gemm_phase<pg8::EpiRes, pg8::StaticOrder, false, true>(F.lds + RING_OFF, g, S, E); } SEAM(9);
    if (IN(10)) { pg8::Gemm g{XN, (const bf16*)(ws + WS_WUP1), SEQ, DFF, DM}; pg8::StaticOrder S; S.init(SEQ, DFF, F.G, (int)blockIdx.x);
        pg8::EpiBf16<1> E{ACT, DFF, SS}; pg8::gemm_phase<pg8::EpiBf16<1>, pg8::StaticOrder, true, true>(F.lds + RING_OFF, g, S, E); } SEAM(10);
    if (IN(11)) { pg8::Gemm g{ACT, (const bf16*)(ws + WS_WDN1), SEQ, DM, DFF}; pg8::StaticOrder S; S.init(SEQ, DM, F.G, (int)blockIdx.x);
        pg8::EpiRes E{F.out, F.out, XN, SS, DM}; pg8::gemm_phase<pg8::EpiRes, pg8::StaticOrder, false, true>(F.lds + RING_OFF, g, S, E); } SEAM(11);
    if (IN(12)) { final_norm(F); }
#undef IN
#undef SEAM
}

extern "C" void kernel_launch(void* const* d_in, const int* in_sizes, int n_in, void* d_out, int out_size, void* d_ws, size_t ws_size, hipStream_t stream) {
    static int grid = 0;
    if (grid == 0) {
        if (n_in != 19 || in_sizes[0] != SEQ * DM || out_size != SEQ * DM || ws_size < WS_END) { fprintf(stderr, "kernel_launch: unexpected shapes (n_in %d, in0 %d, out %d, ws %zu); nothing launched\n", n_in, n_in > 0 ? in_sizes[0] : -1, out_size, ws_size); grid = -1; return; }
        int dev = 0, cus = 0, per_cu = 0;
        if (hipGetDevice(&dev) != hipSuccess || hipDeviceGetAttribute(&cus, hipDeviceAttributeMultiprocessorCount, dev) != hipSuccess) { fprintf(stderr, "kernel_launch: device query failed\n"); grid = -1; return; }
        if (hipFuncSetAttribute((const void*)hybrid_fwd, hipFuncAttributeMaxDynamicSharedMemorySize, LDS_BYTES) != hipSuccess) { fprintf(stderr, "kernel_launch: hipFuncSetAttribute failed\n"); grid = -1; return; }
        if (hipOccupancyMaxActiveBlocksPerMultiprocessor(&per_cu, (const void*)hybrid_fwd, NWAVES * 64, LDS_BYTES) != hipSuccess || per_cu < 1) { fprintf(stderr, "kernel_launch: occupancy query reports %d workgroups per CU\n", per_cu); per_cu = 1; }
        (void)hipGetLastError();
        grid = cus;
        if (grid != 256) fprintf(stderr, "kernel_launch: %d CUs; the residual GEMM phases need exactly 256 workgroups\n", grid);
    }
    if (grid < 0) return;
    (void)hipMemsetAsync((char*)d_ws + WS_CTL, 0, CTL_ZERO_BYTES, stream);
    Args a{};
    for (int i = 0; i < 19; ++i) a.in[i] = (const float*)d_in[i];
    a.out = (float*)d_out; a.ws = (unsigned char*)d_ws;
#if MK_N_LAUNCHES == 1
    a.ph_lo = 0; a.ph_hi = N_PHASES;
    hipLaunchKernelGGL(hybrid_fwd, dim3(grid), dim3(NWAVES * 64), LDS_BYTES, stream, a);
#else
    for (int p = 0; p < N_PHASES; ++p) { a.ph_lo = p; a.ph_hi = p + 1; hipLaunchKernelGGL(hybrid_fwd, dim3(grid), dim3(NWAVES * 64), LDS_BYTES, stream, a); }
#endif
}
```

```cpp
#include <hip/hip_runtime.h>
#include <cstdio>
#include <cstdint>
namespace pg8 {
#define PG8_LAS __attribute__((address_space(3)))
typedef unsigned short bf16_t;
typedef short bf16x8 __attribute__((ext_vector_type(8)));
typedef float f32x4 __attribute__((ext_vector_type(4)));
typedef unsigned u32x4 __attribute__((ext_vector_type(4)));
constexpr int BM = 256, BK = 64, HALF = 128, HTB = HALF * BK * 2  , STAGE_BYTES = 8 * HTB, NXCD = 8, WGM = 8;

__host__ __device__ __forceinline__ int lds_byte(int r, int c) { const int st = (r >> 4) * 2 + (c >> 5), rr = r & 15, cc = c & 31, ob = rr * 64 + cc * 2; return st * 1024 + (ob ^ (((ob >> 9) & 1) << 5)); }
__host__ __device__ __forceinline__ void stage_rc(int b, int& R, int& C) { const int st = b / 1024, sb = b % 1024, swz = sb ^ (((sb >> 9) & 1) << 5); R = (st >> 1) * 16 + swz / 64; C = (st & 1) * 32 + (swz % 64) / 2; }
__host__ __device__ __forceinline__ int perm32(int rho) { const int n = rho >> 4, i = rho & 15; return 8 * (i >> 2) + 4 * n + (i & 3); }

struct Unit { int pm, pn; };
struct Gemm { const bf16_t* A; const bf16_t* Bt; int M, N, K; };

struct StaticOrder {
    int nM, nN, nwg, G, c;
    __host__ __device__ void init(int M, int N, int G_, int c_) { nM = M / BM; nN = N / BM; nwg = nM * nN; G = G_; c = c_; }
    __host__ __device__ bool next(int i, Unit& u) const {
        const long L = (long)i * G + c; if (L >= nwg) return false;
        int wgid = (int)L; { const int q = nwg / NXCD, r = nwg % NXCD, xcd = wgid % NXCD, off = wgid / NXCD; wgid = (xcd < r ? xcd * (q + 1) : r * (q + 1) + (xcd - r) * q) + off; }
        const int nig = WGM * nN, gid = wgid / nig, fm = gid * WGM, gsz = (nM - fm) < WGM ? (nM - fm) : WGM;
        u.pm = fm + ((wgid % nig) % gsz); u.pn = (wgid % nig) / gsz; return true;
    }
    __device__ __forceinline__ void a_ready(const Unit&) const {}
    __device__ __forceinline__ void done(const Unit&) const {}
};

__device__ __forceinline__ unsigned cvt_pk_bf16(float lo, float hi) { unsigned r; asm volatile("v_cvt_pk_bf16_f32 %0, %1, %2" : "=v"(r) : "v"(lo), "v"(hi)); return r; }
constexpr float RMS_EPS = 1e-6f;
__device__ __forceinline__ float row_rstd(const float* ss, int r) {
    const f32x4 a = *(const f32x4*)(ss + (size_t)r * 8), b = *(const f32x4*)(ss + (size_t)r * 8 + 4);
    const float s = ((a[0] + a[1]) + (a[2] + a[3])) + ((b[0] + b[1]) + (b[2] + b[3]));
    return 1.0f / sqrtf(s * (1.0f / 2048.0f) + RMS_EPS);
}
template <int ACT> struct EpiBf16 {
    static constexpr bool PERM = true, AFTER_DRAIN = false;
    bf16_t* O; int ldc; const float* ss; int grp_w, nrows;
    __device__ __forceinline__ void operator()(const f32x4 (&acc)[2][2][4][2], const Unit& u, int wr, int wc, int fr, int fq) const {
        const int row0 = u.pm * BM + wr * 64 + fr, col0 = u.pn * BM + wc * 32 + 8 * fq;
#pragma unroll
        for (int ai = 0; ai < 2; ++ai)
#pragma unroll
            for (int m = 0; m < 4; ++m) { const int r = row0 + ai * HALF + m * 16; const float rs = ss ? row_rstd(ss, r) : 1.0f;
                bf16_t* rowp = grp_w ? O + ((size_t)(col0 / grp_w) * nrows + r) * grp_w + (col0 % grp_w) : O + (size_t)r * ldc + col0;
                const size_t bjstep = grp_w ? (size_t)(HALF / grp_w) * nrows * grp_w : (size_t)HALF;
#pragma unroll
                for (int bj = 0; bj < 2; ++bj) { f32x4 v0 = acc[ai][bj][m][0] * rs, v1 = acc[ai][bj][m][1] * rs;
                    if (ACT == 1) {
#pragma unroll
                        for (int j = 0; j < 4; ++j) { const float a = fmaxf(v0[j], 0.f), b = fmaxf(v1[j], 0.f); v0[j] = a * a; v1[j] = b * b; } }
                    u32x4 w; w.x = cvt_pk_bf16(v0[0], v0[1]); w.y = cvt_pk_bf16(v0[2], v0[3]); w.z = cvt_pk_bf16(v1[0], v1[1]); w.w = cvt_pk_bf16(v1[2], v1[3]);
                    *(u32x4*)(rowp + bj * bjstep) = w; } }
    }
};
struct EpiRes {
    static constexpr bool PERM = true, AFTER_DRAIN = true;
    const float* base; float* out; bf16_t* xn; float* ss; int ldc;
    __device__ __forceinline__ void operator()(const f32x4 (&)[2][2][4][2], const Unit&, int, int, int, int) const {}
    __device__ __forceinline__ void fused(f32x4 (&acc)[2][2][4][2], const Unit& u, int wr, int wc, int fr, int fq, PG8_LAS unsigned char* lds, int wid, int lane) const {
        PG8_LAS float* P = (PG8_LAS float*)lds;
#pragma unroll
        for (int ai = 0; ai < 2; ++ai)
#pragma unroll
            for (int m = 0; m < 4; ++m) { const int rl = ai * HALF + wr * 64 + m * 16 + fr; const size_t off = (size_t)(u.pm * BM + rl) * ldc + u.pn * BM + wc * 32 + 8 * fq; float s = 0.f;
#pragma unroll
                for (int bj = 0; bj < 2; ++bj) { const f32x4 b0 = *(const f32x4*)(base + off + bj * HALF), b1 = *(const f32x4*)(base + off + bj * HALF + 4);
                    const f32x4 v0 = acc[ai][bj][m][0] + b0, v1 = acc[ai][bj][m][1] + b1;
                    *(f32x4*)(out + off + bj * HALF) = v0; *(f32x4*)(out + off + bj * HALF + 4) = v1;
                    u32x4 w; w.x = cvt_pk_bf16(v0[0], v0[1]); w.y = cvt_pk_bf16(v0[2], v0[3]); w.z = cvt_pk_bf16(v1[0], v1[1]); w.w = cvt_pk_bf16(v1[2], v1[3]);
                    *(u32x4*)(xn + off + bj * HALF) = w;
                    s += ((v0[0] * v0[0] + v0[1] * v0[1]) + (v0[2] * v0[2] + v0[3] * v0[3])) + ((v1[0] * v1[0] + v1[1] * v1[1]) + (v1[2] * v1[2] + v1[3] * v1[3])); }
                s += __shfl_xor(s, 16); s += __shfl_xor(s, 32);
                if (fq == 0) P[rl * 4 + wc] = s;
                asm volatile("" ::: "memory"); }
        asm volatile("s_waitcnt lgkmcnt(0)" ::: "memory"); __builtin_amdgcn_s_barrier(); asm volatile("" ::: "memory");
        const int t = wid * 64 + lane;
        if (t < 256) { const f32x4 p = *(const PG8_LAS f32x4*)(P + t * 4); ss[(size_t)(u.pm * BM + t) * 8 + u.pn] = (p[0] + p[1]) + (p[2] + p[3]); }
        asm volatile("s_waitcnt lgkmcnt(0)" ::: "memory"); __builtin_amdgcn_s_barrier(); asm volatile("" ::: "memory");
    }
};

template <class Epi, class Sched, bool ALIGN_EPI = false, bool SP2 = false>
__device__ __forceinline__ void gemm_phase(PG8_LAS unsigned char* lds, const Gemm g, const Sched& S, const Epi& E) {
    const int tid = threadIdx.x, wid = __builtin_amdgcn_readfirstlane(tid >> 6), lane = tid & 63, wr = wid >> 2, wc = wid & 3, fr = lane & 15, fq = lane >> 4;
    const int K = g.K, nt = K / BK;
    unsigned voffA[2], voffB[2];
#pragma unroll
    for (int i = 0; i < 2; ++i) { int R, C; stage_rc(tid * 16 + i * 8192, R, C); const int Rb = Epi::PERM ? ((R & ~31) + perm32(R & 31)) : R;
        voffA[i] = (unsigned)(R * K + C) * 2u; voffB[i] = (unsigned)(Rb * K + C) * 2u; }
    const size_t kstep = (size_t)(BK * 2);
    const size_t hstep = (size_t)HALF * K * 2;
    const size_t tstep = 2 * hstep;
    const unsigned ldsw = (unsigned)wid * 1024u;
    const int aoff = lds_byte(wr * 64 + fr, fq * 8), boff = lds_byte(wc * 32 + fr, fq * 8);
#define PG8_SA(b, h) (((b) * 2 + (h)) * HTB)
#define PG8_SB(b, h) ((4 + (b) * 2 + (h)) * HTB)
#define PG8_STAGE(bufoff, gbase, voff) do { _Pragma("unroll") for (int _i = 0; _i < 2; ++_i) \
        __builtin_amdgcn_global_load_lds((const unsigned*)((const char*)(gbase) + (voff)[_i]), (PG8_LAS unsigned*)(lds + (bufoff) + ldsw + _i * 8192), 16, 0, 0); } while (0)
#define PG8_LDA(dst, b, h) do { _Pragma("unroll") for (int m = 0; m < 4; ++m) _Pragma("unroll") for (int k = 0; k < 2; ++k) dst[m][k] = *(const PG8_LAS bf16x8*)(lds + PG8_SA(b, h) + aoff + m * 2048 + k * 1024); } while (0)
#define PG8_LDB(dst, b, h) do { _Pragma("unroll") for (int n = 0; n < 2; ++n) _Pragma("unroll") for (int k = 0; k < 2; ++k) dst[n][k] = *(const PG8_LAS bf16x8*)(lds + PG8_SB(b, h) + boff + n * 2048 + k * 1024); } while (0)
#define PG8_MMA(ai, bj, At, Bt) do { __builtin_amdgcn_s_setprio(1); _Pragma("unroll") for (int m = 0; m < 4; ++m) _Pragma("unroll") for (int n = 0; n < 2; ++n) _Pragma("unroll") for (int k = 0; k < 2; ++k) \
        acc[ai][bj][m][n] = __builtin_amdgcn_mfma_f32_16x16x32_bf16(Bt[n][k], At[m][k], acc[ai][bj][m][n], 0, 0, 0); __builtin_amdgcn_s_setprio(0); } while (0)
#define PG8_WAIT_V(n) asm volatile("s_waitcnt vmcnt(" #n ")" ::: "memory")
#define PG8_WAIT_L(n) asm volatile("s_waitcnt lgkmcnt(" #n ")" ::: "memory")
#define PG8_BAR __builtin_amdgcn_s_barrier()
#define PG8_SCHED __builtin_amdgcn_sched_barrier(0)
    Unit cur, nxt; int ui = 0;
    if (!S.next(0, cur)) return;
    f32x4 acc[2][2][4][2];
#pragma unroll
    for (int a = 0; a < 2; ++a)
#pragma unroll
        for (int b = 0; b < 2; ++b)
#pragma unroll
            for (int m = 0; m < 4; ++m)
#pragma unroll
                for (int n = 0; n < 2; ++n) acc[a][b][m][n] = (f32x4){0.f, 0.f, 0.f, 0.f};
    bf16x8 At[4][2], B0[2][2], B1[2][2];
    const char* cA = (const char*)g.A + (size_t)cur.pm * tstep; const char* cB = (const char*)g.Bt + (size_t)cur.pn * tstep;
    S.a_ready(cur);
    if constexpr (SP2) {
        PG8_STAGE(PG8_SB(0, 0), cB, voffB); PG8_STAGE(PG8_SB(0, 1), cB + hstep, voffB); PG8_STAGE(PG8_SA(0, 0), cA, voffA); PG8_STAGE(PG8_SA(0, 1), cA + hstep, voffA);
        if (wr == 1) PG8_BAR;
        PG8_WAIT_V(2); PG8_BAR;
        PG8_STAGE(PG8_SB(1, 0), cB + kstep, voffB); PG8_STAGE(PG8_SA(1, 0), cA + kstep, voffA); PG8_STAGE(PG8_SB(1, 1), cB + hstep + kstep, voffB);
        PG8_WAIT_V(6); PG8_BAR;
    } else {
        PG8_STAGE(PG8_SB(0, 0), cB, voffB); PG8_STAGE(PG8_SA(0, 0), cA, voffA); PG8_STAGE(PG8_SB(0, 1), cB + hstep, voffB); PG8_STAGE(PG8_SA(0, 1), cA + hstep, voffA);
        if (wr == 1) PG8_BAR;
        PG8_WAIT_V(4); PG8_BAR;
        PG8_STAGE(PG8_SB(1, 0), cB + kstep, voffB); PG8_STAGE(PG8_SA(1, 0), cA + kstep, voffA); PG8_STAGE(PG8_SB(1, 1), cB + hstep + kstep, voffB);
        PG8_WAIT_V(6); PG8_BAR;
    }
    for (;;) {
        const bool has_next = S.next(ui + 1, nxt);
        const char* nA = has_next ? (const char*)g.A + (size_t)nxt.pm * tstep : cA; const char* nB = has_next ? (const char*)g.Bt + (size_t)nxt.pn * tstep : cB;
        for (int t = 0; t < nt; t += 2) {
            const bool last = (t == nt - 2);
            const char* a1 = cA + (size_t)(t + 1) * kstep;
            const char* a2 = last ? nA : cA + (size_t)(t + 2) * kstep; const char* b2 = last ? nB : cB + (size_t)(t + 2) * kstep;
            const char* a3 = a2 + kstep; const char* b3 = b2 + kstep;
            if (last && has_next) S.a_ready(nxt);
            if constexpr (SP2) {
            PG8_LDB(B0, 0, 0); PG8_LDB(B1, 0, 1); PG8_SCHED; PG8_LDA(At, 0, 0); PG8_STAGE(PG8_SA(1, 1), a1 + hstep, voffA);
            PG8_WAIT_V(8); PG8_WAIT_L(0); PG8_BAR; PG8_MMA(0, 0, At, B0); PG8_MMA(0, 1, At, B1); PG8_BAR; PG8_SCHED;
            PG8_LDA(At, 0, 1); PG8_STAGE(PG8_SB(0, 0), b2, voffB); PG8_STAGE(PG8_SB(0, 1), b2 + hstep, voffB); PG8_STAGE(PG8_SA(0, 0), a2, voffA);
            PG8_WAIT_V(8); PG8_WAIT_L(0); PG8_BAR; PG8_MMA(1, 0, At, B0); PG8_MMA(1, 1, At, B1); PG8_BAR; PG8_SCHED;
            PG8_LDB(B0, 1, 0); PG8_LDB(B1, 1, 1); PG8_SCHED; PG8_LDA(At, 1, 0); PG8_STAGE(PG8_SA(0, 1), a2 + hstep, voffA);
            PG8_WAIT_V(8); PG8_WAIT_L(0); PG8_BAR; PG8_MMA(0, 0, At, B0); PG8_MMA(0, 1, At, B1); PG8_BAR; PG8_SCHED;
            PG8_LDA(At, 1, 1); PG8_STAGE(PG8_SB(1, 0), b3, voffB); PG8_STAGE(PG8_SB(1, 1), b3 + hstep, voffB); PG8_STAGE(PG8_SA(1, 0), a3, voffA);
            PG8_WAIT_V(8); PG8_WAIT_L(0); PG8_BAR; PG8_MMA(1, 0, At, B0); PG8_MMA(1, 1, At, B1); PG8_BAR; PG8_SCHED;
            } else {
            PG8_LDB(B0, 0, 0); PG8_SCHED; PG8_LDA(At, 0, 0); PG8_STAGE(PG8_SA(1, 1), a1 + hstep, voffA);
            PG8_WAIT_L(8); PG8_BAR; PG8_WAIT_L(0); PG8_MMA(0, 0, At, B0); PG8_BAR; PG8_SCHED;
            PG8_LDB(B1, 0, 1); PG8_STAGE(PG8_SB(0, 0), b2, voffB);
            PG8_BAR; PG8_WAIT_L(0); PG8_MMA(0, 1, At, B1); PG8_BAR;
            PG8_LDA(At, 0, 1); PG8_STAGE(PG8_SA(0, 0), a2, voffA);
            PG8_BAR; PG8_WAIT_L(0); PG8_MMA(1, 0, At, B0); PG8_BAR; PG8_SCHED;
            PG8_STAGE(PG8_SB(0, 1), b2 + hstep, voffB);
            PG8_WAIT_V(6); PG8_BAR; PG8_MMA(1, 1, At, B1); PG8_BAR;
            PG8_LDB(B0, 1, 0); PG8_SCHED; PG8_LDA(At, 1, 0); PG8_STAGE(PG8_SA(0, 1), a2 + hstep, voffA);
            PG8_WAIT_L(8); PG8_BAR; PG8_WAIT_L(0); PG8_MMA(0, 0, At, B0); PG8_BAR; PG8_SCHED;
            PG8_LDB(B1, 1, 1); PG8_STAGE(PG8_SB(1, 0), b3, voffB);
            PG8_BAR; PG8_WAIT_L(0); PG8_MMA(0, 1, At, B1); PG8_BAR;
            PG8_LDA(At, 1, 1); PG8_STAGE(PG8_SA(1, 0), a3, voffA);
            PG8_BAR; PG8_WAIT_L(0); PG8_MMA(1, 0, At, B0); PG8_BAR; PG8_SCHED;
            PG8_STAGE(PG8_SB(1, 1), b3 + hstep, voffB);
            PG8_WAIT_V(6); PG8_BAR; PG8_MMA(1, 1, At, B1); PG8_BAR;
            }
        }
        if constexpr (ALIGN_EPI) { if (wr == 0) PG8_BAR; }
        if constexpr (!Epi::AFTER_DRAIN) { E(acc, cur, wr, wc, fr, fq); S.done(cur); }
        if (!has_next) break;
#pragma unroll
        for (int a = 0; a < 2; ++a)
#pragma unroll
            for (int b = 0; b < 2; ++b)
#pragma unroll
                for (int m = 0; m < 4; ++m)
#pragma unroll
                    for (int n = 0; n < 2; ++n) acc[a][b][m][n] = (f32x4){0.f, 0.f, 0.f, 0.f};
        cur = nxt; cA = nA; cB = nB; ++ui;
        if constexpr (ALIGN_EPI) { if (wr == 1) PG8_BAR; }
    }
    PG8_WAIT_V(0);
    if constexpr (!ALIGN_EPI) { if (wr == 0) PG8_BAR; }
    PG8_BAR;
    if constexpr (Epi::AFTER_DRAIN) { E.fused(acc, cur, wr, wc, fr, fq, lds, wid, lane); S.done(cur); }
#undef PG8_SA
#undef PG8_SB
#undef PG8_STAGE
#undef PG8_LDA
#undef PG8_LDB
#undef PG8_MMA
#undef PG8_WAIT_V
#undef PG8_WAIT_L
#undef PG8_BAR
#undef PG8_SCHED
}
}

constexpr int NWAVES = 8;
constexpr int SEQ = 8192, DM = 2048, DFF = 8192, EVEN_IN = 3584, ODD_IN = 6144;
constexpr int OFF_K = 1024, OFF_V = 1280, OFF_X = 1536, OFF_G = 2560;
#ifndef MK_N_LAUNCHES
#define MK_N_LAUNCHES 1
#endif
constexpr int N_PHASES = 13;
constexpr size_t MiB = 1u << 20;
constexpr size_t WS_CTL = 0, CTL_ZERO_BYTES = 64 * 1024;
constexpr size_t WS_SS = 1 * MiB;
constexpr size_t WS_BT = 1 * MiB + 512 * 1024;
constexpr size_t WS_GWT = 1 * MiB + 768 * 1024;
constexpr size_t WS_WIN0 = 2 * MiB, WS_WOUT0 = 16 * MiB, WS_WUP0 = 24 * MiB, WS_WDN0 = 56 * MiB, WS_WIN1 = 88 * MiB, WS_WOUT1 = 112 * MiB, WS_WUP1 = 120 * MiB, WS_WDN1 = 152 * MiB;
constexpr size_t WS_XN = 184 * MiB;
constexpr size_t WS_Y = 216 * MiB;
constexpr size_t WS_PROJ = 248 * MiB;
constexpr size_t WS_HL = 344 * MiB, WS_PA = 376 * MiB;
constexpr size_t WS_ACT = 248 * MiB;
constexpr size_t WS_END = 408 * MiB;
constexpr int CW_BAR = 1024;

constexpr int RING_OFF = 0, RING_BYTES = 131072;
constexpr int LDSCTL_OFF = RING_BYTES, MISC_OFF = LDSCTL_OFF + 320;
constexpr int LDS_BYTES = 147456;

#define GAS __attribute__((address_space(1)))
#define LAS __attribute__((address_space(3)))
typedef unsigned short bf16;
typedef unsigned v4u __attribute__((ext_vector_type(4)));
typedef unsigned v2u __attribute__((ext_vector_type(2)));
typedef float f32x4 __attribute__((ext_vector_type(4)));
#define LDS_WAIT() asm volatile("s_waitcnt lgkmcnt(0)" ::: "memory")
#define VM_WAIT() asm volatile("s_waitcnt vmcnt(0)" ::: "memory")
__device__ __forceinline__ unsigned f2bf(float f) { unsigned u = __builtin_bit_cast(unsigned, f); return (u + 0x7fffu + ((u >> 16) & 1u)) >> 16; }
__device__ __forceinline__ unsigned pk2(float lo, float hi) { return f2bf(lo) | (f2bf(hi) << 16); }
__device__ __forceinline__ float bflo(unsigned w) { return __builtin_bit_cast(float, w << 16); }
__device__ __forceinline__ float bfhi(unsigned w) { return __builtin_bit_cast(float, w & 0xffff0000u); }

#define XB_TMO      128
#define XB_XCNT(j)  (256  + 64 * (j))
#define XB_XSUB(j)  (1280 + 64 * (j))
#define XB_XGEN(j)  (2304 + 64 * (j))
#define XB_TOP      3328
#define XB_TOPGEN   3392
#define XCD_BAR_WORDS 3456
#define XB_SPIN_CAP (1u << 22)

__device__ __forceinline__ unsigned xb_ld(unsigned* p)              { return __hip_atomic_load(p, __ATOMIC_RELAXED, __HIP_MEMORY_SCOPE_AGENT); }
__device__ __forceinline__ unsigned xb_add(unsigned* p, unsigned v) { return __hip_atomic_fetch_add(p, v, __ATOMIC_RELAXED, __HIP_MEMORY_SCOPE_AGENT); }
__device__ __forceinline__ unsigned xb_xcc_id() { return (unsigned)__builtin_amdgcn_s_getreg((3 << 11) | 20) & 0xFu; }
#define XB_SPIN(cond, bar) do { unsigned _sp = 0; while (cond) { __builtin_amdgcn_s_sleep(1); \
    if ((++_sp & 255u) == 0u) { if (xb_ld(&(bar)[XB_TMO])) break; if (_sp > XB_SPIN_CAP) { atomicAdd(&(bar)[XB_TMO], 1u); break; } } } } while (0)

struct XcdBarrier {
    unsigned* bar; unsigned x;
    volatile LAS unsigned* st;
};

__device__ __forceinline__ XcdBarrier xcd_barrier_post(unsigned* bar, volatile LAS unsigned* st) {
    XcdBarrier b; b.bar = bar; b.x = xb_xcc_id(); b.st = st;
    if (threadIdx.x == 0) (void)xb_add(&bar[XB_XCNT(b.x)], 1u);
    return b;
}
__device__ __forceinline__ void xcd_barrier_complete(unsigned* bar, unsigned x, unsigned& nloc, unsigned& nx) {
    const unsigned G = gridDim.x * gridDim.y * gridDim.z;
    unsigned sum, cnt, mine, sp = 0u;
    for (;;) {
        sum = 0u; cnt = 0u; mine = 0u;
#pragma unroll
        for (unsigned j = 0; j < 16; ++j) { const unsigned c = xb_ld(&bar[XB_XCNT(j)]); sum += c; cnt += (c > 0u) ? 1u : 0u; mine = (j == x) ? c : mine; }
        if (sum == G) break;
        __builtin_amdgcn_s_sleep(1);
        if ((++sp & 255u) == 0u) { if (xb_ld(&bar[XB_TMO])) break; if (sp > XB_SPIN_CAP) { atomicAdd(&bar[XB_TMO], 1u); break; } }
    }
    nloc = mine > 0u ? mine : 1u; nx = cnt > 0u ? cnt : 1u;
}

__device__ __forceinline__ void xcd_barrier(const XcdBarrier& b) {
    asm volatile("s_waitcnt vmcnt(0)" ::: "memory");
    __syncthreads();
    if (threadIdx.x == 0) {
        unsigned* bar = b.bar;
        __builtin_amdgcn_s_waitcnt(0);
        unsigned nloc = b.st[0], nx = b.st[1];
        if (nloc == 0u) { xcd_barrier_complete(bar, b.x, nloc, nx); b.st[0] = nloc; b.st[1] = nx; }
        const unsigned old = xb_add(&bar[XB_XSUB(b.x)], 1u);
        const unsigned gen = old / nloc;
        if (old + 1u == (gen + 1u) * nloc) {
            __builtin_amdgcn_fence(__ATOMIC_RELEASE, "agent");
            asm volatile("s_waitcnt vmcnt(0)" ::: "memory");
            const unsigned og = xb_add(&bar[XB_TOP], 1u);
            const unsigned tg = og / nx;
            if (og + 1u == (tg + 1u) * nx) xb_add(&bar[XB_TOPGEN], 1u);
            else XB_SPIN(xb_ld(&bar[XB_TOPGEN]) == tg, bar);
            __builtin_amdgcn_fence(__ATOMIC_ACQUIRE, "agent");
            xb_add(&bar[XB_XGEN(b.x)], 1u);
            asm volatile("s_waitcnt vmcnt(0)" ::: "memory");
        } else {
            XB_SPIN(xb_ld(&bar[XB_XGEN(b.x)]) == gen, bar);
            __builtin_amdgcn_fence(__ATOMIC_ACQUIRE, "agent");
            asm volatile("s_waitcnt vmcnt(0)" ::: "memory");
        }
    }
    __syncthreads();
}
struct Frame {
    LAS unsigned char* lds;
    int tid, lane, wave, G;
    const float* in[19]; float* out; unsigned char* ws;
};
#define IN_X 0
#define IN_RELB 1
#define IN_NMIX 2
#define IN_EWIN 3
#define IN_CONVW 4
#define IN_CONVB 5
#define IN_GAW 6
#define IN_GAB 7
#define IN_GXW 8
#define IN_GXB 9
#define IN_LAMBDA 10
#define IN_SINKS 11
#define IN_EWOUT 12
#define IN_OWIN 13
#define IN_OWOUT 14
#define IN_NMLP 15
#define IN_WUP 16
#define IN_WDOWN 17
#define IN_FNORM 18

__device__ __forceinline__ float wave_sum(float v) {
#pragma unroll
    for (int o = 1; o < 64; o <<= 1) v += __shfl_xor(v, o);
    return v;
}
struct P0Tile { const float* W; const float* gain; bf16* WT; int K, N, k0, n0; };
__device__ __forceinline__ void p0_tile_load(const P0Tile& t, int lane, f32x4 (&v)[16]) {
    const GAS f32x4* p = (const GAS f32x4*)(t.W + (size_t)(t.k0 + (lane >> 4)) * t.N + t.n0 + 4 * (lane & 15));
#pragma unroll
    for (int i = 0; i < 16; ++i) v[i] = p[(size_t)i * t.N];
}
__device__ __forceinline__ void p0_tile_store(const P0Tile& t, int lane, const f32x4 (&v)[16], LAS float* scr) {
#pragma unroll
    for (int i = 0; i < 16; ++i) { const int kk = (lane >> 4) + 4 * i; *(LAS f32x4*)(scr + kk * 64 + ((4 * (lane & 15)) ^ (4 * ((kk >> 3) & 7)))) = v[i]; }
    LDS_WAIT(); asm volatile("" ::: "memory");
    const int kc = lane & 7;
    float g[8];
    if (t.gain) { const f32x4 a = *(const GAS f32x4*)(t.gain + t.k0 + 8 * kc), b = *(const GAS f32x4*)(t.gain + t.k0 + 8 * kc + 4); g[0] = a[0]; g[1] = a[1]; g[2] = a[2]; g[3] = a[3]; g[4] = b[0]; g[5] = b[1]; g[6] = b[2]; g[7] = b[3]; }
    else {
#pragma unroll
        for (int e = 0; e < 8; ++e) g[e] = 1.0f; }
#pragma unroll
    for (int j = 0; j < 8; ++j) { const int n = (lane >> 3) + 8 * j; const LAS float* s = scr + (8 * kc) * 64 + (n ^ (4 * kc));
        v4u o; o.x = pk2(s[0] * g[0], s[64] * g[1]); o.y = pk2(s[128] * g[2], s[192] * g[3]); o.z = pk2(s[256] * g[4], s[320] * g[5]); o.w = pk2(s[384] * g[6], s[448] * g[7]);
        *(GAS v4u*)(t.WT + (size_t)(t.n0 + n) * t.K + t.k0 + 8 * kc) = o; }
    LDS_WAIT(); asm volatile("" ::: "memory");
}
__device__ __forceinline__ int t5_bucket(int rel) {
    const int ret = rel > 0 ? 16 : 0, n = rel < 0 ? -rel : rel;
    if (n < 8) return ret + n;
    int large = 8 + (31 - __builtin_clz((unsigned)(n * n))) - 6; if (large > 15) large = 15;
    return ret + large;
}
__device__ __forceinline__ void p0_prologue(Frame& F) {
    LAS float* scr = (LAS float*)(F.lds + RING_OFF + F.wave * 16384);
    const int gw = blockIdx.x * NWAVES + F.wave, NGW = F.G * NWAVES;
    unsigned char* ws = F.ws;
    constexpr int T_IN0 = (DM / 64) * (EVEN_IN / 64), T_OUT = (DM / 64) * (DM / 64), T_UP = (DM / 64) * (DFF / 64), T_DN = (DFF / 64) * (DM / 64), T_IN1 = (DM / 64) * (ODD_IN / 64);
    constexpr int NTILES = T_IN0 + T_IN1 + 2 * T_OUT + 2 * T_UP + 2 * T_DN;
#define P0_DESC(it, t) do { int r_ = (it); \
        if (r_ < T_IN0) { t.W = F.in[IN_EWIN]; t.gain = F.in[IN_NMIX]; t.WT = (bf16*)(ws + WS_WIN0); t.K = DM; t.N = EVEN_IN; } else { r_ -= T_IN0; \
        if (r_ < T_OUT) { t.W = F.in[IN_EWOUT]; t.gain = nullptr; t.WT = (bf16*)(ws + WS_WOUT0); t.K = DM; t.N = DM; } else { r_ -= T_OUT; \
        if (r_ < T_UP) { t.W = F.in[IN_WUP]; t.gain = F.in[IN_NMLP]; t.WT = (bf16*)(ws + WS_WUP0); t.K = DM; t.N = DFF; } else { r_ -= T_UP; \
        if (r_ < T_DN) { t.W = F.in[IN_WDOWN]; t.gain = nullptr; t.WT = (bf16*)(ws + WS_WDN0); t.K = DFF; t.N = DM; } else { r_ -= T_DN; \
        if (r_ < T_IN1) { t.W = F.in[IN_OWIN]; t.gain = F.in[IN_NMIX] + DM; t.WT = (bf16*)(ws + WS_WIN1); t.K = DM; t.N = ODD_IN; } else { r_ -= T_IN1; \
        if (r_ < T_OUT) { t.W = F.in[IN_OWOUT]; t.gain = nullptr; t.WT = (bf16*)(ws + WS_WOUT1); t.K = DM; t.N = DM; } else { r_ -= T_OUT; \
        if (r_ < T_UP) { t.W = F.in[IN_WUP] + (size_t)DM * DFF; t.gain = F.in[IN_NMLP] + DM; t.WT = (bf16*)(ws + WS_WUP1); t.K = DM; t.N = DFF; } else { r_ -= T_UP; \
        t.W = F.in[IN_WDOWN] + (size_t)DFF * DM; t.gain = nullptr; t.WT = (bf16*)(ws + WS_WDN1); t.K = DFF; t.N = DM; } } } } } } } \
        const int nb_ = t.N / 64; t.k0 = 64 * (r_ / nb_); t.n0 = 64 * (r_ % nb_); } while (0)
    {
        f32x4 va[16], vb[16]; P0Tile ta, tb;
        int it = gw;
        if (it < NTILES) { P0_DESC(it, ta); p0_tile_load(ta, F.lane, va); }
        while (it < NTILES) {
            const int itn = it + NGW; const bool more = itn < NTILES;
            if (more) { P0_DESC(itn, tb); p0_tile_load(tb, F.lane, vb); }
            p0_tile_store(ta, F.lane, va, scr);
            if (more) { ta = tb;
#pragma unroll
                for (int i = 0; i < 16; ++i) va[i] = vb[i]; }
            it = itn;
        }
    }
#undef P0_DESC
    bf16* XN = (bf16*)(ws + WS_XN); float* SS = (float*)(ws + WS_SS);
    for (int m = gw; m < SEQ; m += NGW) {
        const GAS f32x4* xr = (const GAS f32x4*)(F.in[IN_X] + (size_t)m * DM) + F.lane;
        f32x4 v[8]; float s = 0.f;
#pragma unroll
        for (int j = 0; j < 8; ++j) { v[j] = xr[64 * j]; s += (v[j].x * v[j].x + v[j].y * v[j].y) + (v[j].z * v[j].z + v[j].w * v[j].w); }
        s = wave_sum(s);
        GAS v2u* o8 = (GAS v2u*)(XN + (size_t)m * DM) + F.lane;
#pragma unroll
        for (int j = 0; j < 8; ++j) { v2u w; w.x = pk2(v[j].x, v[j].y); w.y = pk2(v[j].z, v[j].w); o8[64 * j] = w; }
        if (F.lane < 8) SS[(size_t)m * 8 + F.lane] = F.lane == 0 ? s : 0.f;
    }
    float* BT = (float*)(ws + WS_BT);
    for (int i = blockIdx.x * 512 + F.tid; i < 16 * 256; i += F.G * 512) { const int head = i >> 8, rel = (i & 255) - 191; BT[i] = F.in[IN_RELB][t5_bucket(rel) * 16 + head]; }
    bf16* GWT = (bf16*)(ws + WS_GWT);
    for (int i = blockIdx.x * 512 + F.tid; i < 2 * 16 * 64 * 64; i += F.G * 512) { const int gate = i >> 16, hb = (i >> 12) & 15, jo = (i >> 6) & 63, ii = i & 63;
        GWT[i] = (bf16)f2bf(F.in[gate ? IN_GXW : IN_GAW][(size_t)(hb * 64 + ii) * 64 + jo]); }
}

__device__ __forceinline__ void ld8(const bf16* p, float (&o)[8]) { const v4u w = *(const GAS v4u*)p; o[0] = bflo(w.x); o[1] = bfhi(w.x); o[2] = bflo(w.y); o[3] = bfhi(w.y); o[4] = bflo(w.z); o[5] = bfhi(w.z); o[6] = bflo(w.w); o[7] = bfhi(w.w); }
__device__ __forceinline__ void swa_naive(Frame& F) {
    const bf16* PROJ = (const bf16*)(F.ws + WS_PROJ); bf16* Y = (bf16*)(F.ws + WS_Y); const float* BT = (const float*)(F.ws + WS_BT);
    for (int idx = blockIdx.x * 512 + F.tid; idx < SEQ * 16; idx += F.G * 512) {
        const int head = idx >> 13, tok = idx & (SEQ - 1), kvh = head >> 2, c = tok >> 6;
        float q[64], acc[64];
#pragma unroll
        for (int i = 0; i < 8; ++i) { float t[8]; ld8(PROJ + (size_t)tok * EVEN_IN + head * 64 + 8 * i, t);
#pragma unroll
            for (int j = 0; j < 8; ++j) { q[8 * i + j] = t[j] * 0.125f; acc[8 * i + j] = 0.f; } }
        float m = F.in[IN_SINKS][head], l = 1.0f;
        const int k0 = c >= 2 ? (c - 2) * 64 : 0, k1 = (c + 1) * 64;
        const float* bt = BT + head * 256;
        for (int j = k0; j < k1; ++j) {
            const bf16* kp = PROJ + (size_t)j * EVEN_IN + OFF_K + kvh * 64; float s = 0.f;
#pragma unroll
            for (int i = 0; i < 8; ++i) { float t[8]; ld8(kp + 8 * i, t);
#pragma unroll
                for (int e = 0; e < 8; ++e) s += q[8 * i + e] * t[e]; }
            s += bt[j - tok + 191];
            const float mn = fmaxf(m, s), corr = expf(m - mn), p = expf(s - mn);
            l = l * corr + p; m = mn;
            const bf16* vp = PROJ + (size_t)j * EVEN_IN + OFF_V + kvh * 64;
#pragma unroll
            for (int i = 0; i < 8; ++i) { float t[8]; ld8(vp + 8 * i, t);
#pragma unroll
                for (int e = 0; e < 8; ++e) acc[8 * i + e] = acc[8 * i + e] * corr + p * t[e]; }
        }
        const float inv = 1.0f / l;
#pragma unroll
        for (int i = 0; i < 8; ++i) { v4u w; w.x = pk2(acc[8 * i] * inv, acc[8 * i + 1] * inv); w.y = pk2(acc[8 * i + 2] * inv, acc[8 * i + 3] * inv); w.z = pk2(acc[8 * i + 4] * inv, acc[8 * i + 5] * inv); w.w = pk2(acc[8 * i + 6] * inv, acc[8 * i + 7] * inv);
            *(GAS v4u*)(Y + (size_t)tok * DM + head * 64 + 8 * i) = w; }
    }
}
__device__ __forceinline__ float softplusf(float z) { return fmaxf(z, 0.f) + log1pf(expf(-fabsf(z))); }
__device__ __forceinline__ float sigmoidf_(float z) { return 1.0f / (1.0f + expf(-z)); }
__device__ __forceinline__ float gelu_tanh(float x) { const float u = 0.7978845608028654f * (x + 0.044715f * x * x * x); return 0.5f * x * (1.0f + tanhf(u)); }
__device__ __forceinline__ void lru_naive(Frame& F) {
    if (blockIdx.x >= 16 || F.wave != 0) return;
    const bf16* PROJ = (const bf16*)(F.ws + WS_PROJ); bf16* Y = (bf16*)(F.ws + WS_Y);
    const int hb = blockIdx.x, lane = F.lane, c = hb * 64 + lane;
    float Wa[64], Wx[64];
#pragma unroll
    for (int i = 0; i < 64; ++i) { Wa[i] = F.in[IN_GAW][(size_t)(hb * 64 + i) * 64 + lane]; Wx[i] = F.in[IN_GXW][(size_t)(hb * 64 + i) * 64 + lane]; }
    const float ba = F.in[IN_GAB][c], bx = F.in[IN_GXB][c], cb = F.in[IN_CONVB][c];
    const float cw0 = F.in[IN_CONVW][c], cw1 = F.in[IN_CONVW][1024 + c], cw2 = F.in[IN_CONVW][2048 + c], cw3 = F.in[IN_CONVW][3072 + c];
    const float sp8 = 8.0f * softplusf(-F.in[IN_LAMBDA][c]);
    float x1 = 0.f, x2 = 0.f, x3 = 0.f, h = 0.f;
    for (int t0 = 0; t0 < SEQ; t0 += 8) {
        float xb[8], g[8];
#pragma unroll
        for (int u = 0; u < 8; ++u) { xb[u] = bflo((unsigned)PROJ[(size_t)(t0 + u) * EVEN_IN + OFF_X + c]); g[u] = bflo((unsigned)PROJ[(size_t)(t0 + u) * EVEN_IN + OFF_G + c]); }
#pragma unroll
        for (int u = 0; u < 8; ++u) {
            const float xt = xb[u], xc = cb + cw0 * x3 + cw1 * x2 + cw2 * x1 + cw3 * xt; x3 = x2; x2 = x1; x1 = xt;
            float ra = ba, rx = bx; const int xci = __builtin_bit_cast(int, xc);
#pragma unroll
            for (int i = 0; i < 64; ++i) { const float xi = __builtin_bit_cast(float, __builtin_amdgcn_readlane(xci, i)); ra += xi * Wa[i]; rx += xi * Wx[i]; }
            const float r = sigmoidf_(ra), ig = sigmoidf_(rx), log_a = -r * sp8, a = expf(log_a), mult = sqrtf(-expm1f(2.0f * log_a));
            h = a * h + mult * (ig * xc);
            Y[(size_t)(t0 + u) * DM + 1024 + c] = (bf16)f2bf(gelu_tanh(g[u]) * h);
        }
    }
}
__device__ __forceinline__ void sb_naive(Frame& F) {
    const bf16* PROJ = (const bf16*)(F.ws + WS_PROJ); bf16* Y = (bf16*)(F.ws + WS_Y);
    const int gt = blockIdx.x * 512 + F.tid, half = gt & 1;
    for (int pidx = gt >> 1; pidx < SEQ * 16; pidx += (F.G * 512) >> 1) {
        const int head = pidx >> 13, tok = pidx & (SEQ - 1);
        float q[64], acc[64];
#pragma unroll
        for (int i = 0; i < 8; ++i) { float t[8]; ld8(PROJ + (size_t)tok * ODD_IN + head * 128 + half * 64 + 8 * i, t);
#pragma unroll
            for (int j = 0; j < 8; ++j) { q[8 * i + j] = t[j] * 0.08838834764831845f; acc[8 * i + j] = 0.f; } }
        float stick = 0.f;
        for (int j = tok - 1; j >= 0; --j) {
            const bf16* kp = PROJ + (size_t)j * ODD_IN + 2048 + head * 128 + half * 64; float s = 0.f;
#pragma unroll
            for (int i = 0; i < 8; ++i) { float t[8]; ld8(kp + 8 * i, t);
#pragma unroll
                for (int e = 0; e < 8; ++e) s += q[8 * i + e] * t[e]; }
            const float z = s + __shfl_xor(s, 1);
            const float lk = -softplusf(z), w = expf(z + lk + stick);
            const bf16* vp = PROJ + (size_t)j * ODD_IN + 4096 + head * 128 + half * 64;
#pragma unroll
            for (int i = 0; i < 8; ++i) { float t[8]; ld8(vp + 8 * i, t);
#pragma unroll
                for (int e = 0; e < 8; ++e) acc[8 * i + e] += w * t[e]; }
            stick += lk;
            if (stick < -104.0f) break;
        }
#pragma unroll
        for (int i = 0; i < 8; ++i) { v4u w; w.x = pk2(acc[8 * i], acc[8 * i + 1]); w.y = pk2(acc[8 * i + 2], acc[8 * i + 3]); w.z = pk2(acc[8 * i + 4], acc[8 * i + 5]); w.w = pk2(acc[8 * i + 6], acc[8 * i + 7]);
            *(GAS v4u*)(Y + (size_t)tok * DM + head * 128 + half * 64 + 8 * i) = w; }
    }
}
__device__ __forceinline__ void final_norm(Frame& F) {
    const int gw = blockIdx.x * NWAVES + F.wave, NGW = F.G * NWAVES;
    const GAS f32x4* gp = (const GAS f32x4*)F.in[IN_FNORM] + F.lane;
    for (int m = gw; m < SEQ; m += NGW) {
        GAS f32x4* xr = (GAS f32x4*)(F.out + (size_t)m * DM) + F.lane;
        f32x4 v[8]; float s = 0.f;
#pragma unroll
        for (int j = 0; j < 8; ++j) { v[j] = xr[64 * j]; s += (v[j].x * v[j].x + v[j].y * v[j].y) + (v[j].z * v[j].z + v[j].w * v[j].w); }
        const float rstd = 1.0f / sqrtf(wave_sum(s) * (1.0f / DM) + 1e-6f);
#pragma unroll
        for (int j = 0; j < 8; ++j) xr[64 * j] = v[j] * rstd * gp[64 * j];
    }
}
typedef float f32x16 __attribute__((ext_vector_type(16)));
typedef short s16x8 __attribute__((ext_vector_type(8)));
typedef short s16x4 __attribute__((ext_vector_type(4)));
typedef __bf16 bf16x2v __attribute__((ext_vector_type(2)));
#define MFMA32(a, b, c) __builtin_amdgcn_mfma_f32_32x32x16_bf16((a), (b), (c), 0, 0, 0)
__device__ __forceinline__ int crow(int i, int h) { return (i & 3) + 8 * (i >> 2) + 4 * h; }
__device__ __forceinline__ unsigned pkbf(float a, float b) { bf16x2v v; v.x = (__bf16)a; v.y = (__bf16)b; return __builtin_bit_cast(unsigned, v); }
__device__ __forceinline__ s16x8 pack8(const float (&p)[16], int s) {
    v4u w; w.x = pkbf(p[8 * s], p[8 * s + 1]); w.y = pkbf(p[8 * s + 2], p[8 * s + 3]); w.z = pkbf(p[8 * s + 4], p[8 * s + 5]); w.w = pkbf(p[8 * s + 6], p[8 * s + 7]);
    return __builtin_bit_cast(s16x8, w);
}
__device__ __forceinline__ s16x8 tr_frag(const LAS unsigned char* p0, const LAS unsigned char* p1) {
    const s16x4 lo = __builtin_amdgcn_ds_read_tr16_b64_v4i16((LAS s16x4*)p0), hi = __builtin_amdgcn_ds_read_tr16_b64_v4i16((LAS s16x4*)p1);
    return __builtin_shufflevector(lo, hi, 0, 1, 2, 3, 4, 5, 6, 7);
}
__device__ __forceinline__ float ex2(float x) { return __builtin_amdgcn_exp2f(x); }
__device__ __forceinline__ float lg2(float x) { return __builtin_amdgcn_logf(x); }
__device__ __forceinline__ float fast_exp(float x) { return ex2(x * 1.4426950408889634f); }
__device__ __forceinline__ float fast_softplus(float z) { return fmaxf(z, 0.f) + 0.6931471805599453f * lg2(1.0f + ex2(-1.4426950408889634f * fabsf(z))); }
__device__ __forceinline__ float fast_sigmoid(float z) { return __builtin_amdgcn_rcpf(1.0f + ex2(-1.4426950408889634f * z)); }
#define G0(g, tok) (PROJ + ((size_t)(g) * SEQ + (tok)) * 64)
#define G1(g, tok) (PROJ + ((size_t)(g) * SEQ + (tok)) * 128)

__device__ __forceinline__ void lru_local(Frame& F) {
    const bf16* PROJ = (const bf16*)(F.ws + WS_PROJ); float* HL = (float*)(F.ws + WS_HL); float* PA = (float*)(F.ws + WS_PA); const bf16* GWT = (const bf16*)(F.ws + WS_GWT);
    LAS unsigned char* xc16 = F.lds;
    LAS float* xc32 = (LAS float*)(F.lds + 18432);
    LAS float* comp = (LAS float*)(F.lds + 18432 + 34816);
    const int tid = F.tid, lane = F.lane, w = F.wave, ts = w & 3, ch = w >> 2, r = lane & 31, h = lane >> 5;
    for (int u = blockIdx.x; u < 1024; u += F.G) {
        const int hb = u & 15, k = u >> 4, t0 = k * 128;
        {
            const int tt = tid >> 2, cg = tid & 3, cbase = hb * 64 + cg * 16, t = t0 + tt;
            float xc[16];
            { const GAS f32x4* cbp = (const GAS f32x4*)(F.in[IN_CONVB] + cbase);
#pragma unroll
              for (int q4 = 0; q4 < 4; ++q4) { const f32x4 b = cbp[q4]; xc[4 * q4] = b[0]; xc[4 * q4 + 1] = b[1]; xc[4 * q4 + 2] = b[2]; xc[4 * q4 + 3] = b[3]; } }
#pragma unroll
            for (int d = 0; d < 4; ++d) { const int row = t - 3 + d;
                float xv[16];
                if (row >= 0) { float a8[8], b8[8]; ld8(G0(24 + hb, row) + cg * 16, a8); ld8(G0(24 + hb, row) + cg * 16 + 8, b8);
#pragma unroll
                    for (int e = 0; e < 8; ++e) { xv[e] = a8[e]; xv[8 + e] = b8[e]; } }
                else {
#pragma unroll
                    for (int e = 0; e < 16; ++e) xv[e] = 0.f; }
                const GAS f32x4* cwp = (const GAS f32x4*)(F.in[IN_CONVW] + d * 1024 + cbase);
#pragma unroll
                for (int q4 = 0; q4 < 4; ++q4) { const f32x4 cw = cwp[q4];
#pragma unroll
                    for (int e = 0; e < 4; ++e) xc[4 * q4 + e] += cw[e] * xv[4 * q4 + e]; } }
#pragma unroll
            for (int q4 = 0; q4 < 4; ++q4) *(LAS f32x4*)(xc32 + tt * 68 + cg * 16 + 4 * q4) = (f32x4){xc[4 * q4], xc[4 * q4 + 1], xc[4 * q4 + 2], xc[4 * q4 + 3]};
#pragma unroll
            for (int q8 = 0; q8 < 2; ++q8) { v4u o; o.x = pkbf(xc[8 * q8], xc[8 * q8 + 1]); o.y = pkbf(xc[8 * q8 + 2], xc[8 * q8 + 3]); o.z = pkbf(xc[8 * q8 + 4], xc[8 * q8 + 5]); o.w = pkbf(xc[8 * q8 + 6], xc[8 * q8 + 7]);
                *(LAS v4u*)(xc16 + tt * 144 + cg * 32 + q8 * 16) = o; }
        }
        __syncthreads();
        f32x16 acc_a, acc_x;
#pragma unroll
        for (int i = 0; i < 16; ++i) { acc_a[i] = 0.f; acc_x[i] = 0.f; }
#pragma unroll
        for (int s = 0; s < 4; ++s) {
            const s16x8 af = *(const LAS s16x8*)(xc16 + (ts * 32 + r) * 144 + (16 * s + 8 * h) * 2);
            const s16x8 ba = *(const GAS s16x8*)(GWT + (size_t)((0 * 16 + hb) * 64 + ch * 32 + r) * 64 + 16 * s + 8 * h);
            const s16x8 bx = *(const GAS s16x8*)(GWT + (size_t)((1 * 16 + hb) * 64 + ch * 32 + r) * 64 + 16 * s + 8 * h);
            acc_a = MFMA32(af, ba, acc_a); acc_x = MFMA32(af, bx, acc_x);
        }
        const int c = hb * 64 + ch * 32 + r;
        const float gab = F.in[IN_GAB][c], gxb = F.in[IN_GXB][c], sp8 = 8.0f * softplusf(-F.in[IN_LAMBDA][c]);
        float pa[16], hl[16], gA[4], gU[4];
#pragma unroll
        for (int g = 0; g < 4; ++g) { float A = 1.f, U = 0.f;
#pragma unroll
            for (int e = 0; e < 4; ++e) { const int i = 4 * g + e; const float xcv = xc32[(ts * 32 + crow(i, h)) * 68 + ch * 32 + r];
                const float rg = fast_sigmoid(acc_a[i] + gab), ig = fast_sigmoid(acc_x[i] + gxb), log_a = -rg * sp8, a = fast_exp(log_a), mult = sqrtf(-expm1f(2.0f * log_a));
                U = a * U + mult * (ig * xcv); A *= a; pa[i] = A; hl[i] = U; }
            gA[g] = A; gU[g] = U; }
        float PAc = 1.f, Hc = 0.f;
#pragma unroll
        for (int g = 0; g < 4; ++g) { const float oA = __shfl_xor(gA[g], 32), oU = __shfl_xor(gU[g], 32);
            const float fA = h ? oA : gA[g], fU = h ? oU : gU[g], sA = h ? gA[g] : oA, sU = h ? gU[g] : oU;
            const float c0P = PAc, c0H = Hc; Hc = fA * Hc + fU; PAc *= fA; const float c1P = PAc, c1H = Hc; Hc = sA * Hc + sU; PAc *= sA;
            const float ciP = h ? c1P : c0P, ciH = h ? c1H : c0H;
#pragma unroll
            for (int e = 0; e < 4; ++e) { const int i = 4 * g + e; hl[i] += pa[i] * ciH; pa[i] *= ciP; } }
        if (h == 0) { comp[(ts * 64 + ch * 32 + r) * 2] = PAc; comp[(ts * 64 + ch * 32 + r) * 2 + 1] = Hc; }
        __syncthreads();
        float PAin = 1.f, Hin = 0.f;
        for (int t2 = 0; t2 < ts; ++t2) { const float A2 = comp[(t2 * 64 + ch * 32 + r) * 2], U2 = comp[(t2 * 64 + ch * 32 + r) * 2 + 1]; Hin = A2 * Hin + U2; PAin *= A2; }
#pragma unroll
        for (int i = 0; i < 16; ++i) { const size_t o = ((size_t)hb * SEQ + t0 + ts * 32 + crow(i, h)) * 64 + ch * 32 + r; HL[o] = hl[i] + pa[i] * Hin; PA[o] = pa[i] * PAin; }
        __syncthreads();
    }
}
__device__ __forceinline__ void lru_fix(Frame& F) {
    const bf16* PROJ = (const bf16*)(F.ws + WS_PROJ); const float* HL = (const float*)(F.ws + WS_HL); const float* PA = (const float*)(F.ws + WS_PA); bf16* Y = (bf16*)(F.ws + WS_Y);
    const int gw = blockIdx.x * NWAVES + F.wave, NGW = F.G * NWAVES;
    for (int it = gw; it < 4096; it += NGW) {
        const int cgp = it & 15, sub = (it >> 4) & 3, k = it >> 6, c = cgp * 64 + F.lane;
        float H = 0.f;
#pragma unroll 8
        for (int kk = 0; kk < k; ++kk) { const size_t row = ((size_t)cgp * SEQ + kk * 128 + 127) * 64 + F.lane; H = PA[row] * H + HL[row]; }
#pragma unroll 8
        for (int tt = 0; tt < 32; ++tt) { const int t = k * 128 + sub * 32 + tt;
            const size_t o = ((size_t)cgp * SEQ + t) * 64 + F.lane; const float hv = HL[o] + PA[o] * H, g = bflo((unsigned)G0(40 + cgp, t)[F.lane]);
            const float u2 = 1.5957691216057308f * (g + 0.044715f * g * g * g), ge = g * fast_sigmoid(u2);
            Y[(size_t)t * DM + 1024 + c] = (bf16)f2bf(ge * hv); }
    }
}
__device__ __forceinline__ void sb_attn(Frame& F) {
    const bf16* PROJ = (const bf16*)(F.ws + WS_PROJ); bf16* Y = (bf16*)(F.ws + WS_Y);
    LAS unsigned char* vt = F.lds + F.wave * 16384;
    const int lane = F.lane, r = lane & 31, h = lane >> 5;
    const int gw = blockIdx.x * NWAVES + F.wave, NGW = F.G * NWAVES;
    const LAS unsigned char* trb = vt + (4 * h + ((lane & 15) >> 2)) * 320 + (16 * ((lane >> 4) & 1) + 4 * (lane & 3)) * 2;
    for (int it = gw; it < 4096; it += NGW) {
        const int head = (it >> 3) & 15, qb = ((it >> 7) << 3) + (it & 7), q0 = qb * 32;
        s16x8 qf[8];
#pragma unroll
        for (int s = 0; s < 8; ++s) qf[s] = *(const GAS s16x8*)(G1(head, q0 + r) + 16 * s + 8 * h);
        f32x16 o[4];
#pragma unroll
        for (int db = 0; db < 4; ++db)
#pragma unroll
            for (int i = 0; i < 16; ++i) o[db][i] = 0.f;
        float carry = 0.f;
        s16x8 kf[8]; v4u vreg[8];
#pragma unroll
        for (int s = 0; s < 8; ++s) kf[s] = *(const GAS s16x8*)(G1(16 + head, q0 + r) + 16 * s + 8 * h);
#pragma unroll
        for (int i = 0; i < 8; ++i) { const int p = lane + 64 * i; vreg[i] = *(const GAS v4u*)(G1(32 + head, q0) + p * 8); }
        for (int kt = qb; kt >= 0; --kt) {
            const int kbn = (kt > 0 ? kt - 1 : 0) * 32;
            f32x16 sacc;
#pragma unroll
            for (int i = 0; i < 16; ++i) sacc[i] = 0.f;
#pragma unroll
            for (int s = 0; s < 8; ++s) sacc = MFMA32(kf[s], qf[s], sacc);
#pragma unroll
            for (int s = 0; s < 8; ++s) kf[s] = *(const GAS s16x8*)(G1(16 + head, kbn + r) + 16 * s + 8 * h);
#pragma unroll
            for (int i = 0; i < 8; ++i) { const int p = lane + 64 * i; *(LAS v4u*)(vt + (p >> 4) * 320 + (p & 15) * 16) = vreg[i]; }
            LDS_WAIT();
#pragma unroll
            for (int i = 0; i < 8; ++i) { const int p = lane + 64 * i; vreg[i] = *(const GAS v4u*)(G1(32 + head, kbn) + p * 8); }
            const bool diag = (kt == qb);
            float z[16], lk[16], G[4];
#pragma unroll
            for (int g = 0; g < 4; ++g) { float gs = 0.f;
#pragma unroll
                for (int e = 0; e < 4; ++e) { const int i = 4 * g + e; z[i] = sacc[i] * 0.08838834764831845f; const bool valid = !diag || (crow(i, h) < r);
                    const float sp = fast_softplus(z[i]); lk[i] = valid ? -sp : 0.f; z[i] = valid ? z[i] : -1e30f; gs += lk[i]; }
                G[g] = gs; }
            float run = carry, pw[16];
#pragma unroll
            for (int g = 3; g >= 0; --g) { const float og = __shfl_xor(G[g], 32);
                const float s1 = run; run += h ? G[g] : og;
                const float s0 = run; run += h ? og : G[g];
                float ex = h ? s1 : s0;
#pragma unroll
                for (int e = 3; e >= 0; --e) { const int i = 4 * g + e; pw[i] = fast_exp(z[i] + lk[i] + ex); ex += lk[i]; } }
            carry = run;
            const s16x8 p0 = pack8(pw, 0), p1 = pack8(pw, 1);
#pragma unroll
            for (int db = 0; db < 4; ++db) {
                const s16x8 v0 = tr_frag(trb + db * 64, trb + 8 * 320 + db * 64);
                const s16x8 v1 = tr_frag(trb + 16 * 320 + db * 64, trb + 24 * 320 + db * 64);
                o[db] = MFMA32(v0, p0, o[db]); o[db] = MFMA32(v1, p1, o[db]); }
            if (__all(carry < -104.0f)) break;
        }
#pragma unroll
        for (int db = 0; db < 4; ++db)
#pragma unroll
            for (int g = 0; g < 4; ++g) { v2u w; w.x = pkbf(o[db][4 * g], o[db][4 * g + 1]); w.y = pkbf(o[db][4 * g + 2], o[db][4 * g + 3]);
                *(GAS v2u*)(Y + (size_t)(q0 + r) * DM + head * 128 + db * 32 + 8 * g + 4 * h) = w; }
    }
}
__device__ __forceinline__ void swa_attn(Frame& F) {
    const bf16* PROJ = (const bf16*)(F.ws + WS_PROJ); bf16* Y = (bf16*)(F.ws + WS_Y); const float* BT = (const float*)(F.ws + WS_BT);
    LAS unsigned char* vt = F.lds + 65536 + F.wave * 8192;
    LAS float* btl = (LAS float*)(vt + 6144);
    const int lane = F.lane, r = lane & 31, h = lane >> 5;
    const int gw = blockIdx.x * NWAVES + F.wave, NGW = F.G * NWAVES;
    const LAS unsigned char* trb = vt + (4 * h + ((lane & 15) >> 2)) * 192 + (16 * ((lane >> 4) & 1) + 4 * (lane & 3)) * 2;
    for (int it = gw; it < 4096; it += NGW) {
        const int wu = it >> 3, kvh = wu & 3, c = wu >> 2, head = kvh * 4 + (it & 3), qb = 2 * c + ((it >> 2) & 1), q0 = qb * 32,
                  kbase = (c - 2) * 64, kt0 = c >= 2 ? 0 : (2 - c) * 2;
#pragma unroll
        for (int i = 0; i < 4; ++i) btl[lane + 64 * i] = BT[head * 256 + lane + 64 * i];
        LDS_WAIT();
        s16x8 qf[4];
#pragma unroll
        for (int s = 0; s < 4; ++s) qf[s] = *(const GAS s16x8*)(G0(head, q0 + r) + 16 * s + 8 * h);
        const float sink = F.in[IN_SINKS][head];
        float sc[6][16]; float m = sink;
#pragma unroll
        for (int kt = 0; kt < 6; ++kt) {
            if (kt >= kt0) {
                const int kb = kbase + kt * 32;
                f32x16 sacc;
#pragma unroll
                for (int i = 0; i < 16; ++i) sacc[i] = 0.f;
#pragma unroll
                for (int s = 0; s < 4; ++s) { const s16x8 kf = *(const GAS s16x8*)(G0(16 + kvh, kb + r) + 16 * s + 8 * h); sacc = MFMA32(kf, qf[s], sacc); }
#pragma unroll
                for (int i = 0; i < 16; ++i) { const float v = sacc[i] * 0.125f + btl[kb + crow(i, h) - (q0 + r) + 191]; sc[kt][i] = v; m = fmaxf(m, v); }
            } else {
#pragma unroll
                for (int i = 0; i < 16; ++i) sc[kt][i] = -1e30f;
            }
        }
        m = fmaxf(m, __shfl_xor(m, 32));
        float l = 0.f;
#pragma unroll
        for (int kt = 0; kt < 6; ++kt)
#pragma unroll
            for (int i = 0; i < 16; ++i) { const float p = fast_exp(sc[kt][i] - m); sc[kt][i] = p; l += p; }
        l += __shfl_xor(l, 32); l += fast_exp(sink - m);
        f32x16 o[2];
#pragma unroll
        for (int db = 0; db < 2; ++db)
#pragma unroll
            for (int i = 0; i < 16; ++i) o[db][i] = 0.f;
#pragma unroll
        for (int kt = 0; kt < 6; ++kt) {
            if (kt >= kt0) {
                const int kb = kbase + kt * 32;
#pragma unroll
                for (int i = 0; i < 4; ++i) { const int p = lane + 64 * i; const v4u v = *(const GAS v4u*)(G0(20 + kvh, kb) + p * 8); *(LAS v4u*)(vt + (p >> 3) * 192 + (p & 7) * 16) = v; }
                LDS_WAIT();
                const s16x8 p0 = pack8(sc[kt], 0), p1 = pack8(sc[kt], 1);
#pragma unroll
                for (int db = 0; db < 2; ++db) {
                    const s16x8 v0 = tr_frag(trb + db * 64, trb + 8 * 192 + db * 64);
                    const s16x8 v1 = tr_frag(trb + 16 * 192 + db * 64, trb + 24 * 192 + db * 64);
                    o[db] = MFMA32(v0, p0, o[db]); o[db] = MFMA32(v1, p1, o[db]); }
            }
        }
        const float inv = 1.0f / l;
#pragma unroll
        for (int db = 0; db < 2; ++db)
#pragma unroll
            for (int g = 0; g < 4; ++g) { v2u w; w.x = pkbf(o[db][4 * g] * inv, o[db][4 * g + 1] * inv); w.y = pkbf(o[db][4 * g + 2] * inv, o[db][4 * g + 3] * inv);
                *(GAS v2u*)(Y + (size_t)(q0 + r) * DM + head * 64 + db * 32 + 8 * g + 4 * h) = w; }
    }
}

#ifndef REP_P0
#define REP_P0 1
#endif
#define REP_LRU 1
#define REP_SWA 1
#define REP_FIX 1
#define REP_SB 1
struct Args { const float* in[19]; float* out; unsigned char* ws; int ph_lo, ph_hi; };
__global__ void __launch_bounds__(NWAVES * 64, 2) hybrid_fwd(Args args) {
    extern __shared__ __attribute__((aligned(16))) unsigned char lds[];
    Frame F;
    F.lds = (LAS unsigned char*)lds;
    F.tid = threadIdx.x; F.lane = F.tid & 63; F.wave = __builtin_amdgcn_readfirstlane(F.tid >> 6);
    F.G = gridDim.x;
#pragma unroll
    for (int i = 0; i < 19; ++i) F.in[i] = args.in[i];
    F.out = args.out; F.ws = args.ws;
    unsigned char* ws = args.ws;
    for (int u = F.tid; u < (LDS_BYTES - LDSCTL_OFF) / 4; u += NWAVES * 64) ((LAS unsigned*)(F.lds + LDSCTL_OFF))[u] = 0u;
    __syncthreads();
    const int lo = args.ph_lo, hi = args.ph_hi;
    XcdBarrier bar; bar.bar = (unsigned*)(ws + WS_CTL) + CW_BAR; bar.x = 0; bar.st = nullptr;
    if (hi - lo > 1) bar = xcd_barrier_post((unsigned*)(ws + WS_CTL) + CW_BAR, (volatile LAS unsigned*)(F.lds + MISC_OFF) + 8);
#define IN(k) (lo <= (k) && (k) < hi)
#define SEAM(k) do { if (IN(k) && IN((k) + 1)) xcd_barrier(bar); } while (0)
    bf16* XN = (bf16*)(ws + WS_XN); bf16* Yb = (bf16*)(ws + WS_Y); bf16* PROJ = (bf16*)(ws + WS_PROJ); bf16* ACT = (bf16*)(ws + WS_ACT); float* SS = (float*)(ws + WS_SS);

    if (IN(0)) { for (int rep = 0; rep < REP_P0; ++rep) { p0_prologue(F); if (rep + 1 < REP_P0) xcd_barrier(bar); } } SEAM(0);
    if (IN(1)) { pg8::Gemm g{XN, (const bf16*)(ws + WS_WIN0), SEQ, EVEN_IN, DM}; pg8::StaticOrder S; S.init(SEQ, EVEN_IN, F.G, (int)blockIdx.x);
        pg8::EpiBf16<0> E{PROJ, EVEN_IN, SS, 64, SEQ}; pg8::gemm_phase<pg8::EpiBf16<0>, pg8::StaticOrder, true, true>(F.lds + RING_OFF, g, S, E); } SEAM(1);
    if (IN(2)) { for (int rep = 0; rep < REP_LRU; ++rep) { lru_local(F); if (rep + 1 < REP_LRU) xcd_barrier(bar); } for (int rep = 0; rep < REP_SWA; ++rep) { swa_attn(F); if (rep + 1 < REP_SWA) xcd_barrier(bar); } } SEAM(2);
    if (IN(3)) { for (int rep = 0; rep < REP_FIX; ++rep) { lru_fix(F); if (rep + 1 < REP_FIX) xcd_barrier(bar); } } SEAM(3);
    if (IN(4)) { pg8::Gemm g{Yb, (const bf16*)(ws + WS_WOUT0), SEQ, DM, DM}; pg8::StaticOrder S; S.init(SEQ, DM, F.G, (int)blockIdx.x);
        pg8::EpiRes E{F.in[IN_X], F.out, XN, SS, DM}; pg8::gemm_phase<pg8::EpiRes, pg8::StaticOrder, false, true>(F.lds + RING_OFF, g, S, E); } SEAM(4);
    if (IN(5)) { pg8::Gemm g{XN, (const bf16*)(ws + WS_WUP0), SEQ, DFF, DM}; pg8::StaticOrder S; S.init(SEQ, DFF, F.G, (int)blockIdx.x);
        pg8::EpiBf16<1> E{ACT, DFF, SS, 0, 0}; pg8::gemm_phase<pg8::EpiBf16<1>, pg8::StaticOrder, true, true>(F.lds + RING_OFF, g, S, E); } SEAM(5);
    if (IN(6)) { pg8::Gemm g{ACT, (const bf16*)(ws + WS_WDN0), SEQ, DM, DFF}; pg8::StaticOrder S; S.init(SEQ, DM, F.G, (int)blockIdx.x);
        pg8::EpiRes E{F.out, F.out, XN, SS, DM}; pg8::gemm_phase<pg8::EpiRes, pg8::StaticOrder, false, true>(F.lds + RING_OFF, g, S, E); } SEAM(6);
    if (IN(7)) { pg8::Gemm g{XN, (const bf16*)(ws + WS_WIN1), SEQ, ODD_IN, DM}; pg8::StaticOrder S; S.init(SEQ, ODD_IN, F.G, (int)blockIdx.x);
        pg8::EpiBf16<0> E{PROJ, ODD_IN, SS, 128, SEQ}; pg8::gemm_phase<pg8::EpiBf16<0>, pg8::StaticOrder, true, true>(F.lds + RING_OFF, g, S, E); } SEAM(7);
    if (IN(8)) { for (int rep = 0; rep < REP_SB; ++rep) { sb_attn(F); if (rep + 1 < REP_SB) xcd_barrier(bar); } } SEAM(8);
    if (IN(9)) { pg8::Gemm g{Yb, (const bf16*)(ws + WS_WOUT1), SEQ, DM, DM}; pg8::StaticOrder S; S.init(SEQ, DM, F.G, (int)blockIdx.x);
        pg8::EpiRes E{F.out, F.out, XN, SS, DM}; pg8::gemm_phase<pg8::EpiRes, pg8::StaticOrder, false, true>(F.lds + RING_OFF, g, S, E); } SEAM(9);
    if (IN(10)) { pg8::Gemm g{XN, (const bf16*)(ws + WS_WUP1), SEQ, DFF, DM}; pg8::StaticOrder S; S.init(SEQ, DFF, F.G, (int)blockIdx.x);
        pg8::EpiBf16<1> E{ACT, DFF, SS, 0, 0}; pg8::gemm_phase<pg8::EpiBf16<1>, pg8::StaticOrder, true, true>(F.lds + RING_OFF, g, S, E); } SEAM(10);
    if (IN(11)) { pg8::Gemm g{ACT, (const bf16*)(ws + WS_WDN1), SEQ, DM, DFF}; pg8::StaticOrder S; S.init(SEQ, DM, F.G, (int)blockIdx.x);
        pg8::EpiRes E{F.out, F.out, XN, SS, DM}; pg8::gemm_phase<pg8::EpiRes, pg8::StaticOrder, false, true>(F.lds + RING_OFF, g, S, E); } SEAM(11);
    if (IN(12)) { final_norm(F); }
#undef IN
#undef SEAM
}

extern "C" void kernel_launch(void* const* d_in, const int* in_sizes, int n_in, void* d_out, int out_size, void* d_ws, size_t ws_size, hipStream_t stream) {
    static int grid = 0;
    if (grid == 0) {
        if (n_in != 19 || in_sizes[0] != SEQ * DM || out_size != SEQ * DM || ws_size < WS_END) { fprintf(stderr, "kernel_launch: unexpected shapes (n_in %d, in0 %d, out %d, ws %zu); nothing launched\n", n_in, n_in > 0 ? in_sizes[0] : -1, out_size, ws_size); grid = -1; return; }
        int dev = 0, cus = 0, per_cu = 0;
        if (hipGetDevice(&dev) != hipSuccess || hipDeviceGetAttribute(&cus, hipDeviceAttributeMultiprocessorCount, dev) != hipSuccess) { fprintf(stderr, "kernel_launch: device query failed\n"); grid = -1; return; }
        if (hipFuncSetAttribute((const void*)hybrid_fwd, hipFuncAttributeMaxDynamicSharedMemorySize, LDS_BYTES) != hipSuccess) { fprintf(stderr, "kernel_launch: hipFuncSetAttribute failed\n"); grid = -1; return; }
        if (hipOccupancyMaxActiveBlocksPerMultiprocessor(&per_cu, (const void*)hybrid_fwd, NWAVES * 64, LDS_BYTES) != hipSuccess || per_cu < 1) { fprintf(stderr, "kernel_launch: occupancy query reports %d workgroups per CU\n", per_cu); per_cu = 1; }
        (void)hipGetLastError();
        grid = cus;
        if (grid != 256) fprintf(stderr, "kernel_launch: %d CUs; the residual GEMM phases need exactly 256 workgroups\n", grid);
    }
    if (grid < 0) return;
    (void)hipMemsetAsync((char*)d_ws + WS_CTL, 0, CTL_ZERO_BYTES, stream);
    Args a{};
    for (int i = 0; i < 19; ++i) a.in[i] = (const float*)d_in[i];
    a.out = (float*)d_out; a.ws = (unsigned char*)d_ws;
#if MK_N_LAUNCHES == 1
    a.ph_lo = 0; a.ph_hi = N_PHASES;
    hipLaunchKernelGGL(hybrid_fwd, dim3(grid), dim3(NWAVES * 64), LDS_BYTES, stream, a);
#else
    for (int p = 0; p < N_PHASES; ++p) { a.ph_lo = p; a.ph_hi = p + 1; hipLaunchKernelGGL(hybrid_fwd, dim3(grid), dim3(NWAVES * 64), LDS_BYTES, stream, a); }
#endif
}
```

```cpp
#include <hip/hip_runtime.h>
#include <cstdio>
#include <cstdint>
namespace pg8 {
#define PG8_LAS __attribute__((address_space(3)))
typedef unsigned short bf16_t;
typedef short bf16x8 __attribute__((ext_vector_type(8)));
typedef float f32x4 __attribute__((ext_vector_type(4)));
typedef unsigned u32x4 __attribute__((ext_vector_type(4)));
constexpr int BM = 256, BK = 64, HALF = 128, HTB = HALF * BK * 2  , STAGE_BYTES = 8 * HTB, NXCD = 8, WGM = 8;

__host__ __device__ __forceinline__ int lds_byte(int r, int c) { const int st = (r >> 4) * 2 + (c >> 5), rr = r & 15, cc = c & 31, ob = rr * 64 + cc * 2; return st * 1024 + (ob ^ (((ob >> 9) & 1) << 5)); }
__host__ __device__ __forceinline__ void stage_rc(int b, int& R, int& C) { const int st = b / 1024, sb = b % 1024, swz = sb ^ (((sb >> 9) & 1) << 5); R = (st >> 1) * 16 + swz / 64; C = (st & 1) * 32 + (swz % 64) / 2; }
__host__ __device__ __forceinline__ int perm32(int rho) { const int n = rho >> 4, i = rho & 15; return 8 * (i >> 2) + 4 * n + (i & 3); }

struct Unit { int pm, pn; };
struct Gemm { const bf16_t* A; const bf16_t* Bt; int M, N, K; };

struct StaticOrder {
    int nM, nN, nwg, G, c;
    __host__ __device__ void init(int M, int N, int G_, int c_) { nM = M / BM; nN = N / BM; nwg = nM * nN; G = G_; c = c_; }
    __host__ __device__ bool next(int i, Unit& u) const {
        const long L = (long)i * G + c; if (L >= nwg) return false;
        int wgid = (int)L; { const int q = nwg / NXCD, r = nwg % NXCD, xcd = wgid % NXCD, off = wgid / NXCD; wgid = (xcd < r ? xcd * (q + 1) : r * (q + 1) + (xcd - r) * q) + off; }
        const int nig = WGM * nN, gid = wgid / nig, fm = gid * WGM, gsz = (nM - fm) < WGM ? (nM - fm) : WGM;
        u.pm = fm + ((wgid % nig) % gsz); u.pn = (wgid % nig) / gsz; return true;
    }
    __device__ __forceinline__ void a_ready(const Unit&) const {}
    __device__ __forceinline__ void done(const Unit&) const {}
};

__device__ __forceinline__ unsigned cvt_pk_bf16(float lo, float hi) { unsigned r; asm volatile("v_cvt_pk_bf16_f32 %0, %1, %2" : "=v"(r) : "v"(lo), "v"(hi)); return r; }
constexpr float RMS_EPS = 1e-6f;
__device__ __forceinline__ float row_rstd(const float* ss, int r) {
    const f32x4 a = *(const f32x4*)(ss + (size_t)r * 8), b = *(const f32x4*)(ss + (size_t)r * 8 + 4);
    const float s = ((a[0] + a[1]) + (a[2] + a[3])) + ((b[0] + b[1]) + (b[2] + b[3]));
    return 1.0f / sqrtf(s * (1.0f / 2048.0f) + RMS_EPS);
}
template <int ACT> struct EpiBf16 {
    static constexpr bool PERM = true, AFTER_DRAIN = false;
    bf16_t* O; int ldc; const float* ss; int grp_w, nrows;
    __device__ __forceinline__ void operator()(const f32x4 (&acc)[2][2][4][2], const Unit& u, int wr, int wc, int fr, int fq) const {
        const int row0 = u.pm * BM + wr * 64 + fr, col0 = u.pn * BM + wc * 32 + 8 * fq;
#pragma unroll
        for (int ai = 0; ai < 2; ++ai)
#pragma unroll
            for (int m = 0; m < 4; ++m) { const int r = row0 + ai * HALF + m * 16; const float rs = ss ? row_rstd(ss, r) : 1.0f;
                bf16_t* rowp = grp_w ? O + ((size_t)(col0 / grp_w) * nrows + r) * grp_w + (col0 % grp_w) : O + (size_t)r * ldc + col0;
                const size_t bjstep = grp_w ? (size_t)(HALF / grp_w) * nrows * grp_w : (size_t)HALF;
#pragma unroll
                for (int bj = 0; bj < 2; ++bj) { f32x4 v0 = acc[ai][bj][m][0] * rs, v1 = acc[ai][bj][m][1] * rs;
                    if (ACT == 1) {
#pragma unroll
                        for (int j = 0; j < 4; ++j) { const float a = fmaxf(v0[j], 0.f), b = fmaxf(v1[j], 0.f); v0[j] = a * a; v1[j] = b * b; } }
                    u32x4 w; w.x = cvt_pk_bf16(v0[0], v0[1]); w.y = cvt_pk_bf16(v0[2], v0[3]); w.z = cvt_pk_bf16(v1[0], v1[1]); w.w = cvt_pk_bf16(v1[2], v1[3]);
                    *(u32x4*)(rowp + bj * bjstep) = w; } }
    }
};
struct EpiRes {
    static constexpr bool PERM = true, AFTER_DRAIN = true;
    const float* base; float* out; bf16_t* xn; float* ss; int ldc;
    __device__ __forceinline__ void operator()(const f32x4 (&)[2][2][4][2], const Unit&, int, int, int, int) const {}
    __device__ __forceinline__ void fused(f32x4 (&acc)[2][2][4][2], const Unit& u, int wr, int wc, int fr, int fq, PG8_LAS unsigned char* lds, int wid, int lane) const {
        PG8_LAS float* P = (PG8_LAS float*)lds;
#pragma unroll
        for (int ai = 0; ai < 2; ++ai)
#pragma unroll
            for (int m = 0; m < 4; ++m) { const int rl = ai * HALF + wr * 64 + m * 16 + fr; const size_t off = (size_t)(u.pm * BM + rl) * ldc + u.pn * BM + wc * 32 + 8 * fq; float s = 0.f;
#pragma unroll
                for (int bj = 0; bj < 2; ++bj) { const f32x4 b0 = *(const f32x4*)(base + off + bj * HALF), b1 = *(const f32x4*)(base + off + bj * HALF + 4);
                    const f32x4 v0 = acc[ai][bj][m][0] + b0, v1 = acc[ai][bj][m][1] + b1;
                    *(f32x4*)(out + off + bj * HALF) = v0; *(f32x4*)(out + off + bj * HALF + 4) = v1;
                    u32x4 w; w.x = cvt_pk_bf16(v0[0], v0[1]); w.y = cvt_pk_bf16(v0[2], v0[3]); w.z = cvt_pk_bf16(v1[0], v1[1]); w.w = cvt_pk_bf16(v1[2], v1[3]);
                    *(u32x4*)(xn + off + bj * HALF) = w;
                    s += ((v0[0] * v0[0] + v0[1] * v0[1]) + (v0[2] * v0[2] + v0[3] * v0[3])) + ((v1[0] * v1[0] + v1[1] * v1[1]) + (v1[2] * v1[2] + v1[3] * v1[3])); }
                s += __shfl_xor(s, 16); s += __shfl_xor(s, 32);
                if (fq == 0) P[rl * 4 + wc] = s;
                asm volatile("" ::: "memory"); }
        asm volatile("s_waitcnt lgkmcnt(0)" ::: "memory"); __builtin_amdgcn_s_barrier(); asm volatile("" ::: "memory");
        const int t = wid * 64 + lane;
        if (t < 256) { const f32x4 p = *(const PG8_LAS f32x4*)(P + t * 4); ss[(size_t)(u.pm * BM + t) * 8 + u.pn] = (p[0] + p[1]) + (p[2] + p[3]); }
        asm volatile("s_waitcnt lgkmcnt(0)" ::: "memory"); __builtin_amdgcn_s_barrier(); asm volatile("" ::: "memory");
    }
};

template <class Epi, class Sched, bool ALIGN_EPI = false, bool SP2 = false>
__device__ __forceinline__ void gemm_phase(PG8_LAS unsigned char* lds, const Gemm g, const Sched& S, const Epi& E) {
    const int tid = threadIdx.x, wid = __builtin_amdgcn_readfirstlane(tid >> 6), lane = tid & 63, wr = wid >> 2, wc = wid & 3, fr = lane & 15, fq = lane >> 4;
    const int K = g.K, nt = K / BK;
    unsigned voffA[2], voffB[2];
#pragma unroll
    for (int i = 0; i < 2; ++i) { int R, C; stage_rc(tid * 16 + i * 8192, R, C); const int Rb = Epi::PERM ? ((R & ~31) + perm32(R & 31)) : R;
        voffA[i] = (unsigned)(R * K + C) * 2u; voffB[i] = (unsigned)(Rb * K + C) * 2u; }
    const size_t kstep = (size_t)(BK * 2);
    const size_t hstep = (size_t)HALF * K * 2;
    const size_t tstep = 2 * hstep;
    const unsigned ldsw = (unsigned)wid * 1024u;
    const int aoff = lds_byte(wr * 64 + fr, fq * 8), boff = lds_byte(wc * 32 + fr, fq * 8);
#define PG8_SA(b, h) (((b) * 2 + (h)) * HTB)
#define PG8_SB(b, h) ((4 + (b) * 2 + (h)) * HTB)
#define PG8_STAGE(bufoff, gbase, voff) do { _Pragma("unroll") for (int _i = 0; _i < 2; ++_i) \
        __builtin_amdgcn_global_load_lds((const unsigned*)((const char*)(gbase) + (voff)[_i]), (PG8_LAS unsigned*)(lds + (bufoff) + ldsw + _i * 8192), 16, 0, 0); } while (0)
#define PG8_LDA(dst, b, h) do { _Pragma("unroll") for (int m = 0; m < 4; ++m) _Pragma("unroll") for (int k = 0; k < 2; ++k) dst[m][k] = *(const PG8_LAS bf16x8*)(lds + PG8_SA(b, h) + aoff + m * 2048 + k * 1024); } while (0)
#define PG8_LDB(dst, b, h) do { _Pragma("unroll") for (int n = 0; n < 2; ++n) _Pragma("unroll") for (int k = 0; k < 2; ++k) dst[n][k] = *(const PG8_LAS bf16x8*)(lds + PG8_SB(b, h) + boff + n * 2048 + k * 1024); } while (0)
#define PG8_MMA(ai, bj, At, Bt) do { __builtin_amdgcn_s_setprio(1); _Pragma("unroll") for (int m = 0; m < 4; ++m) _Pragma("unroll") for (int n = 0; n < 2; ++n) _Pragma("unroll") for (int k = 0; k < 2; ++k) \
        acc[ai][bj][m][n] = __builtin_amdgcn_mfma_f32_16x16x32_bf16(Bt[n][k], At[m][k], acc[ai][bj][m][n], 0, 0, 0); __builtin_amdgcn_s_setprio(0); } while (0)
#define PG8_WAIT_V(n) asm volatile("s_waitcnt vmcnt(" #n ")" ::: "memory")
#define PG8_WAIT_L(n) asm volatile("s_waitcnt lgkmcnt(" #n ")" ::: "memory")
#define PG8_BAR __builtin_amdgcn_s_barrier()
#define PG8_SCHED __builtin_amdgcn_sched_barrier(0)
    Unit cur, nxt; int ui = 0;
    if (!S.next(0, cur)) return;
    f32x4 acc[2][2][4][2];
#pragma unroll
    for (int a = 0; a < 2; ++a)
#pragma unroll
        for (int b = 0; b < 2; ++b)
#pragma unroll
            for (int m = 0; m < 4; ++m)
#pragma unroll
                for (int n = 0; n < 2; ++n) acc[a][b][m][n] = (f32x4){0.f, 0.f, 0.f, 0.f};
    bf16x8 At[4][2], B0[2][2], B1[2][2];
    const char* cA = (const char*)g.A + (size_t)cur.pm * tstep; const char* cB = (const char*)g.Bt + (size_t)cur.pn * tstep;
    S.a_ready(cur);
    if constexpr (SP2) {
        PG8_STAGE(PG8_SB(0, 0), cB, voffB); PG8_STAGE(PG8_SB(0, 1), cB + hstep, voffB); PG8_STAGE(PG8_SA(0, 0), cA, voffA); PG8_STAGE(PG8_SA(0, 1), cA + hstep, voffA);
        if (wr == 1) PG8_BAR;
        PG8_WAIT_V(2); PG8_BAR;
        PG8_STAGE(PG8_SB(1, 0), cB + kstep, voffB); PG8_STAGE(PG8_SA(1, 0), cA + kstep, voffA); PG8_STAGE(PG8_SB(1, 1), cB + hstep + kstep, voffB);
        PG8_WAIT_V(6); PG8_BAR;
    } else {
        PG8_STAGE(PG8_SB(0, 0), cB, voffB); PG8_STAGE(PG8_SA(0, 0), cA, voffA); PG8_STAGE(PG8_SB(0, 1), cB + hstep, voffB); PG8_STAGE(PG8_SA(0, 1), cA + hstep, voffA);
        if (wr == 1) PG8_BAR;
        PG8_WAIT_V(4); PG8_BAR;
        PG8_STAGE(PG8_SB(1, 0), cB + kstep, voffB); PG8_STAGE(PG8_SA(1, 0), cA + kstep, voffA); PG8_STAGE(PG8_SB(1, 1), cB + hstep + kstep, voffB);
        PG8_WAIT_V(6); PG8_BAR;
    }
    for (;;) {
        const bool has_next = S.next(ui + 1, nxt);
        const char* nA = has_next ? (const char*)g.A + (size_t)nxt.pm * tstep : cA; const char* nB = has_next ? (const char*)g.Bt + (size_t)nxt.pn * tstep : cB;
        for (int t = 0; t < nt; t += 2) {
            const bool last = (t == nt - 2);
            const char* a1 = cA + (size_t)(t + 1) * kstep;
            const char* a2 = last ? nA : cA + (size_t)(t + 2) * kstep; const char* b2 = last ? nB : cB + (size_t)(t + 2) * kstep;
            const char* a3 = a2 + kstep; const char* b3 = b2 + kstep;
            if (last && has_next) S.a_ready(nxt);
            if constexpr (SP2) {
            PG8_LDB(B0, 0, 0); PG8_LDB(B1, 0, 1); PG8_SCHED; PG8_LDA(At, 0, 0); PG8_STAGE(PG8_SA(1, 1), a1 + hstep, voffA);
            PG8_WAIT_V(8); PG8_WAIT_L(0); PG8_BAR; PG8_MMA(0, 0, At, B0); PG8_MMA(0, 1, At, B1); PG8_BAR; PG8_SCHED;
            PG8_LDA(At, 0, 1); PG8_STAGE(PG8_SB(0, 0), b2, voffB); PG8_STAGE(PG8_SB(0, 1), b2 + hstep, voffB); PG8_STAGE(PG8_SA(0, 0), a2, voffA);
            PG8_WAIT_V(8); PG8_WAIT_L(0); PG8_BAR; PG8_MMA(1, 0, At, B0); PG8_MMA(1, 1, At, B1); PG8_BAR; PG8_SCHED;
            PG8_LDB(B0, 1, 0); PG8_LDB(B1, 1, 1); PG8_SCHED; PG8_LDA(At, 1, 0); PG8_STAGE(PG8_SA(0, 1), a2 + hstep, voffA);
            PG8_WAIT_V(8); PG8_WAIT_L(0); PG8_BAR; PG8_MMA(0, 0, At, B0); PG8_MMA(0, 1, At, B1); PG8_BAR; PG8_SCHED;
            PG8_LDA(At, 1, 1); PG8_STAGE(PG8_SB(1, 0), b3, voffB); PG8_STAGE(PG8_SB(1, 1), b3 + hstep, voffB); PG8_STAGE(PG8_SA(1, 0), a3, voffA);
            PG8_WAIT_V(8); PG8_WAIT_L(0); PG8_BAR; PG8_MMA(1, 0, At, B0); PG8_MMA(1, 1, At, B1); PG8_BAR; PG8_SCHED;
            } else {
            PG8_LDB(B0, 0, 0); PG8_SCHED; PG8_LDA(At, 0, 0); PG8_STAGE(PG8_SA(1, 1), a1 + hstep, voffA);
            PG8_WAIT_L(8); PG8_BAR; PG8_WAIT_L(0); PG8_MMA(0, 0, At, B0); PG8_BAR; PG8_SCHED;
            PG8_LDB(B1, 0, 1); PG8_STAGE(PG8_SB(0, 0), b2, voffB);
            PG8_BAR; PG8_WAIT_L(0); PG8_MMA(0, 1, At, B1); PG8_BAR;
            PG8_LDA(At, 0, 1); PG8_STAGE(PG8_SA(0, 0), a2, voffA);
            PG8_BAR; PG8_WAIT_L(0); PG8_MMA(1, 0, At, B0); PG8_BAR; PG8_SCHED;
            PG8_STAGE(PG8_SB(0, 1), b2 + hstep, voffB);
            PG8_WAIT_V(6); PG8_BAR; PG8_MMA(1, 1, At, B1); PG8_BAR;
            PG8_LDB(B0, 1, 0); PG8_SCHED; PG8_LDA(At, 1, 0); PG8_STAGE(PG8_SA(0, 1), a2 + hstep, voffA);
            PG8_WAIT_L(8); PG8_BAR; PG8_WAIT_L(0); PG8_MMA(0, 0, At, B0); PG8_BAR; PG8_SCHED;
            PG8_LDB(B1, 1, 1); PG8_STAGE(PG8_SB(1, 0), b3, voffB);
            PG8_BAR; PG8_WAIT_L(0); PG8_MMA(0, 1, At, B1); PG8_BAR;
            PG8_LDA(At, 1, 1); PG8_STAGE(PG8_SA(1, 0), a3, voffA);
            PG8_BAR; PG8_WAIT_L(0); PG8_MMA(1, 0, At, B0); PG8_BAR; PG8_SCHED;
            PG8_STAGE(PG8_SB(1, 1), b3 + hstep, voffB);
            PG8_WAIT_V(6); PG8_BAR; PG8_MMA(1, 1, At, B1); PG8_BAR;
            }
        }
        if constexpr (ALIGN_EPI) { if (wr == 0) PG8_BAR; }
        if constexpr (!Epi::AFTER_DRAIN) { E(acc, cur, wr, wc, fr, fq); S.done(cur); }
        if (!has_next) break;
#pragma unroll
        for (int a = 0; a < 2; ++a)
#pragma unroll
            for (int b = 0; b < 2; ++b)
#pragma unroll
                for (int m = 0; m < 4; ++m)
#pragma unroll
                    for (int n = 0; n < 2; ++n) acc[a][b][m][n] = (f32x4){0.f, 0.f, 0.f, 0.f};
        cur = nxt; cA = nA; cB = nB; ++ui;
        if constexpr (ALIGN_EPI) { if (wr == 1) PG8_BAR; }
    }
    PG8_WAIT_V(0);
    if constexpr (!ALIGN_EPI) { if (wr == 0) PG8_BAR; }
    PG8_BAR;
    if constexpr (Epi::AFTER_DRAIN) { E.fused(acc, cur, wr, wc, fr, fq, lds, wid, lane); S.done(cur); }
#undef PG8_SA
#undef PG8_SB
#undef PG8_STAGE
#undef PG8_LDA
#undef PG8_LDB
#undef PG8_MMA
#undef PG8_WAIT_V
#undef PG8_WAIT_L
#undef PG8_BAR
#undef PG8_SCHED
}
}

constexpr int NWAVES = 8;
constexpr int SEQ = 8192, DM = 2048, DFF = 8192, EVEN_IN = 3584, ODD_IN = 6144;
constexpr int OFF_K = 1024, OFF_V = 1280, OFF_X = 1536, OFF_G = 2560;
#ifndef MK_N_LAUNCHES
#define MK_N_LAUNCHES 1
#endif
constexpr int N_PHASES = 13;
constexpr size_t MiB = 1u << 20;
constexpr size_t WS_CTL = 0, CTL_ZERO_BYTES = 64 * 1024;
constexpr size_t WS_SS = 1 * MiB;
constexpr size_t WS_BT = 1 * MiB + 512 * 1024;
constexpr size_t WS_GWT = 1 * MiB + 768 * 1024;
constexpr size_t WS_WIN0 = 2 * MiB, WS_WOUT0 = 16 * MiB, WS_WUP0 = 24 * MiB, WS_WDN0 = 56 * MiB, WS_WIN1 = 88 * MiB, WS_WOUT1 = 112 * MiB, WS_WUP1 = 120 * MiB, WS_WDN1 = 152 * MiB;
constexpr size_t WS_XN = 184 * MiB;
constexpr size_t WS_Y = 216 * MiB;
constexpr size_t WS_PROJ = 248 * MiB;
constexpr size_t WS_HL = 344 * MiB, WS_PA = 376 * MiB;
constexpr size_t WS_ACT = 248 * MiB;
constexpr size_t WS_END = 408 * MiB;
constexpr int CW_BAR = 1024;

constexpr int RING_OFF = 0, RING_BYTES = 131072;
constexpr int LDSCTL_OFF = RING_BYTES, MISC_OFF = LDSCTL_OFF + 320;
constexpr int LDS_BYTES = 147456;

#define GAS __attribute__((address_space(1)))
#define LAS __attribute__((address_space(3)))
typedef unsigned short bf16;
typedef unsigned v4u __attribute__((ext_vector_type(4)));
typedef unsigned v2u __attribute__((ext_vector_type(2)));
typedef float f32x4 __attribute__((ext_vector_type(4)));
#define LDS_WAIT() asm volatile("s_waitcnt lgkmcnt(0)" ::: "memory")
#define VM_WAIT() asm volatile("s_waitcnt vmcnt(0)" ::: "memory")
__device__ __forceinline__ unsigned f2bf(float f) { unsigned u = __builtin_bit_cast(unsigned, f); return (u + 0x7fffu + ((u >> 16) & 1u)) >> 16; }
__device__ __forceinline__ unsigned pk2(float lo, float hi) { return f2bf(lo) | (f2bf(hi) << 16); }
__device__ __forceinline__ float bflo(unsigned w) { return __builtin_bit_cast(float, w << 16); }
__device__ __forceinline__ float bfhi(unsigned w) { return __builtin_bit_cast(float, w & 0xffff0000u); }

#define XB_TMO      128
#define XB_XCNT(j)  (256  + 64 * (j))
#define XB_XSUB(j)  (1280 + 64 * (j))
#define XB_XGEN(j)  (2304 + 64 * (j))
#define XB_TOP      3328
#define XB_TOPGEN   3392
#define XCD_BAR_WORDS 3456
#define XB_SPIN_CAP (1u << 22)

__device__ __forceinline__ unsigned xb_ld(unsigned* p)              { return __hip_atomic_load(p, __ATOMIC_RELAXED, __HIP_MEMORY_SCOPE_AGENT); }
__device__ __forceinline__ unsigned xb_add(unsigned* p, unsigned v) { return __hip_atomic_fetch_add(p, v, __ATOMIC_RELAXED, __HIP_MEMORY_SCOPE_AGENT); }
__device__ __forceinline__ unsigned xb_xcc_id() { return (unsigned)__builtin_amdgcn_s_getreg((3 << 11) | 20) & 0xFu; }
#define XB_SPIN(cond, bar) do { unsigned _sp = 0; while (cond) { __builtin_amdgcn_s_sleep(1); \
    if ((++_sp & 255u) == 0u) { if (xb_ld(&(bar)[XB_TMO])) break; if (_sp > XB_SPIN_CAP) { atomicAdd(&(bar)[XB_TMO], 1u); break; } } } } while (0)

struct XcdBarrier {
    unsigned* bar; unsigned x;
    volatile LAS unsigned* st;
};

__device__ __forceinline__ XcdBarrier xcd_barrier_post(unsigned* bar, volatile LAS unsigned* st) {
    XcdBarrier b; b.bar = bar; b.x = xb_xcc_id(); b.st = st;
    if (threadIdx.x == 0) (void)xb_add(&bar[XB_XCNT(b.x)], 1u);
    return b;
}
__device__ __forceinline__ void xcd_barrier_complete(unsigned* bar, unsigned x, unsigned& nloc, unsigned& nx) {
    const unsigned G = gridDim.x * gridDim.y * gridDim.z;
    unsigned sum, cnt, mine, sp = 0u;
    for (;;) {
        sum = 0u; cnt = 0u; mine = 0u;
#pragma unroll
        for (unsigned j = 0; j < 16; ++j) { const unsigned c = xb_ld(&bar[XB_XCNT(j)]); sum += c; cnt += (c > 0u) ? 1u : 0u; mine = (j == x) ? c : mine; }
        if (sum == G) break;
        __builtin_amdgcn_s_sleep(1);
        if ((++sp & 255u) == 0u) { if (xb_ld(&bar[XB_TMO])) break; if (sp > XB_SPIN_CAP) { atomicAdd(&bar[XB_TMO], 1u); break; } }
    }
    nloc = mine > 0u ? mine : 1u; nx = cnt > 0u ? cnt : 1u;
}

__device__ __forceinline__ void xcd_barrier(const XcdBarrier& b) {
    asm volatile("s_waitcnt vmcnt(0)" ::: "memory");
    __syncthreads();
    if (threadIdx.x == 0) {
        unsigned* bar = b.bar;
        __builtin_amdgcn_s_waitcnt(0);
        unsigned nloc = b.st[0], nx = b.st[1];
        if (nloc == 0u) { xcd_barrier_complete(bar, b.x, nloc, nx); b.st[0] = nloc; b.st[1] = nx; }
        const unsigned old = xb_add(&bar[XB_XSUB(b.x)], 1u);
        const unsigned gen = old / nloc;
        if (old + 1u == (gen + 1u) * nloc) {
            __builtin_amdgcn_fence(__ATOMIC_RELEASE, "agent");
            asm volatile("s_waitcnt vmcnt(0)" ::: "memory");
            const unsigned og = xb_add(&bar[XB_TOP], 1u);
            const unsigned tg = og / nx;
            if (og + 1u == (tg + 1u) * nx) xb_add(&bar[XB_TOPGEN], 1u);
            else XB_SPIN(xb_ld(&bar[XB_TOPGEN]) == tg, bar);
            __builtin_amdgcn_fence(__ATOMIC_ACQUIRE, "agent");
            xb_add(&bar[XB_XGEN(b.x)], 1u);
            asm volatile("s_waitcnt vmcnt(0)" ::: "memory");
        } else {
            XB_SPIN(xb_ld(&bar[XB_XGEN(b.x)]) == gen, bar);
            __builtin_amdgcn_fence(__ATOMIC_ACQUIRE, "agent");
            asm volatile("s_waitcnt vmcnt(0)" ::: "memory");
        }
    }
    __syncthreads();
}
struct Frame {
    LAS unsigned char* lds;
    int tid, lane, wave, G;
    const float* in[19]; float* out; unsigned char* ws;
};
#define IN_X 0
#define IN_RELB 1
#define IN_NMIX 2
#define IN_EWIN 3
#define IN_CONVW 4
#define IN_CONVB 5
#define IN_GAW 6
#define IN_GAB 7
#define IN_GXW 8
#define IN_GXB 9
#define IN_LAMBDA 10
#define IN_SINKS 11
#define IN_EWOUT 12
#define IN_OWIN 13
#define IN_OWOUT 14
#define IN_NMLP 15
#define IN_WUP 16
#define IN_WDOWN 17
#define IN_FNORM 18

__device__ __forceinline__ float wave_sum(float v) {
#pragma unroll
    for (int o = 1; o < 64; o <<= 1) v += __shfl_xor(v, o);
    return v;
}
struct P0Tile { const float* W; const float* gain; bf16* WT; int K, N, k0, n0; };
__device__ __forceinline__ void p0_tile_load(const P0Tile& t, int lane, f32x4 (&v)[16]) {
    const GAS f32x4* p = (const GAS f32x4*)(t.W + (size_t)(t.k0 + (lane >> 4)) * t.N + t.n0 + 4 * (lane & 15));
#pragma unroll
    for (int i = 0; i < 16; ++i) v[i] = p[(size_t)i * t.N];
}
__device__ __forceinline__ void p0_tile_store(const P0Tile& t, int lane, const f32x4 (&v)[16], LAS float* scr) {
#pragma unroll
    for (int i = 0; i < 16; ++i) { const int kk = (lane >> 4) + 4 * i; *(LAS f32x4*)(scr + kk * 64 + ((4 * (lane & 15)) ^ (4 * ((kk >> 3) & 7)))) = v[i]; }
    LDS_WAIT(); asm volatile("" ::: "memory");
    const int kc = lane & 7;
    float g[8];
    if (t.gain) { const f32x4 a = *(const GAS f32x4*)(t.gain + t.k0 + 8 * kc), b = *(const GAS f32x4*)(t.gain + t.k0 + 8 * kc + 4); g[0] = a[0]; g[1] = a[1]; g[2] = a[2]; g[3] = a[3]; g[4] = b[0]; g[5] = b[1]; g[6] = b[2]; g[7] = b[3]; }
    else {
#pragma unroll
        for (int e = 0; e < 8; ++e) g[e] = 1.0f; }
#pragma unroll
    for (int j = 0; j < 8; ++j) { const int n = (lane >> 3) + 8 * j; const LAS float* s = scr + (8 * kc) * 64 + (n ^ (4 * kc));
        v4u o; o.x = pk2(s[0] * g[0], s[64] * g[1]); o.y = pk2(s[128] * g[2], s[192] * g[3]); o.z = pk2(s[256] * g[4], s[320] * g[5]); o.w = pk2(s[384] * g[6], s[448] * g[7]);
        *(GAS v4u*)(t.WT + (size_t)(t.n0 + n) * t.K + t.k0 + 8 * kc) = o; }
    LDS_WAIT(); asm volatile("" ::: "memory");
}
__device__ __forceinline__ int t5_bucket(int rel) {
    const int ret = rel > 0 ? 16 : 0, n = rel < 0 ? -rel : rel;
    if (n < 8) return ret + n;
    int large = 8 + (31 - __builtin_clz((unsigned)(n * n))) - 6; if (large > 15) large = 15;
    return ret + large;
}
__device__ __forceinline__ void p0_prologue(Frame& F) {
    LAS float* scr = (LAS float*)(F.lds + RING_OFF + F.wave * 16384);
    const int gw = blockIdx.x * NWAVES + F.wave, NGW = F.G * NWAVES;
    unsigned char* ws = F.ws;
    constexpr int T_IN0 = (DM / 64) * (EVEN_IN / 64), T_OUT = (DM / 64) * (DM / 64), T_UP = (DM / 64) * (DFF / 64), T_DN = (DFF / 64) * (DM / 64), T_IN1 = (DM / 64) * (ODD_IN / 64);
    constexpr int NTILES = T_IN0 + T_IN1 + 2 * T_OUT + 2 * T_UP + 2 * T_DN;
#define P0_DESC(it, t) do { int r_ = (it); \
        if (r_ < T_IN0) { t.W = F.in[IN_EWIN]; t.gain = F.in[IN_NMIX]; t.WT = (bf16*)(ws + WS_WIN0); t.K = DM; t.N = EVEN_IN; } else { r_ -= T_IN0; \
        if (r_ < T_OUT) { t.W = F.in[IN_EWOUT]; t.gain = nullptr; t.WT = (bf16*)(ws + WS_WOUT0); t.K = DM; t.N = DM; } else { r_ -= T_OUT; \
        if (r_ < T_UP) { t.W = F.in[IN_WUP]; t.gain = F.in[IN_NMLP]; t.WT = (bf16*)(ws + WS_WUP0); t.K = DM; t.N = DFF; } else { r_ -= T_UP; \
        if (r_ < T_DN) { t.W = F.in[IN_WDOWN]; t.gain = nullptr; t.WT = (bf16*)(ws + WS_WDN0); t.K = DFF; t.N = DM; } else { r_ -= T_DN; \
        if (r_ < T_IN1) { t.W = F.in[IN_OWIN]; t.gain = F.in[IN_NMIX] + DM; t.WT = (bf16*)(ws + WS_WIN1); t.K = DM; t.N = ODD_IN; } else { r_ -= T_IN1; \
        if (r_ < T_OUT) { t.W = F.in[IN_OWOUT]; t.gain = nullptr; t.WT = (bf16*)(ws + WS_WOUT1); t.K = DM; t.N = DM; } else { r_ -= T_OUT; \
        if (r_ < T_UP) { t.W = F.in[IN_WUP] + (size_t)DM * DFF; t.gain = F.in[IN_NMLP] + DM; t.WT = (bf16*)(ws + WS_WUP1); t.K = DM; t.N = DFF; } else { r_ -= T_UP; \
        t.W = F.in[IN_WDOWN] + (size_t)DFF * DM; t.gain = nullptr; t.WT = (bf16*)(ws + WS_WDN1); t.K = DFF; t.N = DM; } } } } } } } \
        const int nb_ = t.N / 64; t.k0 = 64 * (r_ / nb_); t.n0 = 64 * (r_ % nb_); } while (0)
    {
        f32x4 va[16], vb[16]; P0Tile ta, tb;
        int it = gw;
        if (it < NTILES) { P0_DESC(it, ta); p0_tile_load(ta, F.lane, va); }
        while (it < NTILES) {
            const int itn = it + NGW; const bool more = itn < NTILES;
            if (more) { P0_DESC(itn, tb); p0_tile_load(tb, F.lane, vb); }
            p0_tile_store(ta, F.lane, va, scr);
            if (more) { ta = tb;
#pragma unroll
                for (int i = 0; i < 16; ++i) va[i] = vb[i]; }
            it = itn;
        }
    }
#undef P0_DESC
    bf16* XN = (bf16*)(ws + WS_XN); float* SS = (float*)(ws + WS_SS);
    for (int m = gw; m < SEQ; m += NGW) {
        const GAS f32x4* xr = (const GAS f32x4*)(F.in[IN_X] + (size_t)m * DM) + F.lane;
        f32x4 v[8]; float s = 0.f;
#pragma unroll
        for (int j = 0; j < 8; ++j) { v[j] = xr[64 * j]; s += (v[j].x * v[j].x + v[j].y * v[j].y) + (v[j].z * v[j].z + v[j].w * v[j].w); }
        s = wave_sum(s);
        GAS v2u* o8 = (GAS v2u*)(XN + (size_t)m * DM) + F.lane;
#pragma unroll
        for (int j = 0; j < 8; ++j) { v2u w; w.x = pk2(v[j].x, v[j].y); w.y = pk2(v[j].z, v[j].w); o8[64 * j] = w; }
        if (F.lane < 8) SS[(size_t)m * 8 + F.lane] = F.lane == 0 ? s : 0.f;
    }
    float* BT = (float*)(ws + WS_BT);
    for (int i = blockIdx.x * 512 + F.tid; i < 16 * 256; i += F.G * 512) { const int head = i >> 8, rel = (i & 255) - 191; BT[i] = F.in[IN_RELB][t5_bucket(rel) * 16 + head]; }
    bf16* GWT = (bf16*)(ws + WS_GWT);
    for (int i = blockIdx.x * 512 + F.tid; i < 2 * 16 * 64 * 64; i += F.G * 512) { const int gate = i >> 16, hb = (i >> 12) & 15, jo = (i >> 6) & 63, ii = i & 63;
        GWT[i] = (bf16)f2bf(F.in[gate ? IN_GXW : IN_GAW][(size_t)(hb * 64 + ii) * 64 + jo]); }
}

__device__ __forceinline__ void ld8(const bf16* p, float (&o)[8]) { const v4u w = *(const GAS v4u*)p; o[0] = bflo(w.x); o[1] = bfhi(w.x); o[2] = bflo(w.y); o[3] = bfhi(w.y); o[4] = bflo(w.z); o[5] = bfhi(w.z); o[6] = bflo(w.w); o[7] = bfhi(w.w); }
__device__ __forceinline__ void swa_naive(Frame& F) {
    const bf16* PROJ = (const bf16*)(F.ws + WS_PROJ); bf16* Y = (bf16*)(F.ws + WS_Y); const float* BT = (const float*)(F.ws + WS_BT);
    for (int idx = blockIdx.x * 512 + F.tid; idx < SEQ * 16; idx += F.G * 512) {
        const int head = idx >> 13, tok = idx & (SEQ - 1), kvh = head >> 2, c = tok >> 6;
        float q[64], acc[64];
#pragma unroll
        for (int i = 0; i < 8; ++i) { float t[8]; ld8(PROJ + (size_t)tok * EVEN_IN + head * 64 + 8 * i, t);
#pragma unroll
            for (int j = 0; j < 8; ++j) { q[8 * i + j] = t[j] * 0.125f; acc[8 * i + j] = 0.f; } }
        float m = F.in[IN_SINKS][head], l = 1.0f;
        const int k0 = c >= 2 ? (c - 2) * 64 : 0, k1 = (c + 1) * 64;
        const float* bt = BT + head * 256;
        for (int j = k0; j < k1; ++j) {
            const bf16* kp = PROJ + (size_t)j * EVEN_IN + OFF_K + kvh * 64; float s = 0.f;
#pragma unroll
            for (int i = 0; i < 8; ++i) { float t[8]; ld8(kp + 8 * i, t);
#pragma unroll
                for (int e = 0; e < 8; ++e) s += q[8 * i + e] * t[e]; }
            s += bt[j - tok + 191];
            const float mn = fmaxf(m, s), corr = expf(m - mn), p = expf(s - mn);
            l = l * corr + p; m = mn;
            const bf16* vp = PROJ + (size_t)j * EVEN_IN + OFF_V + kvh * 64;
#pragma unroll
            for (int i = 0; i < 8; ++i) { float t[8]; ld8(vp + 8 * i, t);
#pragma unroll
                for (int e = 0; e < 8; ++e) acc[8 * i + e] = acc[8 * i + e] * corr + p * t[e]; }
        }
        const float inv = 1.0f / l;
#pragma unroll
        for (int i = 0; i < 8; ++i) { v4u w; w.x = pk2(acc[8 * i] * inv, acc[8 * i + 1] * inv); w.y = pk2(acc[8 * i + 2] * inv, acc[8 * i + 3] * inv); w.z = pk2(acc[8 * i + 4] * inv, acc[8 * i + 5] * inv); w.w = pk2(acc[8 * i + 6] * inv, acc[8 * i + 7] * inv);
            *(GAS v4u*)(Y + (size_t)tok * DM + head * 64 + 8 * i) = w; }
    }
}
__device__ __forceinline__ float softplusf(float z) { return fmaxf(z, 0.f) + log1pf(expf(-fabsf(z))); }
__device__ __forceinline__ float sigmoidf_(float z) { return 1.0f / (1.0f + expf(-z)); }
__device__ __forceinline__ float gelu_tanh(float x) { const float u = 0.7978845608028654f * (x + 0.044715f * x * x * x); return 0.5f * x * (1.0f + tanhf(u)); }
__device__ __forceinline__ void lru_naive(Frame& F) {
    if (blockIdx.x >= 16 || F.wave != 0) return;
    const bf16* PROJ = (const bf16*)(F.ws + WS_PROJ); bf16* Y = (bf16*)(F.ws + WS_Y);
    const int hb = blockIdx.x, lane = F.lane, c = hb * 64 + lane;
    float Wa[64], Wx[64];
#pragma unroll
    for (int i = 0; i < 64; ++i) { Wa[i] = F.in[IN_GAW][(size_t)(hb * 64 + i) * 64 + lane]; Wx[i] = F.in[IN_GXW][(size_t)(hb * 64 + i) * 64 + lane]; }
    const float ba = F.in[IN_GAB][c], bx = F.in[IN_GXB][c], cb = F.in[IN_CONVB][c];
    const float cw0 = F.in[IN_CONVW][c], cw1 = F.in[IN_CONVW][1024 + c], cw2 = F.in[IN_CONVW][2048 + c], cw3 = F.in[IN_CONVW][3072 + c];
    const float sp8 = 8.0f * softplusf(-F.in[IN_LAMBDA][c]);
    float x1 = 0.f, x2 = 0.f, x3 = 0.f, h = 0.f;
    for (int t0 = 0; t0 < SEQ; t0 += 8) {
        float xb[8], g[8];
#pragma unroll
        for (int u = 0; u < 8; ++u) { xb[u] = bflo((unsigned)PROJ[(size_t)(t0 + u) * EVEN_IN + OFF_X + c]); g[u] = bflo((unsigned)PROJ[(size_t)(t0 + u) * EVEN_IN + OFF_G + c]); }
#pragma unroll
        for (int u = 0; u < 8; ++u) {
            const float xt = xb[u], xc = cb + cw0 * x3 + cw1 * x2 + cw2 * x1 + cw3 * xt; x3 = x2; x2 = x1; x1 = xt;
            float ra = ba, rx = bx; const int xci = __builtin_bit_cast(int, xc);
#pragma unroll
            for (int i = 0; i < 64; ++i) { const float xi = __builtin_bit_cast(float, __builtin_amdgcn_readlane(xci, i)); ra += xi * Wa[i]; rx += xi * Wx[i]; }
            const float r = sigmoidf_(ra), ig = sigmoidf_(rx), log_a = -r * sp8, a = expf(log_a), mult = sqrtf(-expm1f(2.0f * log_a));
            h = a * h + mult * (ig * xc);
            Y[(size_t)(t0 + u) * DM + 1024 + c] = (bf16)f2bf(gelu_tanh(g[u]) * h);
        }
    }
}
__device__ __forceinline__ void sb_naive(Frame& F) {
    const bf16* PROJ = (const bf16*)(F.ws + WS_PROJ); bf16* Y = (bf16*)(F.ws + WS_Y);
    const int gt = blockIdx.x * 512 + F.tid, half = gt & 1;
    for (int pidx = gt >> 1; pidx < SEQ * 16; pidx += (F.G * 512) >> 1) {
        const int head = pidx >> 13, tok = pidx & (SEQ - 1);
        float q[64], acc[64];
#pragma unroll
        for (int i = 0; i < 8; ++i) { float t[8]; ld8(PROJ + (size_t)tok * ODD_IN + head * 128 + half * 64 + 8 * i, t);
#pragma unroll
            for (int j = 0; j < 8; ++j) { q[8 * i + j] = t[j] * 0.08838834764831845f; acc[8 * i + j] = 0.f; } }
        float stick = 0.f;
        for (int j = tok - 1; j >= 0; --j) {
            const bf16* kp = PROJ + (size_t)j * ODD_IN + 2048 + head * 128 + half * 64; float s = 0.f;
#pragma unroll
            for (int i = 0; i < 8; ++i) { float t[8]; ld8(kp + 8 * i, t);
#pragma unroll
                for (int e = 0; e < 8; ++e) s += q[8 * i + e] * t[e]; }
            const float z = s + __shfl_xor(s, 1);
            const float lk = -softplusf(z), w = expf(z + lk + stick);
            const bf16* vp = PROJ + (size_t)j * ODD_IN + 4096 + head * 128 + half * 64;
#pragma unroll
            for (int i = 0; i < 8; ++i) { float t[8]; ld8(vp + 8 * i, t);
#pragma unroll
                for (int e = 0; e < 8; ++e) acc[8 * i + e] += w * t[e]; }
            stick += lk;
            if (stick < -104.0f) break;
        }
#pragma unroll
        for (int i = 0; i < 8; ++i) { v4u w; w.x = pk2(acc[8 * i], acc[8 * i + 1]); w.y = pk2(acc[8 * i + 2], acc[8 * i + 3]); w.z = pk2(acc[8 * i + 4], acc[8 * i + 5]); w.w = pk2(acc[8 * i + 6], acc[8 * i + 7]);
            *(GAS v4u*)(Y + (size_t)tok * DM + head * 128 + half * 64 + 8 * i) = w; }
    }
}
__device__ __forceinline__ void final_norm(Frame& F) {
    const int gw = blockIdx.x * NWAVES + F.wave, NGW = F.G * NWAVES;
    const GAS f32x4* gp = (const GAS f32x4*)F.in[IN_FNORM] + F.lane;
    for (int m = gw; m < SEQ; m += NGW) {
        GAS f32x4* xr = (GAS f32x4*)(F.out + (size_t)m * DM) + F.lane;
        f32x4 v[8]; float s = 0.f;
#pragma unroll
        for (int j = 0; j < 8; ++j) { v[j] = xr[64 * j]; s += (v[j].x * v[j].x + v[j].y * v[j].y) + (v[j].z * v[j].z + v[j].w * v[j].w); }
        const float rstd = 1.0f / sqrtf(wave_sum(s) * (1.0f / DM) + 1e-6f);
#pragma unroll
        for (int j = 0; j < 8; ++j) xr[64 * j] = v[j] * rstd * gp[64 * j];
    }
}
typedef float f32x16 __attribute__((ext_vector_type(16)));
typedef short s16x8 __attribute__((ext_vector_type(8)));
typedef short s16x4 __attribute__((ext_vector_type(4)));
typedef __bf16 bf16x2v __attribute__((ext_vector_type(2)));
#define MFMA32(a, b, c) __builtin_amdgcn_mfma_f32_32x32x16_bf16((a), (b), (c), 0, 0, 0)
__device__ __forceinline__ int crow(int i, int h) { return (i & 3) + 8 * (i >> 2) + 4 * h; }
__device__ __forceinline__ unsigned pkbf(float a, float b) { bf16x2v v; v.x = (__bf16)a; v.y = (__bf16)b; return __builtin_bit_cast(unsigned, v); }
__device__ __forceinline__ s16x8 pack8(const float (&p)[16], int s) {
    v4u w; w.x = pkbf(p[8 * s], p[8 * s + 1]); w.y = pkbf(p[8 * s + 2], p[8 * s + 3]); w.z = pkbf(p[8 * s + 4], p[8 * s + 5]); w.w = pkbf(p[8 * s + 6], p[8 * s + 7]);
    return __builtin_bit_cast(s16x8, w);
}
__device__ __forceinline__ s16x8 tr_frag(const LAS unsigned char* p0, const LAS unsigned char* p1) {
    const s16x4 lo = __builtin_amdgcn_ds_read_tr16_b64_v4i16((LAS s16x4*)p0), hi = __builtin_amdgcn_ds_read_tr16_b64_v4i16((LAS s16x4*)p1);
    return __builtin_shufflevector(lo, hi, 0, 1, 2, 3, 4, 5, 6, 7);
}
__device__ __forceinline__ float ex2(float x) { return __builtin_amdgcn_exp2f(x); }
__device__ __forceinline__ float lg2(float x) { return __builtin_amdgcn_logf(x); }
__device__ __forceinline__ float fast_exp(float x) { return ex2(x * 1.4426950408889634f); }
__device__ __forceinline__ float fast_softplus(float z) { return fmaxf(z, 0.f) + 0.6931471805599453f * lg2(1.0f + ex2(-1.4426950408889634f * fabsf(z))); }
__device__ __forceinline__ float fast_sigmoid(float z) { return __builtin_amdgcn_rcpf(1.0f + ex2(-1.4426950408889634f * z)); }
#define G0(g, tok) (PROJ + ((size_t)(g) * SEQ + (tok)) * 64)
#define G1(g, tok) (PROJ + ((size_t)(g) * SEQ + (tok)) * 128)

__device__ __forceinline__ void lru_local(Frame& F) {
    const bf16* PROJ = (const bf16*)(F.ws + WS_PROJ); float* HL = (float*)(F.ws + WS_HL); float* PA = (float*)(F.ws + WS_PA); const bf16* GWT = (const bf16*)(F.ws + WS_GWT);
    LAS unsigned char* xc16 = F.lds;
    LAS float* xc32 = (LAS float*)(F.lds + 18432);
    LAS float* comp = (LAS float*)(F.lds + 18432 + 34816);
    const int tid = F.tid, lane = F.lane, w = F.wave, ts = w & 3, ch = w >> 2, r = lane & 31, h = lane >> 5;
    for (int u = blockIdx.x; u < 1024; u += F.G) {
        const int hb = u & 15, k = u >> 4, t0 = k * 128;
        {
            const int tt = tid >> 2, cg = tid & 3, cbase = hb * 64 + cg * 16, t = t0 + tt;
            float xc[16];
            { const GAS f32x4* cbp = (const GAS f32x4*)(F.in[IN_CONVB] + cbase);
#pragma unroll
              for (int q4 = 0; q4 < 4; ++q4) { const f32x4 b = cbp[q4]; xc[4 * q4] = b[0]; xc[4 * q4 + 1] = b[1]; xc[4 * q4 + 2] = b[2]; xc[4 * q4 + 3] = b[3]; } }
#pragma unroll
            for (int d = 0; d < 4; ++d) { const int row = t - 3 + d;
                float xv[16];
                if (row >= 0) { float a8[8], b8[8]; ld8(G0(24 + hb, row) + cg * 16, a8); ld8(G0(24 + hb, row) + cg * 16 + 8, b8);
#pragma unroll
                    for (int e = 0; e < 8; ++e) { xv[e] = a8[e]; xv[8 + e] = b8[e]; } }
                else {
#pragma unroll
                    for (int e = 0; e < 16; ++e) xv[e] = 0.f; }
                const GAS f32x4* cwp = (const GAS f32x4*)(F.in[IN_CONVW] + d * 1024 + cbase);
#pragma unroll
                for (int q4 = 0; q4 < 4; ++q4) { const f32x4 cw = cwp[q4];
#pragma unroll
                    for (int e = 0; e < 4; ++e) xc[4 * q4 + e] += cw[e] * xv[4 * q4 + e]; } }
#pragma unroll
            for (int q4 = 0; q4 < 4; ++q4) *(LAS f32x4*)(xc32 + tt * 68 + cg * 16 + 4 * q4) = (f32x4){xc[4 * q4], xc[4 * q4 + 1], xc[4 * q4 + 2], xc[4 * q4 + 3]};
#pragma unroll
            for (int q8 = 0; q8 < 2; ++q8) { v4u o; o.x = pkbf(xc[8 * q8], xc[8 * q8 + 1]); o.y = pkbf(xc[8 * q8 + 2], xc[8 * q8 + 3]); o.z = pkbf(xc[8 * q8 + 4], xc[8 * q8 + 5]); o.w = pkbf(xc[8 * q8 + 6], xc[8 * q8 + 7]);
                *(LAS v4u*)(xc16 + tt * 144 + cg * 32 + q8 * 16) = o; }
        }
        __syncthreads();
        f32x16 acc_a, acc_x;
#pragma unroll
        for (int i = 0; i < 16; ++i) { acc_a[i] = 0.f; acc_x[i] = 0.f; }
#pragma unroll
        for (int s = 0; s < 4; ++s) {
            const s16x8 af = *(const LAS s16x8*)(xc16 + (ts * 32 + r) * 144 + (16 * s + 8 * h) * 2);
            const s16x8 ba = *(const GAS s16x8*)(GWT + (size_t)((0 * 16 + hb) * 64 + ch * 32 + r) * 64 + 16 * s + 8 * h);
            const s16x8 bx = *(const GAS s16x8*)(GWT + (size_t)((1 * 16 + hb) * 64 + ch * 32 + r) * 64 + 16 * s + 8 * h);
            acc_a = MFMA32(af, ba, acc_a); acc_x = MFMA32(af, bx, acc_x);
        }
        const int c = hb * 64 + ch * 32 + r;
        const float gab = F.in[IN_GAB][c], gxb = F.in[IN_GXB][c], sp8 = 8.0f * softplusf(-F.in[IN_LAMBDA][c]);
        float pa[16], hl[16], gA[4], gU[4];
#pragma unroll
        for (int g = 0; g < 4; ++g) { float A = 1.f, U = 0.f;
#pragma unroll
            for (int e = 0; e < 4; ++e) { const int i = 4 * g + e; const float xcv = xc32[(ts * 32 + crow(i, h)) * 68 + ch * 32 + r];
                const float rg = fast_sigmoid(acc_a[i] + gab), ig = fast_sigmoid(acc_x[i] + gxb), log_a = -rg * sp8, a = fast_exp(log_a), mult = sqrtf(-expm1f(2.0f * log_a));
                U = a * U + mult * (ig * xcv); A *= a; pa[i] = A; hl[i] = U; }
            gA[g] = A; gU[g] = U; }
        float PAc = 1.f, Hc = 0.f;
#pragma unroll
        for (int g = 0; g < 4; ++g) { const float oA = __shfl_xor(gA[g], 32), oU = __shfl_xor(gU[g], 32);
            const float fA = h ? oA : gA[g], fU = h ? oU : gU[g], sA = h ? gA[g] : oA, sU = h ? gU[g] : oU;
            const float c0P = PAc, c0H = Hc; Hc = fA * Hc + fU; PAc *= fA; const float c1P = PAc, c1H = Hc; Hc = sA * Hc + sU; PAc *= sA;
            const float ciP = h ? c1P : c0P, ciH = h ? c1H : c0H;
#pragma unroll
            for (int e = 0; e < 4; ++e) { const int i = 4 * g + e; hl[i] += pa[i] * ciH; pa[i] *= ciP; } }
        if (h == 0) { comp[(ts * 64 + ch * 32 + r) * 2] = PAc; comp[(ts * 64 + ch * 32 + r) * 2 + 1] = Hc; }
        __syncthreads();
        float PAin = 1.f, Hin = 0.f;
        for (int t2 = 0; t2 < ts; ++t2) { const float A2 = comp[(t2 * 64 + ch * 32 + r) * 2], U2 = comp[(t2 * 64 + ch * 32 + r) * 2 + 1]; Hin = A2 * Hin + U2; PAin *= A2; }
#pragma unroll
        for (int i = 0; i < 16; ++i) { const size_t o = ((size_t)hb * SEQ + t0 + ts * 32 + crow(i, h)) * 64 + ch * 32 + r; HL[o] = hl[i] + pa[i] * Hin; PA[o] = pa[i] * PAin; }
        __syncthreads();
    }
}
__device__ __forceinline__ void lru_fix(Frame& F) {
    const bf16* PROJ = (const bf16*)(F.ws + WS_PROJ); const float* HL = (const float*)(F.ws + WS_HL); const float* PA = (const float*)(F.ws + WS_PA); bf16* Y = (bf16*)(F.ws + WS_Y);
    const int gw = blockIdx.x * NWAVES + F.wave, NGW = F.G * NWAVES;
    for (int it = gw; it < 2048; it += NGW) {
        const int cgp = it & 15, sub = (it >> 4) & 1, k = it >> 5, c = cgp * 64 + F.lane;
        float H = 0.f;
        for (int kb = 0; kb < k; kb += 16) {
            float a[16], u[16];
#pragma unroll
            for (int j = 0; j < 16; ++j) { const int kk = (kb + j < k) ? kb + j : 0; const size_t row = ((size_t)cgp * SEQ + kk * 128 + 127) * 64 + F.lane; a[j] = PA[row]; u[j] = HL[row]; }
#pragma unroll
            for (int j = 0; j < 16; ++j) { const bool on = kb + j < k; H = on ? a[j] * H + u[j] : H; }
        }
#pragma unroll
        for (int tb = 0; tb < 64; tb += 32) {
            float hv[32], pv[32], gv[32];
#pragma unroll
            for (int tt = 0; tt < 32; ++tt) { const int t = k * 128 + sub * 64 + tb + tt; const size_t o = ((size_t)cgp * SEQ + t) * 64 + F.lane; hv[tt] = HL[o]; pv[tt] = PA[o]; gv[tt] = bflo((unsigned)G0(40 + cgp, t)[F.lane]); }
#pragma unroll
            for (int tt = 0; tt < 32; ++tt) { const int t = k * 128 + sub * 64 + tb + tt; const float g = gv[tt], u2 = 1.5957691216057308f * (g + 0.044715f * g * g * g), ge = g * fast_sigmoid(u2);
                Y[(size_t)t * DM + 1024 + c] = (bf16)f2bf(ge * (hv[tt] + pv[tt] * H)); }
        }
    }
}
__device__ __forceinline__ void sb_attn(Frame& F) {
    const bf16* PROJ = (const bf16*)(F.ws + WS_PROJ); bf16* Y = (bf16*)(F.ws + WS_Y);
    LAS unsigned char* vt = F.lds + F.wave * 16384;
    const int lane = F.lane, r = lane & 31, h = lane >> 5;
    const int gw = blockIdx.x * NWAVES + F.wave, NGW = F.G * NWAVES;
    const int troff = (4 * h + ((lane & 15) >> 2)) * 256 + (16 * ((lane >> 4) & 1) + 4 * (lane & 3)) * 2;
    for (int it = gw; it < 4096; it += NGW) {
        const int head = (it >> 3) & 15, qb = ((it >> 7) << 3) + (it & 7), q0 = qb * 32;
        s16x8 qf[8];
#pragma unroll
        for (int s = 0; s < 8; ++s) qf[s] = *(const GAS s16x8*)(G1(head, q0 + r) + 16 * s + 8 * h);
        f32x16 o[4];
#pragma unroll
        for (int db = 0; db < 4; ++db)
#pragma unroll
            for (int i = 0; i < 16; ++i) o[db][i] = 0.f;
        float carry = 0.f;
        s16x8 kf[8];
#pragma unroll
        for (int s = 0; s < 8; ++s) kf[s] = *(const GAS s16x8*)(G1(16 + head, q0 + r) + 16 * s + 8 * h);
        {   v4u v0[8];
#pragma unroll
            for (int i = 0; i < 8; ++i) v0[i] = *(const GAS v4u*)(G1(32 + head, q0) + (lane + 64 * i) * 8);
#pragma unroll
            for (int i = 0; i < 8; ++i) *(LAS v4u*)(vt + (lane + 64 * i) * 16) = v0[i];
            LDS_WAIT(); }
        int cur = 0;
        for (int kt = qb; kt >= 0; --kt) {
            const int kbn = (kt > 0 ? kt - 1 : 0) * 32;
            f32x16 sacc;
#pragma unroll
            for (int i = 0; i < 16; ++i) sacc[i] = 0.f;
#pragma unroll
            for (int s = 0; s < 8; ++s) sacc = MFMA32(kf[s], qf[s], sacc);
#pragma unroll
            for (int s = 0; s < 8; ++s) kf[s] = *(const GAS s16x8*)(G1(16 + head, kbn + r) + 16 * s + 8 * h);
            v4u vreg[8];
#pragma unroll
            for (int i = 0; i < 8; ++i) vreg[i] = *(const GAS v4u*)(G1(32 + head, kbn) + (lane + 64 * i) * 8);
            __builtin_amdgcn_sched_barrier(0);
            const bool diag = (kt == qb);
            float z[16], lk[16], G[4];
#pragma unroll
            for (int g = 0; g < 4; ++g) { float gs = 0.f;
#pragma unroll
                for (int e = 0; e < 4; ++e) { const int i = 4 * g + e; z[i] = sacc[i] * 0.08838834764831845f; const bool valid = !diag || (crow(i, h) < r);
                    const float sp = fast_softplus(z[i]); lk[i] = valid ? -sp : 0.f; z[i] = valid ? z[i] : -1e30f; gs += lk[i]; }
                G[g] = gs; }
            float run = carry, pw[16];
#pragma unroll
            for (int g = 3; g >= 0; --g) { const float og = __shfl_xor(G[g], 32);
                const float s1 = run; run += h ? G[g] : og;
                const float s0 = run; run += h ? og : G[g];
                float ex = h ? s1 : s0;
#pragma unroll
                for (int e = 3; e >= 0; --e) { const int i = 4 * g + e; pw[i] = fast_exp(z[i] + lk[i] + ex); ex += lk[i]; } }
            carry = run;
            const s16x8 p0 = pack8(pw, 0), p1 = pack8(pw, 1);
            const LAS unsigned char* trb = vt + cur * 8192 + troff;
#pragma unroll
            for (int db = 0; db < 4; ++db) {
                const s16x8 v0 = tr_frag(trb + db * 64, trb + 8 * 256 + db * 64);
                const s16x8 v1 = tr_frag(trb + 16 * 256 + db * 64, trb + 24 * 256 + db * 64);
                o[db] = MFMA32(v0, p0, o[db]); o[db] = MFMA32(v1, p1, o[db]); }
            cur ^= 1;
#pragma unroll
            for (int i = 0; i < 8; ++i) *(LAS v4u*)(vt + cur * 8192 + (lane + 64 * i) * 16) = vreg[i];
            LDS_WAIT();
            if (__all(carry < -104.0f)) break;
        }
#pragma unroll
        for (int db = 0; db < 4; ++db)
#pragma unroll
            for (int g = 0; g < 4; ++g) { v2u w; w.x = pkbf(o[db][4 * g], o[db][4 * g + 1]); w.y = pkbf(o[db][4 * g + 2], o[db][4 * g + 3]);
                *(GAS v2u*)(Y + (size_t)(q0 + r) * DM + head * 128 + db * 32 + 8 * g + 4 * h) = w; }
    }
}
__device__ __forceinline__ void swa_attn(Frame& F) {
    const bf16* PROJ = (const bf16*)(F.ws + WS_PROJ); bf16* Y = (bf16*)(F.ws + WS_Y); const float* BT = (const float*)(F.ws + WS_BT);
    LAS unsigned char* vt = F.lds + 65536 + F.wave * 8192;
    LAS float* btl = (LAS float*)(vt + 6144);
    const int lane = F.lane, r = lane & 31, h = lane >> 5;
    const int gw = blockIdx.x * NWAVES + F.wave, NGW = F.G * NWAVES;
    const LAS unsigned char* trb = vt + (4 * h + ((lane & 15) >> 2)) * 192 + (16 * ((lane >> 4) & 1) + 4 * (lane & 3)) * 2;
    for (int it = gw; it < 4096; it += NGW) {
        const int wu = it >> 3, kvh = wu & 3, c = wu >> 2, head = kvh * 4 + (it & 3), qb = 2 * c + ((it >> 2) & 1), q0 = qb * 32,
                  kbase = (c - 2) * 64, kt0 = c >= 2 ? 0 : (2 - c) * 2;
#pragma unroll
        for (int i = 0; i < 4; ++i) btl[lane + 64 * i] = BT[head * 256 + lane + 64 * i];
        LDS_WAIT();
        s16x8 qf[4];
#pragma unroll
        for (int s = 0; s < 4; ++s) qf[s] = *(const GAS s16x8*)(G0(head, q0 + r) + 16 * s + 8 * h);
        const float sink = F.in[IN_SINKS][head];
        float sc[6][16]; float m = sink;
#pragma unroll
        for (int kt = 0; kt < 6; ++kt) {
            if (kt >= kt0) {
                const int kb = kbase + kt * 32;
                f32x16 sacc;
#pragma unroll
                for (int i = 0; i < 16; ++i) sacc[i] = 0.f;
#pragma unroll
                for (int s = 0; s < 4; ++s) { const s16x8 kf = *(const GAS s16x8*)(G0(16 + kvh, kb + r) + 16 * s + 8 * h); sacc = MFMA32(kf, qf[s], sacc); }
#pragma unroll
                for (int i = 0; i < 16; ++i) { const float v = sacc[i] * 0.125f + btl[kb + crow(i, h) - (q0 + r) + 191]; sc[kt][i] = v; m = fmaxf(m, v); }
            } else {
#pragma unroll
                for (int i = 0; i < 16; ++i) sc[kt][i] = -1e30f;
            }
        }
        m = fmaxf(m, __shfl_xor(m, 32));
        float l = 0.f;
#pragma unroll
        for (int kt = 0; kt < 6; ++kt)
#pragma unroll
            for (int i = 0; i < 16; ++i) { const float p = fast_exp(sc[kt][i] - m); sc[kt][i] = p; l += p; }
        l += __shfl_xor(l, 32); l += fast_exp(sink - m);
        f32x16 o[2];
#pragma unroll
        for (int db = 0; db < 2; ++db)
#pragma unroll
            for (int i = 0; i < 16; ++i) o[db][i] = 0.f;
#pragma unroll
        for (int kt = 0; kt < 6; ++kt) {
            if (kt >= kt0) {
                const int kb = kbase + kt * 32;
#pragma unroll
                for (int i = 0; i < 4; ++i) { const int p = lane + 64 * i; const v4u v = *(const GAS v4u*)(G0(20 + kvh, kb) + p * 8); *(LAS v4u*)(vt + (p >> 3) * 192 + (p & 7) * 16) = v; }
                LDS_WAIT();
                const s16x8 p0 = pack8(sc[kt], 0), p1 = pack8(sc[kt], 1);
#pragma unroll
                for (int db = 0; db < 2; ++db) {
                    const s16x8 v0 = tr_frag(trb + db * 64, trb + 8 * 192 + db * 64);
                    const s16x8 v1 = tr_frag(trb + 16 * 192 + db * 64, trb + 24 * 192 + db * 64);
                    o[db] = MFMA32(v0, p0, o[db]); o[db] = MFMA32(v1, p1, o[db]); }
            }
        }
        const float inv = 1.0f / l;
#pragma unroll
        for (int db = 0; db < 2; ++db)
#pragma unroll
            for (int g = 0; g < 4; ++g) { v2u w; w.x = pkbf(o[db][4 * g] * inv, o[db][4 * g + 1] * inv); w.y = pkbf(o[db][4 * g + 2] * inv, o[db][4 * g + 3] * inv);
                *(GAS v2u*)(Y + (size_t)(q0 + r) * DM + head * 64 + db * 32 + 8 * g + 4 * h) = w; }
    }
}

#ifndef REP_P0
#define REP_P0 1
#endif
#define REP_LRU 1
#define REP_SWA 1
#define REP_FIX 1
#define REP_SB 1
struct Args { const float* in[19]; float* out; unsigned char* ws; int ph_lo, ph_hi; };
__global__ void __launch_bounds__(NWAVES * 64, 2) hybrid_fwd(Args args) {
    extern __shared__ __attribute__((aligned(16))) unsigned char lds[];
    Frame F;
    F.lds = (LAS unsigned char*)lds;
    F.tid = threadIdx.x; F.lane = F.tid & 63; F.wave = __builtin_amdgcn_readfirstlane(F.tid >> 6);
    F.G = gridDim.x;
#pragma unroll
    for (int i = 0; i < 19; ++i) F.in[i] = args.in[i];
    F.out = args.out; F.ws = args.ws;
    unsigned char* ws = args.ws;
    for (int u = F.tid; u < (LDS_BYTES - LDSCTL_OFF) / 4; u += NWAVES * 64) ((LAS unsigned*)(F.lds + LDSCTL_OFF))[u] = 0u;
    __syncthreads();
    const int lo = args.ph_lo, hi = args.ph_hi;
    XcdBarrier bar; bar.bar = (unsigned*)(ws + WS_CTL) + CW_BAR; bar.x = 0; bar.st = nullptr;
    if (hi - lo > 1) bar = xcd_barrier_post((unsigned*)(ws + WS_CTL) + CW_BAR, (volatile LAS unsigned*)(F.lds + MISC_OFF) + 8);
#define IN(k) (lo <= (k) && (k) < hi)
#define SEAM(k) do { if (IN(k) && IN((k) + 1)) xcd_barrier(bar); } while (0)
    bf16* XN = (bf16*)(ws + WS_XN); bf16* Yb = (bf16*)(ws + WS_Y); bf16* PROJ = (bf16*)(ws + WS_PROJ); bf16* ACT = (bf16*)(ws + WS_ACT); float* SS = (float*)(ws + WS_SS);

    if (IN(0)) { for (int rep = 0; rep < REP_P0; ++rep) { p0_prologue(F); if (rep + 1 < REP_P0) xcd_barrier(bar); } } SEAM(0);
    if (IN(1)) { pg8::Gemm g{XN, (const bf16*)(ws + WS_WIN0), SEQ, EVEN_IN, DM}; pg8::StaticOrder S; S.init(SEQ, EVEN_IN, F.G, (int)blockIdx.x);
        pg8::EpiBf16<0> E{PROJ, EVEN_IN, SS, 64, SEQ}; pg8::gemm_phase<pg8::EpiBf16<0>, pg8::StaticOrder, true, true>(F.lds + RING_OFF, g, S, E); } SEAM(1);
    if (IN(2)) { for (int rep = 0; rep < REP_LRU; ++rep) { lru_local(F); if (rep + 1 < REP_LRU) xcd_barrier(bar); } for (int rep = 0; rep < REP_SWA; ++rep) { swa_attn(F); if (rep + 1 < REP_SWA) xcd_barrier(bar); } } SEAM(2);
    if (IN(3)) { for (int rep = 0; rep < REP_FIX; ++rep) { lru_fix(F); if (rep + 1 < REP_FIX) xcd_barrier(bar); } } SEAM(3);
    if (IN(4)) { pg8::Gemm g{Yb, (const bf16*)(ws + WS_WOUT0), SEQ, DM, DM}; pg8::StaticOrder S; S.init(SEQ, DM, F.G, (int)blockIdx.x);
        pg8::EpiRes E{F.in[IN_X], F.out, XN, SS, DM}; pg8::gemm_phase<pg8::EpiRes, pg8::StaticOrder, false, true>(F.lds + RING_OFF, g, S, E); } SEAM(4);
    if (IN(5)) { pg8::Gemm g{XN, (const bf16*)(ws + WS_WUP0), SEQ, DFF, DM}; pg8::StaticOrder S; S.init(SEQ, DFF, F.G, (int)blockIdx.x);
        pg8::EpiBf16<1> E{ACT, DFF, SS, 0, 0}; pg8::gemm_phase<pg8::EpiBf16<1>, pg8::StaticOrder, true, true>(F.lds + RING_OFF, g, S, E); } SEAM(5);
    if (IN(6)) { pg8::Gemm g{ACT, (const bf16*)(ws + WS_WDN0), SEQ, DM, DFF}; pg8::StaticOrder S; S.init(SEQ, DM, F.G, (int)blockIdx.x);
        pg8::EpiRes E{F.out, F.out, XN, SS, DM}; pg8::gemm_phase<pg8::EpiRes, pg8::StaticOrder, false, true>(F.lds + RING_OFF, g, S, E); } SEAM(6);
    if (IN(7)) { pg8::Gemm g{XN, (const bf16*)(ws + WS_WIN1), SEQ, ODD_IN, DM}; pg8::StaticOrder S; S.init(SEQ, ODD_IN, F.G, (int)blockIdx.x);
        pg8::EpiBf16<0> E{PROJ, ODD_IN, SS, 128, SEQ}; pg8::gemm_phase<pg8::EpiBf16<0>, pg8::StaticOrder, true, true>(F.lds + RING_OFF, g, S, E); } SEAM(7);
    if (IN(8)) { for (int rep = 0; rep < REP_SB; ++rep) { sb_attn(F); if (rep + 1 < REP_SB) xcd_barrier(bar); } } SEAM(8);
    if (IN(9)) { pg8::Gemm g{Yb, (const bf16*)(ws + WS_WOUT1), SEQ, DM, DM}; pg8::StaticOrder S; S.init(SEQ, DM, F.G, (int)blockIdx.x);
        pg8::EpiRes E{F.out, F.out, XN, SS, DM}; pg8::gemm_phase<pg8::EpiRes, pg8::StaticOrder, false, true>(F.lds + RING_OFF, g, S, E); } SEAM(9);
    if (IN(10)) { pg8::Gemm g{XN, (const bf16*)(ws + WS_WUP1), SEQ, DFF, DM}; pg8::StaticOrder S; S.init(SEQ, DFF, F.G, (int)blockIdx.x);
        pg8::EpiBf16<1> E{ACT, DFF, SS, 0, 0}; pg8::gemm_phase<pg8::EpiBf16<1>, pg8::StaticOrder, true, true>(F.lds + RING_OFF, g, S, E); } SEAM(10);
    if (IN(11)) { pg8::Gemm g{ACT, (const bf16*)(ws + WS_WDN1), SEQ, DM, DFF}; pg8::StaticOrder S; S.init(SEQ, DM, F.G, (int)blockIdx.x);
        pg8::EpiRes E{F.out, F.out, XN, SS, DM}; pg8::gemm_phase<pg8::EpiRes, pg8::StaticOrder, false, true>(F.lds + RING_OFF, g, S, E); } SEAM(11);
    if (IN(12)) { final_norm(F); }
#undef IN
#undef SEAM
}

extern "C" void kernel_launch(void* const* d_in, const int* in_sizes, int n_in, void* d_out, int out_size, void* d_ws, size_t ws_size, hipStream_t stream) {
    static int grid = 0;
    if (grid == 0) {
        if (n_in != 19 || in_sizes[0] != SEQ * DM || out_size != SEQ * DM || ws_size < WS_END) { fprintf(stderr, "kernel_launch: unexpected shapes (n_in %d, in0 %d, out %d, ws %zu); nothing launched\n", n_in, n_in > 0 ? in_sizes[0] : -1, out_size, ws_size); grid = -1; return; }
        int dev = 0, cus = 0, per_cu = 0;
        if (hipGetDevice(&dev) != hipSuccess || hipDeviceGetAttribute(&cus, hipDeviceAttributeMultiprocessorCount, dev) != hipSuccess) { fprintf(stderr, "kernel_launch: device query failed\n"); grid = -1; return; }
        if (hipFuncSetAttribute((const void*)hybrid_fwd, hipFuncAttributeMaxDynamicSharedMemorySize, LDS_BYTES) != hipSuccess) { fprintf(stderr, "kernel_launch: hipFuncSetAttribute failed\n"); grid = -1; return; }
        if (hipOccupancyMaxActiveBlocksPerMultiprocessor(&per_cu, (const void*)hybrid_fwd, NWAVES * 64, LDS_BYTES) != hipSuccess || per_cu < 1) { fprintf(stderr, "kernel_launch: occupancy query reports %d workgroups per CU\n", per_cu); per_cu = 1; }
        (void)hipGetLastError();
        grid = cus;
        if (grid != 256) fprintf(stderr, "kernel_launch: %d CUs; the residual GEMM phases need exactly 256 workgroups\n", grid);
    }
    if (grid < 0) return;
    (void)hipMemsetAsync((char*)d_ws + WS_CTL, 0, CTL_ZERO_BYTES, stream);
    Args a{};
    for (int i = 0; i < 19; ++i) a.in[i] = (const float*)d_in[i];
    a.out = (float*)d_out; a.ws = (unsigned char*)d_ws;
#if MK_N_LAUNCHES == 1
    a.ph_lo = 0; a.ph_hi = N_PHASES;
    hipLaunchKernelGGL(hybrid_fwd, dim3(grid), dim3(NWAVES * 64), LDS_BYTES, stream, a);
#else
    for (int p = 0; p < N_PHASES; ++p) { a.ph_lo = p; a.ph_hi = p + 1; hipLaunchKernelGGL(hybrid_fwd, dim3(grid), dim3(NWAVES * 64), LDS_BYTES, stream, a); }
#endif
}
```

```cpp
#include <hip/hip_runtime.h>
#include <cstdio>
#include <cstdint>
namespace pg8 {
#define PG8_LAS __attribute__((address_space(3)))
typedef unsigned short bf16_t;
typedef short bf16x8 __attribute__((ext_vector_type(8)));
typedef float f32x4 __attribute__((ext_vector_type(4)));
typedef unsigned u32x4 __attribute__((ext_vector_type(4)));
constexpr int BM = 256, BK = 64, HALF = 128, HTB = HALF * BK * 2  , STAGE_BYTES = 8 * HTB, NXCD = 8, WGM = 8;

__host__ __device__ __forceinline__ int lds_byte(int r, int c) { const int st = (r >> 4) * 2 + (c >> 5), rr = r & 15, cc = c & 31, ob = rr * 64 + cc * 2; return st * 1024 + (ob ^ (((ob >> 9) & 1) << 5)); }
__host__ __device__ __forceinline__ void stage_rc(int b, int& R, int& C) { const int st = b / 1024, sb = b % 1024, swz = sb ^ (((sb >> 9) & 1) << 5); R = (st >> 1) * 16 + swz / 64; C = (st & 1) * 32 + (swz % 64) / 2; }
__host__ __device__ __forceinline__ int perm32(int rho) { const int n = rho >> 4, i = rho & 15; return 8 * (i >> 2) + 4 * n + (i & 3); }

struct Unit { int pm, pn; };
struct Gemm { const bf16_t* A; const bf16_t* Bt; int M, N, K; };

struct StaticOrder {
    int nM, nN, nwg, G, c;
    __host__ __device__ void init(int M, int N, int G_, int c_) { nM = M / BM; nN = N / BM; nwg = nM * nN; G = G_; c = c_; }
    __host__ __device__ bool next(int i, Unit& u) const {
        const long L = (long)i * G + c; if (L >= nwg) return false;
        int wgid = (int)L; { const int q = nwg / NXCD, r = nwg % NXCD, xcd = wgid % NXCD, off = wgid / NXCD; wgid = (xcd < r ? xcd * (q + 1) : r * (q + 1) + (xcd - r) * q) + off; }
        const int nig = WGM * nN, gid = wgid / nig, fm = gid * WGM, gsz = (nM - fm) < WGM ? (nM - fm) : WGM;
        u.pm = fm + ((wgid % nig) % gsz); u.pn = (wgid % nig) / gsz; return true;
    }
    __device__ __forceinline__ void a_ready(const Unit&) const {}
    __device__ __forceinline__ void done(const Unit&) const {}
};

__device__ __forceinline__ unsigned cvt_pk_bf16(float lo, float hi) { unsigned r; asm volatile("v_cvt_pk_bf16_f32 %0, %1, %2" : "=v"(r) : "v"(lo), "v"(hi)); return r; }
constexpr float RMS_EPS = 1e-6f;
__device__ __forceinline__ float row_rstd(const float* ss, int r) {
    const f32x4 a = *(const f32x4*)(ss + (size_t)r * 8), b = *(const f32x4*)(ss + (size_t)r * 8 + 4);
    const float s = ((a[0] + a[1]) + (a[2] + a[3])) + ((b[0] + b[1]) + (b[2] + b[3]));
    return 1.0f / sqrtf(s * (1.0f / 2048.0f) + RMS_EPS);
}
template <int ACT> struct EpiBf16 {
    static constexpr bool PERM = true, AFTER_DRAIN = false;
    bf16_t* O; int ldc; const float* ss; int grp_w, nrows;
    __device__ __forceinline__ void operator()(const f32x4 (&acc)[2][2][4][2], const Unit& u, int wr, int wc, int fr, int fq) const {
        const int row0 = u.pm * BM + wr * 64 + fr, col0 = u.pn * BM + wc * 32 + 8 * fq;
#pragma unroll
        for (int ai = 0; ai < 2; ++ai)
#pragma unroll
            for (int m = 0; m < 4; ++m) { const int r = row0 + ai * HALF + m * 16; const float rs = ss ? row_rstd(ss, r) : 1.0f;
                bf16_t* rowp = grp_w ? O + ((size_t)(col0 / grp_w) * nrows + r) * grp_w + (col0 % grp_w) : O + (size_t)r * ldc + col0;
                const size_t bjstep = grp_w ? (size_t)(HALF / grp_w) * nrows * grp_w : (size_t)HALF;
#pragma unroll
                for (int bj = 0; bj < 2; ++bj) { f32x4 v0 = acc[ai][bj][m][0] * rs, v1 = acc[ai][bj][m][1] * rs;
                    if (ACT == 1) {
#pragma unroll
                        for (int j = 0; j < 4; ++j) { const float a = fmaxf(v0[j], 0.f), b = fmaxf(v1[j], 0.f); v0[j] = a * a; v1[j] = b * b; } }
                    u32x4 w; w.x = cvt_pk_bf16(v0[0], v0[1]); w.y = cvt_pk_bf16(v0[2], v0[3]); w.z = cvt_pk_bf16(v1[0], v1[1]); w.w = cvt_pk_bf16(v1[2], v1[3]);
                    *(u32x4*)(rowp + bj * bjstep) = w; } }
    }
};
struct EpiRes {
    static constexpr bool PERM = true, AFTER_DRAIN = true;
    const float* base; float* out; bf16_t* xn; float* ss; int ldc;
    __device__ __forceinline__ void operator()(const f32x4 (&)[2][2][4][2], const Unit&, int, int, int, int) const {}
    __device__ __forceinline__ void fused(f32x4 (&acc)[2][2][4][2], const Unit& u, int wr, int wc, int fr, int fq, PG8_LAS unsigned char* lds, int wid, int lane) const {
        PG8_LAS float* P = (PG8_LAS float*)lds;
#pragma unroll
        for (int ai = 0; ai < 2; ++ai)
#pragma unroll
            for (int m = 0; m < 4; ++m) { const int rl = ai * HALF + wr * 64 + m * 16 + fr; const size_t off = (size_t)(u.pm * BM + rl) * ldc + u.pn * BM + wc * 32 + 8 * fq; float s = 0.f;
#pragma unroll
                for (int bj = 0; bj < 2; ++bj) { const f32x4 b0 = *(const f32x4*)(base + off + bj * HALF), b1 = *(const f32x4*)(base + off + bj * HALF + 4);
                    const f32x4 v0 = acc[ai][bj][m][0] + b0, v1 = acc[ai][bj][m][1] + b1;
                    *(f32x4*)(out + off + bj * HALF) = v0; *(f32x4*)(out + off + bj * HALF + 4) = v1;
                    u32x4 w; w.x = cvt_pk_bf16(v0[0], v0[1]); w.y = cvt_pk_bf16(v0[2], v0[3]); w.z = cvt_pk_bf16(v1[0], v1[1]); w.w = cvt_pk_bf16(v1[2], v1[3]);
                    *(u32x4*)(xn + off + bj * HALF) = w;
                    s += ((v0[0] * v0[0] + v0[1] * v0[1]) + (v0[2] * v0[2] + v0[3] * v0[3])) + ((v1[0] * v1[0] + v1[1] * v1[1]) + (v1[2] * v1[2] + v1[3] * v1[3])); }
                s += __shfl_xor(s, 16); s += __shfl_xor(s, 32);
                if (fq == 0) P[rl * 4 + wc] = s;
                asm volatile("" ::: "memory"); }
        asm volatile("s_waitcnt lgkmcnt(0)" ::: "memory"); __builtin_amdgcn_s_barrier(); asm volatile("" ::: "memory");
        const int t = wid * 64 + lane;
        if (t < 256) { const f32x4 p = *(const PG8_LAS f32x4*)(P + t * 4); ss[(size_t)(u.pm * BM + t) * 8 + u.pn] = (p[0] + p[1]) + (p[2] + p[3]); }
        asm volatile("s_waitcnt lgkmcnt(0)" ::: "memory"); __builtin_amdgcn_s_barrier(); asm volatile("" ::: "memory");
    }
};

template <class Epi, class Sched, bool ALIGN_EPI = false, bool SP2 = false>
__device__ __forceinline__ void gemm_phase(PG8_LAS unsigned char* lds, const Gemm g, const Sched& S, const Epi& E) {
    const int tid = threadIdx.x, wid = __builtin_amdgcn_readfirstlane(tid >> 6), lane = tid & 63, wr = wid >> 2, wc = wid & 3, fr = lane & 15, fq = lane >> 4;
    const int K = g.K, nt = K / BK;
    unsigned voffA[2], voffB[2];
#pragma unroll
    for (int i = 0; i < 2; ++i) { int R, C; stage_rc(tid * 16 + i * 8192, R, C); const int Rb = Epi::PERM ? ((R & ~31) + perm32(R & 31)) : R;
        voffA[i] = (unsigned)(R * K + C) * 2u; voffB[i] = (unsigned)(Rb * K + C) * 2u; }
    const size_t kstep = (size_t)(BK * 2);
    const size_t hstep = (size_t)HALF * K * 2;
    const size_t tstep = 2 * hstep;
    const unsigned ldsw = (unsigned)wid * 1024u;
    const int aoff = lds_byte(wr * 64 + fr, fq * 8), boff = lds_byte(wc * 32 + fr, fq * 8);
#define PG8_SA(b, h) (((b) * 2 + (h)) * HTB)
#define PG8_SB(b, h) ((4 + (b) * 2 + (h)) * HTB)
#define PG8_STAGE(bufoff, gbase, voff) do { _Pragma("unroll") for (int _i = 0; _i < 2; ++_i) \
        __builtin_amdgcn_global_load_lds((const unsigned*)((const char*)(gbase) + (voff)[_i]), (PG8_LAS unsigned*)(lds + (bufoff) + ldsw + _i * 8192), 16, 0, 0); } while (0)
#define PG8_LDA(dst, b, h) do { _Pragma("unroll") for (int m = 0; m < 4; ++m) _Pragma("unroll") for (int k = 0; k < 2; ++k) dst[m][k] = *(const PG8_LAS bf16x8*)(lds + PG8_SA(b, h) + aoff + m * 2048 + k * 1024); } while (0)
#define PG8_LDB(dst, b, h) do { _Pragma("unroll") for (int n = 0; n < 2; ++n) _Pragma("unroll") for (int k = 0; k < 2; ++k) dst[n][k] = *(const PG8_LAS bf16x8*)(lds + PG8_SB(b, h) + boff + n * 2048 + k * 1024); } while (0)
#define PG8_MMA(ai, bj, At, Bt) do { __builtin_amdgcn_s_setprio(1); _Pragma("unroll") for (int m = 0; m < 4; ++m) _Pragma("unroll") for (int n = 0; n < 2; ++n) _Pragma("unroll") for (int k = 0; k < 2; ++k) \
        acc[ai][bj][m][n] = __builtin_amdgcn_mfma_f32_16x16x32_bf16(Bt[n][k], At[m][k], acc[ai][bj][m][n], 0, 0, 0); __builtin_amdgcn_s_setprio(0); } while (0)
#define PG8_WAIT_V(n) asm volatile("s_waitcnt vmcnt(" #n ")" ::: "memory")
#define PG8_WAIT_L(n) asm volatile("s_waitcnt lgkmcnt(" #n ")" ::: "memory")
#define PG8_BAR __builtin_amdgcn_s_barrier()
#define PG8_SCHED __builtin_amdgcn_sched_barrier(0)
    Unit cur, nxt; int ui = 0;
    if (!S.next(0, cur)) return;
    f32x4 acc[2][2][4][2];
#pragma unroll
    for (int a = 0; a < 2; ++a)
#pragma unroll
        for (int b = 0; b < 2; ++b)
#pragma unroll
            for (int m = 0; m < 4; ++m)
#pragma unroll
                for (int n = 0; n < 2; ++n) acc[a][b][m][n] = (f32x4){0.f, 0.f, 0.f, 0.f};
    bf16x8 At[4][2], B0[2][2], B1[2][2];
    const char* cA = (const char*)g.A + (size_t)cur.pm * tstep; const char* cB = (const char*)g.Bt + (size_t)cur.pn * tstep;
    S.a_ready(cur);
    if constexpr (SP2) {
        PG8_STAGE(PG8_SB(0, 0), cB, voffB); PG8_STAGE(PG8_SB(0, 1), cB + hstep, voffB); PG8_STAGE(PG8_SA(0, 0), cA, voffA); PG8_STAGE(PG8_SA(0, 1), cA + hstep, voffA);
        if (wr == 1) PG8_BAR;
        PG8_WAIT_V(2); PG8_BAR;
        PG8_STAGE(PG8_SB(1, 0), cB + kstep, voffB); PG8_STAGE(PG8_SA(1, 0), cA + kstep, voffA); PG8_STAGE(PG8_SB(1, 1), cB + hstep + kstep, voffB);
        PG8_WAIT_V(6); PG8_BAR;
    } else {
        PG8_STAGE(PG8_SB(0, 0), cB, voffB); PG8_STAGE(PG8_SA(0, 0), cA, voffA); PG8_STAGE(PG8_SB(0, 1), cB + hstep, voffB); PG8_STAGE(PG8_SA(0, 1), cA + hstep, voffA);
        if (wr == 1) PG8_BAR;
        PG8_WAIT_V(4); PG8_BAR;
        PG8_STAGE(PG8_SB(1, 0), cB + kstep, voffB); PG8_STAGE(PG8_SA(1, 0), cA + kstep, voffA); PG8_STAGE(PG8_SB(1, 1), cB + hstep + kstep, voffB);
        PG8_WAIT_V(6); PG8_BAR;
    }
    for (;;) {
        const bool has_next = S.next(ui + 1, nxt);
        const char* nA = has_next ? (const char*)g.A + (size_t)nxt.pm * tstep : cA; const char* nB = has_next ? (const char*)g.Bt + (size_t)nxt.pn * tstep : cB;
        for (int t = 0; t < nt; t += 2) {
            const bool last = (t == nt - 2);
            const char* a1 = cA + (size_t)(t + 1) * kstep;
            const char* a2 = last ? nA : cA + (size_t)(t + 2) * kstep; const char* b2 = last ? nB : cB + (size_t)(t + 2) * kstep;
            const char* a3 = a2 + kstep; const char* b3 = b2 + kstep;
            if (last && has_next) S.a_ready(nxt);
            if constexpr (SP2) {
            PG8_LDB(B0, 0, 0); PG8_LDB(B1, 0, 1); PG8_SCHED; PG8_LDA(At, 0, 0); PG8_STAGE(PG8_SA(1, 1), a1 + hstep, voffA);
            PG8_WAIT_V(8); PG8_WAIT_L(0); PG8_BAR; PG8_MMA(0, 0, At, B0); PG8_MMA(0, 1, At, B1); PG8_BAR; PG8_SCHED;
            PG8_LDA(At, 0, 1); PG8_STAGE(PG8_SB(0, 0), b2, voffB); PG8_STAGE(PG8_SB(0, 1), b2 + hstep, voffB); PG8_STAGE(PG8_SA(0, 0), a2, voffA);
            PG8_WAIT_V(8); PG8_WAIT_L(0); PG8_BAR; PG8_MMA(1, 0, At, B0); PG8_MMA(1, 1, At, B1); PG8_BAR; PG8_SCHED;
            PG8_LDB(B0, 1, 0); PG8_LDB(B1, 1, 1); PG8_SCHED; PG8_LDA(At, 1, 0); PG8_STAGE(PG8_SA(0, 1), a2 + hstep, voffA);
            PG8_WAIT_V(8); PG8_WAIT_L(0); PG8_BAR; PG8_MMA(0, 0, At, B0); PG8_MMA(0, 1, At, B1); PG8_BAR; PG8_SCHED;
            PG8_LDA(At, 1, 1); PG8_STAGE(PG8_SB(1, 0), b3, voffB); PG8_STAGE(PG8_SB(1, 1), b3 + hstep, voffB); PG8_STAGE(PG8_SA(1, 0), a3, voffA);
            PG8_WAIT_V(8); PG8_WAIT_L(0); PG8_BAR; PG8_MMA(1, 0, At, B0); PG8_MMA(1, 1, At, B1); PG8_BAR; PG8_SCHED;
            } else {
            PG8_LDB(B0, 0, 0); PG8_SCHED; PG8_LDA(At, 0, 0); PG8_STAGE(PG8_SA(1, 1), a1 + hstep, voffA);
            PG8_WAIT_L(8); PG8_BAR; PG8_WAIT_L(0); PG8_MMA(0, 0, At, B0); PG8_BAR; PG8_SCHED;
            PG8_LDB(B1, 0, 1); PG8_STAGE(PG8_SB(0, 0), b2, voffB);
            PG8_BAR; PG8_WAIT_L(0); PG8_MMA(0, 1, At, B1); PG8_BAR;
            PG8_LDA(At, 0, 1); PG8_STAGE(PG8_SA(0, 0), a2, voffA);
            PG8_BAR; PG8_WAIT_L(0); PG8_MMA(1, 0, At, B0); PG8_BAR; PG8_SCHED;
            PG8_STAGE(PG8_SB(0, 1), b2 + hstep, voffB);
            PG8_WAIT_V(6); PG8_BAR; PG8_MMA(1, 1, At, B1); PG8_BAR;
            PG8_LDB(B0, 1, 0); PG8_SCHED; PG8_LDA(At, 1, 0); PG8_STAGE(PG8_SA(0, 1), a2 + hstep, voffA);
            PG8_WAIT_L(8); PG8_BAR; PG8_WAIT_L(0); PG8_MMA(0, 0, At, B0); PG8_BAR; PG8_SCHED;
            PG8_LDB(B1, 1, 1); PG8_STAGE(PG8_SB(1, 0), b3, voffB);
            PG8_BAR; PG8_WAIT_L(0); PG8_MMA(0, 1, At, B1); PG8_BAR;
            PG8_LDA(At, 1, 1); PG8_STAGE(PG8_SA(1, 0), a3, voffA);
            PG8_BAR; PG8_WAIT_L(0); PG8_MMA(1, 0, At, B0); PG8_BAR; PG8_SCHED;
            PG8_STAGE(PG8_SB(1, 1), b3 + hstep, voffB);
            PG8_WAIT_V(6); PG8_BAR; PG8_MMA(1, 1, At, B1); PG8_BAR;
            }
        }
        if constexpr (ALIGN_EPI) { if (wr == 0) PG8_BAR; }
        if constexpr (!Epi::AFTER_DRAIN) { E(acc, cur, wr, wc, fr, fq); S.done(cur); }
        if (!has_next) break;
#pragma unroll
        for (int a = 0; a < 2; ++a)
#pragma unroll
            for (int b = 0; b < 2; ++b)
#pragma unroll
                for (int m = 0; m < 4; ++m)
#pragma unroll
                    for (int n = 0; n < 2; ++n) acc[a][b][m][n] = (f32x4){0.f, 0.f, 0.f, 0.f};
        cur = nxt; cA = nA; cB = nB; ++ui;
        if constexpr (ALIGN_EPI) { if (wr == 1) PG8_BAR; }
    }
    PG8_WAIT_V(0);
    if constexpr (!ALIGN_EPI) { if (wr == 0) PG8_BAR; }
    PG8_BAR;
    if constexpr (Epi::AFTER_DRAIN) { E.fused(acc, cur, wr, wc, fr, fq, lds, wid, lane); S.done(cur); }
#undef PG8_SA
#undef PG8_SB
#undef PG8_STAGE
#undef PG8_LDA
#undef PG8_LDB
#undef PG8_MMA
#undef PG8_WAIT_V
#undef PG8_WAIT_L
#undef PG8_BAR
#undef PG8_SCHED
}
}

constexpr int NWAVES = 8;
constexpr int SEQ = 8192, DM = 2048, DFF = 8192, EVEN_IN = 3584, ODD_IN = 6144;
constexpr int OFF_K = 1024, OFF_V = 1280, OFF_X = 1536, OFF_G = 2560;
#ifndef MK_N_LAUNCHES
#define MK_N_LAUNCHES 1
#endif
constexpr int N_PHASES = 13;
constexpr size_t MiB = 1u << 20;
constexpr size_t WS_CTL = 0, CTL_ZERO_BYTES = 64 * 1024;
constexpr size_t WS_SS = 1 * MiB;
constexpr size_t WS_BT = 1 * MiB + 512 * 1024;
constexpr size_t WS_GWT = 1 * MiB + 768 * 1024;
constexpr size_t WS_WIN0 = 2 * MiB, WS_WOUT0 = 16 * MiB, WS_WUP0 = 24 * MiB, WS_WDN0 = 56 * MiB, WS_WIN1 = 88 * MiB, WS_WOUT1 = 112 * MiB, WS_WUP1 = 120 * MiB, WS_WDN1 = 152 * MiB;
constexpr size_t WS_XN = 184 * MiB;
constexpr size_t WS_Y = 216 * MiB;
constexpr size_t WS_PROJ = 248 * MiB;
constexpr size_t WS_HL = 344 * MiB, WS_PA = 376 * MiB;
constexpr size_t WS_ACT = 248 * MiB;
constexpr size_t WS_END = 408 * MiB;
constexpr int CW_BAR = 1024;

constexpr int RING_OFF = 0, RING_BYTES = 131072;
constexpr int LDSCTL_OFF = RING_BYTES, MISC_OFF = LDSCTL_OFF + 320;
constexpr int LDS_BYTES = 147456;

#define GAS __attribute__((address_space(1)))
#define LAS __attribute__((address_space(3)))
typedef unsigned short bf16;
typedef unsigned v4u __attribute__((ext_vector_type(4)));
typedef unsigned v2u __attribute__((ext_vector_type(2)));
typedef float f32x4 __attribute__((ext_vector_type(4)));
#define LDS_WAIT() asm volatile("s_waitcnt lgkmcnt(0)" ::: "memory")
#define VM_WAIT() asm volatile("s_waitcnt vmcnt(0)" ::: "memory")
__device__ __forceinline__ unsigned f2bf(float f) { unsigned u = __builtin_bit_cast(unsigned, f); return (u + 0x7fffu + ((u >> 16) & 1u)) >> 16; }
__device__ __forceinline__ unsigned pk2(float lo, float hi) { return f2bf(lo) | (f2bf(hi) << 16); }
__device__ __forceinline__ float bflo(unsigned w) { return __builtin_bit_cast(float, w << 16); }
__device__ __forceinline__ float bfhi(unsigned w) { return __builtin_bit_cast(float, w & 0xffff0000u); }

#define XB_TMO      128
#define XB_XCNT(j)  (256  + 64 * (j))
#define XB_XSUB(j)  (1280 + 64 * (j))
#define XB_XGEN(j)  (2304 + 64 * (j))
#define XB_TOP      3328
#define XB_TOPGEN   3392
#define XCD_BAR_WORDS 3456
#define XB_SPIN_CAP (1u << 22)

__device__ __forceinline__ unsigned xb_ld(unsigned* p)              { return __hip_atomic_load(p, __ATOMIC_RELAXED, __HIP_MEMORY_SCOPE_AGENT); }
__device__ __forceinline__ unsigned xb_add(unsigned* p, unsigned v) { return __hip_atomic_fetch_add(p, v, __ATOMIC_RELAXED, __HIP_MEMORY_SCOPE_AGENT); }
__device__ __forceinline__ unsigned xb_xcc_id() { return (unsigned)__builtin_amdgcn_s_getreg((3 << 11) | 20) & 0xFu; }
#define XB_SPIN(cond, bar) do { unsigned _sp = 0; while (cond) { __builtin_amdgcn_s_sleep(1); \
    if ((++_sp & 255u) == 0u) { if (xb_ld(&(bar)[XB_TMO])) break; if (_sp > XB_SPIN_CAP) { atomicAdd(&(bar)[XB_TMO], 1u); break; } } } } while (0)

struct XcdBarrier {
    unsigned* bar; unsigned x;
    volatile LAS unsigned* st;
};

__device__ __forceinline__ XcdBarrier xcd_barrier_post(unsigned* bar, volatile LAS unsigned* st) {
    XcdBarrier b; b.bar = bar; b.x = xb_xcc_id(); b.st = st;
    if (threadIdx.x == 0) (void)xb_add(&bar[XB_XCNT(b.x)], 1u);
    return b;
}
__device__ __forceinline__ void xcd_barrier_complete(unsigned* bar, unsigned x, unsigned& nloc, unsigned& nx) {
    const unsigned G = gridDim.x * gridDim.y * gridDim.z;
    unsigned sum, cnt, mine, sp = 0u;
    for (;;) {
        sum = 0u; cnt = 0u; mine = 0u;
#pragma unroll
        for (unsigned j = 0; j < 16; ++j) { const unsigned c = xb_ld(&bar[XB_XCNT(j)]); sum += c; cnt += (c > 0u) ? 1u : 0u; mine = (j == x) ? c : mine; }
        if (sum == G) break;
        __builtin_amdgcn_s_sleep(1);
        if ((++sp & 255u) == 0u) { if (xb_ld(&bar[XB_TMO])) break; if (sp > XB_SPIN_CAP) { atomicAdd(&bar[XB_TMO], 1u); break; } }
    }
    nloc = mine > 0u ? mine : 1u; nx = cnt > 0u ? cnt : 1u;
}

__device__ __forceinline__ void xcd_barrier(const XcdBarrier& b) {
    asm volatile("s_waitcnt vmcnt(0)" ::: "memory");
    __syncthreads();
    if (threadIdx.x == 0) {
        unsigned* bar = b.bar;
        __builtin_amdgcn_s_waitcnt(0);
        unsigned nloc = b.st[0], nx = b.st[1];
        if (nloc == 0u) { xcd_barrier_complete(bar, b.x, nloc, nx); b.st[0] = nloc; b.st[1] = nx; }
        const unsigned old = xb_add(&bar[XB_XSUB(b.x)], 1u);
        const unsigned gen = old / nloc;
        if (old + 1u == (gen + 1u) * nloc) {
            __builtin_amdgcn_fence(__ATOMIC_RELEASE, "agent");
            asm volatile("s_waitcnt vmcnt(0)" ::: "memory");
            const unsigned og = xb_add(&bar[XB_TOP], 1u);
            const unsigned tg = og / nx;
            if (og + 1u == (tg + 1u) * nx) xb_add(&bar[XB_TOPGEN], 1u);
            else XB_SPIN(xb_ld(&bar[XB_TOPGEN]) == tg, bar);
            __builtin_amdgcn_fence(__ATOMIC_ACQUIRE, "agent");
            xb_add(&bar[XB_XGEN(b.x)], 1u);
            asm volatile("s_waitcnt vmcnt(0)" ::: "memory");
        } else {
            XB_SPIN(xb_ld(&bar[XB_XGEN(b.x)]) == gen, bar);
            __builtin_amdgcn_fence(__ATOMIC_ACQUIRE, "agent");
            asm volatile("s_waitcnt vmcnt(0)" ::: "memory");
        }
    }
    __syncthreads();
}
struct Frame {
    LAS unsigned char* lds;
    int tid, lane, wave, G;
    const float* in[19]; float* out; unsigned char* ws;
};
#define IN_X 0
#define IN_RELB 1
#define IN_NMIX 2
#define IN_EWIN 3
#define IN_CONVW 4
#define IN_CONVB 5
#define IN_GAW 6
#define IN_GAB 7
#define IN_GXW 8
#define IN_GXB 9
#define IN_LAMBDA 10
#define IN_SINKS 11
#define IN_EWOUT 12
#define IN_OWIN 13
#define IN_OWOUT 14
#define IN_NMLP 15
#define IN_WUP 16
#define IN_WDOWN 17
#define IN_FNORM 18

__device__ __forceinline__ float wave_sum(float v) {
#pragma unroll
    for (int o = 1; o < 64; o <<= 1) v += __shfl_xor(v, o);
    return v;
}
struct P0Tile { const float* W; const float* gain; bf16* WT; int K, N, k0, n0; };
__device__ __forceinline__ void p0_tile_load(const P0Tile& t, int lane, f32x4 (&v)[16]) {
    const GAS f32x4* p = (const GAS f32x4*)(t.W + (size_t)(t.k0 + (lane >> 4)) * t.N + t.n0 + 4 * (lane & 15));
#pragma unroll
    for (int i = 0; i < 16; ++i) v[i] = p[(size_t)i * t.N];
}
__device__ __forceinline__ void p0_tile_store(const P0Tile& t, int lane, const f32x4 (&v)[16], LAS float* scr) {
#pragma unroll
    for (int i = 0; i < 16; ++i) { const int kk = (lane >> 4) + 4 * i; *(LAS f32x4*)(scr + kk * 64 + ((4 * (lane & 15)) ^ (4 * ((kk >> 3) & 7)))) = v[i]; }
    LDS_WAIT(); asm volatile("" ::: "memory");
    const int kc = lane & 7;
    float g[8];
    if (t.gain) { const f32x4 a = *(const GAS f32x4*)(t.gain + t.k0 + 8 * kc), b = *(const GAS f32x4*)(t.gain + t.k0 + 8 * kc + 4); g[0] = a[0]; g[1] = a[1]; g[2] = a[2]; g[3] = a[3]; g[4] = b[0]; g[5] = b[1]; g[6] = b[2]; g[7] = b[3]; }
    else {
#pragma unroll
        for (int e = 0; e < 8; ++e) g[e] = 1.0f; }
#pragma unroll
    for (int j = 0; j < 8; ++j) { const int n = (lane >> 3) + 8 * j; const LAS float* s = scr + (8 * kc) * 64 + (n ^ (4 * kc));
        v4u o; o.x = pk2(s[0] * g[0], s[64] * g[1]); o.y = pk2(s[128] * g[2], s[192] * g[3]); o.z = pk2(s[256] * g[4], s[320] * g[5]); o.w = pk2(s[384] * g[6], s[448] * g[7]);
        *(GAS v4u*)(t.WT + (size_t)(t.n0 + n) * t.K + t.k0 + 8 * kc) = o; }
    LDS_WAIT(); asm volatile("" ::: "memory");
}
__device__ __forceinline__ int t5_bucket(int rel) {
    const int ret = rel > 0 ? 16 : 0, n = rel < 0 ? -rel : rel;
    if (n < 8) return ret + n;
    int large = 8 + (31 - __builtin_clz((unsigned)(n * n))) - 6; if (large > 15) large = 15;
    return ret + large;
}
__device__ __forceinline__ void p0_prologue(Frame& F) {
    LAS float* scr = (LAS float*)(F.lds + RING_OFF + F.wave * 16384);
    const int gw = blockIdx.x * NWAVES + F.wave, NGW = F.G * NWAVES;
    unsigned char* ws = F.ws;
    constexpr int T_IN0 = (DM / 64) * (EVEN_IN / 64), T_OUT = (DM / 64) * (DM / 64), T_UP = (DM / 64) * (DFF / 64), T_DN = (DFF / 64) * (DM / 64), T_IN1 = (DM / 64) * (ODD_IN / 64);
    constexpr int NTILES = T_IN0 + T_IN1 + 2 * T_OUT + 2 * T_UP + 2 * T_DN;
#define P0_DESC(it, t) do { int r_ = (it); \
        if (r_ < T_IN0) { t.W = F.in[IN_EWIN]; t.gain = F.in[IN_NMIX]; t.WT = (bf16*)(ws + WS_WIN0); t.K = DM; t.N = EVEN_IN; } else { r_ -= T_IN0; \
        if (r_ < T_OUT) { t.W = F.in[IN_EWOUT]; t.gain = nullptr; t.WT = (bf16*)(ws + WS_WOUT0); t.K = DM; t.N = DM; } else { r_ -= T_OUT; \
        if (r_ < T_UP) { t.W = F.in[IN_WUP]; t.gain = F.in[IN_NMLP]; t.WT = (bf16*)(ws + WS_WUP0); t.K = DM; t.N = DFF; } else { r_ -= T_UP; \
        if (r_ < T_DN) { t.W = F.in[IN_WDOWN]; t.gain = nullptr; t.WT = (bf16*)(ws + WS_WDN0); t.K = DFF; t.N = DM; } else { r_ -= T_DN; \
        if (r_ < T_IN1) { t.W = F.in[IN_OWIN]; t.gain = F.in[IN_NMIX] + DM; t.WT = (bf16*)(ws + WS_WIN1); t.K = DM; t.N = ODD_IN; } else { r_ -= T_IN1; \
        if (r_ < T_OUT) { t.W = F.in[IN_OWOUT]; t.gain = nullptr; t.WT = (bf16*)(ws + WS_WOUT1); t.K = DM; t.N = DM; } else { r_ -= T_OUT; \
        if (r_ < T_UP) { t.W = F.in[IN_WUP] + (size_t)DM * DFF; t.gain = F.in[IN_NMLP] + DM; t.WT = (bf16*)(ws + WS_WUP1); t.K = DM; t.N = DFF; } else { r_ -= T_UP; \
        t.W = F.in[IN_WDOWN] + (size_t)DFF * DM; t.gain = nullptr; t.WT = (bf16*)(ws + WS_WDN1); t.K = DFF; t.N = DM; } } } } } } } \
        const int nb_ = t.N / 64; t.k0 = 64 * (r_ / nb_); t.n0 = 64 * (r_ % nb_); } while (0)
    {
        f32x4 va[16], vb[16]; P0Tile ta, tb;
        int it = gw;
        if (it < NTILES) { P0_DESC(it, ta); p0_tile_load(ta, F.lane, va); }
        while (it < NTILES) {
            const int itn = it + NGW; const bool more = itn < NTILES;
            if (more) { P0_DESC(itn, tb); p0_tile_load(tb, F.lane, vb); }
            p0_tile_store(ta, F.lane, va, scr);
            if (more) { ta = tb;
#pragma unroll
                for (int i = 0; i < 16; ++i) va[i] = vb[i]; }
            it = itn;
        }
    }
#undef P0_DESC
    bf16* XN = (bf16*)(ws + WS_XN); float* SS = (float*)(ws + WS_SS);
    for (int m = gw; m < SEQ; m += NGW) {
        const GAS f32x4* xr = (const GAS f32x4*)(F.in[IN_X] + (size_t)m * DM) + F.lane;
        f32x4 v[8]; float s = 0.f;
#pragma unroll
        for (int j = 0; j < 8; ++j) { v[j] = xr[64 * j]; s += (v[j].x * v[j].x + v[j].y * v[j].y) + (v[j].z * v[j].z + v[j].w * v[j].w); }
        s = wave_sum(s);
        GAS v2u* o8 = (GAS v2u*)(XN + (size_t)m * DM) + F.lane;
#pragma unroll
        for (int j = 0; j < 8; ++j) { v2u w; w.x = pk2(v[j].x, v[j].y); w.y = pk2(v[j].z, v[j].w); o8[64 * j] = w; }
        if (F.lane < 8) SS[(size_t)m * 8 + F.lane] = F.lane == 0 ? s : 0.f;
    }
    float* BT = (float*)(ws + WS_BT);
    for (int i = blockIdx.x * 512 + F.tid; i < 16 * 256; i += F.G * 512) { const int head = i >> 8, rel = (i & 255) - 191; BT[i] = F.in[IN_RELB][t5_bucket(rel) * 16 + head]; }
    bf16* GWT = (bf16*)(ws + WS_GWT);
    for (int i = blockIdx.x * 512 + F.tid; i < 2 * 16 * 64 * 64; i += F.G * 512) { const int gate = i >> 16, hb = (i >> 12) & 15, jo = (i >> 6) & 63, ii = i & 63;
        GWT[i] = (bf16)f2bf(F.in[gate ? IN_GXW : IN_GAW][(size_t)(hb * 64 + ii) * 64 + jo]); }
}

__device__ __forceinline__ void ld8(const bf16* p, float (&o)[8]) { const v4u w = *(const GAS v4u*)p; o[0] = bflo(w.x); o[1] = bfhi(w.x); o[2] = bflo(w.y); o[3] = bfhi(w.y); o[4] = bflo(w.z); o[5] = bfhi(w.z); o[6] = bflo(w.w); o[7] = bfhi(w.w); }
__device__ __forceinline__ void swa_naive(Frame& F) {
    const bf16* PROJ = (const bf16*)(F.ws + WS_PROJ); bf16* Y = (bf16*)(F.ws + WS_Y); const float* BT = (const float*)(F.ws + WS_BT);
    for (int idx = blockIdx.x * 512 + F.tid; idx < SEQ * 16; idx += F.G * 512) {
        const int head = idx >> 13, tok = idx & (SEQ - 1), kvh = head >> 2, c = tok >> 6;
        float q[64], acc[64];
#pragma unroll
        for (int i = 0; i < 8; ++i) { float t[8]; ld8(PROJ + (size_t)tok * EVEN_IN + head * 64 + 8 * i, t);
#pragma unroll
            for (int j = 0; j < 8; ++j) { q[8 * i + j] = t[j] * 0.125f; acc[8 * i + j] = 0.f; } }
        float m = F.in[IN_SINKS][head], l = 1.0f;
        const int k0 = c >= 2 ? (c - 2) * 64 : 0, k1 = (c + 1) * 64;
        const float* bt = BT + head * 256;
        for (int j = k0; j < k1; ++j) {
            const bf16* kp = PROJ + (size_t)j * EVEN_IN + OFF_K + kvh * 64; float s = 0.f;
#pragma unroll
            for (int i = 0; i < 8; ++i) { float t[8]; ld8(kp + 8 * i, t);
#pragma unroll
                for (int e = 0; e < 8; ++e) s += q[8 * i + e] * t[e]; }
            s += bt[j - tok + 191];
            const float mn = fmaxf(m, s), corr = expf(m - mn), p = expf(s - mn);
            l = l * corr + p; m = mn;
            const bf16* vp = PROJ + (size_t)j * EVEN_IN + OFF_V + kvh * 64;
#pragma unroll
            for (int i = 0; i < 8; ++i) { float t[8]; ld8(vp + 8 * i, t);
#pragma unroll
                for (int e = 0; e < 8; ++e) acc[8 * i + e] = acc[8 * i + e] * corr + p * t[e]; }
        }
        const float inv = 1.0f / l;
#pragma unroll
        for (int i = 0; i < 8; ++i) { v4u w; w.x = pk2(acc[8 * i] * inv, acc[8 * i + 1] * inv); w.y = pk2(acc[8 * i + 2] * inv, acc[8 * i + 3] * inv); w.z = pk2(acc[8 * i + 4] * inv, acc[8 * i + 5] * inv); w.w = pk2(acc[8 * i + 6] * inv, acc[8 * i + 7] * inv);
            *(GAS v4u*)(Y + (size_t)tok * DM + head * 64 + 8 * i) = w; }
    }
}
__device__ __forceinline__ float softplusf(float z) { return fmaxf(z, 0.f) + log1pf(expf(-fabsf(z))); }
__device__ __forceinline__ float sigmoidf_(float z) { return 1.0f / (1.0f + expf(-z)); }
__device__ __forceinline__ float gelu_tanh(float x) { const float u = 0.7978845608028654f * (x + 0.044715f * x * x * x); return 0.5f * x * (1.0f + tanhf(u)); }
__device__ __forceinline__ void lru_naive(Frame& F) {
    if (blockIdx.x >= 16 || F.wave != 0) return;
    const bf16* PROJ = (const bf16*)(F.ws + WS_PROJ); bf16* Y = (bf16*)(F.ws + WS_Y);
    const int hb = blockIdx.x, lane = F.lane, c = hb * 64 + lane;
    float Wa[64], Wx[64];
#pragma unroll
    for (int i = 0; i < 64; ++i) { Wa[i] = F.in[IN_GAW][(size_t)(hb * 64 + i) * 64 + lane]; Wx[i] = F.in[IN_GXW][(size_t)(hb * 64 + i) * 64 + lane]; }
    const float ba = F.in[IN_GAB][c], bx = F.in[IN_GXB][c], cb = F.in[IN_CONVB][c];
    const float cw0 = F.in[IN_CONVW][c], cw1 = F.in[IN_CONVW][1024 + c], cw2 = F.in[IN_CONVW][2048 + c], cw3 = F.in[IN_CONVW][3072 + c];
    const float sp8 = 8.0f * softplusf(-F.in[IN_LAMBDA][c]);
    float x1 = 0.f, x2 = 0.f, x3 = 0.f, h = 0.f;
    for (int t0 = 0; t0 < SEQ; t0 += 8) {
        float xb[8], g[8];
#pragma unroll
        for (int u = 0; u < 8; ++u) { xb[u] = bflo((unsigned)PROJ[(size_t)(t0 + u) * EVEN_IN + OFF_X + c]); g[u] = bflo((unsigned)PROJ[(size_t)(t0 + u) * EVEN_IN + OFF_G + c]); }
#pragma unroll
        for (int u = 0; u < 8; ++u) {
            const float xt = xb[u], xc = cb + cw0 * x3 + cw1 * x2 + cw2 * x1 + cw3 * xt; x3 = x2; x2 = x1; x1 = xt;
            float ra = ba, rx = bx; const int xci = __builtin_bit_cast(int, xc);
#pragma unroll
            for (int i = 0; i < 64; ++i) { const float xi = __builtin_bit_cast(float, __builtin_amdgcn_readlane(xci, i)); ra += xi * Wa[i]; rx += xi * Wx[i]; }
            const float r = sigmoidf_(ra), ig = sigmoidf_(rx), log_a = -r * sp8, a = expf(log_a), mult = sqrtf(-expm1f(2.0f * log_a));
            h = a * h + mult * (ig * xc);
            Y[(size_t)(t0 + u) * DM + 1024 + c] = (bf16)f2bf(gelu_tanh(g[u]) * h);
        }
    }
}
__device__ __forceinline__ void sb_naive(Frame& F) {
    const bf16* PROJ = (const bf16*)(F.ws + WS_PROJ); bf16* Y = (bf16*)(F.ws + WS_Y);
    const int gt = blockIdx.x * 512 + F.tid, half = gt & 1;
    for (int pidx = gt >> 1; pidx < SEQ * 16; pidx += (F.G * 512) >> 1) {
        const int head = pidx >> 13, tok = pidx & (SEQ - 1);
        float q[64], acc[64];
#pragma unroll
        for (int i = 0; i < 8; ++i) { float t[8]; ld8(PROJ + (size_t)tok * ODD_IN + head * 128 + half * 64 + 8 * i, t);
#pragma unroll
            for (int j = 0; j < 8; ++j) { q[8 * i + j] = t[j] * 0.08838834764831845f; acc[8 * i + j] = 0.f; } }
        float stick = 0.f;
        for (int j = tok - 1; j >= 0; --j) {
            const bf16* kp = PROJ + (size_t)j * ODD_IN + 2048 + head * 128 + half * 64; float s = 0.f;
#pragma unroll
            for (int i = 0; i < 8; ++i) { float t[8]; ld8(kp + 8 * i, t);
#pragma unroll
                for (int e = 0; e < 8; ++e) s += q[8 * i + e] * t[e]; }
            const float z = s + __shfl_xor(s, 1);
            const float lk = -softplusf(z), w = expf(z + lk + stick);
            const bf16* vp = PROJ + (size_t)j * ODD_IN + 4096 + head * 128 + half * 64;
#pragma unroll
            for (int i = 0; i < 8; ++i) { float t[8]; ld8(vp + 8 * i, t);
#pragma unroll
                for (int e = 0; e < 8; ++e) acc[8 * i + e] += w * t[e]; }
            stick += lk;
            if (stick < -104.0f) break;
        }
#pragma unroll
        for (int i = 0; i < 8; ++i) { v4u w; w.x = pk2(acc[8 * i], acc[8 * i + 1]); w.y = pk2(acc[8 * i + 2], acc[8 * i + 3]); w.z = pk2(acc[8 * i + 4], acc[8 * i + 5]); w.w = pk2(acc[8 * i + 6], acc[8 * i + 7]);
            *(GAS v4u*)(Y + (size_t)tok * DM + head * 128 + half * 64 + 8 * i) = w; }
    }
}
__device__ __forceinline__ void final_norm(Frame& F) {
    const int gw = blockIdx.x * NWAVES + F.wave, NGW = F.G * NWAVES;
    const GAS f32x4* gp = (const GAS f32x4*)F.in[IN_FNORM] + F.lane;
    for (int m = gw; m < SEQ; m += NGW) {
        GAS f32x4* xr = (GAS f32x4*)(F.out + (size_t)m * DM) + F.lane;
        f32x4 v[8]; float s = 0.f;
#pragma unroll
        for (int j = 0; j < 8; ++j) { v[j] = xr[64 * j]; s += (v[j].x * v[j].x + v[j].y * v[j].y) + (v[j].z * v[j].z + v[j].w * v[j].w); }
        const float rstd = 1.0f / sqrtf(wave_sum(s) * (1.0f / DM) + 1e-6f);
#pragma unroll
        for (int j = 0; j < 8; ++j) xr[64 * j] = v[j] * rstd * gp[64 * j];
    }
}
typedef float f32x16 __attribute__((ext_vector_type(16)));
typedef short s16x8 __attribute__((ext_vector_type(8)));
typedef short s16x4 __attribute__((ext_vector_type(4)));
typedef __bf16 bf16x2v __attribute__((ext_vector_type(2)));
#define MFMA32(a, b, c) __builtin_amdgcn_mfma_f32_32x32x16_bf16((a), (b), (c), 0, 0, 0)
__device__ __forceinline__ int crow(int i, int h) { return (i & 3) + 8 * (i >> 2) + 4 * h; }
__device__ __forceinline__ unsigned pkbf(float a, float b) { bf16x2v v; v.x = (__bf16)a; v.y = (__bf16)b; return __builtin_bit_cast(unsigned, v); }
__device__ __forceinline__ s16x8 pack8(const float (&p)[16], int s) {
    v4u w; w.x = pkbf(p[8 * s], p[8 * s + 1]); w.y = pkbf(p[8 * s + 2], p[8 * s + 3]); w.z = pkbf(p[8 * s + 4], p[8 * s + 5]); w.w = pkbf(p[8 * s + 6], p[8 * s + 7]);
    return __builtin_bit_cast(s16x8, w);
}
__device__ __forceinline__ s16x8 tr_frag(const LAS unsigned char* p0, const LAS unsigned char* p1) {
    const s16x4 lo = __builtin_amdgcn_ds_read_tr16_b64_v4i16((LAS s16x4*)p0), hi = __builtin_amdgcn_ds_read_tr16_b64_v4i16((LAS s16x4*)p1);
    return __builtin_shufflevector(lo, hi, 0, 1, 2, 3, 4, 5, 6, 7);
}
__device__ __forceinline__ float ex2(float x) { return __builtin_amdgcn_exp2f(x); }
__device__ __forceinline__ float lg2(float x) { return __builtin_amdgcn_logf(x); }
__device__ __forceinline__ float fast_exp(float x) { return ex2(x * 1.4426950408889634f); }
__device__ __forceinline__ float fast_softplus(float z) { return fmaxf(z, 0.f) + 0.6931471805599453f * lg2(1.0f + ex2(-1.4426950408889634f * fabsf(z))); }
__device__ __forceinline__ float fast_sigmoid(float z) { return __builtin_amdgcn_rcpf(1.0f + ex2(-1.4426950408889634f * z)); }
#define G0(g, tok) (PROJ + ((size_t)(g) * SEQ + (tok)) * 64)
#define G1(g, tok) (PROJ + ((size_t)(g) * SEQ + (tok)) * 128)

__device__ __forceinline__ void lru_local(Frame& F) {
    const bf16* PROJ = (const bf16*)(F.ws + WS_PROJ); float* HL = (float*)(F.ws + WS_HL); float* PA = (float*)(F.ws + WS_PA); const bf16* GWT = (const bf16*)(F.ws + WS_GWT);
    LAS unsigned char* xc16 = F.lds;
    LAS float* xc32 = (LAS float*)(F.lds + 18432);
    LAS float* comp = (LAS float*)(F.lds + 18432 + 34816);
    const int tid = F.tid, lane = F.lane, w = F.wave, ts = w & 3, ch = w >> 2, r = lane & 31, h = lane >> 5;
    for (int u = blockIdx.x; u < 1024; u += F.G) {
        const int hb = u & 15, k = u >> 4, t0 = k * 128;
        {
            const int tt = tid >> 2, cg = tid & 3, cbase = hb * 64 + cg * 16, t = t0 + tt;
            float xc[16];
            { const GAS f32x4* cbp = (const GAS f32x4*)(F.in[IN_CONVB] + cbase);
#pragma unroll
              for (int q4 = 0; q4 < 4; ++q4) { const f32x4 b = cbp[q4]; xc[4 * q4] = b[0]; xc[4 * q4 + 1] = b[1]; xc[4 * q4 + 2] = b[2]; xc[4 * q4 + 3] = b[3]; } }
#pragma unroll
            for (int d = 0; d < 4; ++d) { const int row = t - 3 + d;
                float xv[16];
                if (row >= 0) { float a8[8], b8[8]; ld8(G0(24 + hb, row) + cg * 16, a8); ld8(G0(24 + hb, row) + cg * 16 + 8, b8);
#pragma unroll
                    for (int e = 0; e < 8; ++e) { xv[e] = a8[e]; xv[8 + e] = b8[e]; } }
                else {
#pragma unroll
                    for (int e = 0; e < 16; ++e) xv[e] = 0.f; }
                const GAS f32x4* cwp = (const GAS f32x4*)(F.in[IN_CONVW] + d * 1024 + cbase);
#pragma unroll
                for (int q4 = 0; q4 < 4; ++q4) { const f32x4 cw = cwp[q4];
#pragma unroll
                    for (int e = 0; e < 4; ++e) xc[4 * q4 + e] += cw[e] * xv[4 * q4 + e]; } }
#pragma unroll
            for (int q4 = 0; q4 < 4; ++q4) *(LAS f32x4*)(xc32 + tt * 68 + cg * 16 + 4 * q4) = (f32x4){xc[4 * q4], xc[4 * q4 + 1], xc[4 * q4 + 2], xc[4 * q4 + 3]};
#pragma unroll
            for (int q8 = 0; q8 < 2; ++q8) { v4u o; o.x = pkbf(xc[8 * q8], xc[8 * q8 + 1]); o.y = pkbf(xc[8 * q8 + 2], xc[8 * q8 + 3]); o.z = pkbf(xc[8 * q8 + 4], xc[8 * q8 + 5]); o.w = pkbf(xc[8 * q8 + 6], xc[8 * q8 + 7]);
                *(LAS v4u*)(xc16 + tt * 144 + cg * 32 + q8 * 16) = o; }
        }
        __syncthreads();
        f32x16 acc_a, acc_x;
#pragma unroll
        for (int i = 0; i < 16; ++i) { acc_a[i] = 0.f; acc_x[i] = 0.f; }
#pragma unroll
        for (int s = 0; s < 4; ++s) {
            const s16x8 af = *(const LAS s16x8*)(xc16 + (ts * 32 + r) * 144 + (16 * s + 8 * h) * 2);
            const s16x8 ba = *(const GAS s16x8*)(GWT + (size_t)((0 * 16 + hb) * 64 + ch * 32 + r) * 64 + 16 * s + 8 * h);
            const s16x8 bx = *(const GAS s16x8*)(GWT + (size_t)((1 * 16 + hb) * 64 + ch * 32 + r) * 64 + 16 * s + 8 * h);
            acc_a = MFMA32(af, ba, acc_a); acc_x = MFMA32(af, bx, acc_x);
        }
        const int c = hb * 64 + ch * 32 + r;
        const float gab = F.in[IN_GAB][c], gxb = F.in[IN_GXB][c], sp8 = 8.0f * softplusf(-F.in[IN_LAMBDA][c]);
        float pa[16], hl[16], gA[4], gU[4];
#pragma unroll
        for (int g = 0; g < 4; ++g) { float A = 1.f, U = 0.f;
#pragma unroll
            for (int e = 0; e < 4; ++e) { const int i = 4 * g + e; const float xcv = xc32[(ts * 32 + crow(i, h)) * 68 + ch * 32 + r];
                const float rg = fast_sigmoid(acc_a[i] + gab), ig = fast_sigmoid(acc_x[i] + gxb), log_a = -rg * sp8, a = fast_exp(log_a), mult = sqrtf(-expm1f(2.0f * log_a));
                U = a * U + mult * (ig * xcv); A *= a; pa[i] = A; hl[i] = U; }
            gA[g] = A; gU[g] = U; }
        float PAc = 1.f, Hc = 0.f;
#pragma unroll
        for (int g = 0; g < 4; ++g) { const float oA = __shfl_xor(gA[g], 32), oU = __shfl_xor(gU[g], 32);
            const float fA = h ? oA : gA[g], fU = h ? oU : gU[g], sA = h ? gA[g] : oA, sU = h ? gU[g] : oU;
            const float c0P = PAc, c0H = Hc; Hc = fA * Hc + fU; PAc *= fA; const float c1P = PAc, c1H = Hc; Hc = sA * Hc + sU; PAc *= sA;
            const float ciP = h ? c1P : c0P, ciH = h ? c1H : c0H;
#pragma unroll
            for (int e = 0; e < 4; ++e) { const int i = 4 * g + e; hl[i] += pa[i] * ciH; pa[i] *= ciP; } }
        if (h == 0) { comp[(ts * 64 + ch * 32 + r) * 2] = PAc; comp[(ts * 64 + ch * 32 + r) * 2 + 1] = Hc; }
        __syncthreads();
        float PAin = 1.f, Hin = 0.f;
        for (int t2 = 0; t2 < ts; ++t2) { const float A2 = comp[(t2 * 64 + ch * 32 + r) * 2], U2 = comp[(t2 * 64 + ch * 32 + r) * 2 + 1]; Hin = A2 * Hin + U2; PAin *= A2; }
#pragma unroll
        for (int i = 0; i < 16; ++i) { const size_t o = ((size_t)hb * SEQ + t0 + ts * 32 + crow(i, h)) * 64 + ch * 32 + r; HL[o] = hl[i] + pa[i] * Hin; PA[o] = pa[i] * PAin; }
        __syncthreads();
    }
}
__device__ __forceinline__ void lru_fix(Frame& F) {
    const bf16* PROJ = (const bf16*)(F.ws + WS_PROJ); const float* HL = (const float*)(F.ws + WS_HL); const float* PA = (const float*)(F.ws + WS_PA); bf16* Y = (bf16*)(F.ws + WS_Y);
    const int gw = blockIdx.x * NWAVES + F.wave, NGW = F.G * NWAVES;
    for (int it = gw; it < 2048; it += NGW) {
        const int cgp = it & 15, sub = (it >> 4) & 1, k = it >> 5, c = cgp * 64 + F.lane;
        float H = 0.f;
        for (int kb = 0; kb < k; kb += 16) {
            float a[16], u[16];
#pragma unroll
            for (int j = 0; j < 16; ++j) { const int kk = (kb + j < k) ? kb + j : 0; const size_t row = ((size_t)cgp * SEQ + kk * 128 + 127) * 64 + F.lane; a[j] = PA[row]; u[j] = HL[row]; }
#pragma unroll
            for (int j = 0; j < 16; ++j) { const bool on = kb + j < k; H = on ? a[j] * H + u[j] : H; }
        }
#pragma unroll
        for (int tb = 0; tb < 64; tb += 32) {
            float hv[32], pv[32], gv[32];
#pragma unroll
            for (int tt = 0; tt < 32; ++tt) { const int t = k * 128 + sub * 64 + tb + tt; const size_t o = ((size_t)cgp * SEQ + t) * 64 + F.lane; hv[tt] = HL[o]; pv[tt] = PA[o]; gv[tt] = bflo((unsigned)G0(40 + cgp, t)[F.lane]); }
#pragma unroll
            for (int tt = 0; tt < 32; ++tt) { const int t = k * 128 + sub * 64 + tb + tt; const float g = gv[tt], u2 = 1.5957691216057308f * (g + 0.044715f * g * g * g), ge = g * fast_sigmoid(u2);
                Y[(size_t)t * DM + 1024 + c] = (bf16)f2bf(ge * (hv[tt] + pv[tt] * H)); }
        }
    }
}
__device__ __forceinline__ void sb_attn(Frame& F) {
    const bf16* PROJ = (const bf16*)(F.ws + WS_PROJ); bf16* Y = (bf16*)(F.ws + WS_Y);
    LAS unsigned char* vt = F.lds + F.wave * 16384;
    const int lane = F.lane, r = lane & 31, h = lane >> 5;
    const int gw = blockIdx.x * NWAVES + F.wave, NGW = F.G * NWAVES;
    const int troff = (4 * h + ((lane & 15) >> 2)) * 256 + (16 * ((lane >> 4) & 1) + 4 * (lane & 3)) * 2;
    for (int it = gw; it < 4096; it += NGW) {
        const int head = (it >> 3) & 15, qb = ((it >> 7) << 3) + (it & 7), q0 = qb * 32;
        s16x8 qf[8];
#pragma unroll
        for (int s = 0; s < 8; ++s) qf[s] = *(const GAS s16x8*)(G1(head, q0 + r) + 16 * s + 8 * h);
        f32x16 o[4];
#pragma unroll
        for (int db = 0; db < 4; ++db)
#pragma unroll
            for (int i = 0; i < 16; ++i) o[db][i] = 0.f;
        float carry = 0.f;
        s16x8 kf[8];
#pragma unroll
        for (int s = 0; s < 8; ++s) kf[s] = *(const GAS s16x8*)(G1(16 + head, q0 + r) + 16 * s + 8 * h);
        {   v4u v0[8];
#pragma unroll
            for (int i = 0; i < 8; ++i) v0[i] = *(const GAS v4u*)(G1(32 + head, q0) + (lane + 64 * i) * 8);
#pragma unroll
            for (int i = 0; i < 8; ++i) *(LAS v4u*)(vt + (lane + 64 * i) * 16) = v0[i];
            LDS_WAIT(); }
        int cur = 0;
        for (int kt = qb; kt >= 0; --kt) {
            const int kbn = (kt > 0 ? kt - 1 : 0) * 32;
            f32x16 sacc;
#pragma unroll
            for (int i = 0; i < 16; ++i) sacc[i] = 0.f;
#pragma unroll
            for (int s = 0; s < 8; ++s) sacc = MFMA32(kf[s], qf[s], sacc);
#pragma unroll
            for (int s = 0; s < 8; ++s) kf[s] = *(const GAS s16x8*)(G1(16 + head, kbn + r) + 16 * s + 8 * h);
            v4u vreg[8];
#pragma unroll
            for (int i = 0; i < 8; ++i) vreg[i] = *(const GAS v4u*)(G1(32 + head, kbn) + (lane + 64 * i) * 8);
            __builtin_amdgcn_sched_barrier(0);
            const bool diag = (kt == qb);
            float z[16], lk[16], G[4];
#pragma unroll
            for (int g = 0; g < 4; ++g) { float gs = 0.f;
#pragma unroll
                for (int e = 0; e < 4; ++e) { const int i = 4 * g + e; z[i] = sacc[i] * 0.08838834764831845f; const bool valid = !diag || (crow(i, h) < r);
                    const float sp = fast_softplus(z[i]); lk[i] = valid ? -sp : 0.f; z[i] = valid ? z[i] : -1e30f; gs += lk[i]; }
                G[g] = gs; }
            float run = carry, pw[16];
#pragma unroll
            for (int g = 3; g >= 0; --g) { const float og = __shfl_xor(G[g], 32);
                const float s1 = run; run += h ? G[g] : og;
                const float s0 = run; run += h ? og : G[g];
                float ex = h ? s1 : s0;
#pragma unroll
                for (int e = 3; e >= 0; --e) { const int i = 4 * g + e; pw[i] = fast_exp(z[i] + lk[i] + ex); ex += lk[i]; } }
            carry = run;
            const s16x8 p0 = pack8(pw, 0), p1 = pack8(pw, 1);
            const LAS unsigned char* trb = vt + cur * 8192 + troff;
#pragma unroll
            for (int db = 0; db < 4; ++db) {
                const s16x8 v0 = tr_frag(trb + db * 64, trb + 8 * 256 + db * 64);
                const s16x8 v1 = tr_frag(trb + 16 * 256 + db * 64, trb + 24 * 256 + db * 64);
                o[db] = MFMA32(v0, p0, o[db]); o[db] = MFMA32(v1, p1, o[db]); }
            cur ^= 1;
#pragma unroll
            for (int i = 0; i < 8; ++i) *(LAS v4u*)(vt + cur * 8192 + (lane + 64 * i) * 16) = vreg[i];
            LDS_WAIT();
            if (__all(carry < -104.0f)) break;
        }
#pragma unroll
        for (int db = 0; db < 4; ++db)
#pragma unroll
            for (int g = 0; g < 4; ++g) { v2u w; w.x = pkbf(o[db][4 * g], o[db][4 * g + 1]); w.y = pkbf(o[db][4 * g + 2], o[db][4 * g + 3]);
                *(GAS v2u*)(Y + (size_t)(q0 + r) * DM + head * 128 + db * 32 + 8 * g + 4 * h) = w; }
    }
}
__device__ __forceinline__ void swa_attn(Frame& F) {
    const bf16* PROJ = (const bf16*)(F.ws + WS_PROJ); bf16* Y = (bf16*)(F.ws + WS_Y); const float* BT = (const float*)(F.ws + WS_BT);
    LAS unsigned char* KL = F.lds + 57344;
    LAS unsigned char* VL = KL + 27648;
    LAS float* btl = (LAS float*)(VL + 36864);
    const int tid = F.tid, lane = F.lane, w = F.wave, r = lane & 31, h = lane >> 5;
    const int kvh = blockIdx.x & 3;
    btl[tid] = BT[kvh * 1024 + tid]; btl[tid + 512] = BT[kvh * 1024 + 512 + tid];
    const int head = kvh * 4 + (w & 3);
    const float sink = F.in[IN_SINKS][head];
    const LAS float* bth = btl + (w & 3) * 256;
    const LAS unsigned char* trb = VL + (4 * h + ((lane & 15) >> 2)) * 192 + (16 * ((lane >> 4) & 1) + 4 * (lane & 3)) * 2;
    v4u kreg[3], vreg[3];
    const int nun = (512 - (int)blockIdx.x + F.G - 1) / F.G;
    {   const int c = blockIdx.x >> 2, kbase = (c - 2) * 64;
#pragma unroll
        for (int i = 0; i < 3; ++i) { const int j = tid + 512 * i; int row = kbase + (j >> 3); row = row < 0 ? 0 : row;
            kreg[i] = *(const GAS v4u*)(G0(16 + kvh, row) + (j & 7) * 8); vreg[i] = *(const GAS v4u*)(G0(20 + kvh, row) + (j & 7) * 8); } }
    for (int ui = 0; ui < nun; ++ui) {
        const int wu = blockIdx.x + ui * F.G, c = wu >> 2, q0 = c * 64 + (w >> 2) * 32, kbase = (c - 2) * 64, kt0 = c >= 2 ? 0 : (2 - c) * 2;
#pragma unroll
        for (int i = 0; i < 3; ++i) { const int j = tid + 512 * i; *(LAS v4u*)(KL + (j >> 3) * 144 + (j & 7) * 16) = kreg[i]; *(LAS v4u*)(VL + (j >> 3) * 192 + (j & 7) * 16) = vreg[i]; }
        __syncthreads();
        if (ui + 1 < nun) { const int c2 = (wu + F.G) >> 2, kb2 = (c2 - 2) * 64;
#pragma unroll
            for (int i = 0; i < 3; ++i) { const int j = tid + 512 * i; int row = kb2 + (j >> 3); row = row < 0 ? 0 : row;
                kreg[i] = *(const GAS v4u*)(G0(16 + kvh, row) + (j & 7) * 8); vreg[i] = *(const GAS v4u*)(G0(20 + kvh, row) + (j & 7) * 8); } }
        s16x8 qf[4];
#pragma unroll
        for (int s = 0; s < 4; ++s) qf[s] = *(const GAS s16x8*)(G0(head, q0 + r) + 16 * s + 8 * h);
        __builtin_amdgcn_sched_barrier(0);
        float sc[6][16]; float m = sink;
#pragma unroll
        for (int kt = 0; kt < 6; ++kt) {
            f32x16 sacc;
#pragma unroll
            for (int i = 0; i < 16; ++i) sacc[i] = 0.f;
#pragma unroll
            for (int s = 0; s < 4; ++s) { const s16x8 kf = *(const LAS s16x8*)(KL + (kt * 32 + r) * 144 + (16 * s + 8 * h) * 2); sacc = MFMA32(kf, qf[s], sacc); }
            const bool on = kt >= kt0;
#pragma unroll
            for (int i = 0; i < 16; ++i) { const float v = sacc[i] * 0.125f + bth[kt * 32 + crow(i, h) - 128 - (w >> 2) * 32 - r + 191]; sc[kt][i] = on ? v : -1e30f; m = fmaxf(m, sc[kt][i]); }
        }
        m = fmaxf(m, __shfl_xor(m, 32));
        float l = 0.f;
#pragma unroll
        for (int kt = 0; kt < 6; ++kt)
#pragma unroll
            for (int i = 0; i < 16; ++i) { const float p = fast_exp(sc[kt][i] - m); sc[kt][i] = p; l += p; }
        l += __shfl_xor(l, 32); l += fast_exp(sink - m);
        f32x16 o[2];
#pragma unroll
        for (int db = 0; db < 2; ++db)
#pragma unroll
            for (int i = 0; i < 16; ++i) o[db][i] = 0.f;
#pragma unroll
        for (int kt = 0; kt < 6; ++kt) {
            const s16x8 p0 = pack8(sc[kt], 0), p1 = pack8(sc[kt], 1);
#pragma unroll
            for (int db = 0; db < 2; ++db) {
                const LAS unsigned char* tb = trb + kt * 32 * 192 + db * 64;
                const s16x8 v0 = tr_frag(tb, tb + 8 * 192);
                const s16x8 v1 = tr_frag(tb + 16 * 192, tb + 24 * 192);
                o[db] = MFMA32(v0, p0, o[db]); o[db] = MFMA32(v1, p1, o[db]); }
        }
        const float inv = 1.0f / l;
#pragma unroll
        for (int db = 0; db < 2; ++db)
#pragma unroll
            for (int g = 0; g < 4; ++g) { v2u wv; wv.x = pkbf(o[db][4 * g] * inv, o[db][4 * g + 1] * inv); wv.y = pkbf(o[db][4 * g + 2] * inv, o[db][4 * g + 3] * inv);
                *(GAS v2u*)(Y + (size_t)(q0 + r) * DM + head * 64 + db * 32 + 8 * g + 4 * h) = wv; }
        __syncthreads();
    }
}

#ifndef REP_P0
#define REP_P0 1
#endif
#define REP_LRU 1
#define REP_SWA 1
#define REP_FIX 1
#define REP_SB 1
struct Args { const float* in[19]; float* out; unsigned char* ws; int ph_lo, ph_hi; };
__global__ void __launch_bounds__(NWAVES * 64, 2) hybrid_fwd(Args args) {
    extern __shared__ __attribute__((aligned(16))) unsigned char lds[];
    Frame F;
    F.lds = (LAS unsigned char*)lds;
    F.tid = threadIdx.x; F.lane = F.tid & 63; F.wave = __builtin_amdgcn_readfirstlane(F.tid >> 6);
    F.G = gridDim.x;
#pragma unroll
    for (int i = 0; i < 19; ++i) F.in[i] = args.in[i];
    F.out = args.out; F.ws = args.ws;
    unsigned char* ws = args.ws;
    for (int u = F.tid; u < (LDS_BYTES - LDSCTL_OFF) / 4; u += NWAVES * 64) ((LAS unsigned*)(F.lds + LDSCTL_OFF))[u] = 0u;
    __syncthreads();
    const int lo = args.ph_lo, hi = args.ph_hi;
    XcdBarrier bar; bar.bar = (unsigned*)(ws + WS_CTL) + CW_BAR; bar.x = 0; bar.st = nullptr;
    if (hi - lo > 1) bar = xcd_barrier_post((unsigned*)(ws + WS_CTL) + CW_BAR, (volatile LAS unsigned*)(F.lds + MISC_OFF) + 8);
#define IN(k) (lo <= (k) && (k) < hi)
#define SEAM(k) do { if (IN(k) && IN((k) + 1)) xcd_barrier(bar); } while (0)
    bf16* XN = (bf16*)(ws + WS_XN); bf16* Yb = (bf16*)(ws + WS_Y); bf16* PROJ = (bf16*)(ws + WS_PROJ); bf16* ACT = (bf16*)(ws + WS_ACT); float* SS = (float*)(ws + WS_SS);

    if (IN(0)) { for (int rep = 0; rep < REP_P0; ++rep) { p0_prologue(F); if (rep + 1 < REP_P0) xcd_barrier(bar); } } SEAM(0);
    if (IN(1)) { pg8::Gemm g{XN, (const bf16*)(ws + WS_WIN0), SEQ, EVEN_IN, DM}; pg8::StaticOrder S; S.init(SEQ, EVEN_IN, F.G, (int)blockIdx.x);
        pg8::EpiBf16<0> E{PROJ, EVEN_IN, SS, 64, SEQ}; pg8::gemm_phase<pg8::EpiBf16<0>, pg8::StaticOrder, true, true>(F.lds + RING_OFF, g, S, E); } SEAM(1);
    if (IN(2)) { for (int rep = 0; rep < REP_LRU; ++rep) { lru_local(F); if (rep + 1 < REP_LRU) xcd_barrier(bar); } for (int rep = 0; rep < REP_SWA; ++rep) { swa_attn(F); if (rep + 1 < REP_SWA) xcd_barrier(bar); } } SEAM(2);
    if (IN(3)) { for (int rep = 0; rep < REP_FIX; ++rep) { lru_fix(F); if (rep + 1 < REP_FIX) xcd_barrier(bar); } } SEAM(3);
    if (IN(4)) { pg8::Gemm g{Yb, (const bf16*)(ws + WS_WOUT0), SEQ, DM, DM}; pg8::StaticOrder S; S.init(SEQ, DM, F.G, (int)blockIdx.x);
        pg8::EpiRes E{F.in[IN_X], F.out, XN, SS, DM}; pg8::gemm_phase<pg8::EpiRes, pg8::StaticOrder, false, true>(F.lds + RING_OFF, g, S, E); } SEAM(4);
    if (IN(5)) { pg8::Gemm g{XN, (const bf16*)(ws + WS_WUP0), SEQ, DFF, DM}; pg8::StaticOrder S; S.init(SEQ, DFF, F.G, (int)blockIdx.x);
        pg8::EpiBf16<1> E{ACT, DFF, SS, 0, 0}; pg8::gemm_phase<pg8::EpiBf16<1>, pg8::StaticOrder, true, true>(F.lds + RING_OFF, g, S, E); } SEAM(5);
    if (IN(6)) { pg8::Gemm g{ACT, (const bf16*)(ws + WS_WDN0), SEQ, DM, DFF}; pg8::StaticOrder S; S.init(SEQ, DM, F.G, (int)blockIdx.x);
        pg8::EpiRes E{F.out, F.out, XN, SS, DM}; pg8::gemm_phase<pg8::EpiRes, pg8::StaticOrder, false, true>(F.lds + RING_OFF, g, S, E); } SEAM(6);
    if (IN(7)) { pg8::Gemm g{XN, (const bf16*)(ws + WS_WIN1), SEQ, ODD_IN, DM}; pg8::StaticOrder S; S.init(SEQ, ODD_IN, F.G, (int)blockIdx.x);
        pg8::EpiBf16<0> E{PROJ, ODD_IN, SS, 128, SEQ}; pg8::gemm_phase<pg8::EpiBf16<0>, pg8::StaticOrder, true, true>(F.lds + RING_OFF, g, S, E); } SEAM(7);
    if (IN(8)) { for (int rep = 0; rep < REP_SB; ++rep) { sb_attn(F); if (rep + 1 < REP_SB) xcd_barrier(bar); } } SEAM(8);
    if (IN(9)) { pg8::Gemm g{Yb, (const bf16*)(ws + WS_WOUT1), SEQ, DM, DM}; pg8::StaticOrder S; S.init(SEQ, DM, F.G, (int)blockIdx.x);
        pg8::EpiRes E{F.out, F.out, XN, SS, DM}; pg8::gemm_phase<pg8::EpiRes, pg8::StaticOrder, false, true>(F.lds + RING_OFF, g, S, E); } SEAM(9);
    if (IN(10)) { pg8::Gemm g{XN, (const bf16*)(ws + WS_WUP1), SEQ, DFF, DM}; pg8::StaticOrder S; S.init(SEQ, DFF, F.G, (int)blockIdx.x);
        pg8::EpiBf16<1> E{ACT, DFF, SS, 0, 0}; pg8::gemm_phase<pg8::EpiBf16<1>, pg8::StaticOrder, true, true>(F.lds + RING_OFF, g, S, E); } SEAM(10);
    if (IN(11)) { pg8::Gemm g{ACT, (const bf16*)(ws + WS_WDN1), SEQ, DM, DFF}; pg8::StaticOrder S; S.init(SEQ, DM, F.G, (int)blockIdx.x);
        pg8::EpiRes E{F.out, F.out, XN, SS, DM}; pg8::gemm_phase<pg8::EpiRes, pg8::StaticOrder, false, true>(F.lds + RING_OFF, g, S, E); } SEAM(11);
    if (IN(12)) { final_norm(F); }
#undef IN
#undef SEAM
}

extern "C" void kernel_launch(void* const* d_in, const int* in_sizes, int n_in, void* d_out, int out_size, void* d_ws, size_t ws_size, hipStream_t stream) {
    static int grid = 0;
    if (grid == 0) {
        if (n_in != 19 || in_sizes[0] != SEQ * DM || out_size != SEQ * DM || ws_size < WS_END) { fprintf(stderr, "kernel_launch: unexpected shapes (n_in %d, in0 %d, out %d, ws %zu); nothing launched\n", n_in, n_in > 0 ? in_sizes[0] : -1, out_size, ws_size); grid = -1; return; }
        int dev = 0, cus = 0, per_cu = 0;
        if (hipGetDevice(&dev) != hipSuccess || hipDeviceGetAttribute(&cus, hipDeviceAttributeMultiprocessorCount, dev) != hipSuccess) { fprintf(stderr, "kernel_launch: device query failed\n"); grid = -1; return; }
        if (hipFuncSetAttribute((const void*)hybrid_fwd, hipFuncAttributeMaxDynamicSharedMemorySize, LDS_BYTES) != hipSuccess) { fprintf(stderr, "kernel_launch: hipFuncSetAttribute failed\n"); grid = -1; return; }
        if (hipOccupancyMaxActiveBlocksPerMultiprocessor(&per_cu, (const void*)hybrid_fwd, NWAVES * 64, LDS_BYTES) != hipSuccess || per_cu < 1) { fprintf(stderr, "kernel_launch: occupancy query reports %d workgroups per CU\n", per_cu); per_cu = 1; }
        (void)hipGetLastError();
        grid = cus;
        if (grid != 256) fprintf(stderr, "kernel_launch: %d CUs; the residual GEMM phases need exactly 256 workgroups\n", grid);
    }
    if (grid < 0) return;
    (void)hipMemsetAsync((char*)d_ws + WS_CTL, 0, CTL_ZERO_BYTES, stream);
    Args a{};
    for (int i = 0; i < 19; ++i) a.in[i] = (const float*)d_in[i];
    a.out = (float*)d_out; a.ws = (unsigned char*)d_ws;
#if MK_N_LAUNCHES == 1
    a.ph_lo = 0; a.ph_hi = N_PHASES;
    hipLaunchKernelGGL(hybrid_fwd, dim3(grid), dim3(NWAVES * 64), LDS_BYTES, stream, a);
#else
    for (int p = 0; p < N_PHASES; ++p) { a.ph_lo = p; a.ph_hi = p + 1; hipLaunchKernelGGL(hybrid_fwd, dim3(grid), dim3(NWAVES * 64), LDS_BYTES, stream, a); }
#endif
}
```

```cpp
#include <hip/hip_runtime.h>
#include <cstdio>
#include <cstdint>
namespace pg8 {
#define PG8_LAS __attribute__((address_space(3)))
typedef unsigned short bf16_t;
typedef short bf16x8 __attribute__((ext_vector_type(8)));
typedef float f32x4 __attribute__((ext_vector_type(4)));
typedef unsigned u32x4 __attribute__((ext_vector_type(4)));
constexpr int BM = 256, BK = 64, HALF = 128, HTB = HALF * BK * 2  , STAGE_BYTES = 8 * HTB, NXCD = 8, WGM = 8;

__host__ __device__ __forceinline__ int lds_byte(int r, int c) { const int st = (r >> 4) * 2 + (c >> 5), rr = r & 15, cc = c & 31, ob = rr * 64 + cc * 2; return st * 1024 + (ob ^ (((ob >> 9) & 1) << 5)); }
__host__ __device__ __forceinline__ void stage_rc(int b, int& R, int& C) { const int st = b / 1024, sb = b % 1024, swz = sb ^ (((sb >> 9) & 1) << 5); R = (st >> 1) * 16 + swz / 64; C = (st & 1) * 32 + (swz % 64) / 2; }
__host__ __device__ __forceinline__ int perm32(int rho) { const int n = rho >> 4, i = rho & 15; return 8 * (i >> 2) + 4 * n + (i & 3); }

struct Unit { int pm, pn; };
struct Gemm { const bf16_t* A; const bf16_t* Bt; int M, N, K; };

struct StaticOrder {
    int nM, nN, nwg, G, c;
    __host__ __device__ void init(int M, int N, int G_, int c_) { nM = M / BM; nN = N / BM; nwg = nM * nN; G = G_; c = c_; }
    __host__ __device__ bool next(int i, Unit& u) const {
        const long L = (long)i * G + c; if (L >= nwg) return false;
        int wgid = (int)L; { const int q = nwg / NXCD, r = nwg % NXCD, xcd = wgid % NXCD, off = wgid / NXCD; wgid = (xcd < r ? xcd * (q + 1) : r * (q + 1) + (xcd - r) * q) + off; }
        const int nig = WGM * nN, gid = wgid / nig, fm = gid * WGM, gsz = (nM - fm) < WGM ? (nM - fm) : WGM;
        u.pm = fm + ((wgid % nig) % gsz); u.pn = (wgid % nig) / gsz; return true;
    }
    __device__ __forceinline__ void a_ready(const Unit&) const {}
    __device__ __forceinline__ void done(const Unit&) const {}
};

__device__ __forceinline__ unsigned cvt_pk_bf16(float lo, float hi) { unsigned r; asm volatile("v_cvt_pk_bf16_f32 %0, %1, %2" : "=v"(r) : "v"(lo), "v"(hi)); return r; }
constexpr float RMS_EPS = 1e-6f;
__device__ __forceinline__ float row_rstd(const float* ss, int r) {
    const f32x4 a = *(const f32x4*)(ss + (size_t)r * 8), b = *(const f32x4*)(ss + (size_t)r * 8 + 4);
    const float s = ((a[0] + a[1]) + (a[2] + a[3])) + ((b[0] + b[1]) + (b[2] + b[3]));
    return 1.0f / sqrtf(s * (1.0f / 2048.0f) + RMS_EPS);
}
template <int ACT> struct EpiBf16 {
    static constexpr bool PERM = true, AFTER_DRAIN = false;
    bf16_t* O; int ldc; const float* ss; int grp_w, nrows;
    __device__ __forceinline__ void operator()(const f32x4 (&acc)[2][2][4][2], const Unit& u, int wr, int wc, int fr, int fq) const {
        const int row0 = u.pm * BM + wr * 64 + fr, col0 = u.pn * BM + wc * 32 + 8 * fq;
#pragma unroll
        for (int ai = 0; ai < 2; ++ai)
#pragma unroll
            for (int m = 0; m < 4; ++m) { const int r = row0 + ai * HALF + m * 16; const float rs = ss ? row_rstd(ss, r) : 1.0f;
                bf16_t* rowp = grp_w ? O + ((size_t)(col0 / grp_w) * nrows + r) * grp_w + (col0 % grp_w) : O + (size_t)r * ldc + col0;
                const size_t bjstep = grp_w ? (size_t)(HALF / grp_w) * nrows * grp_w : (size_t)HALF;
#pragma unroll
                for (int bj = 0; bj < 2; ++bj) { f32x4 v0 = acc[ai][bj][m][0] * rs, v1 = acc[ai][bj][m][1] * rs;
                    if (ACT == 1) {
#pragma unroll
                        for (int j = 0; j < 4; ++j) { const float a = fmaxf(v0[j], 0.f), b = fmaxf(v1[j], 0.f); v0[j] = a * a; v1[j] = b * b; } }
                    u32x4 w; w.x = cvt_pk_bf16(v0[0], v0[1]); w.y = cvt_pk_bf16(v0[2], v0[3]); w.z = cvt_pk_bf16(v1[0], v1[1]); w.w = cvt_pk_bf16(v1[2], v1[3]);
                    *(u32x4*)(rowp + bj * bjstep) = w; } }
    }
};
template <bool BASE_F32> struct EpiRes {
    static constexpr bool PERM = true, AFTER_DRAIN = true;
    const float* base; bf16_t* xn; float* ss; int ldc;
    __device__ __forceinline__ void operator()(const f32x4 (&)[2][2][4][2], const Unit&, int, int, int, int) const {}
    __device__ __forceinline__ void fused(f32x4 (&acc)[2][2][4][2], const Unit& u, int wr, int wc, int fr, int fq, PG8_LAS unsigned char* lds, int wid, int lane) const {
        PG8_LAS float* P = (PG8_LAS float*)lds;
#pragma unroll
        for (int ai = 0; ai < 2; ++ai)
#pragma unroll
            for (int m = 0; m < 4; ++m) { const int rl = ai * HALF + wr * 64 + m * 16 + fr; const size_t off = (size_t)(u.pm * BM + rl) * ldc + u.pn * BM + wc * 32 + 8 * fq; float s = 0.f;
#pragma unroll
                for (int bj = 0; bj < 2; ++bj) { f32x4 b0, b1;
                    if (BASE_F32) { b0 = *(const f32x4*)(base + off + bj * HALF); b1 = *(const f32x4*)(base + off + bj * HALF + 4); }
                    else { const u32x4 q = *(const u32x4*)(xn + off + bj * HALF);
                        b0 = (f32x4){__builtin_bit_cast(float, q.x << 16), __builtin_bit_cast(float, q.x & 0xffff0000u), __builtin_bit_cast(float, q.y << 16), __builtin_bit_cast(float, q.y & 0xffff0000u)};
                        b1 = (f32x4){__builtin_bit_cast(float, q.z << 16), __builtin_bit_cast(float, q.z & 0xffff0000u), __builtin_bit_cast(float, q.w << 16), __builtin_bit_cast(float, q.w & 0xffff0000u)}; }
                    const f32x4 v0 = acc[ai][bj][m][0] + b0, v1 = acc[ai][bj][m][1] + b1;
                    u32x4 w; w.x = cvt_pk_bf16(v0[0], v0[1]); w.y = cvt_pk_bf16(v0[2], v0[3]); w.z = cvt_pk_bf16(v1[0], v1[1]); w.w = cvt_pk_bf16(v1[2], v1[3]);
                    *(u32x4*)(xn + off + bj * HALF) = w;
                    s += ((v0[0] * v0[0] + v0[1] * v0[1]) + (v0[2] * v0[2] + v0[3] * v0[3])) + ((v1[0] * v1[0] + v1[1] * v1[1]) + (v1[2] * v1[2] + v1[3] * v1[3])); }
                s += __shfl_xor(s, 16); s += __shfl_xor(s, 32);
                if (fq == 0) P[rl * 4 + wc] = s; }
        asm volatile("s_waitcnt lgkmcnt(0)" ::: "memory"); __builtin_amdgcn_s_barrier(); asm volatile("" ::: "memory");
        const int t = wid * 64 + lane;
        if (t < 256) { const f32x4 p = *(const PG8_LAS f32x4*)(P + t * 4); ss[(size_t)(u.pm * BM + t) * 8 + u.pn] = (p[0] + p[1]) + (p[2] + p[3]); }
        asm volatile("s_waitcnt lgkmcnt(0)" ::: "memory"); __builtin_amdgcn_s_barrier(); asm volatile("" ::: "memory");
    }
};

template <class Epi, class Sched, bool ALIGN_EPI = false, bool SP2 = false>
__device__ __forceinline__ void gemm_phase(PG8_LAS unsigned char* lds, const Gemm g, const Sched& S, const Epi& E) {
    const int tid = threadIdx.x, wid = __builtin_amdgcn_readfirstlane(tid >> 6), lane = tid & 63, wr = wid >> 2, wc = wid & 3, fr = lane & 15, fq = lane >> 4;
    const int K = g.K, nt = K / BK;
    unsigned voffA[2], voffB[2];
#pragma unroll
    for (int i = 0; i < 2; ++i) { int R, C; stage_rc(tid * 16 + i * 8192, R, C); const int Rb = Epi::PERM ? ((R & ~31) + perm32(R & 31)) : R;
        voffA[i] = (unsigned)(R * K + C) * 2u; voffB[i] = (unsigned)(Rb * K + C) * 2u; }
    const size_t kstep = (size_t)(BK * 2);
    const size_t hstep = (size_t)HALF * K * 2;
    const size_t tstep = 2 * hstep;
    const unsigned ldsw = (unsigned)wid * 1024u;
    const int aoff = lds_byte(wr * 64 + fr, fq * 8), boff = lds_byte(wc * 32 + fr, fq * 8);
#define PG8_SA(b, h) (((b) * 2 + (h)) * HTB)
#define PG8_SB(b, h) ((4 + (b) * 2 + (h)) * HTB)
#define PG8_STAGE(bufoff, gbase, voff) do { _Pragma("unroll") for (int _i = 0; _i < 2; ++_i) \
        __builtin_amdgcn_global_load_lds((const unsigned*)((const char*)(gbase) + (voff)[_i]), (PG8_LAS unsigned*)(lds + (bufoff) + ldsw + _i * 8192), 16, 0, 0); } while (0)
#define PG8_LDA(dst, b, h) do { _Pragma("unroll") for (int m = 0; m < 4; ++m) _Pragma("unroll") for (int k = 0; k < 2; ++k) dst[m][k] = *(const PG8_LAS bf16x8*)(lds + PG8_SA(b, h) + aoff + m * 2048 + k * 1024); } while (0)
#define PG8_LDB(dst, b, h) do { _Pragma("unroll") for (int n = 0; n < 2; ++n) _Pragma("unroll") for (int k = 0; k < 2; ++k) dst[n][k] = *(const PG8_LAS bf16x8*)(lds + PG8_SB(b, h) + boff + n * 2048 + k * 1024); } while (0)
#define PG8_MMA(ai, bj, At, Bt) do { __builtin_amdgcn_s_setprio(1); _Pragma("unroll") for (int m = 0; m < 4; ++m) _Pragma("unroll") for (int n = 0; n < 2; ++n) _Pragma("unroll") for (int k = 0; k < 2; ++k) \
        acc[ai][bj][m][n] = __builtin_amdgcn_mfma_f32_16x16x32_bf16(Bt[n][k], At[m][k], acc[ai][bj][m][n], 0, 0, 0); __builtin_amdgcn_s_setprio(0); } while (0)
#define PG8_WAIT_V(n) asm volatile("s_waitcnt vmcnt(" #n ")" ::: "memory")
#define PG8_WAIT_L(n) asm volatile("s_waitcnt lgkmcnt(" #n ")" ::: "memory")
#define PG8_BAR __builtin_amdgcn_s_barrier()
#define PG8_SCHED __builtin_amdgcn_sched_barrier(0)
    Unit cur, nxt; int ui = 0;
    if (!S.next(0, cur)) return;
    f32x4 acc[2][2][4][2];
#pragma unroll
    for (int a = 0; a < 2; ++a)
#pragma unroll
        for (int b = 0; b < 2; ++b)
#pragma unroll
            for (int m = 0; m < 4; ++m)
#pragma unroll
                for (int n = 0; n < 2; ++n) acc[a][b][m][n] = (f32x4){0.f, 0.f, 0.f, 0.f};
    bf16x8 At[4][2], B0[2][2], B1[2][2];
    const char* cA = (const char*)g.A + (size_t)cur.pm * tstep; const char* cB = (const char*)g.Bt + (size_t)cur.pn * tstep;
    S.a_ready(cur);
    if constexpr (SP2) {
        PG8_STAGE(PG8_SB(0, 0), cB, voffB); PG8_STAGE(PG8_SB(0, 1), cB + hstep, voffB); PG8_STAGE(PG8_SA(0, 0), cA, voffA); PG8_STAGE(PG8_SA(0, 1), cA + hstep, voffA);
        if (wr == 1) PG8_BAR;
        PG8_WAIT_V(2); PG8_BAR;
        PG8_STAGE(PG8_SB(1, 0), cB + kstep, voffB); PG8_STAGE(PG8_SA(1, 0), cA + kstep, voffA); PG8_STAGE(PG8_SB(1, 1), cB + hstep + kstep, voffB);
        PG8_WAIT_V(6); PG8_BAR;
    } else {
        PG8_STAGE(PG8_SB(0, 0), cB, voffB); PG8_STAGE(PG8_SA(0, 0), cA, voffA); PG8_STAGE(PG8_SB(0, 1), cB + hstep, voffB); PG8_STAGE(PG8_SA(0, 1), cA + hstep, voffA);
        if (wr == 1) PG8_BAR;
        PG8_WAIT_V(4); PG8_BAR;
        PG8_STAGE(PG8_SB(1, 0), cB + kstep, voffB); PG8_STAGE(PG8_SA(1, 0), cA + kstep, voffA); PG8_STAGE(PG8_SB(1, 1), cB + hstep + kstep, voffB);
        PG8_WAIT_V(6); PG8_BAR;
    }
    for (;;) {
        const bool has_next = S.next(ui + 1, nxt);
        const char* nA = has_next ? (const char*)g.A + (size_t)nxt.pm * tstep : cA; const char* nB = has_next ? (const char*)g.Bt + (size_t)nxt.pn * tstep : cB;
        for (int t = 0; t < nt; t += 2) {
            const bool last = (t == nt - 2);
            const char* a1 = cA + (size_t)(t + 1) * kstep;
            const char* a2 = last ? nA : cA + (size_t)(t + 2) * kstep; const char* b2 = last ? nB : cB + (size_t)(t + 2) * kstep;
            const char* a3 = a2 + kstep; const char* b3 = b2 + kstep;
            if (last && has_next) S.a_ready(nxt);
            if constexpr (SP2) {
            PG8_LDB(B0, 0, 0); PG8_LDB(B1, 0, 1); PG8_SCHED; PG8_LDA(At, 0, 0); PG8_STAGE(PG8_SA(1, 1), a1 + hstep, voffA);
            PG8_WAIT_V(8); PG8_WAIT_L(0); PG8_BAR; PG8_MMA(0, 0, At, B0); PG8_MMA(0, 1, At, B1); PG8_BAR; PG8_SCHED;
            PG8_LDA(At, 0, 1); PG8_STAGE(PG8_SB(0, 0), b2, voffB); PG8_STAGE(PG8_SB(0, 1), b2 + hstep, voffB); PG8_STAGE(PG8_SA(0, 0), a2, voffA);
            PG8_WAIT_V(8); PG8_WAIT_L(0); PG8_BAR; PG8_MMA(1, 0, At, B0); PG8_MMA(1, 1, At, B1); PG8_BAR; PG8_SCHED;
            PG8_LDB(B0, 1, 0); PG8_LDB(B1, 1, 1); PG8_SCHED; PG8_LDA(At, 1, 0); PG8_STAGE(PG8_SA(0, 1), a2 + hstep, voffA);
            PG8_WAIT_V(8); PG8_WAIT_L(0); PG8_BAR; PG8_MMA(0, 0, At, B0); PG8_MMA(0, 1, At, B1); PG8_BAR; PG8_SCHED;
            PG8_LDA(At, 1, 1); PG8_STAGE(PG8_SB(1, 0), b3, voffB); PG8_STAGE(PG8_SB(1, 1), b3 + hstep, voffB); PG8_STAGE(PG8_SA(1, 0), a3, voffA);
            PG8_WAIT_V(8); PG8_WAIT_L(0); PG8_BAR; PG8_MMA(1, 0, At, B0); PG8_MMA(1, 1, At, B1); PG8_BAR; PG8_SCHED;
            } else {
            PG8_LDB(B0, 0, 0); PG8_SCHED; PG8_LDA(At, 0, 0); PG8_STAGE(PG8_SA(1, 1), a1 + hstep, voffA);
            PG8_WAIT_L(8); PG8_BAR; PG8_WAIT_L(0); PG8_MMA(0, 0, At, B0); PG8_BAR; PG8_SCHED;
            PG8_LDB(B1, 0, 1); PG8_STAGE(PG8_SB(0, 0), b2, voffB);
            PG8_BAR; PG8_WAIT_L(0); PG8_MMA(0, 1, At, B1); PG8_BAR;
            PG8_LDA(At, 0, 1); PG8_STAGE(PG8_SA(0, 0), a2, voffA);
            PG8_BAR; PG8_WAIT_L(0); PG8_MMA(1, 0, At, B0); PG8_BAR; PG8_SCHED;
            PG8_STAGE(PG8_SB(0, 1), b2 + hstep, voffB);
            PG8_WAIT_V(6); PG8_BAR; PG8_MMA(1, 1, At, B1); PG8_BAR;
            PG8_LDB(B0, 1, 0); PG8_SCHED; PG8_LDA(At, 1, 0); PG8_STAGE(PG8_SA(0, 1), a2 + hstep, voffA);
            PG8_WAIT_L(8); PG8_BAR; PG8_WAIT_L(0); PG8_MMA(0, 0, At, B0); PG8_BAR; PG8_SCHED;
            PG8_LDB(B1, 1, 1); PG8_STAGE(PG8_SB(1, 0), b3, voffB);
            PG8_BAR; PG8_WAIT_L(0); PG8_MMA(0, 1, At, B1); PG8_BAR;
            PG8_LDA(At, 1, 1); PG8_STAGE(PG8_SA(1, 0), a3, voffA);
            PG8_BAR; PG8_WAIT_L(0); PG8_MMA(1, 0, At, B0); PG8_BAR; PG8_SCHED;
            PG8_STAGE(PG8_SB(1, 1), b3 + hstep, voffB);
            PG8_WAIT_V(6); PG8_BAR; PG8_MMA(1, 1, At, B1); PG8_BAR;
            }
        }
        if constexpr (ALIGN_EPI) { if (wr == 0) PG8_BAR; }
        if constexpr (!Epi::AFTER_DRAIN) { E(acc, cur, wr, wc, fr, fq); S.done(cur); }
        if (!has_next) break;
#pragma unroll
        for (int a = 0; a < 2; ++a)
#pragma unroll
            for (int b = 0; b < 2; ++b)
#pragma unroll
                for (int m = 0; m < 4; ++m)
#pragma unroll
                    for (int n = 0; n < 2; ++n) acc[a][b][m][n] = (f32x4){0.f, 0.f, 0.f, 0.f};
        cur = nxt; cA = nA; cB = nB; ++ui;
        if constexpr (ALIGN_EPI) { if (wr == 1) PG8_BAR; }
    }
    PG8_WAIT_V(0);
    if constexpr (!ALIGN_EPI) { if (wr == 0) PG8_BAR; }
    PG8_BAR;
    if constexpr (Epi::AFTER_DRAIN) { E.fused(acc, cur, wr, wc, fr, fq, lds, wid, lane); S.done(cur); }
#undef PG8_SA
#undef PG8_SB
#undef PG8_STAGE
#undef PG8_LDA
#undef PG8_LDB
#undef PG8_MMA
#undef PG8_WAIT_V
#undef PG8_WAIT_L
#undef PG8_BAR
#undef PG8_SCHED
}
}

constexpr int NWAVES = 8;
constexpr int SEQ = 8192, DM = 2048, DFF = 8192, EVEN_IN = 3584, ODD_IN = 6144;
constexpr int OFF_K = 1024, OFF_V = 1280, OFF_X = 1536, OFF_G = 2560;
#ifndef MK_N_LAUNCHES
#define MK_N_LAUNCHES 1
#endif
constexpr int N_PHASES = 13;
constexpr size_t MiB = 1u << 20;
constexpr size_t WS_CTL = 0, CTL_ZERO_BYTES = 64 * 1024;
constexpr size_t WS_SS = 1 * MiB;
constexpr size_t WS_BT = 1 * MiB + 512 * 1024;
constexpr size_t WS_GWT = 1 * MiB + 768 * 1024;
constexpr size_t WS_WIN0 = 2 * MiB, WS_WOUT0 = 16 * MiB, WS_WUP0 = 24 * MiB, WS_WDN0 = 56 * MiB, WS_WIN1 = 88 * MiB, WS_WOUT1 = 112 * MiB, WS_WUP1 = 120 * MiB, WS_WDN1 = 152 * MiB;
constexpr size_t WS_XN = 184 * MiB;
constexpr size_t WS_Y = 216 * MiB;
constexpr size_t WS_PROJ = 248 * MiB;
constexpr size_t WS_HL = 344 * MiB, WS_PA = 376 * MiB;
constexpr size_t WS_ACT = 248 * MiB;
constexpr size_t WS_END = 408 * MiB;
constexpr int CW_BAR = 1024;

constexpr int RING_OFF = 0, RING_BYTES = 131072;
constexpr int LDSCTL_OFF = RING_BYTES, MISC_OFF = LDSCTL_OFF + 320;
constexpr int LDS_BYTES = 147456;

#define GAS __attribute__((address_space(1)))
#define LAS __attribute__((address_space(3)))
typedef unsigned short bf16;
typedef unsigned v4u __attribute__((ext_vector_type(4)));
typedef unsigned v2u __attribute__((ext_vector_type(2)));
typedef float f32x4 __attribute__((ext_vector_type(4)));
#define LDS_WAIT() asm volatile("s_waitcnt lgkmcnt(0)" ::: "memory")
#define VM_WAIT() asm volatile("s_waitcnt vmcnt(0)" ::: "memory")
__device__ __forceinline__ unsigned f2bf(float f) { unsigned u = __builtin_bit_cast(unsigned, f); return (u + 0x7fffu + ((u >> 16) & 1u)) >> 16; }
__device__ __forceinline__ unsigned pk2(float lo, float hi) { return f2bf(lo) | (f2bf(hi) << 16); }
__device__ __forceinline__ float bflo(unsigned w) { return __builtin_bit_cast(float, w << 16); }
__device__ __forceinline__ float bfhi(unsigned w) { return __builtin_bit_cast(float, w & 0xffff0000u); }

#define XB_TMO      128
#define XB_XCNT(j)  (256  + 64 * (j))
#define XB_XSUB(j)  (1280 + 64 * (j))
#define XB_XGEN(j)  (2304 + 64 * (j))
#define XB_TOP      3328
#define XB_TOPGEN   3392
#define XCD_BAR_WORDS 3456
#define XB_SPIN_CAP (1u << 22)

__device__ __forceinline__ unsigned xb_ld(unsigned* p)              { return __hip_atomic_load(p, __ATOMIC_RELAXED, __HIP_MEMORY_SCOPE_AGENT); }
__device__ __forceinline__ unsigned xb_add(unsigned* p, unsigned v) { return __hip_atomic_fetch_add(p, v, __ATOMIC_RELAXED, __HIP_MEMORY_SCOPE_AGENT); }
__device__ __forceinline__ unsigned xb_xcc_id() { return (unsigned)__builtin_amdgcn_s_getreg((3 << 11) | 20) & 0xFu; }
#define XB_SPIN(cond, bar) do { unsigned _sp = 0; while (cond) { __builtin_amdgcn_s_sleep(1); \
    if ((++_sp & 255u) == 0u) { if (xb_ld(&(bar)[XB_TMO])) break; if (_sp > XB_SPIN_CAP) { atomicAdd(&(bar)[XB_TMO], 1u); break; } } } } while (0)

struct XcdBarrier {
    unsigned* bar; unsigned x;
    volatile LAS unsigned* st;
};

__device__ __forceinline__ XcdBarrier xcd_barrier_post(unsigned* bar, volatile LAS unsigned* st) {
    XcdBarrier b; b.bar = bar; b.x = xb_xcc_id(); b.st = st;
    if (threadIdx.x == 0) (void)xb_add(&bar[XB_XCNT(b.x)], 1u);
    return b;
}
__device__ __forceinline__ void xcd_barrier_complete(unsigned* bar, unsigned x, unsigned& nloc, unsigned& nx) {
    const unsigned G = gridDim.x * gridDim.y * gridDim.z;
    unsigned sum, cnt, mine, sp = 0u;
    for (;;) {
        sum = 0u; cnt = 0u; mine = 0u;
#pragma unroll
        for (unsigned j = 0; j < 16; ++j) { const unsigned c = xb_ld(&bar[XB_XCNT(j)]); sum += c; cnt += (c > 0u) ? 1u : 0u; mine = (j == x) ? c : mine; }
        if (sum == G) break;
        __builtin_amdgcn_s_sleep(1);
        if ((++sp & 255u) == 0u) { if (xb_ld(&bar[XB_TMO])) break; if (sp > XB_SPIN_CAP) { atomicAdd(&bar[XB_TMO], 1u); break; } }
    }
    nloc = mine > 0u ? mine : 1u; nx = cnt > 0u ? cnt : 1u;
}

__device__ __forceinline__ void xcd_barrier(const XcdBarrier& b) {
    asm volatile("s_waitcnt vmcnt(0)" ::: "memory");
    __syncthreads();
    if (threadIdx.x == 0) {
        unsigned* bar = b.bar;
        __builtin_amdgcn_s_waitcnt(0);
        unsigned nloc = b.st[0], nx = b.st[1];
        if (nloc == 0u) { xcd_barrier_complete(bar, b.x, nloc, nx); b.st[0] = nloc; b.st[1] = nx; }
        const unsigned old = xb_add(&bar[XB_XSUB(b.x)], 1u);
        const unsigned gen = old / nloc;
        if (old + 1u == (gen + 1u) * nloc) {
            __builtin_amdgcn_fence(__ATOMIC_RELEASE, "agent");
            asm volatile("s_waitcnt vmcnt(0)" ::: "memory");
            const unsigned og = xb_add(&bar[XB_TOP], 1u);
            const unsigned tg = og / nx;
            if (og + 1u == (tg + 1u) * nx) xb_add(&bar[XB_TOPGEN], 1u);
            else XB_SPIN(xb_ld(&bar[XB_TOPGEN]) == tg, bar);
            __builtin_amdgcn_fence(__ATOMIC_ACQUIRE, "agent");
            xb_add(&bar[XB_XGEN(b.x)], 1u);
            asm volatile("s_waitcnt vmcnt(0)" ::: "memory");
        } else {
            XB_SPIN(xb_ld(&bar[XB_XGEN(b.x)]) == gen, bar);
            __builtin_amdgcn_fence(__ATOMIC_ACQUIRE, "agent");
            asm volatile("s_waitcnt vmcnt(0)" ::: "memory");
        }
    }
    __syncthreads();
}
struct Frame {
    LAS unsigned char* lds;
    int tid, lane, wave, G;
    const float* in[19]; float* out; unsigned char* ws;
};
#define IN_X 0
#define IN_RELB 1
#define IN_NMIX 2
#define IN_EWIN 3
#define IN_CONVW 4
#define IN_CONVB 5
#define IN_GAW 6
#define IN_GAB 7
#define IN_GXW 8
#define IN_GXB 9
#define IN_LAMBDA 10
#define IN_SINKS 11
#define IN_EWOUT 12
#define IN_OWIN 13
#define IN_OWOUT 14
#define IN_NMLP 15
#define IN_WUP 16
#define IN_WDOWN 17
#define IN_FNORM 18

__device__ __forceinline__ float wave_sum(float v) {
#pragma unroll
    for (int o = 1; o < 64; o <<= 1) v += __shfl_xor(v, o);
    return v;
}
struct P0Tile { const float* W; const float* gain; bf16* WT; int K, N, k0, n0; };
__device__ __forceinline__ void p0_tile_load(const P0Tile& t, int lane, f32x4 (&v)[16]) {
    const GAS f32x4* p = (const GAS f32x4*)(t.W + (size_t)(t.k0 + (lane >> 4)) * t.N + t.n0 + 4 * (lane & 15));
#pragma unroll
    for (int i = 0; i < 16; ++i) v[i] = p[(size_t)i * t.N];
}
__device__ __forceinline__ void p0_tile_store(const P0Tile& t, int lane, const f32x4 (&v)[16], LAS float* scr) {
#pragma unroll
    for (int i = 0; i < 16; ++i) { const int kk = (lane >> 4) + 4 * i; *(LAS f32x4*)(scr + kk * 64 + ((4 * (lane & 15)) ^ (4 * ((kk >> 3) & 7)))) = v[i]; }
    LDS_WAIT(); asm volatile("" ::: "memory");
    const int kc = lane & 7;
    float g[8];
    if (t.gain) { const f32x4 a = *(const GAS f32x4*)(t.gain + t.k0 + 8 * kc), b = *(const GAS f32x4*)(t.gain + t.k0 + 8 * kc + 4); g[0] = a[0]; g[1] = a[1]; g[2] = a[2]; g[3] = a[3]; g[4] = b[0]; g[5] = b[1]; g[6] = b[2]; g[7] = b[3]; }
    else {
#pragma unroll
        for (int e = 0; e < 8; ++e) g[e] = 1.0f; }
#pragma unroll
    for (int j = 0; j < 8; ++j) { const int n = (lane >> 3) + 8 * j; const LAS float* s = scr + (8 * kc) * 64 + (n ^ (4 * kc));
        v4u o; o.x = pk2(s[0] * g[0], s[64] * g[1]); o.y = pk2(s[128] * g[2], s[192] * g[3]); o.z = pk2(s[256] * g[4], s[320] * g[5]); o.w = pk2(s[384] * g[6], s[448] * g[7]);
        *(GAS v4u*)(t.WT + (size_t)(t.n0 + n) * t.K + t.k0 + 8 * kc) = o; }
    LDS_WAIT(); asm volatile("" ::: "memory");
}
__device__ __forceinline__ int t5_bucket(int rel) {
    const int ret = rel > 0 ? 16 : 0, n = rel < 0 ? -rel : rel;
    if (n < 8) return ret + n;
    int large = 8 + (31 - __builtin_clz((unsigned)(n * n))) - 6; if (large > 15) large = 15;
    return ret + large;
}
__device__ __forceinline__ void p0_prologue(Frame& F) {
    LAS float* scr = (LAS float*)(F.lds + RING_OFF + F.wave * 16384);
    const int gw = blockIdx.x * NWAVES + F.wave, NGW = F.G * NWAVES;
    unsigned char* ws = F.ws;
    constexpr int T_IN0 = (DM / 64) * (EVEN_IN / 64), T_OUT = (DM / 64) * (DM / 64), T_UP = (DM / 64) * (DFF / 64), T_DN = (DFF / 64) * (DM / 64), T_IN1 = (DM / 64) * (ODD_IN / 64);
    constexpr int NTILES = T_IN0 + T_IN1 + 2 * T_OUT + 2 * T_UP + 2 * T_DN;
#define P0_DESC(it, t) do { int r_ = (it); \
        if (r_ < T_IN0) { t.W = F.in[IN_EWIN]; t.gain = F.in[IN_NMIX]; t.WT = (bf16*)(ws + WS_WIN0); t.K = DM; t.N = EVEN_IN; } else { r_ -= T_IN0; \
        if (r_ < T_OUT) { t.W = F.in[IN_EWOUT]; t.gain = nullptr; t.WT = (bf16*)(ws + WS_WOUT0); t.K = DM; t.N = DM; } else { r_ -= T_OUT; \
        if (r_ < T_UP) { t.W = F.in[IN_WUP]; t.gain = F.in[IN_NMLP]; t.WT = (bf16*)(ws + WS_WUP0); t.K = DM; t.N = DFF; } else { r_ -= T_UP; \
        if (r_ < T_DN) { t.W = F.in[IN_WDOWN]; t.gain = nullptr; t.WT = (bf16*)(ws + WS_WDN0); t.K = DFF; t.N = DM; } else { r_ -= T_DN; \
        if (r_ < T_IN1) { t.W = F.in[IN_OWIN]; t.gain = F.in[IN_NMIX] + DM; t.WT = (bf16*)(ws + WS_WIN1); t.K = DM; t.N = ODD_IN; } else { r_ -= T_IN1; \
        if (r_ < T_OUT) { t.W = F.in[IN_OWOUT]; t.gain = nullptr; t.WT = (bf16*)(ws + WS_WOUT1); t.K = DM; t.N = DM; } else { r_ -= T_OUT; \
        if (r_ < T_UP) { t.W = F.in[IN_WUP] + (size_t)DM * DFF; t.gain = F.in[IN_NMLP] + DM; t.WT = (bf16*)(ws + WS_WUP1); t.K = DM; t.N = DFF; } else { r_ -= T_UP; \
        t.W = F.in[IN_WDOWN] + (size_t)DFF * DM; t.gain = nullptr; t.WT = (bf16*)(ws + WS_WDN1); t.K = DFF; t.N = DM; } } } } } } } \
        const int nb_ = t.N / 64; t.k0 = 64 * (r_ / nb_); t.n0 = 64 * (r_ % nb_); } while (0)
    {
        f32x4 va[16], vb[16]; P0Tile ta, tb;
        int it = gw;
        if (it < NTILES) { P0_DESC(it, ta); p0_tile_load(ta, F.lane, va); }
        while (it < NTILES) {
            const int itn = it + NGW; const bool more = itn < NTILES;
            if (more) { P0_DESC(itn, tb); p0_tile_load(tb, F.lane, vb); }
            p0_tile_store(ta, F.lane, va, scr);
            if (more) { ta = tb;
#pragma unroll
                for (int i = 0; i < 16; ++i) va[i] = vb[i]; }
            it = itn;
        }
    }
#undef P0_DESC
    bf16* XN = (bf16*)(ws + WS_XN); float* SS = (float*)(ws + WS_SS);
    for (int m = gw; m < SEQ; m += NGW) {
        const GAS f32x4* xr = (const GAS f32x4*)(F.in[IN_X] + (size_t)m * DM) + F.lane;
        f32x4 v[8]; float s = 0.f;
#pragma unroll
        for (int j = 0; j < 8; ++j) { v[j] = xr[64 * j]; s += (v[j].x * v[j].x + v[j].y * v[j].y) + (v[j].z * v[j].z + v[j].w * v[j].w); }
        s = wave_sum(s);
        GAS v2u* o8 = (GAS v2u*)(XN + (size_t)m * DM) + F.lane;
#pragma unroll
        for (int j = 0; j < 8; ++j) { v2u w; w.x = pk2(v[j].x, v[j].y); w.y = pk2(v[j].z, v[j].w); o8[64 * j] = w; }
        if (F.lane < 8) SS[(size_t)m * 8 + F.lane] = F.lane == 0 ? s : 0.f;
    }
    float* BT = (float*)(ws + WS_BT);
    for (int i = blockIdx.x * 512 + F.tid; i < 16 * 256; i += F.G * 512) { const int head = i >> 8, rel = (i & 255) - 191; BT[i] = F.in[IN_RELB][t5_bucket(rel) * 16 + head]; }
    bf16* GWT = (bf16*)(ws + WS_GWT);
    for (int i = blockIdx.x * 512 + F.tid; i < 2 * 16 * 64 * 64; i += F.G * 512) { const int gate = i >> 16, hb = (i >> 12) & 15, jo = (i >> 6) & 63, ii = i & 63;
        GWT[i] = (bf16)f2bf(F.in[gate ? IN_GXW : IN_GAW][(size_t)(hb * 64 + ii) * 64 + jo]); }
}

__device__ __forceinline__ void ld8(const bf16* p, float (&o)[8]) { const v4u w = *(const GAS v4u*)p; o[0] = bflo(w.x); o[1] = bfhi(w.x); o[2] = bflo(w.y); o[3] = bfhi(w.y); o[4] = bflo(w.z); o[5] = bfhi(w.z); o[6] = bflo(w.w); o[7] = bfhi(w.w); }
__device__ __forceinline__ void swa_naive(Frame& F) {
    const bf16* PROJ = (const bf16*)(F.ws + WS_PROJ); bf16* Y = (bf16*)(F.ws + WS_Y); const float* BT = (const float*)(F.ws + WS_BT);
    for (int idx = blockIdx.x * 512 + F.tid; idx < SEQ * 16; idx += F.G * 512) {
        const int head = idx >> 13, tok = idx & (SEQ - 1), kvh = head >> 2, c = tok >> 6;
        float q[64], acc[64];
#pragma unroll
        for (int i = 0; i < 8; ++i) { float t[8]; ld8(PROJ + (size_t)tok * EVEN_IN + head * 64 + 8 * i, t);
#pragma unroll
            for (int j = 0; j < 8; ++j) { q[8 * i + j] = t[j] * 0.125f; acc[8 * i + j] = 0.f; } }
        float m = F.in[IN_SINKS][head], l = 1.0f;
        const int k0 = c >= 2 ? (c - 2) * 64 : 0, k1 = (c + 1) * 64;
        const float* bt = BT + head * 256;
        for (int j = k0; j < k1; ++j) {
            const bf16* kp = PROJ + (size_t)j * EVEN_IN + OFF_K + kvh * 64; float s = 0.f;
#pragma unroll
            for (int i = 0; i < 8; ++i) { float t[8]; ld8(kp + 8 * i, t);
#pragma unroll
                for (int e = 0; e < 8; ++e) s += q[8 * i + e] * t[e]; }
            s += bt[j - tok + 191];
            const float mn = fmaxf(m, s), corr = expf(m - mn), p = expf(s - mn);
            l = l * corr + p; m = mn;
            const bf16* vp = PROJ + (size_t)j * EVEN_IN + OFF_V + kvh * 64;
#pragma unroll
            for (int i = 0; i < 8; ++i) { float t[8]; ld8(vp + 8 * i, t);
#pragma unroll
                for (int e = 0; e < 8; ++e) acc[8 * i + e] = acc[8 * i + e] * corr + p * t[e]; }
        }
        const float inv = 1.0f / l;
#pragma unroll
        for (int i = 0; i < 8; ++i) { v4u w; w.x = pk2(acc[8 * i] * inv, acc[8 * i + 1] * inv); w.y = pk2(acc[8 * i + 2] * inv, acc[8 * i + 3] * inv); w.z = pk2(acc[8 * i + 4] * inv, acc[8 * i + 5] * inv); w.w = pk2(acc[8 * i + 6] * inv, acc[8 * i + 7] * inv);
            *(GAS v4u*)(Y + (size_t)tok * DM + head * 64 + 8 * i) = w; }
    }
}
__device__ __forceinline__ float softplusf(float z) { return fmaxf(z, 0.f) + log1pf(expf(-fabsf(z))); }
__device__ __forceinline__ float sigmoidf_(float z) { return 1.0f / (1.0f + expf(-z)); }
__device__ __forceinline__ float gelu_tanh(float x) { const float u = 0.7978845608028654f * (x + 0.044715f * x * x * x); return 0.5f * x * (1.0f + tanhf(u)); }
__device__ __forceinline__ void lru_naive(Frame& F) {
    if (blockIdx.x >= 16 || F.wave != 0) return;
    const bf16* PROJ = (const bf16*)(F.ws + WS_PROJ); bf16* Y = (bf16*)(F.ws + WS_Y);
    const int hb = blockIdx.x, lane = F.lane, c = hb * 64 + lane;
    float Wa[64], Wx[64];
#pragma unroll
    for (int i = 0; i < 64; ++i) { Wa[i] = F.in[IN_GAW][(size_t)(hb * 64 + i) * 64 + lane]; Wx[i] = F.in[IN_GXW][(size_t)(hb * 64 + i) * 64 + lane]; }
    const float ba = F.in[IN_GAB][c], bx = F.in[IN_GXB][c], cb = F.in[IN_CONVB][c];
    const float cw0 = F.in[IN_CONVW][c], cw1 = F.in[IN_CONVW][1024 + c], cw2 = F.in[IN_CONVW][2048 + c], cw3 = F.in[IN_CONVW][3072 + c];
    const float sp8 = 8.0f * softplusf(-F.in[IN_LAMBDA][c]);
    float x1 = 0.f, x2 = 0.f, x3 = 0.f, h = 0.f;
    for (int t0 = 0; t0 < SEQ; t0 += 8) {
        float xb[8], g[8];
#pragma unroll
        for (int u = 0; u < 8; ++u) { xb[u] = bflo((unsigned)PROJ[(size_t)(t0 + u) * EVEN_IN + OFF_X + c]); g[u] = bflo((unsigned)PROJ[(size_t)(t0 + u) * EVEN_IN + OFF_G + c]); }
#pragma unroll
        for (int u = 0; u < 8; ++u) {
            const float xt = xb[u], xc = cb + cw0 * x3 + cw1 * x2 + cw2 * x1 + cw3 * xt; x3 = x2; x2 = x1; x1 = xt;
            float ra = ba, rx = bx; const int xci = __builtin_bit_cast(int, xc);
#pragma unroll
            for (int i = 0; i < 64; ++i) { const float xi = __builtin_bit_cast(float, __builtin_amdgcn_readlane(xci, i)); ra += xi * Wa[i]; rx += xi * Wx[i]; }
            const float r = sigmoidf_(ra), ig = sigmoidf_(rx), log_a = -r * sp8, a = expf(log_a), mult = sqrtf(-expm1f(2.0f * log_a));
            h = a * h + mult * (ig * xc);
            Y[(size_t)(t0 + u) * DM + 1024 + c] = (bf16)f2bf(gelu_tanh(g[u]) * h);
        }
    }
}
__device__ __forceinline__ void sb_naive(Frame& F) {
    const bf16* PROJ = (const bf16*)(F.ws + WS_PROJ); bf16* Y = (bf16*)(F.ws + WS_Y);
    const int gt = blockIdx.x * 512 + F.tid, half = gt & 1;
    for (int pidx = gt >> 1; pidx < SEQ * 16; pidx += (F.G * 512) >> 1) {
        const int head = pidx >> 13, tok = pidx & (SEQ - 1);
        float q[64], acc[64];
#pragma unroll
        for (int i = 0; i < 8; ++i) { float t[8]; ld8(PROJ + (size_t)tok * ODD_IN + head * 128 + half * 64 + 8 * i, t);
#pragma unroll
            for (int j = 0; j < 8; ++j) { q[8 * i + j] = t[j] * 0.08838834764831845f; acc[8 * i + j] = 0.f; } }
        float stick = 0.f;
        for (int j = tok - 1; j >= 0; --j) {
            const bf16* kp = PROJ + (size_t)j * ODD_IN + 2048 + head * 128 + half * 64; float s = 0.f;
#pragma unroll
            for (int i = 0; i < 8; ++i) { float t[8]; ld8(kp + 8 * i, t);
#pragma unroll
                for (int e = 0; e < 8; ++e) s += q[8 * i + e] * t[e]; }
            const float z = s + __shfl_xor(s, 1);
            const float lk = -softplusf(z), w = expf(z + lk + stick);
            const bf16* vp = PROJ + (size_t)j * ODD_IN + 4096 + head * 128 + half * 64;
#pragma unroll
            for (int i = 0; i < 8; ++i) { float t[8]; ld8(vp + 8 * i, t);
#pragma unroll
                for (int e = 0; e < 8; ++e) acc[8 * i + e] += w * t[e]; }
            stick += lk;
            if (stick < -104.0f) break;
        }
#pragma unroll
        for (int i = 0; i < 8; ++i) { v4u w; w.x = pk2(acc[8 * i], acc[8 * i + 1]); w.y = pk2(acc[8 * i + 2], acc[8 * i + 3]); w.z = pk2(acc[8 * i + 4], acc[8 * i + 5]); w.w = pk2(acc[8 * i + 6], acc[8 * i + 7]);
            *(GAS v4u*)(Y + (size_t)tok * DM + head * 128 + half * 64 + 8 * i) = w; }
    }
}
__device__ __forceinline__ void final_norm(Frame& F) {
    const int gw = blockIdx.x * NWAVES + F.wave, NGW = F.G * NWAVES;
    const bf16* XN = (const bf16*)(F.ws + WS_XN); const float* SS = (const float*)(F.ws + WS_SS);
    const GAS f32x4* gp = (const GAS f32x4*)F.in[IN_FNORM] + 2 * F.lane;
    for (int m = gw; m < SEQ; m += NGW) {
        const GAS v4u* xr = (const GAS v4u*)(XN + (size_t)m * DM) + F.lane;
        GAS f32x4* orow = (GAS f32x4*)(F.out + (size_t)m * DM) + 2 * F.lane;
        const f32x4 sa = *(const GAS f32x4*)(SS + (size_t)m * 8), sb = *(const GAS f32x4*)(SS + (size_t)m * 8 + 4);
        const float rstd = 1.0f / sqrtf((((sa[0] + sa[1]) + (sa[2] + sa[3])) + ((sb[0] + sb[1]) + (sb[2] + sb[3]))) * (1.0f / DM) + 1e-6f);
        v4u v[4];
#pragma unroll
        for (int j = 0; j < 4; ++j) v[j] = xr[64 * j];
#pragma unroll
        for (int j = 0; j < 4; ++j) { const f32x4 g0 = gp[128 * j], g1 = gp[128 * j + 1];
            orow[128 * j] = (f32x4){bflo(v[j].x) * rstd * g0[0], bfhi(v[j].x) * rstd * g0[1], bflo(v[j].y) * rstd * g0[2], bfhi(v[j].y) * rstd * g0[3]};
            orow[128 * j + 1] = (f32x4){bflo(v[j].z) * rstd * g1[0], bfhi(v[j].z) * rstd * g1[1], bflo(v[j].w) * rstd * g1[2], bfhi(v[j].w) * rstd * g1[3]}; }
    }
}
typedef float f32x16 __attribute__((ext_vector_type(16)));
typedef short s16x8 __attribute__((ext_vector_type(8)));
typedef short s16x4 __attribute__((ext_vector_type(4)));
typedef __bf16 bf16x2v __attribute__((ext_vector_type(2)));
#define MFMA32(a, b, c) __builtin_amdgcn_mfma_f32_32x32x16_bf16((a), (b), (c), 0, 0, 0)
__device__ __forceinline__ int crow(int i, int h) { return (i & 3) + 8 * (i >> 2) + 4 * h; }
__device__ __forceinline__ unsigned pkbf(float a, float b) { bf16x2v v; v.x = (__bf16)a; v.y = (__bf16)b; return __builtin_bit_cast(unsigned, v); }
__device__ __forceinline__ s16x8 pack8(const float (&p)[16], int s) {
    v4u w; w.x = pkbf(p[8 * s], p[8 * s + 1]); w.y = pkbf(p[8 * s + 2], p[8 * s + 3]); w.z = pkbf(p[8 * s + 4], p[8 * s + 5]); w.w = pkbf(p[8 * s + 6], p[8 * s + 7]);
    return __builtin_bit_cast(s16x8, w);
}
__device__ __forceinline__ s16x8 tr_frag(const LAS unsigned char* p0, const LAS unsigned char* p1) {
    const s16x4 lo = __builtin_amdgcn_ds_read_tr16_b64_v4i16((LAS s16x4*)p0), hi = __builtin_amdgcn_ds_read_tr16_b64_v4i16((LAS s16x4*)p1);
    return __builtin_shufflevector(lo, hi, 0, 1, 2, 3, 4, 5, 6, 7);
}
__device__ __forceinline__ float ex2(float x) { return __builtin_amdgcn_exp2f(x); }
__device__ __forceinline__ float lg2(float x) { return __builtin_amdgcn_logf(x); }
__device__ __forceinline__ float fast_exp(float x) { return ex2(x * 1.4426950408889634f); }
__device__ __forceinline__ float fast_softplus(float z) { return fmaxf(z, 0.f) + 0.6931471805599453f * lg2(1.0f + ex2(-1.4426950408889634f * fabsf(z))); }
__device__ __forceinline__ float fast_sigmoid(float z) { return __builtin_amdgcn_rcpf(1.0f + ex2(-1.4426950408889634f * z)); }
#define G0(g, tok) (PROJ + ((size_t)(g) * SEQ + (tok)) * 64)
#define G1(g, tok) (PROJ + ((size_t)(g) * SEQ + (tok)) * 128)

__device__ __forceinline__ void lru_local(Frame& F) {
    const bf16* PROJ = (const bf16*)(F.ws + WS_PROJ); float* HL = (float*)(F.ws + WS_HL); float* PA = (float*)(F.ws + WS_PA); const bf16* GWT = (const bf16*)(F.ws + WS_GWT);
    LAS unsigned char* xc16 = F.lds;
    LAS float* xc32 = (LAS float*)(F.lds + 18432);
    LAS float* comp = (LAS float*)(F.lds + 18432 + 34816);
    const int tid = F.tid, lane = F.lane, w = F.wave, ts = w & 3, ch = w >> 2, r = lane & 31, h = lane >> 5;
    for (int u = blockIdx.x; u < 1024; u += F.G) {
        const int hb = u & 15, k = u >> 4, t0 = k * 128;
        {
            const int tt = tid >> 2, cg = tid & 3, cbase = hb * 64 + cg * 16, t = t0 + tt;
            float xc[16];
            { const GAS f32x4* cbp = (const GAS f32x4*)(F.in[IN_CONVB] + cbase);
#pragma unroll
              for (int q4 = 0; q4 < 4; ++q4) { const f32x4 b = cbp[q4]; xc[4 * q4] = b[0]; xc[4 * q4 + 1] = b[1]; xc[4 * q4 + 2] = b[2]; xc[4 * q4 + 3] = b[3]; } }
#pragma unroll
            for (int d = 0; d < 4; ++d) { const int row = t - 3 + d;
                float xv[16];
                if (row >= 0) { float a8[8], b8[8]; ld8(G0(24 + hb, row) + cg * 16, a8); ld8(G0(24 + hb, row) + cg * 16 + 8, b8);
#pragma unroll
                    for (int e = 0; e < 8; ++e) { xv[e] = a8[e]; xv[8 + e] = b8[e]; } }
                else {
#pragma unroll
                    for (int e = 0; e < 16; ++e) xv[e] = 0.f; }
                const GAS f32x4* cwp = (const GAS f32x4*)(F.in[IN_CONVW] + d * 1024 + cbase);
#pragma unroll
                for (int q4 = 0; q4 < 4; ++q4) { const f32x4 cw = cwp[q4];
#pragma unroll
                    for (int e = 0; e < 4; ++e) xc[4 * q4 + e] += cw[e] * xv[4 * q4 + e]; } }
#pragma unroll
            for (int q4 = 0; q4 < 4; ++q4) *(LAS f32x4*)(xc32 + tt * 68 + cg * 16 + 4 * q4) = (f32x4){xc[4 * q4], xc[4 * q4 + 1], xc[4 * q4 + 2], xc[4 * q4 + 3]};
#pragma unroll
            for (int q8 = 0; q8 < 2; ++q8) { v4u o; o.x = pkbf(xc[8 * q8], xc[8 * q8 + 1]); o.y = pkbf(xc[8 * q8 + 2], xc[8 * q8 + 3]); o.z = pkbf(xc[8 * q8 + 4], xc[8 * q8 + 5]); o.w = pkbf(xc[8 * q8 + 6], xc[8 * q8 + 7]);
                *(LAS v4u*)(xc16 + tt * 144 + cg * 32 + q8 * 16) = o; }
        }
        __syncthreads();
        f32x16 acc_a, acc_x;
#pragma unroll
        for (int i = 0; i < 16; ++i) { acc_a[i] = 0.f; acc_x[i] = 0.f; }
#pragma unroll
        for (int s = 0; s < 4; ++s) {
            const s16x8 af = *(const LAS s16x8*)(xc16 + (ts * 32 + r) * 144 + (16 * s + 8 * h) * 2);
            const s16x8 ba = *(const GAS s16x8*)(GWT + (size_t)((0 * 16 + hb) * 64 + ch * 32 + r) * 64 + 16 * s + 8 * h);
            const s16x8 bx = *(const GAS s16x8*)(GWT + (size_t)((1 * 16 + hb) * 64 + ch * 32 + r) * 64 + 16 * s + 8 * h);
            acc_a = MFMA32(af, ba, acc_a); acc_x = MFMA32(af, bx, acc_x);
        }
        const int c = hb * 64 + ch * 32 + r;
        const float gab = F.in[IN_GAB][c], gxb = F.in[IN_GXB][c], sp8 = 8.0f * softplusf(-F.in[IN_LAMBDA][c]);
        float pa[16], hl[16], gA[4], gU[4];
#pragma unroll
        for (int g = 0; g < 4; ++g) { float A = 1.f, U = 0.f;
#pragma unroll
            for (int e = 0; e < 4; ++e) { const int i = 4 * g + e; const float xcv = xc32[(ts * 32 + crow(i, h)) * 68 + ch * 32 + r];
                const float rg = fast_sigmoid(acc_a[i] + gab), ig = fast_sigmoid(acc_x[i] + gxb), log_a = -rg * sp8, a = fast_exp(log_a), mult = sqrtf(-expm1f(2.0f * log_a));
                U = a * U + mult * (ig * xcv); A *= a; pa[i] = A; hl[i] = U; }
            gA[g] = A; gU[g] = U; }
        float PAc = 1.f, Hc = 0.f;
#pragma unroll
        for (int g = 0; g < 4; ++g) { const float oA = __shfl_xor(gA[g], 32), oU = __shfl_xor(gU[g], 32);
            const float fA = h ? oA : gA[g], fU = h ? oU : gU[g], sA = h ? gA[g] : oA, sU = h ? gU[g] : oU;
            const float c0P = PAc, c0H = Hc; Hc = fA * Hc + fU; PAc *= fA; const float c1P = PAc, c1H = Hc; Hc = sA * Hc + sU; PAc *= sA;
            const float ciP = h ? c1P : c0P, ciH = h ? c1H : c0H;
#pragma unroll
            for (int e = 0; e < 4; ++e) { const int i = 4 * g + e; hl[i] += pa[i] * ciH; pa[i] *= ciP; } }
        if (h == 0) { comp[(ts * 64 + ch * 32 + r) * 2] = PAc; comp[(ts * 64 + ch * 32 + r) * 2 + 1] = Hc; }
        __syncthreads();
        float PAin = 1.f, Hin = 0.f;
        for (int t2 = 0; t2 < ts; ++t2) { const float A2 = comp[(t2 * 64 + ch * 32 + r) * 2], U2 = comp[(t2 * 64 + ch * 32 + r) * 2 + 1]; Hin = A2 * Hin + U2; PAin *= A2; }
#pragma unroll
        for (int i = 0; i < 16; ++i) { const size_t o = ((size_t)hb * SEQ + t0 + ts * 32 + crow(i, h)) * 64 + ch * 32 + r; HL[o] = hl[i] + pa[i] * Hin; PA[o] = pa[i] * PAin; }
        __syncthreads();
    }
}
__device__ __forceinline__ void lru_fix(Frame& F) {
    const bf16* PROJ = (const bf16*)(F.ws + WS_PROJ); const float* HL = (const float*)(F.ws + WS_HL); const float* PA = (const float*)(F.ws + WS_PA); bf16* Y = (bf16*)(F.ws + WS_Y);
    const int gw = blockIdx.x * NWAVES + F.wave, NGW = F.G * NWAVES;
    for (int it = gw; it < 2048; it += NGW) {
        const int cgp = it & 15, sub = (it >> 4) & 1, k = it >> 5, c = cgp * 64 + F.lane;
        float H = 0.f;
        for (int kb = 0; kb < k; kb += 16) {
            float a[16], u[16];
#pragma unroll
            for (int j = 0; j < 16; ++j) { const int kk = (kb + j < k) ? kb + j : 0; const size_t row = ((size_t)cgp * SEQ + kk * 128 + 127) * 64 + F.lane; a[j] = PA[row]; u[j] = HL[row]; }
#pragma unroll
            for (int j = 0; j < 16; ++j) { const bool on = kb + j < k; H = on ? a[j] * H + u[j] : H; }
        }
#pragma unroll
        for (int tb = 0; tb < 64; tb += 32) {
            float hv[32], pv[32], gv[32];
#pragma unroll
            for (int tt = 0; tt < 32; ++tt) { const int t = k * 128 + sub * 64 + tb + tt; const size_t o = ((size_t)cgp * SEQ + t) * 64 + F.lane; hv[tt] = HL[o]; pv[tt] = PA[o]; gv[tt] = bflo((unsigned)G0(40 + cgp, t)[F.lane]); }
#pragma unroll
            for (int tt = 0; tt < 32; ++tt) { const int t = k * 128 + sub * 64 + tb + tt; const float g = gv[tt], u2 = 1.5957691216057308f * (g + 0.044715f * g * g * g), ge = g * fast_sigmoid(u2);
                Y[(size_t)t * DM + 1024 + c] = (bf16)f2bf(ge * (hv[tt] + pv[tt] * H)); }
        }
    }
}
__device__ __forceinline__ void sb_attn(Frame& F) {
    const bf16* PROJ = (const bf16*)(F.ws + WS_PROJ); bf16* Y = (bf16*)(F.ws + WS_Y);
    LAS unsigned char* vt = F.lds + F.wave * 16384;
    const int lane = F.lane, r = lane & 31, h = lane >> 5;
    const int gw = blockIdx.x * NWAVES + F.wave, NGW = F.G * NWAVES;
    const int troff = (4 * h + ((lane & 15) >> 2)) * 256 + (16 * ((lane >> 4) & 1) + 4 * (lane & 3)) * 2;
    for (int it = gw; it < 4096; it += NGW) {
        const int head = (it >> 3) & 15, qb = ((it >> 7) << 3) + (it & 7), q0 = qb * 32;
        s16x8 qf[8];
#pragma unroll
        for (int s = 0; s < 8; ++s) qf[s] = *(const GAS s16x8*)(G1(head, q0 + r) + 16 * s + 8 * h);
        f32x16 o[4];
#pragma unroll
        for (int db = 0; db < 4; ++db)
#pragma unroll
            for (int i = 0; i < 16; ++i) o[db][i] = 0.f;
        float carry = 0.f;
        s16x8 kf[8];
#pragma unroll
        for (int s = 0; s < 8; ++s) kf[s] = *(const GAS s16x8*)(G1(16 + head, q0 + r) + 16 * s + 8 * h);
        {   v4u v0[8];
#pragma unroll
            for (int i = 0; i < 8; ++i) v0[i] = *(const GAS v4u*)(G1(32 + head, q0) + (lane + 64 * i) * 8);
#pragma unroll
            for (int i = 0; i < 8; ++i) *(LAS v4u*)(vt + (lane + 64 * i) * 16) = v0[i];
            LDS_WAIT(); }
        int cur = 0;
        for (int kt = qb; kt >= 0; --kt) {
            const int kbn = (kt > 0 ? kt - 1 : 0) * 32;
            f32x16 sacc;
#pragma unroll
            for (int i = 0; i < 16; ++i) sacc[i] = 0.f;
#pragma unroll
            for (int s = 0; s < 8; ++s) sacc = MFMA32(kf[s], qf[s], sacc);
#pragma unroll
            for (int s = 0; s < 8; ++s) kf[s] = *(const GAS s16x8*)(G1(16 + head, kbn + r) + 16 * s + 8 * h);
            v4u vreg[8];
#pragma unroll
            for (int i = 0; i < 8; ++i) vreg[i] = *(const GAS v4u*)(G1(32 + head, kbn) + (lane + 64 * i) * 8);
            __builtin_amdgcn_sched_barrier(0);
            const bool diag = (kt == qb);
            float z[16], lk[16], G[4];
#pragma unroll
            for (int g = 0; g < 4; ++g) { float gs = 0.f;
#pragma unroll
                for (int e = 0; e < 4; ++e) { const int i = 4 * g + e; z[i] = sacc[i] * 0.08838834764831845f; const bool valid = !diag || (crow(i, h) < r);
                    const float sp = fast_softplus(z[i]); lk[i] = valid ? -sp : 0.f; z[i] = valid ? z[i] : -1e30f; gs += lk[i]; }
                G[g] = gs; }
            float run = carry, pw[16];
#pragma unroll
            for (int g = 3; g >= 0; --g) { const float og = __shfl_xor(G[g], 32);
                const float s1 = run; run += h ? G[g] : og;
                const float s0 = run; run += h ? og : G[g];
                float ex = h ? s1 : s0;
#pragma unroll
                for (int e = 3; e >= 0; --e) { const int i = 4 * g + e; pw[i] = fast_exp(z[i] + lk[i] + ex); ex += lk[i]; } }
            carry = run;
            const s16x8 p0 = pack8(pw, 0), p1 = pack8(pw, 1);
            const LAS unsigned char* trb = vt + cur * 8192 + troff;
#pragma unroll
            for (int db = 0; db < 4; ++db) {
                const s16x8 v0 = tr_frag(trb + db * 64, trb + 8 * 256 + db * 64);
                const s16x8 v1 = tr_frag(trb + 16 * 256 + db * 64, trb + 24 * 256 + db * 64);
                o[db] = MFMA32(v0, p0, o[db]); o[db] = MFMA32(v1, p1, o[db]); }
            cur ^= 1;
#pragma unroll
            for (int i = 0; i < 8; ++i) *(LAS v4u*)(vt + cur * 8192 + (lane + 64 * i) * 16) = vreg[i];
            LDS_WAIT();
            if (__all(carry < -104.0f)) break;
        }
#pragma unroll
        for (int db = 0; db < 4; ++db)
#pragma unroll
            for (int g = 0; g < 4; ++g) { v2u w; w.x = pkbf(o[db][4 * g], o[db][4 * g + 1]); w.y = pkbf(o[db][4 * g + 2], o[db][4 * g + 3]);
                *(GAS v2u*)(Y + (size_t)(q0 + r) * DM + head * 128 + db * 32 + 8 * g + 4 * h) = w; }
    }
}
__device__ __forceinline__ void swa_attn(Frame& F) {
    const bf16* PROJ = (const bf16*)(F.ws + WS_PROJ); bf16* Y = (bf16*)(F.ws + WS_Y); const float* BT = (const float*)(F.ws + WS_BT);
    LAS unsigned char* KL = F.lds + 57344;
    LAS unsigned char* VL = KL + 27648;
    LAS float* btl = (LAS float*)(VL + 36864);
    const int tid = F.tid, lane = F.lane, w = F.wave, r = lane & 31, h = lane >> 5;
    const int kvh = blockIdx.x & 3;
    btl[tid] = BT[kvh * 1024 + tid]; btl[tid + 512] = BT[kvh * 1024 + 512 + tid];
    const int head = kvh * 4 + (w & 3);
    const float sink = F.in[IN_SINKS][head];
    const LAS float* bth = btl + (w & 3) * 256;
    const LAS unsigned char* trb = VL + (4 * h + ((lane & 15) >> 2)) * 192 + (16 * ((lane >> 4) & 1) + 4 * (lane & 3)) * 2;
    v4u kreg[3], vreg[3];
    const int nun = (512 - (int)blockIdx.x + F.G - 1) / F.G;
    {   const int c = blockIdx.x >> 2, kbase = (c - 2) * 64;
#pragma unroll
        for (int i = 0; i < 3; ++i) { const int j = tid + 512 * i; int row = kbase + (j >> 3); row = row < 0 ? 0 : row;
            kreg[i] = *(const GAS v4u*)(G0(16 + kvh, row) + (j & 7) * 8); vreg[i] = *(const GAS v4u*)(G0(20 + kvh, row) + (j & 7) * 8); } }
    for (int ui = 0; ui < nun; ++ui) {
        const int wu = blockIdx.x + ui * F.G, c = wu >> 2, q0 = c * 64 + (w >> 2) * 32, kbase = (c - 2) * 64, kt0 = c >= 2 ? 0 : (2 - c) * 2;
#pragma unroll
        for (int i = 0; i < 3; ++i) { const int j = tid + 512 * i; *(LAS v4u*)(KL + (j >> 3) * 144 + (j & 7) * 16) = kreg[i]; *(LAS v4u*)(VL + (j >> 3) * 192 + (j & 7) * 16) = vreg[i]; }
        __syncthreads();
        if (ui + 1 < nun) { const int c2 = (wu + F.G) >> 2, kb2 = (c2 - 2) * 64;
#pragma unroll
            for (int i = 0; i < 3; ++i) { const int j = tid + 512 * i; int row = kb2 + (j >> 3); row = row < 0 ? 0 : row;
                kreg[i] = *(const GAS v4u*)(G0(16 + kvh, row) + (j & 7) * 8); vreg[i] = *(const GAS v4u*)(G0(20 + kvh, row) + (j & 7) * 8); } }
        s16x8 qf[4];
#pragma unroll
        for (int s = 0; s < 4; ++s) qf[s] = *(const GAS s16x8*)(G0(head, q0 + r) + 16 * s + 8 * h);
        __builtin_amdgcn_sched_barrier(0);
        float sc[6][16]; float m = sink;
#pragma unroll
        for (int kt = 0; kt < 6; ++kt) {
            f32x16 sacc;
#pragma unroll
            for (int i = 0; i < 16; ++i) sacc[i] = 0.f;
#pragma unroll
            for (int s = 0; s < 4; ++s) { const s16x8 kf = *(const LAS s16x8*)(KL + (kt * 32 + r) * 144 + (16 * s + 8 * h) * 2); sacc = MFMA32(kf, qf[s], sacc); }
            const bool on = kt >= kt0;
#pragma unroll
            for (int i = 0; i < 16; ++i) { const float v = sacc[i] * 0.125f + bth[kt * 32 + crow(i, h) - 128 - (w >> 2) * 32 - r + 191]; sc[kt][i] = on ? v : -1e30f; m = fmaxf(m, sc[kt][i]); }
        }
        m = fmaxf(m, __shfl_xor(m, 32));
        float l = 0.f;
#pragma unroll
        for (int kt = 0; kt < 6; ++kt)
#pragma unroll
            for (int i = 0; i < 16; ++i) { const float p = fast_exp(sc[kt][i] - m); sc[kt][i] = p; l += p; }
        l += __shfl_xor(l, 32); l += fast_exp(sink - m);
        f32x16 o[2];
#pragma unroll
        for (int db = 0; db < 2; ++db)
#pragma unroll
            for (int i = 0; i < 16; ++i) o[db][i] = 0.f;
#pragma unroll
        for (int kt = 0; kt < 6; ++kt) {
            const s16x8 p0 = pack8(sc[kt], 0), p1 = pack8(sc[kt], 1);
#pragma unroll
            for (int db = 0; db < 2; ++db) {
                const LAS unsigned char* tb = trb + kt * 32 * 192 + db * 64;
                const s16x8 v0 = tr_frag(tb, tb + 8 * 192);
                const s16x8 v1 = tr_frag(tb + 16 * 192, tb + 24 * 192);
                o[db] = MFMA32(v0, p0, o[db]); o[db] = MFMA32(v1, p1, o[db]); }
        }
        const float inv = 1.0f / l;
#pragma unroll
        for (int db = 0; db < 2; ++db)
#pragma unroll
            for (int g = 0; g < 4; ++g) { v2u wv; wv.x = pkbf(o[db][4 * g] * inv, o[db][4 * g + 1] * inv); wv.y = pkbf(o[db][4 * g + 2] * inv, o[db][4 * g + 3] * inv);
                *(GAS v2u*)(Y + (size_t)(q0 + r) * DM + head * 64 + db * 32 + 8 * g + 4 * h) = wv; }
        __syncthreads();
    }
}

#ifndef REP_P0
#define REP_P0 1
#endif
#define REP_LRU 1
#define REP_SWA 1
#define REP_FIX 1
#define REP_SB 1
struct Args { const float* in[19]; float* out; unsigned char* ws; int ph_lo, ph_hi; };
__global__ void __launch_bounds__(NWAVES * 64, 2) hybrid_fwd(Args args) {
    extern __shared__ __attribute__((aligned(16))) unsigned char lds[];
    Frame F;
    F.lds = (LAS unsigned char*)lds;
    F.tid = threadIdx.x; F.lane = F.tid & 63; F.wave = __builtin_amdgcn_readfirstlane(F.tid >> 6);
    F.G = gridDim.x;
#pragma unroll
    for (int i = 0; i < 19; ++i) F.in[i] = args.in[i];
    F.out = args.out; F.ws = args.ws;
    unsigned char* ws = args.ws;
    for (int u = F.tid; u < (LDS_BYTES - LDSCTL_OFF) / 4; u += NWAVES * 64) ((LAS unsigned*)(F.lds + LDSCTL_OFF))[u] = 0u;
    __syncthreads();
    const int lo = args.ph_lo, hi = args.ph_hi;
    XcdBarrier bar; bar.bar = (unsigned*)(ws + WS_CTL) + CW_BAR; bar.x = 0; bar.st = nullptr;
    if (hi - lo > 1) bar = xcd_barrier_post((unsigned*)(ws + WS_CTL) + CW_BAR, (volatile LAS unsigned*)(F.lds + MISC_OFF) + 8);
#define IN(k) (lo <= (k) && (k) < hi)
#define SEAM(k) do { if (IN(k) && IN((k) + 1)) xcd_barrier(bar); } while (0)
    bf16* XN = (bf16*)(ws + WS_XN); bf16* Yb = (bf16*)(ws + WS_Y); bf16* PROJ = (bf16*)(ws + WS_PROJ); bf16* ACT = (bf16*)(ws + WS_ACT); float* SS = (float*)(ws + WS_SS);

    if (IN(0)) { for (int rep = 0; rep < REP_P0; ++rep) { p0_prologue(F); if (rep + 1 < REP_P0) xcd_barrier(bar); } } SEAM(0);
    if (IN(1)) { pg8::Gemm g{XN, (const bf16*)(ws + WS_WIN0), SEQ, EVEN_IN, DM}; pg8::StaticOrder S; S.init(SEQ, EVEN_IN, F.G, (int)blockIdx.x);
        pg8::EpiBf16<0> E{PROJ, EVEN_IN, SS, 64, SEQ}; pg8::gemm_phase<pg8::EpiBf16<0>, pg8::StaticOrder, true, true>(F.lds + RING_OFF, g, S, E); } SEAM(1);
    if (IN(2)) { for (int rep = 0; rep < REP_LRU; ++rep) { lru_local(F); if (rep + 1 < REP_LRU) xcd_barrier(bar); } for (int rep = 0; rep < REP_SWA; ++rep) { swa_attn(F); if (rep + 1 < REP_SWA) xcd_barrier(bar); } } SEAM(2);
    if (IN(3)) { for (int rep = 0; rep < REP_FIX; ++rep) { lru_fix(F); if (rep + 1 < REP_FIX) xcd_barrier(bar); } } SEAM(3);
    if (IN(4)) { pg8::Gemm g{Yb, (const bf16*)(ws + WS_WOUT0), SEQ, DM, DM}; pg8::StaticOrder S; S.init(SEQ, DM, F.G, (int)blockIdx.x);
        pg8::EpiRes<true> E{F.in[IN_X], XN, SS, DM}; pg8::gemm_phase<pg8::EpiRes<true>, pg8::StaticOrder, false, true>(F.lds + RING_OFF, g, S, E); } SEAM(4);
    if (IN(5)) { pg8::Gemm g{XN, (const bf16*)(ws + WS_WUP0), SEQ, DFF, DM}; pg8::StaticOrder S; S.init(SEQ, DFF, F.G, (int)blockIdx.x);
        pg8::EpiBf16<1> E{ACT, DFF, SS, 0, 0}; pg8::gemm_phase<pg8::EpiBf16<1>, pg8::StaticOrder, true, true>(F.lds + RING_OFF, g, S, E); } SEAM(5);
    if (IN(6)) { pg8::Gemm g{ACT, (const bf16*)(ws + WS_WDN0), SEQ, DM, DFF}; pg8::StaticOrder S; S.init(SEQ, DM, F.G, (int)blockIdx.x);
        pg8::EpiRes<false> E{nullptr, XN, SS, DM}; pg8::gemm_phase<pg8::EpiRes<false>, pg8::StaticOrder, false, true>(F.lds + RING_OFF, g, S, E); } SEAM(6);
    if (IN(7)) { pg8::Gemm g{XN, (const bf16*)(ws + WS_WIN1), SEQ, ODD_IN, DM}; pg8::StaticOrder S; S.init(SEQ, ODD_IN, F.G, (int)blockIdx.x);
        pg8::EpiBf16<0> E{PROJ, ODD_IN, SS, 128, SEQ}; pg8::gemm_phase<pg8::EpiBf16<0>, pg8::StaticOrder, true, true>(F.lds + RING_OFF, g, S, E); } SEAM(7);
    if (IN(8)) { for (int rep = 0; rep < REP_SB; ++rep) { sb_attn(F); if (rep + 1 < REP_SB) xcd_barrier(bar); } } SEAM(8);
    if (IN(9)) { pg8::Gemm g{Yb, (const bf16*)(ws + WS_WOUT1), SEQ, DM, DM}; pg8::StaticOrder S; S.init(SEQ, DM, F.G, (int)blockIdx.x);
        pg8::EpiRes<false> E{nullptr, XN, SS, DM}; pg8::gemm_phase<pg8::EpiRes<false>, pg8::StaticOrder, false, true>(F.lds + RING_OFF, g, S, E); } SEAM(9);
    if (IN(10)) { pg8::Gemm g{XN, (const bf16*)(ws + WS_WUP1), SEQ, DFF, DM}; pg8::StaticOrder S; S.init(SEQ, DFF, F.G, (int)blockIdx.x);
        pg8::EpiBf16<1> E{ACT, DFF, SS, 0, 0}; pg8::gemm_phase<pg8::EpiBf16<1>, pg8::StaticOrder, true, true>(F.lds + RING_OFF, g, S, E); } SEAM(10);
    if (IN(11)) { pg8::Gemm g{ACT, (const bf16*)(ws + WS_WDN1), SEQ, DM, DFF}; pg8::StaticOrder S; S.init(SEQ, DM, F.G, (int)blockIdx.x);
        pg8::EpiRes<false> E{nullptr, XN, SS, DM}; pg8::gemm_phase<pg8::EpiRes<false>, pg8::StaticOrder, false, true>(F.lds + RING_OFF, g, S, E); } SEAM(11);
    if (IN(12)) { final_norm(F); }
#undef IN
#undef SEAM
}

extern "C" void kernel_launch(void* const* d_in, const int* in_sizes, int n_in, void* d_out, int out_size, void* d_ws, size_t ws_size, hipStream_t stream) {
    static int grid = 0;
    if (grid == 0) {
        if (n_in != 19 || in_sizes[0] != SEQ * DM || out_size != SEQ * DM || ws_size < WS_END) { fprintf(stderr, "kernel_launch: unexpected shapes (n_in %d, in0 %d, out %d, ws %zu); nothing launched\n", n_in, n_in > 0 ? in_sizes[0] : -1, out_size, ws_size); grid = -1; return; }
        int dev = 0, cus = 0, per_cu = 0;
        if (hipGetDevice(&dev) != hipSuccess || hipDeviceGetAttribute(&cus, hipDeviceAttributeMultiprocessorCount, dev) != hipSuccess) { fprintf(stderr, "kernel_launch: device query failed\n"); grid = -1; return; }
        if (hipFuncSetAttribute((const void*)hybrid_fwd, hipFuncAttributeMaxDynamicSharedMemorySize, LDS_BYTES) != hipSuccess) { fprintf(stderr, "kernel_launch: hipFuncSetAttribute failed\n"); grid = -1; return; }
        if (hipOccupancyMaxActiveBlocksPerMultiprocessor(&per_cu, (const void*)hybrid_fwd, NWAVES * 64, LDS_BYTES) != hipSuccess || per_cu < 1) { fprintf(stderr, "kernel_launch: occupancy query reports %d workgroups per CU\n", per_cu); per_cu = 1; }
        (void)hipGetLastError();
        grid = cus;
        if (grid != 256) fprintf(stderr, "kernel_launch: %d CUs; the residual GEMM phases need exactly 256 workgroups\n", grid);
    }
    if (grid < 0) return;
    (void)hipMemsetAsync((char*)d_ws + WS_CTL, 0, CTL_ZERO_BYTES, stream);
    Args a{};
    for (int i = 0; i < 19; ++i) a.in[i] = (const float*)d_in[i];
    a.out = (float*)d_out; a.ws = (unsigned char*)d_ws;
#if MK_N_LAUNCHES == 1
    a.ph_lo = 0; a.ph_hi = N_PHASES;
    hipLaunchKernelGGL(hybrid_fwd, dim3(grid), dim3(NWAVES * 64), LDS_BYTES, stream, a);
#else
    for (int p = 0; p < N_PHASES; ++p) { a.ph_lo = p; a.ph_hi = p + 1; hipLaunchKernelGGL(hybrid_fwd, dim3(grid), dim3(NWAVES * 64), LDS_BYTES, stream, a); }
#endif
}
```

```cpp
#include <hip/hip_runtime.h>
#include <cstdio>
#include <cstdint>
namespace pg8 {
#define PG8_LAS __attribute__((address_space(3)))
typedef unsigned short bf16_t;
typedef short bf16x8 __attribute__((ext_vector_type(8)));
typedef float f32x4 __attribute__((ext_vector_type(4)));
typedef unsigned u32x4 __attribute__((ext_vector_type(4)));
constexpr int BM = 256, BK = 64, HALF = 128, HTB = HALF * BK * 2  , STAGE_BYTES = 8 * HTB, NXCD = 8, WGM = 8;

__host__ __device__ __forceinline__ int lds_byte(int r, int c) { const int st = (r >> 4) * 2 + (c >> 5), rr = r & 15, cc = c & 31, ob = rr * 64 + cc * 2; return st * 1024 + (ob ^ (((ob >> 9) & 1) << 5)); }
__host__ __device__ __forceinline__ void stage_rc(int b, int& R, int& C) { const int st = b / 1024, sb = b % 1024, swz = sb ^ (((sb >> 9) & 1) << 5); R = (st >> 1) * 16 + swz / 64; C = (st & 1) * 32 + (swz % 64) / 2; }
__host__ __device__ __forceinline__ int perm32(int rho) { const int n = rho >> 4, i = rho & 15; return 8 * (i >> 2) + 4 * n + (i & 3); }

struct Unit { int pm, pn; };
struct Gemm { const bf16_t* A; const bf16_t* Bt; int M, N, K; };

struct StaticOrder {
    int nM, nN, nwg, G, c;
    __host__ __device__ void init(int M, int N, int G_, int c_) { nM = M / BM; nN = N / BM; nwg = nM * nN; G = G_; c = c_; }
    __host__ __device__ bool next(int i, Unit& u) const {
        const long L = (long)i * G + c; if (L >= nwg) return false;
        int wgid = (int)L; { const int q = nwg / NXCD, r = nwg % NXCD, xcd = wgid % NXCD, off = wgid / NXCD; wgid = (xcd < r ? xcd * (q + 1) : r * (q + 1) + (xcd - r) * q) + off; }
        const int nig = WGM * nN, gid = wgid / nig, fm = gid * WGM, gsz = (nM - fm) < WGM ? (nM - fm) : WGM;
        u.pm = fm + ((wgid % nig) % gsz); u.pn = (wgid % nig) / gsz; return true;
    }
    __device__ __forceinline__ void a_ready(const Unit&) const {}
    __device__ __forceinline__ void done(const Unit&) const {}
};

__device__ __forceinline__ unsigned cvt_pk_bf16(float lo, float hi) { unsigned r; asm volatile("v_cvt_pk_bf16_f32 %0, %1, %2" : "=v"(r) : "v"(lo), "v"(hi)); return r; }
constexpr float RMS_EPS = 1e-6f;
__device__ __forceinline__ float row_rstd(const float* ss, int r) {
    const f32x4 a = *(const f32x4*)(ss + (size_t)r * 8), b = *(const f32x4*)(ss + (size_t)r * 8 + 4);
    const float s = ((a[0] + a[1]) + (a[2] + a[3])) + ((b[0] + b[1]) + (b[2] + b[3]));
    return 1.0f / sqrtf(s * (1.0f / 2048.0f) + RMS_EPS);
}
template <int ACT> struct EpiBf16 {
    static constexpr bool PERM = true, AFTER_DRAIN = false;
    bf16_t* O; int ldc; const float* ss; int grp_w, nrows;
    __device__ __forceinline__ void operator()(const f32x4 (&acc)[2][2][4][2], const Unit& u, int wr, int wc, int fr, int fq) const {
        const int row0 = u.pm * BM + wr * 64 + fr, col0 = u.pn * BM + wc * 32 + 8 * fq;
#pragma unroll
        for (int ai = 0; ai < 2; ++ai)
#pragma unroll
            for (int m = 0; m < 4; ++m) { const int r = row0 + ai * HALF + m * 16; const float rs = ss ? row_rstd(ss, r) : 1.0f;
                bf16_t* rowp = grp_w ? O + ((size_t)(col0 / grp_w) * nrows + r) * grp_w + (col0 % grp_w) : O + (size_t)r * ldc + col0;
                const size_t bjstep = grp_w ? (size_t)(HALF / grp_w) * nrows * grp_w : (size_t)HALF;
#pragma unroll
                for (int bj = 0; bj < 2; ++bj) { f32x4 v0 = acc[ai][bj][m][0] * rs, v1 = acc[ai][bj][m][1] * rs;
                    if (ACT == 1) {
#pragma unroll
                        for (int j = 0; j < 4; ++j) { const float a = fmaxf(v0[j], 0.f), b = fmaxf(v1[j], 0.f); v0[j] = a * a; v1[j] = b * b; } }
                    u32x4 w; w.x = cvt_pk_bf16(v0[0], v0[1]); w.y = cvt_pk_bf16(v0[2], v0[3]); w.z = cvt_pk_bf16(v1[0], v1[1]); w.w = cvt_pk_bf16(v1[2], v1[3]);
                    *(u32x4*)(rowp + bj * bjstep) = w; } }
    }
};
template <bool BASE_F32> struct EpiRes {
    static constexpr bool PERM = true, AFTER_DRAIN = true;
    const float* base; bf16_t* xn; float* ss; int ldc;
    __device__ __forceinline__ void operator()(const f32x4 (&)[2][2][4][2], const Unit&, int, int, int, int) const {}
    __device__ __forceinline__ void fused(f32x4 (&acc)[2][2][4][2], const Unit& u, int wr, int wc, int fr, int fq, PG8_LAS unsigned char* lds, int wid, int lane) const {
        PG8_LAS float* P = (PG8_LAS float*)lds;
#pragma unroll
        for (int ai = 0; ai < 2; ++ai)
#pragma unroll
            for (int m = 0; m < 4; ++m) { const int rl = ai * HALF + wr * 64 + m * 16 + fr; const size_t off = (size_t)(u.pm * BM + rl) * ldc + u.pn * BM + wc * 32 + 8 * fq; float s = 0.f;
#pragma unroll
                for (int bj = 0; bj < 2; ++bj) { f32x4 b0, b1;
                    if (BASE_F32) { b0 = *(const f32x4*)(base + off + bj * HALF); b1 = *(const f32x4*)(base + off + bj * HALF + 4); }
                    else { const u32x4 q = *(const u32x4*)(xn + off + bj * HALF);
                        b0 = (f32x4){__builtin_bit_cast(float, q.x << 16), __builtin_bit_cast(float, q.x & 0xffff0000u), __builtin_bit_cast(float, q.y << 16), __builtin_bit_cast(float, q.y & 0xffff0000u)};
                        b1 = (f32x4){__builtin_bit_cast(float, q.z << 16), __builtin_bit_cast(float, q.z & 0xffff0000u), __builtin_bit_cast(float, q.w << 16), __builtin_bit_cast(float, q.w & 0xffff0000u)}; }
                    const f32x4 v0 = acc[ai][bj][m][0] + b0, v1 = acc[ai][bj][m][1] + b1;
                    u32x4 w; w.x = cvt_pk_bf16(v0[0], v0[1]); w.y = cvt_pk_bf16(v0[2], v0[3]); w.z = cvt_pk_bf16(v1[0], v1[1]); w.w = cvt_pk_bf16(v1[2], v1[3]);
                    *(u32x4*)(xn + off + bj * HALF) = w;
                    s += ((v0[0] * v0[0] + v0[1] * v0[1]) + (v0[2] * v0[2] + v0[3] * v0[3])) + ((v1[0] * v1[0] + v1[1] * v1[1]) + (v1[2] * v1[2] + v1[3] * v1[3])); }
                s += __shfl_xor(s, 16); s += __shfl_xor(s, 32);
                if (fq == 0) P[rl * 4 + wc] = s; }
        asm volatile("s_waitcnt lgkmcnt(0)" ::: "memory"); __builtin_amdgcn_s_barrier(); asm volatile("" ::: "memory");
        const int t = wid * 64 + lane;
        if (t < 256) { const f32x4 p = *(const PG8_LAS f32x4*)(P + t * 4); ss[(size_t)(u.pm * BM + t) * 8 + u.pn] = (p[0] + p[1]) + (p[2] + p[3]); }
        asm volatile("s_waitcnt lgkmcnt(0)" ::: "memory"); __builtin_amdgcn_s_barrier(); asm volatile("" ::: "memory");
    }
};

template <class Epi, class Sched, bool ALIGN_EPI = false, bool SP2 = false>
__device__ __forceinline__ void gemm_phase(PG8_LAS unsigned char* lds, const Gemm g, const Sched& S, const Epi& E) {
    const int tid = threadIdx.x, wid = __builtin_amdgcn_readfirstlane(tid >> 6), lane = tid & 63, wr = wid >> 2, wc = wid & 3, fr = lane & 15, fq = lane >> 4;
    const int K = g.K, nt = K / BK;
    unsigned voffA[2], voffB[2];
#pragma unroll
    for (int i = 0; i < 2; ++i) { int R, C; stage_rc(tid * 16 + i * 8192, R, C); const int Rb = Epi::PERM ? ((R & ~31) + perm32(R & 31)) : R;
        voffA[i] = (unsigned)(R * K + C) * 2u; voffB[i] = (unsigned)(Rb * K + C) * 2u; }
    const size_t kstep = (size_t)(BK * 2);
    const size_t hstep = (size_t)HALF * K * 2;
    const size_t tstep = 2 * hstep;
    const unsigned ldsw = (unsigned)wid * 1024u;
    const int aoff = lds_byte(wr * 64 + fr, fq * 8), boff = lds_byte(wc * 32 + fr, fq * 8);
#define PG8_SA(b, h) (((b) * 2 + (h)) * HTB)
#define PG8_SB(b, h) ((4 + (b) * 2 + (h)) * HTB)
#define PG8_STAGE(bufoff, gbase, voff) do { _Pragma("unroll") for (int _i = 0; _i < 2; ++_i) \
        __builtin_amdgcn_global_load_lds((const unsigned*)((const char*)(gbase) + (voff)[_i]), (PG8_LAS unsigned*)(lds + (bufoff) + ldsw + _i * 8192), 16, 0, 0); } while (0)
#define PG8_LDA(dst, b, h) do { _Pragma("unroll") for (int m = 0; m < 4; ++m) _Pragma("unroll") for (int k = 0; k < 2; ++k) dst[m][k] = *(const PG8_LAS bf16x8*)(lds + PG8_SA(b, h) + aoff + m * 2048 + k * 1024); } while (0)
#define PG8_LDB(dst, b, h) do { _Pragma("unroll") for (int n = 0; n < 2; ++n) _Pragma("unroll") for (int k = 0; k < 2; ++k) dst[n][k] = *(const PG8_LAS bf16x8*)(lds + PG8_SB(b, h) + boff + n * 2048 + k * 1024); } while (0)
#define PG8_MMA(ai, bj, At, Bt) do { __builtin_amdgcn_s_setprio(1); _Pragma("unroll") for (int m = 0; m < 4; ++m) _Pragma("unroll") for (int n = 0; n < 2; ++n) _Pragma("unroll") for (int k = 0; k < 2; ++k) \
        acc[ai][bj][m][n] = __builtin_amdgcn_mfma_f32_16x16x32_bf16(Bt[n][k], At[m][k], acc[ai][bj][m][n], 0, 0, 0); __builtin_amdgcn_s_setprio(0); } while (0)
#define PG8_WAIT_V(n) asm volatile("s_waitcnt vmcnt(" #n ")" ::: "memory")
#define PG8_WAIT_L(n) asm volatile("s_waitcnt lgkmcnt(" #n ")" ::: "memory")
#define PG8_BAR __builtin_amdgcn_s_barrier()
#define PG8_SCHED __builtin_amdgcn_sched_barrier(0)
    Unit cur, nxt; int ui = 0;
    if (!S.next(0, cur)) return;
    f32x4 acc[2][2][4][2];
#pragma unroll
    for (int a = 0; a < 2; ++a)
#pragma unroll
        for (int b = 0; b < 2; ++b)
#pragma unroll
            for (int m = 0; m < 4; ++m)
#pragma unroll
                for (int n = 0; n < 2; ++n) acc[a][b][m][n] = (f32x4){0.f, 0.f, 0.f, 0.f};
    bf16x8 At[4][2], B0[2][2], B1[2][2];
    const char* cA = (const char*)g.A + (size_t)cur.pm * tstep; const char* cB = (const char*)g.Bt + (size_t)cur.pn * tstep;
    S.a_ready(cur);
    if constexpr (SP2) {
        PG8_STAGE(PG8_SB(0, 0), cB, voffB); PG8_STAGE(PG8_SB(0, 1), cB + hstep, voffB); PG8_STAGE(PG8_SA(0, 0), cA, voffA); PG8_STAGE(PG8_SA(0, 1), cA + hstep, voffA);
        if (wr == 1) PG8_BAR;
        PG8_WAIT_V(2); PG8_BAR;
        PG8_STAGE(PG8_SB(1, 0), cB + kstep, voffB); PG8_STAGE(PG8_SA(1, 0), cA + kstep, voffA); PG8_STAGE(PG8_SB(1, 1), cB + hstep + kstep, voffB);
        PG8_WAIT_V(6); PG8_BAR;
    } else {
        PG8_STAGE(PG8_SB(0, 0), cB, voffB); PG8_STAGE(PG8_SA(0, 0), cA, voffA); PG8_STAGE(PG8_SB(0, 1), cB + hstep, voffB); PG8_STAGE(PG8_SA(0, 1), cA + hstep, voffA);
        if (wr == 1) PG8_BAR;
        PG8_WAIT_V(4); PG8_BAR;
        PG8_STAGE(PG8_SB(1, 0), cB + kstep, voffB); PG8_STAGE(PG8_SA(1, 0), cA + kstep, voffA); PG8_STAGE(PG8_SB(1, 1), cB + hstep + kstep, voffB);
        PG8_WAIT_V(6); PG8_BAR;
    }
    for (;;) {
        const bool has_next = S.next(ui + 1, nxt);
        const char* nA = has_next ? (const char*)g.A + (size_t)nxt.pm * tstep : cA; const char* nB = has_next ? (const char*)g.Bt + (size_t)nxt.pn * tstep : cB;
        for (int t = 0; t < nt; t += 2) {
            const bool last = (t == nt - 2);
            const char* a1 = cA + (size_t)(t + 1) * kstep;
            const char* a2 = last ? nA : cA + (size_t)(t + 2) * kstep; const char* b2 = last ? nB : cB + (size_t)(t + 2) * kstep;
            const char* a3 = a2 + kstep; const char* b3 = b2 + kstep;
            if (last && has_next) S.a_ready(nxt);
            if constexpr (SP2) {
            PG8_LDB(B0, 0, 0); PG8_LDB(B1, 0, 1); PG8_SCHED; PG8_LDA(At, 0, 0); PG8_STAGE(PG8_SA(1, 1), a1 + hstep, voffA);
            PG8_WAIT_V(8); PG8_WAIT_L(0); PG8_BAR; PG8_MMA(0, 0, At, B0); PG8_MMA(0, 1, At, B1); PG8_BAR; PG8_SCHED;
            PG8_LDA(At, 0, 1); PG8_STAGE(PG8_SB(0, 0), b2, voffB); PG8_STAGE(PG8_SB(0, 1), b2 + hstep, voffB); PG8_STAGE(PG8_SA(0, 0), a2, voffA);
            PG8_WAIT_V(8); PG8_WAIT_L(0); PG8_BAR; PG8_MMA(1, 0, At, B0); PG8_MMA(1, 1, At, B1); PG8_BAR; PG8_SCHED;
            PG8_LDB(B0, 1, 0); PG8_LDB(B1, 1, 1); PG8_SCHED; PG8_LDA(At, 1, 0); PG8_STAGE(PG8_SA(0, 1), a2 + hstep, voffA);
            PG8_WAIT_V(8); PG8_WAIT_L(0); PG8_BAR; PG8_MMA(0, 0, At, B0); PG8_MMA(0, 1, At, B1); PG8_BAR; PG8_SCHED;
            PG8_LDA(At, 1, 1); PG8_STAGE(PG8_SB(1, 0), b3, voffB); PG8_STAGE(PG8_SB(1, 1), b3 + hstep, voffB); PG8_STAGE(PG8_SA(1, 0), a3, voffA);
            PG8_WAIT_V(8); PG8_WAIT_L(0); PG8_BAR; PG8_MMA(1, 0, At, B0); PG8_MMA(1, 1, At, B1); PG8_BAR; PG8_SCHED;
            } else {
            PG8_LDB(B0, 0, 0); PG8_SCHED; PG8_LDA(At, 0, 0); PG8_STAGE(PG8_SA(1, 1), a1 + hstep, voffA);
            PG8_WAIT_L(8); PG8_BAR; PG8_WAIT_L(0); PG8_MMA(0, 0, At, B0); PG8_BAR; PG8_SCHED;
            PG8_LDB(B1, 0, 1); PG8_STAGE(PG8_SB(0, 0), b2, voffB);
            PG8_BAR; PG8_WAIT_L(0); PG8_MMA(0, 1, At, B1); PG8_BAR;
            PG8_LDA(At, 0, 1); PG8_STAGE(PG8_SA(0, 0), a2, voffA);
            PG8_BAR; PG8_WAIT_L(0); PG8_MMA(1, 0, At, B0); PG8_BAR; PG8_SCHED;
            PG8_STAGE(PG8_SB(0, 1), b2 + hstep, voffB);
            PG8_WAIT_V(6); PG8_BAR; PG8_MMA(1, 1, At, B1); PG8_BAR;
            PG8_LDB(B0, 1, 0); PG8_SCHED; PG8_LDA(At, 1, 0); PG8_STAGE(PG8_SA(0, 1), a2 + hstep, voffA);
            PG8_WAIT_L(8); PG8_BAR; PG8_WAIT_L(0); PG8_MMA(0, 0, At, B0); PG8_BAR; PG8_SCHED;
            PG8_LDB(B1, 1, 1); PG8_STAGE(PG8_SB(1, 0), b3, voffB);
            PG8_BAR; PG8_WAIT_L(0); PG8_MMA(0, 1, At, B1); PG8_BAR;
            PG8_LDA(At, 1, 1); PG8_STAGE(PG8_SA(1, 0), a3, voffA);
            PG8_BAR; PG8_WAIT_L(0); PG8_MMA(1, 0, At, B0); PG8_BAR; PG8_SCHED;
            PG8_STAGE(PG8_SB(1, 1), b3 + hstep, voffB);
            PG8_WAIT_V(6); PG8_BAR; PG8_MMA(1, 1, At, B1); PG8_BAR;
            }
        }
        if constexpr (ALIGN_EPI) { if (wr == 0) PG8_BAR; }
        if constexpr (!Epi::AFTER_DRAIN) { E(acc, cur, wr, wc, fr, fq); S.done(cur); }
        if (!has_next) break;
#pragma unroll
        for (int a = 0; a < 2; ++a)
#pragma unroll
            for (int b = 0; b < 2; ++b)
#pragma unroll
                for (int m = 0; m < 4; ++m)
#pragma unroll
                    for (int n = 0; n < 2; ++n) acc[a][b][m][n] = (f32x4){0.f, 0.f, 0.f, 0.f};
        cur = nxt; cA = nA; cB = nB; ++ui;
        if constexpr (ALIGN_EPI) { if (wr == 1) PG8_BAR; }
    }
    PG8_WAIT_V(0);
    if constexpr (!ALIGN_EPI) { if (wr == 0) PG8_BAR; }
    PG8_BAR;
    if constexpr (Epi::AFTER_DRAIN) { E.fused(acc, cur, wr, wc, fr, fq, lds, wid, lane); S.done(cur); }
#undef PG8_SA
#undef PG8_SB
#undef PG8_STAGE
#undef PG8_LDA
#undef PG8_LDB
#undef PG8_MMA
#undef PG8_WAIT_V
#undef PG8_WAIT_L
#undef PG8_BAR
#undef PG8_SCHED
}
}

constexpr int NWAVES = 8;
constexpr int SEQ = 8192, DM = 2048, DFF = 8192, EVEN_IN = 3584, ODD_IN = 6144;
constexpr int OFF_K = 1024, OFF_V = 1280, OFF_X = 1536, OFF_G = 2560;
#ifndef MK_N_LAUNCHES
#define MK_N_LAUNCHES 1
#endif
constexpr int N_PHASES = 13;
constexpr size_t MiB = 1u << 20;
constexpr size_t WS_CTL = 0, CTL_ZERO_BYTES = 64 * 1024;
constexpr size_t WS_SS = 1 * MiB;
constexpr size_t WS_BT = 1 * MiB + 512 * 1024;
constexpr size_t WS_GWT = 1 * MiB + 768 * 1024;
constexpr size_t WS_WIN0 = 2 * MiB, WS_WOUT0 = 16 * MiB, WS_WUP0 = 24 * MiB, WS_WDN0 = 56 * MiB, WS_WIN1 = 88 * MiB, WS_WOUT1 = 112 * MiB, WS_WUP1 = 120 * MiB, WS_WDN1 = 152 * MiB;
constexpr size_t WS_XN = 184 * MiB;
constexpr size_t WS_Y = 216 * MiB;
constexpr size_t WS_PROJ = 248 * MiB;
constexpr size_t WS_HL = 344 * MiB, WS_PA = 376 * MiB;
constexpr size_t WS_ACT = 248 * MiB;
constexpr size_t WS_END = 408 * MiB;
constexpr int CW_BAR = 1024;

constexpr int RING_OFF = 0, RING_BYTES = 131072;
constexpr int LDSCTL_OFF = RING_BYTES, MISC_OFF = LDSCTL_OFF + 320;
constexpr int LDS_BYTES = 147456;

#define GAS __attribute__((address_space(1)))
#define LAS __attribute__((address_space(3)))
typedef unsigned short bf16;
typedef unsigned v4u __attribute__((ext_vector_type(4)));
typedef unsigned v2u __attribute__((ext_vector_type(2)));
typedef float f32x4 __attribute__((ext_vector_type(4)));
#define LDS_WAIT() asm volatile("s_waitcnt lgkmcnt(0)" ::: "memory")
#define VM_WAIT() asm volatile("s_waitcnt vmcnt(0)" ::: "memory")
__device__ __forceinline__ unsigned f2bf(float f) { unsigned u = __builtin_bit_cast(unsigned, f); return (u + 0x7fffu + ((u >> 16) & 1u)) >> 16; }
__device__ __forceinline__ unsigned pk2(float lo, float hi) { return f2bf(lo) | (f2bf(hi) << 16); }
__device__ __forceinline__ float bflo(unsigned w) { return __builtin_bit_cast(float, w << 16); }
__device__ __forceinline__ float bfhi(unsigned w) { return __builtin_bit_cast(float, w & 0xffff0000u); }

#define XB_TMO      128
#define XB_XCNT(j)  (256  + 64 * (j))
#define XB_XSUB(j)  (1280 + 64 * (j))
#define XB_XGEN(j)  (2304 + 64 * (j))
#define XB_TOP      3328
#define XB_TOPGEN   3392
#define XCD_BAR_WORDS 3456
#define XB_SPIN_CAP (1u << 22)

__device__ __forceinline__ unsigned xb_ld(unsigned* p)              { return __hip_atomic_load(p, __ATOMIC_RELAXED, __HIP_MEMORY_SCOPE_AGENT); }
__device__ __forceinline__ unsigned xb_add(unsigned* p, unsigned v) { return __hip_atomic_fetch_add(p, v, __ATOMIC_RELAXED, __HIP_MEMORY_SCOPE_AGENT); }
__device__ __forceinline__ unsigned xb_xcc_id() { return (unsigned)__builtin_amdgcn_s_getreg((3 << 11) | 20) & 0xFu; }
#define XB_SPIN(cond, bar) do { unsigned _sp = 0; while (cond) { __builtin_amdgcn_s_sleep(1); \
    if ((++_sp & 255u) == 0u) { if (xb_ld(&(bar)[XB_TMO])) break; if (_sp > XB_SPIN_CAP) { atomicAdd(&(bar)[XB_TMO], 1u); break; } } } } while (0)

struct XcdBarrier {
    unsigned* bar; unsigned x;
    volatile LAS unsigned* st;
};

__device__ __forceinline__ XcdBarrier xcd_barrier_post(unsigned* bar, volatile LAS unsigned* st) {
    XcdBarrier b; b.bar = bar; b.x = xb_xcc_id(); b.st = st;
    if (threadIdx.x == 0) (void)xb_add(&bar[XB_XCNT(b.x)], 1u);
    return b;
}
__device__ __forceinline__ void xcd_barrier_complete(unsigned* bar, unsigned x, unsigned& nloc, unsigned& nx) {
    const unsigned G = gridDim.x * gridDim.y * gridDim.z;
    unsigned sum, cnt, mine, sp = 0u;
    for (;;) {
        sum = 0u; cnt = 0u; mine = 0u;
#pragma unroll
        for (unsigned j = 0; j < 16; ++j) { const unsigned c = xb_ld(&bar[XB_XCNT(j)]); sum += c; cnt += (c > 0u) ? 1u : 0u; mine = (j == x) ? c : mine; }
        if (sum == G) break;
        __builtin_amdgcn_s_sleep(1);
        if ((++sp & 255u) == 0u) { if (xb_ld(&bar[XB_TMO])) break; if (sp > XB_SPIN_CAP) { atomicAdd(&bar[XB_TMO], 1u); break; } }
    }
    nloc = mine > 0u ? mine : 1u; nx = cnt > 0u ? cnt : 1u;
}

__device__ __forceinline__ void xcd_barrier(const XcdBarrier& b) {
    asm volatile("s_waitcnt vmcnt(0)" ::: "memory");
    __syncthreads();
    if (threadIdx.x == 0) {
        unsigned* bar = b.bar;
        __builtin_amdgcn_s_waitcnt(0);
        unsigned nloc = b.st[0], nx = b.st[1];
        if (nloc == 0u) { xcd_barrier_complete(bar, b.x, nloc, nx); b.st[0] = nloc; b.st[1] = nx; }
        const unsigned old = xb_add(&bar[XB_XSUB(b.x)], 1u);
        const unsigned gen = old / nloc;
        if (old + 1u == (gen + 1u) * nloc) {
            __builtin_amdgcn_fence(__ATOMIC_RELEASE, "agent");
            asm volatile("s_waitcnt vmcnt(0)" ::: "memory");
            const unsigned og = xb_add(&bar[XB_TOP], 1u);
            const unsigned tg = og / nx;
            if (og + 1u == (tg + 1u) * nx) xb_add(&bar[XB_TOPGEN], 1u);
            else XB_SPIN(xb_ld(&bar[XB_TOPGEN]) == tg, bar);
            __builtin_amdgcn_fence(__ATOMIC_ACQUIRE, "agent");
            xb_add(&bar[XB_XGEN(b.x)], 1u);
            asm volatile("s_waitcnt vmcnt(0)" ::: "memory");
        } else {
            XB_SPIN(xb_ld(&bar[XB_XGEN(b.x)]) == gen, bar);
            __builtin_amdgcn_fence(__ATOMIC_ACQUIRE, "agent");
            asm volatile("s_waitcnt vmcnt(0)" ::: "memory");
        }
    }
    __syncthreads();
}
struct Frame {
    LAS unsigned char* lds;
    int tid, lane, wave, G;
    const float* in[19]; float* out; unsigned char* ws;
};
#define IN_X 0
#define IN_RELB 1
#define IN_NMIX 2
#define IN_EWIN 3
#define IN_CONVW 4
#define IN_CONVB 5
#define IN_GAW 6
#define IN_GAB 7
#define IN_GXW 8
#define IN_GXB 9
#define IN_LAMBDA 10
#define IN_SINKS 11
#define IN_EWOUT 12
#define IN_OWIN 13
#define IN_OWOUT 14
#define IN_NMLP 15
#define IN_WUP 16
#define IN_WDOWN 17
#define IN_FNORM 18

__device__ __forceinline__ float wave_sum(float v) {
#pragma unroll
    for (int o = 1; o < 64; o <<= 1) v += __shfl_xor(v, o);
    return v;
}
struct P0Tile { const float* W; const float* gain; bf16* WT; int K, N, k0, n0; };
__device__ __forceinline__ void p0_tile_load(const P0Tile& t, int lane, f32x4 (&v)[16]) {
    const GAS f32x4* p = (const GAS f32x4*)(t.W + (size_t)(t.k0 + (lane >> 4)) * t.N + t.n0 + 4 * (lane & 15));
#pragma unroll
    for (int i = 0; i < 16; ++i) v[i] = p[(size_t)i * t.N];
}
__device__ __forceinline__ void p0_tile_store(const P0Tile& t, int lane, const f32x4 (&v)[16], LAS float* scr) {
#pragma unroll
    for (int i = 0; i < 16; ++i) { const int kk = (lane >> 4) + 4 * i; *(LAS f32x4*)(scr + kk * 64 + ((4 * (lane & 15)) ^ (4 * ((kk >> 3) & 7)))) = v[i]; }
    LDS_WAIT(); asm volatile("" ::: "memory");
    const int kc = lane & 7;
    float g[8];
    if (t.gain) { const f32x4 a = *(const GAS f32x4*)(t.gain + t.k0 + 8 * kc), b = *(const GAS f32x4*)(t.gain + t.k0 + 8 * kc + 4); g[0] = a[0]; g[1] = a[1]; g[2] = a[2]; g[3] = a[3]; g[4] = b[0]; g[5] = b[1]; g[6] = b[2]; g[7] = b[3]; }
    else {
#pragma unroll
        for (int e = 0; e < 8; ++e) g[e] = 1.0f; }
#pragma unroll
    for (int j = 0; j < 8; ++j) { const int n = (lane >> 3) + 8 * j; const LAS float* s = scr + (8 * kc) * 64 + (n ^ (4 * kc));
        v4u o; o.x = pk2(s[0] * g[0], s[64] * g[1]); o.y = pk2(s[128] * g[2], s[192] * g[3]); o.z = pk2(s[256] * g[4], s[320] * g[5]); o.w = pk2(s[384] * g[6], s[448] * g[7]);
        *(GAS v4u*)(t.WT + (size_t)(t.n0 + n) * t.K + t.k0 + 8 * kc) = o; }
    LDS_WAIT(); asm volatile("" ::: "memory");
}
__device__ __forceinline__ int t5_bucket(int rel) {
    const int ret = rel > 0 ? 16 : 0, n = rel < 0 ? -rel : rel;
    if (n < 8) return ret + n;
    int large = 8 + (31 - __builtin_clz((unsigned)(n * n))) - 6; if (large > 15) large = 15;
    return ret + large;
}
__device__ __forceinline__ void p0_prologue(Frame& F) {
    LAS float* scr = (LAS float*)(F.lds + RING_OFF + F.wave * 16384);
    const int gw = blockIdx.x * NWAVES + F.wave, NGW = F.G * NWAVES;
    unsigned char* ws = F.ws;
    constexpr int T_IN0 = (DM / 64) * (EVEN_IN / 64), T_OUT = (DM / 64) * (DM / 64), T_UP = (DM / 64) * (DFF / 64), T_DN = (DFF / 64) * (DM / 64), T_IN1 = (DM / 64) * (ODD_IN / 64);
    constexpr int NTILES = T_IN0 + T_IN1 + 2 * T_OUT + 2 * T_UP + 2 * T_DN;
#define P0_DESC(it, t) do { int r_ = (it); \
        if (r_ < T_IN0) { t.W = F.in[IN_EWIN]; t.gain = F.in[IN_NMIX]; t.WT = (bf16*)(ws + WS_WIN0); t.K = DM; t.N = EVEN_IN; } else { r_ -= T_IN0; \
        if (r_ < T_OUT) { t.W = F.in[IN_EWOUT]; t.gain = nullptr; t.WT = (bf16*)(ws + WS_WOUT0); t.K = DM; t.N = DM; } else { r_ -= T_OUT; \
        if (r_ < T_UP) { t.W = F.in[IN_WUP]; t.gain = F.in[IN_NMLP]; t.WT = (bf16*)(ws + WS_WUP0); t.K = DM; t.N = DFF; } else { r_ -= T_UP; \
        if (r_ < T_DN) { t.W = F.in[IN_WDOWN]; t.gain = nullptr; t.WT = (bf16*)(ws + WS_WDN0); t.K = DFF; t.N = DM; } else { r_ -= T_DN; \
        if (r_ < T_IN1) { t.W = F.in[IN_OWIN]; t.gain = F.in[IN_NMIX] + DM; t.WT = (bf16*)(ws + WS_WIN1); t.K = DM; t.N = ODD_IN; } else { r_ -= T_IN1; \
        if (r_ < T_OUT) { t.W = F.in[IN_OWOUT]; t.gain = nullptr; t.WT = (bf16*)(ws + WS_WOUT1); t.K = DM; t.N = DM; } else { r_ -= T_OUT; \
        if (r_ < T_UP) { t.W = F.in[IN_WUP] + (size_t)DM * DFF; t.gain = F.in[IN_NMLP] + DM; t.WT = (bf16*)(ws + WS_WUP1); t.K = DM; t.N = DFF; } else { r_ -= T_UP; \
        t.W = F.in[IN_WDOWN] + (size_t)DFF * DM; t.gain = nullptr; t.WT = (bf16*)(ws + WS_WDN1); t.K = DFF; t.N = DM; } } } } } } } \
        const int nb_ = t.N / 64; t.k0 = 64 * (r_ / nb_); t.n0 = 64 * (r_ % nb_); } while (0)
    {
        f32x4 va[16], vb[16]; P0Tile ta, tb;
        int it = gw;
        if (it < NTILES) { P0_DESC(it, ta); p0_tile_load(ta, F.lane, va); }
        while (it < NTILES) {
            const int itn = it + NGW; const bool more = itn < NTILES;
            if (more) { P0_DESC(itn, tb); p0_tile_load(tb, F.lane, vb); }
            p0_tile_store(ta, F.lane, va, scr);
            if (more) { ta = tb;
#pragma unroll
                for (int i = 0; i < 16; ++i) va[i] = vb[i]; }
            it = itn;
        }
    }
#undef P0_DESC
    bf16* XN = (bf16*)(ws + WS_XN); float* SS = (float*)(ws + WS_SS);
    for (int m = gw; m < SEQ; m += NGW) {
        const GAS f32x4* xr = (const GAS f32x4*)(F.in[IN_X] + (size_t)m * DM) + F.lane;
        f32x4 v[8]; float s = 0.f;
#pragma unroll
        for (int j = 0; j < 8; ++j) { v[j] = xr[64 * j]; s += (v[j].x * v[j].x + v[j].y * v[j].y) + (v[j].z * v[j].z + v[j].w * v[j].w); }
        s = wave_sum(s);
        GAS v2u* o8 = (GAS v2u*)(XN + (size_t)m * DM) + F.lane;
#pragma unroll
        for (int j = 0; j < 8; ++j) { v2u w; w.x = pk2(v[j].x, v[j].y); w.y = pk2(v[j].z, v[j].w); o8[64 * j] = w; }
        if (F.lane < 8) SS[(size_t)m * 8 + F.lane] = F.lane == 0 ? s : 0.f;
    }
    float* BT = (float*)(ws + WS_BT);
    for (int i = blockIdx.x * 512 + F.tid; i < 16 * 256; i += F.G * 512) { const int head = i >> 8, rel = (i & 255) - 191; BT[i] = F.in[IN_RELB][t5_bucket(rel) * 16 + head]; }
    bf16* GWT = (bf16*)(ws + WS_GWT);
    for (int i = blockIdx.x * 512 + F.tid; i < 2 * 16 * 64 * 64; i += F.G * 512) { const int gate = i >> 16, hb = (i >> 12) & 15, jo = (i >> 6) & 63, ii = i & 63;
        GWT[i] = (bf16)f2bf(F.in[gate ? IN_GXW : IN_GAW][(size_t)(hb * 64 + ii) * 64 + jo]); }
}

__device__ __forceinline__ void ld8(const bf16* p, float (&o)[8]) { const v4u w = *(const GAS v4u*)p; o[0] = bflo(w.x); o[1] = bfhi(w.x); o[2] = bflo(w.y); o[3] = bfhi(w.y); o[4] = bflo(w.z); o[5] = bfhi(w.z); o[6] = bflo(w.w); o[7] = bfhi(w.w); }
__device__ __forceinline__ void swa_naive(Frame& F) {
    const bf16* PROJ = (const bf16*)(F.ws + WS_PROJ); bf16* Y = (bf16*)(F.ws + WS_Y); const float* BT = (const float*)(F.ws + WS_BT);
    for (int idx = blockIdx.x * 512 + F.tid; idx < SEQ * 16; idx += F.G * 512) {
        const int head = idx >> 13, tok = idx & (SEQ - 1), kvh = head >> 2, c = tok >> 6;
        float q[64], acc[64];
#pragma unroll
        for (int i = 0; i < 8; ++i) { float t[8]; ld8(PROJ + (size_t)tok * EVEN_IN + head * 64 + 8 * i, t);
#pragma unroll
            for (int j = 0; j < 8; ++j) { q[8 * i + j] = t[j] * 0.125f; acc[8 * i + j] = 0.f; } }
        float m = F.in[IN_SINKS][head], l = 1.0f;
        const int k0 = c >= 2 ? (c - 2) * 64 : 0, k1 = (c + 1) * 64;
        const float* bt = BT + head * 256;
        for (int j = k0; j < k1; ++j) {
            const bf16* kp = PROJ + (size_t)j * EVEN_IN + OFF_K + kvh * 64; float s = 0.f;
#pragma unroll
            for (int i = 0; i < 8; ++i) { float t[8]; ld8(kp + 8 * i, t);
#pragma unroll
                for (int e = 0; e < 8; ++e) s += q[8 * i + e] * t[e]; }
            s += bt[j - tok + 191];
            const float mn = fmaxf(m, s), corr = expf(m - mn), p = expf(s - mn);
            l = l * corr + p; m = mn;
            const bf16* vp = PROJ + (size_t)j * EVEN_IN + OFF_V + kvh * 64;
#pragma unroll
            for (int i = 0; i < 8; ++i) { float t[8]; ld8(vp + 8 * i, t);
#pragma unroll
                for (int e = 0; e < 8; ++e) acc[8 * i + e] = acc[8 * i + e] * corr + p * t[e]; }
        }
        const float inv = 1.0f / l;
#pragma unroll
        for (int i = 0; i < 8; ++i) { v4u w; w.x = pk2(acc[8 * i] * inv, acc[8 * i + 1] * inv); w.y = pk2(acc[8 * i + 2] * inv, acc[8 * i + 3] * inv); w.z = pk2(acc[8 * i + 4] * inv, acc[8 * i + 5] * inv); w.w = pk2(acc[8 * i + 6] * inv, acc[8 * i + 7] * inv);
            *(GAS v4u*)(Y + (size_t)tok * DM + head * 64 + 8 * i) = w; }
    }
}
__device__ __forceinline__ float softplusf(float z) { return fmaxf(z, 0.f) + log1pf(expf(-fabsf(z))); }
__device__ __forceinline__ float sigmoidf_(float z) { return 1.0f / (1.0f + expf(-z)); }
__device__ __forceinline__ float gelu_tanh(float x) { const float u = 0.7978845608028654f * (x + 0.044715f * x * x * x); return 0.5f * x * (1.0f + tanhf(u)); }
__device__ __forceinline__ void lru_naive(Frame& F) {
    if (blockIdx.x >= 16 || F.wave != 0) return;
    const bf16* PROJ = (const bf16*)(F.ws + WS_PROJ); bf16* Y = (bf16*)(F.ws + WS_Y);
    const int hb = blockIdx.x, lane = F.lane, c = hb * 64 + lane;
    float Wa[64], Wx[64];
#pragma unroll
    for (int i = 0; i < 64; ++i) { Wa[i] = F.in[IN_GAW][(size_t)(hb * 64 + i) * 64 + lane]; Wx[i] = F.in[IN_GXW][(size_t)(hb * 64 + i) * 64 + lane]; }
    const float ba = F.in[IN_GAB][c], bx = F.in[IN_GXB][c], cb = F.in[IN_CONVB][c];
    const float cw0 = F.in[IN_CONVW][c], cw1 = F.in[IN_CONVW][1024 + c], cw2 = F.in[IN_CONVW][2048 + c], cw3 = F.in[IN_CONVW][3072 + c];
    const float sp8 = 8.0f * softplusf(-F.in[IN_LAMBDA][c]);
    float x1 = 0.f, x2 = 0.f, x3 = 0.f, h = 0.f;
    for (int t0 = 0; t0 < SEQ; t0 += 8) {
        float xb[8], g[8];
#pragma unroll
        for (int u = 0; u < 8; ++u) { xb[u] = bflo((unsigned)PROJ[(size_t)(t0 + u) * EVEN_IN + OFF_X + c]); g[u] = bflo((unsigned)PROJ[(size_t)(t0 + u) * EVEN_IN + OFF_G + c]); }
#pragma unroll
        for (int u = 0; u < 8; ++u) {
            const float xt = xb[u], xc = cb + cw0 * x3 + cw1 * x2 + cw2 * x1 + cw3 * xt; x3 = x2; x2 = x1; x1 = xt;
            float ra = ba, rx = bx; const int xci = __builtin_bit_cast(int, xc);
#pragma unroll
            for (int i = 0; i < 64; ++i) { const float xi = __builtin_bit_cast(float, __builtin_amdgcn_readlane(xci, i)); ra += xi * Wa[i]; rx += xi * Wx[i]; }
            const float r = sigmoidf_(ra), ig = sigmoidf_(rx), log_a = -r * sp8, a = expf(log_a), mult = sqrtf(-expm1f(2.0f * log_a));
            h = a * h + mult * (ig * xc);
            Y[(size_t)(t0 + u) * DM + 1024 + c] = (bf16)f2bf(gelu_tanh(g[u]) * h);
        }
    }
}
__device__ __forceinline__ void sb_naive(Frame& F) {
    const bf16* PROJ = (const bf16*)(F.ws + WS_PROJ); bf16* Y = (bf16*)(F.ws + WS_Y);
    const int gt = blockIdx.x * 512 + F.tid, half = gt & 1;
    for (int pidx = gt >> 1; pidx < SEQ * 16; pidx += (F.G * 512) >> 1) {
        const int head = pidx >> 13, tok = pidx & (SEQ - 1);
        float q[64], acc[64];
#pragma unroll
        for (int i = 0; i < 8; ++i) { float t[8]; ld8(PROJ + (size_t)tok * ODD_IN + head * 128 + half * 64 + 8 * i, t);
#pragma unroll
            for (int j = 0; j < 8; ++j) { q[8 * i + j] = t[j] * 0.08838834764831845f; acc[8 * i + j] = 0.f; } }
        float stick = 0.f;
        for (int j = tok - 1; j >= 0; --j) {
            const bf16* kp = PROJ + (size_t)j * ODD_IN + 2048 + head * 128 + half * 64; float s = 0.f;
#pragma unroll
            for (int i = 0; i < 8; ++i) { float t[8]; ld8(kp + 8 * i, t);
#pragma unroll
                for (int e = 0; e < 8; ++e) s += q[8 * i + e] * t[e]; }
            const float z = s + __shfl_xor(s, 1);
            const float lk = -softplusf(z), w = expf(z + lk + stick);
            const bf16* vp = PROJ + (size_t)j * ODD_IN + 4096 + head * 128 + half * 64;
#pragma unroll
            for (int i = 0; i < 8; ++i) { float t[8]; ld8(vp + 8 * i, t);
#pragma unroll
                for (int e = 0; e < 8; ++e) acc[8 * i + e] += w * t[e]; }
            stick += lk;
            if (stick < -104.0f) break;
        }
#pragma unroll
        for (int i = 0; i < 8; ++i) { v4u w; w.x = pk2(acc[8 * i], acc[8 * i + 1]); w.y = pk2(acc[8 * i + 2], acc[8 * i + 3]); w.z = pk2(acc[8 * i + 4], acc[8 * i + 5]); w.w = pk2(acc[8 * i + 6], acc[8 * i + 7]);
            *(GAS v4u*)(Y + (size_t)tok * DM + head * 128 + half * 64 + 8 * i) = w; }
    }
}
__device__ __forceinline__ void final_norm(Frame& F) {
    const int gw = blockIdx.x * NWAVES + F.wave, NGW = F.G * NWAVES;
    const bf16* XN = (const bf16*)(F.ws + WS_XN); const float* SS = (const float*)(F.ws + WS_SS);
    const GAS f32x4* gp = (const GAS f32x4*)F.in[IN_FNORM] + 2 * F.lane;
    for (int m = gw; m < SEQ; m += NGW) {
        const GAS v4u* xr = (const GAS v4u*)(XN + (size_t)m * DM) + F.lane;
        GAS f32x4* orow = (GAS f32x4*)(F.out + (size_t)m * DM) + 2 * F.lane;
        const f32x4 sa = *(const GAS f32x4*)(SS + (size_t)m * 8), sb = *(const GAS f32x4*)(SS + (size_t)m * 8 + 4);
        const float rstd = 1.0f / sqrtf((((sa[0] + sa[1]) + (sa[2] + sa[3])) + ((sb[0] + sb[1]) + (sb[2] + sb[3]))) * (1.0f / DM) + 1e-6f);
        v4u v[4];
#pragma unroll
        for (int j = 0; j < 4; ++j) v[j] = xr[64 * j];
#pragma unroll
        for (int j = 0; j < 4; ++j) { const f32x4 g0 = gp[128 * j], g1 = gp[128 * j + 1];
            orow[128 * j] = (f32x4){bflo(v[j].x) * rstd * g0[0], bfhi(v[j].x) * rstd * g0[1], bflo(v[j].y) * rstd * g0[2], bfhi(v[j].y) * rstd * g0[3]};
            orow[128 * j + 1] = (f32x4){bflo(v[j].z) * rstd * g1[0], bfhi(v[j].z) * rstd * g1[1], bflo(v[j].w) * rstd * g1[2], bfhi(v[j].w) * rstd * g1[3]}; }
    }
}
typedef float f32x16 __attribute__((ext_vector_type(16)));
typedef short s16x8 __attribute__((ext_vector_type(8)));
typedef short s16x4 __attribute__((ext_vector_type(4)));
typedef __bf16 bf16x2v __attribute__((ext_vector_type(2)));
#define MFMA32(a, b, c) __builtin_amdgcn_mfma_f32_32x32x16_bf16((a), (b), (c), 0, 0, 0)
__device__ __forceinline__ int crow(int i, int h) { return (i & 3) + 8 * (i >> 2) + 4 * h; }
__device__ __forceinline__ unsigned pkbf(float a, float b) { bf16x2v v; v.x = (__bf16)a; v.y = (__bf16)b; return __builtin_bit_cast(unsigned, v); }
__device__ __forceinline__ s16x8 pack8(const float (&p)[16], int s) {
    v4u w; w.x = pkbf(p[8 * s], p[8 * s + 1]); w.y = pkbf(p[8 * s + 2], p[8 * s + 3]); w.z = pkbf(p[8 * s + 4], p[8 * s + 5]); w.w = pkbf(p[8 * s + 6], p[8 * s + 7]);
    return __builtin_bit_cast(s16x8, w);
}
__device__ __forceinline__ s16x8 tr_frag(const LAS unsigned char* p0, const LAS unsigned char* p1) {
    const s16x4 lo = __builtin_amdgcn_ds_read_tr16_b64_v4i16((LAS s16x4*)p0), hi = __builtin_amdgcn_ds_read_tr16_b64_v4i16((LAS s16x4*)p1);
    return __builtin_shufflevector(lo, hi, 0, 1, 2, 3, 4, 5, 6, 7);
}
__device__ __forceinline__ float ex2(float x) { return __builtin_amdgcn_exp2f(x); }
__device__ __forceinline__ float lg2(float x) { return __builtin_amdgcn_logf(x); }
__device__ __forceinline__ float fast_exp(float x) { return ex2(x * 1.4426950408889634f); }
__device__ __forceinline__ float fast_softplus(float z) { return fmaxf(z, 0.f) + 0.6931471805599453f * lg2(1.0f + ex2(-1.4426950408889634f * fabsf(z))); }
__device__ __forceinline__ float fast_sigmoid(float z) { return __builtin_amdgcn_rcpf(1.0f + ex2(-1.4426950408889634f * z)); }
#define G0(g, tok) (PROJ + ((size_t)(g) * SEQ + (tok)) * 64)
#define G1(g, tok) (PROJ + ((size_t)(g) * SEQ + (tok)) * 128)

__device__ __forceinline__ float neg_expm1(float x) {
    const float p = -x * (1.0f + x * (0.5f + x * (0.16666667f + x * (0.041666668f + x * (0.0083333338f + x * 0.0013888889f)))));
    return x > -0.25f ? p : 1.0f - fast_exp(x);
}
__device__ __forceinline__ void lru_local(Frame& F) {
    const bf16* PROJ = (const bf16*)(F.ws + WS_PROJ); float* HL = (float*)(F.ws + WS_HL); float* PA = (float*)(F.ws + WS_PA); const bf16* GWT = (const bf16*)(F.ws + WS_GWT);
    LAS unsigned char* xc16 = F.lds;
    LAS float* xc32 = (LAS float*)(F.lds + 18432);
    LAS float* comp = (LAS float*)(F.lds + 18432 + 34816);
    const int tid = F.tid, lane = F.lane, w = F.wave, ts = w & 3, ch = w >> 2, r = lane & 31, h = lane >> 5;
    const int hb = blockIdx.x & 15;
    const int tp = tid >> 3, cg = tid & 7, cb8 = hb * 64 + cg * 8;
    float cw[4][8], cbias[8];
#pragma unroll
    for (int d = 0; d < 4; ++d) { const f32x4 a = *(const GAS f32x4*)(F.in[IN_CONVW] + d * 1024 + cb8), b = *(const GAS f32x4*)(F.in[IN_CONVW] + d * 1024 + cb8 + 4);
        cw[d][0] = a[0]; cw[d][1] = a[1]; cw[d][2] = a[2]; cw[d][3] = a[3]; cw[d][4] = b[0]; cw[d][5] = b[1]; cw[d][6] = b[2]; cw[d][7] = b[3]; }
    { const f32x4 a = *(const GAS f32x4*)(F.in[IN_CONVB] + cb8), b = *(const GAS f32x4*)(F.in[IN_CONVB] + cb8 + 4);
      cbias[0] = a[0]; cbias[1] = a[1]; cbias[2] = a[2]; cbias[3] = a[3]; cbias[4] = b[0]; cbias[5] = b[1]; cbias[6] = b[2]; cbias[7] = b[3]; }
    s16x8 wa[4], wx[4];
#pragma unroll
    for (int s = 0; s < 4; ++s) { wa[s] = *(const GAS s16x8*)(GWT + (size_t)((0 * 16 + hb) * 64 + ch * 32 + r) * 64 + 16 * s + 8 * h); wx[s] = *(const GAS s16x8*)(GWT + (size_t)((1 * 16 + hb) * 64 + ch * 32 + r) * 64 + 16 * s + 8 * h); }
    const int c = hb * 64 + ch * 32 + r;
    const float gab = F.in[IN_GAB][c], gxb = F.in[IN_GXB][c], sp8 = 8.0f * softplusf(-F.in[IN_LAMBDA][c]);
    const int nun = (1024 - (int)blockIdx.x + F.G - 1) / F.G;
    v4u xin[5];
#define LRU_LOAD(kk) do { const int t_ = (kk) * 128 + 2 * tp; _Pragma("unroll") for (int d = 0; d < 5; ++d) { const int row_ = t_ - 3 + d; xin[d] = *(const GAS v4u*)(G0(24 + hb, row_ < 0 ? 0 : row_) + cg * 8); if (row_ < 0) xin[d] = (v4u){0u, 0u, 0u, 0u}; } } while (0)
    LRU_LOAD((int)blockIdx.x >> 4);
    for (int ui = 0; ui < nun; ++ui) {
        const int k = ((int)blockIdx.x + ui * F.G) >> 4, t0 = k * 128;
        {
            float xv[5][8];
#pragma unroll
            for (int d = 0; d < 5; ++d) { xv[d][0] = bflo(xin[d].x); xv[d][1] = bfhi(xin[d].x); xv[d][2] = bflo(xin[d].y); xv[d][3] = bfhi(xin[d].y); xv[d][4] = bflo(xin[d].z); xv[d][5] = bfhi(xin[d].z); xv[d][6] = bflo(xin[d].w); xv[d][7] = bfhi(xin[d].w); }
#pragma unroll
            for (int tk = 0; tk < 2; ++tk) { float xc[8];
#pragma unroll
                for (int e = 0; e < 8; ++e) xc[e] = cbias[e] + cw[0][e] * xv[tk][e] + cw[1][e] * xv[tk + 1][e] + cw[2][e] * xv[tk + 2][e] + cw[3][e] * xv[tk + 3][e];
                const int tt = 2 * tp + tk;
                *(LAS f32x4*)(xc32 + tt * 68 + cg * 8) = (f32x4){xc[0], xc[1], xc[2], xc[3]}; *(LAS f32x4*)(xc32 + tt * 68 + cg * 8 + 4) = (f32x4){xc[4], xc[5], xc[6], xc[7]};
                v4u o; o.x = pkbf(xc[0], xc[1]); o.y = pkbf(xc[2], xc[3]); o.z = pkbf(xc[4], xc[5]); o.w = pkbf(xc[6], xc[7]);
                *(LAS v4u*)(xc16 + tt * 144 + cg * 16) = o; }
        }
        __syncthreads();
        if (ui + 1 < nun) LRU_LOAD(((int)blockIdx.x + (ui + 1) * F.G) >> 4);
        __builtin_amdgcn_sched_barrier(0);
        f32x16 acc_a, acc_x;
#pragma unroll
        for (int i = 0; i < 16; ++i) { acc_a[i] = 0.f; acc_x[i] = 0.f; }
#pragma unroll
        for (int s = 0; s < 4; ++s) { const s16x8 af = *(const LAS s16x8*)(xc16 + (ts * 32 + r) * 144 + (16 * s + 8 * h) * 2); acc_a = MFMA32(af, wa[s], acc_a); acc_x = MFMA32(af, wx[s], acc_x); }
        float pa[16], hl[16], gA[4], gU[4];
#pragma unroll
        for (int g = 0; g < 4; ++g) { float A = 1.f, U = 0.f;
#pragma unroll
            for (int e = 0; e < 4; ++e) { const int i = 4 * g + e; const float xcv = xc32[(ts * 32 + crow(i, h)) * 68 + ch * 32 + r];
                const float rg = fast_sigmoid(acc_a[i] + gab), ig = fast_sigmoid(acc_x[i] + gxb), log_a = -rg * sp8, a = fast_exp(log_a), mult = sqrtf(neg_expm1(2.0f * log_a));
                U = a * U + mult * (ig * xcv); A *= a; pa[i] = A; hl[i] = U; }
            gA[g] = A; gU[g] = U; }
        float PAc = 1.f, Hc = 0.f;
#pragma unroll
        for (int g = 0; g < 4; ++g) { const float oA = __shfl_xor(gA[g], 32), oU = __shfl_xor(gU[g], 32);
            const float fA = h ? oA : gA[g], fU = h ? oU : gU[g], sA = h ? gA[g] : oA, sU = h ? gU[g] : oU;
            const float c0P = PAc, c0H = Hc; Hc = fA * Hc + fU; PAc *= fA; const float c1P = PAc, c1H = Hc; Hc = sA * Hc + sU; PAc *= sA;
            const float ciP = h ? c1P : c0P, ciH = h ? c1H : c0H;
#pragma unroll
            for (int e = 0; e < 4; ++e) { const int i = 4 * g + e; hl[i] += pa[i] * ciH; pa[i] *= ciP; } }
        if (h == 0) { comp[(ts * 64 + ch * 32 + r) * 2] = PAc; comp[(ts * 64 + ch * 32 + r) * 2 + 1] = Hc; }
        __syncthreads();
        float PAin = 1.f, Hin = 0.f;
        for (int t2 = 0; t2 < ts; ++t2) { const float A2 = comp[(t2 * 64 + ch * 32 + r) * 2], U2 = comp[(t2 * 64 + ch * 32 + r) * 2 + 1]; Hin = A2 * Hin + U2; PAin *= A2; }
#pragma unroll
        for (int i = 0; i < 16; ++i) { const size_t o = ((size_t)hb * SEQ + t0 + ts * 32 + crow(i, h)) * 64 + ch * 32 + r; HL[o] = hl[i] + pa[i] * Hin; PA[o] = pa[i] * PAin; }
        __syncthreads();
    }
#undef LRU_LOAD
}
__device__ __forceinline__ void lru_fix(Frame& F) {
    const bf16* PROJ = (const bf16*)(F.ws + WS_PROJ); const float* HL = (const float*)(F.ws + WS_HL); const float* PA = (const float*)(F.ws + WS_PA); bf16* Y = (bf16*)(F.ws + WS_Y);
    const int gw = blockIdx.x * NWAVES + F.wave, NGW = F.G * NWAVES;
    for (int it = gw; it < 2048; it += NGW) {
        const int cgp = it & 15, sub = (it >> 4) & 1, k = it >> 5, c = cgp * 64 + F.lane;
        float H = 0.f;
        for (int kb = 0; kb < k; kb += 16) {
            float a[16], u[16];
#pragma unroll
            for (int j = 0; j < 16; ++j) { const int kk = (kb + j < k) ? kb + j : 0; const size_t row = ((size_t)cgp * SEQ + kk * 128 + 127) * 64 + F.lane; a[j] = PA[row]; u[j] = HL[row]; }
#pragma unroll
            for (int j = 0; j < 16; ++j) { const bool on = kb + j < k; H = on ? a[j] * H + u[j] : H; }
        }
#pragma unroll
        for (int tb = 0; tb < 64; tb += 32) {
            float hv[32], pv[32], gv[32];
#pragma unroll
            for (int tt = 0; tt < 32; ++tt) { const int t = k * 128 + sub * 64 + tb + tt; const size_t o = ((size_t)cgp * SEQ + t) * 64 + F.lane; hv[tt] = HL[o]; pv[tt] = PA[o]; gv[tt] = bflo((unsigned)G0(40 + cgp, t)[F.lane]); }
#pragma unroll
            for (int tt = 0; tt < 32; ++tt) { const int t = k * 128 + sub * 64 + tb + tt; const float g = gv[tt], u2 = 1.5957691216057308f * (g + 0.044715f * g * g * g), ge = g * fast_sigmoid(u2);
                Y[(size_t)t * DM + 1024 + c] = (bf16)f2bf(ge * (hv[tt] + pv[tt] * H)); }
        }
    }
}
template <bool DIAG> __device__ __forceinline__ void sb_tile(const f32x16& sacc, int r, int h, float& run, float (&pw)[16]) {
    float q[16], sp[16], G[4];
#pragma unroll
    for (int g = 0; g < 4; ++g) { float gs = 0.f;
#pragma unroll
        for (int e = 0; e < 4; ++e) { const int i = 4 * g + e; const float y = sacc[i] * 0.12751743082459868f;
            const float lg = lg2(1.0f + ex2(-fabsf(y))); float s_ = fmaxf(y, 0.f) + lg, q_ = fminf(y, 0.f) - lg;
            if (DIAG) { const bool valid = crow(i, h) < r; s_ = valid ? s_ : 0.f; q_ = valid ? q_ : -1e30f; }
            sp[i] = s_; q[i] = q_; gs += s_; }
        G[g] = gs; }
#pragma unroll
    for (int g = 3; g >= 0; --g) { const float og = __shfl_xor(G[g], 32);
        const float s1 = run; run += h ? G[g] : og;
        const float s0 = run; run += h ? og : G[g];
        float ex = h ? s1 : s0;
#pragma unroll
        for (int e = 3; e >= 0; --e) { const int i = 4 * g + e; pw[i] = ex2(q[i] - ex); ex += sp[i]; } }
}
__device__ __forceinline__ void sb_attn(Frame& F) {
    const bf16* PROJ = (const bf16*)(F.ws + WS_PROJ); bf16* Y = (bf16*)(F.ws + WS_Y);
    LAS unsigned char* vt = F.lds + F.wave * 16384;
    const int lane = F.lane, r = lane & 31, h = lane >> 5;
    const int gw = blockIdx.x * NWAVES + F.wave, NGW = F.G * NWAVES;
    const int troff = (4 * h + ((lane & 15) >> 2)) * 256 + (16 * ((lane >> 4) & 1) + 4 * (lane & 3)) * 2;
    for (int it = gw; it < 4096; it += NGW) {
        const int head = (it >> 3) & 15, qb = ((it >> 7) << 3) + (it & 7), q0 = qb * 32;
        s16x8 qf[8];
#pragma unroll
        for (int s = 0; s < 8; ++s) qf[s] = *(const GAS s16x8*)(G1(head, q0 + r) + 16 * s + 8 * h);
        f32x16 o[4];
#pragma unroll
        for (int db = 0; db < 4; ++db)
#pragma unroll
            for (int i = 0; i < 16; ++i) o[db][i] = 0.f;
        float carry = 0.f;
        s16x8 kf[8];
#pragma unroll
        for (int s = 0; s < 8; ++s) kf[s] = *(const GAS s16x8*)(G1(16 + head, q0 + r) + 16 * s + 8 * h);
        {   v4u v0[8];
#pragma unroll
            for (int i = 0; i < 8; ++i) v0[i] = *(const GAS v4u*)(G1(32 + head, q0) + (lane + 64 * i) * 8);
#pragma unroll
            for (int i = 0; i < 8; ++i) *(LAS v4u*)(vt + (lane + 64 * i) * 16) = v0[i];
            LDS_WAIT(); }
        int cur = 0;
        for (int kt = qb; kt >= 0; --kt) {
            const int kbn = (kt > 0 ? kt - 1 : 0) * 32;
            f32x16 sacc;
#pragma unroll
            for (int i = 0; i < 16; ++i) sacc[i] = 0.f;
#pragma unroll
            for (int s = 0; s < 8; ++s) sacc = MFMA32(kf[s], qf[s], sacc);
#pragma unroll
            for (int s = 0; s < 8; ++s) kf[s] = *(const GAS s16x8*)(G1(16 + head, kbn + r) + 16 * s + 8 * h);
            v4u vreg[8];
#pragma unroll
            for (int i = 0; i < 8; ++i) vreg[i] = *(const GAS v4u*)(G1(32 + head, kbn) + (lane + 64 * i) * 8);
            __builtin_amdgcn_sched_barrier(0);
            float pw[16];
            if (kt == qb) sb_tile<true>(sacc, r, h, carry, pw); else sb_tile<false>(sacc, r, h, carry, pw);
            const s16x8 p0 = pack8(pw, 0), p1 = pack8(pw, 1);
            const LAS unsigned char* trb = vt + cur * 8192 + troff;
#pragma unroll
            for (int db = 0; db < 4; ++db) {
                const s16x8 v0 = tr_frag(trb + db * 64, trb + 8 * 256 + db * 64);
                const s16x8 v1 = tr_frag(trb + 16 * 256 + db * 64, trb + 24 * 256 + db * 64);
                o[db] = MFMA32(v0, p0, o[db]); o[db] = MFMA32(v1, p1, o[db]); }
            cur ^= 1;
#pragma unroll
            for (int i = 0; i < 8; ++i) *(LAS v4u*)(vt + cur * 8192 + (lane + 64 * i) * 16) = vreg[i];
            LDS_WAIT();
            if (__all(carry > 150.04f)) break;
        }
#pragma unroll
        for (int db = 0; db < 4; ++db)
#pragma unroll
            for (int g = 0; g < 4; ++g) { v2u w; w.x = pkbf(o[db][4 * g], o[db][4 * g + 1]); w.y = pkbf(o[db][4 * g + 2], o[db][4 * g + 3]);
                *(GAS v2u*)(Y + (size_t)(q0 + r) * DM + head * 128 + db * 32 + 8 * g + 4 * h) = w; }
    }
}
__device__ __forceinline__ void swa_attn(Frame& F) {
    const bf16* PROJ = (const bf16*)(F.ws + WS_PROJ); bf16* Y = (bf16*)(F.ws + WS_Y); const float* BT = (const float*)(F.ws + WS_BT);
    LAS unsigned char* KL = F.lds + 57344;
    LAS unsigned char* VL = KL + 27648;
    LAS float* btl = (LAS float*)(VL + 36864);
    const int tid = F.tid, lane = F.lane, w = F.wave, r = lane & 31, h = lane >> 5;
    const int kvh = blockIdx.x & 3;
    btl[tid] = BT[kvh * 1024 + tid]; btl[tid + 512] = BT[kvh * 1024 + 512 + tid];
    const int head = kvh * 4 + (w & 3);
    const float sink = F.in[IN_SINKS][head];
    const LAS float* bth = btl + (w & 3) * 256;
    const LAS unsigned char* trb = VL + (4 * h + ((lane & 15) >> 2)) * 192 + (16 * ((lane >> 4) & 1) + 4 * (lane & 3)) * 2;
    v4u kreg[3], vreg[3];
    const int nun = (512 - (int)blockIdx.x + F.G - 1) / F.G;
    {   const int c = blockIdx.x >> 2, kbase = (c - 2) * 64;
#pragma unroll
        for (int i = 0; i < 3; ++i) { const int j = tid + 512 * i; int row = kbase + (j >> 3); row = row < 0 ? 0 : row;
            kreg[i] = *(const GAS v4u*)(G0(16 + kvh, row) + (j & 7) * 8); vreg[i] = *(const GAS v4u*)(G0(20 + kvh, row) + (j & 7) * 8); } }
    for (int ui = 0; ui < nun; ++ui) {
        const int wu = blockIdx.x + ui * F.G, c = wu >> 2, q0 = c * 64 + (w >> 2) * 32, kbase = (c - 2) * 64, kt0 = c >= 2 ? 0 : (2 - c) * 2;
#pragma unroll
        for (int i = 0; i < 3; ++i) { const int j = tid + 512 * i; *(LAS v4u*)(KL + (j >> 3) * 144 + (j & 7) * 16) = kreg[i]; *(LAS v4u*)(VL + (j >> 3) * 192 + (j & 7) * 16) = vreg[i]; }
        __syncthreads();
        if (ui + 1 < nun) { const int c2 = (wu + F.G) >> 2, kb2 = (c2 - 2) * 64;
#pragma unroll
            for (int i = 0; i < 3; ++i) { const int j = tid + 512 * i; int row = kb2 + (j >> 3); row = row < 0 ? 0 : row;
                kreg[i] = *(const GAS v4u*)(G0(16 + kvh, row) + (j & 7) * 8); vreg[i] = *(const GAS v4u*)(G0(20 + kvh, row) + (j & 7) * 8); } }
        s16x8 qf[4];
#pragma unroll
        for (int s = 0; s < 4; ++s) qf[s] = *(const GAS s16x8*)(G0(head, q0 + r) + 16 * s + 8 * h);
        __builtin_amdgcn_sched_barrier(0);
        float sc[6][16]; float m = sink;
#pragma unroll
        for (int kt = 0; kt < 6; ++kt) {
            f32x16 sacc;
#pragma unroll
            for (int i = 0; i < 16; ++i) sacc[i] = 0.f;
#pragma unroll
            for (int s = 0; s < 4; ++s) { const s16x8 kf = *(const LAS s16x8*)(KL + (kt * 32 + r) * 144 + (16 * s + 8 * h) * 2); sacc = MFMA32(kf, qf[s], sacc); }
            const bool on = kt >= kt0;
#pragma unroll
            for (int i = 0; i < 16; ++i) { const float v = sacc[i] * 0.125f + bth[kt * 32 + crow(i, h) - 128 - (w >> 2) * 32 - r + 191]; sc[kt][i] = on ? v : -1e30f; m = fmaxf(m, sc[kt][i]); }
        }
        m = fmaxf(m, __shfl_xor(m, 32));
        float l = 0.f;
#pragma unroll
        for (int kt = 0; kt < 6; ++kt)
#pragma unroll
            for (int i = 0; i < 16; ++i) { const float p = fast_exp(sc[kt][i] - m); sc[kt][i] = p; l += p; }
        l += __shfl_xor(l, 32); l += fast_exp(sink - m);
        f32x16 o[2];
#pragma unroll
        for (int db = 0; db < 2; ++db)
#pragma unroll
            for (int i = 0; i < 16; ++i) o[db][i] = 0.f;
#pragma unroll
        for (int kt = 0; kt < 6; ++kt) {
            const s16x8 p0 = pack8(sc[kt], 0), p1 = pack8(sc[kt], 1);
#pragma unroll
            for (int db = 0; db < 2; ++db) {
                const LAS unsigned char* tb = trb + kt * 32 * 192 + db * 64;
                const s16x8 v0 = tr_frag(tb, tb + 8 * 192);
                const s16x8 v1 = tr_frag(tb + 16 * 192, tb + 24 * 192);
                o[db] = MFMA32(v0, p0, o[db]); o[db] = MFMA32(v1, p1, o[db]); }
        }
        const float inv = 1.0f / l;
#pragma unroll
        for (int db = 0; db < 2; ++db)
#pragma unroll
            for (int g = 0; g < 4; ++g) { v2u wv; wv.x = pkbf(o[db][4 * g] * inv, o[db][4 * g + 1] * inv); wv.y = pkbf(o[db][4 * g + 2] * inv, o[db][4 * g + 3] * inv);
                *(GAS v2u*)(Y + (size_t)(q0 + r) * DM + head * 64 + db * 32 + 8 * g + 4 * h) = wv; }
        __syncthreads();
    }
}

#ifndef REP_P0
#define REP_P0 1
#endif
#define REP_LRU 1
#define REP_SWA 1
#define REP_FIX 1
#define REP_SB 1
struct Args { const float* in[19]; float* out; unsigned char* ws; int ph_lo, ph_hi; };
__global__ void __launch_bounds__(NWAVES * 64, 2) hybrid_fwd(Args args) {
    extern __shared__ __attribute__((aligned(16))) unsigned char lds[];
    Frame F;
    F.lds = (LAS unsigned char*)lds;
    F.tid = threadIdx.x; F.lane = F.tid & 63; F.wave = __builtin_amdgcn_readfirstlane(F.tid >> 6);
    F.G = gridDim.x;
#pragma unroll
    for (int i = 0; i < 19; ++i) F.in[i] = args.in[i];
    F.out = args.out; F.ws = args.ws;
    unsigned char* ws = args.ws;
    for (int u = F.tid; u < (LDS_BYTES - LDSCTL_OFF) / 4; u += NWAVES * 64) ((LAS unsigned*)(F.lds + LDSCTL_OFF))[u] = 0u;
    __syncthreads();
    const int lo = args.ph_lo, hi = args.ph_hi;
    XcdBarrier bar; bar.bar = (unsigned*)(ws + WS_CTL) + CW_BAR; bar.x = 0; bar.st = nullptr;
    if (hi - lo > 1) bar = xcd_barrier_post((unsigned*)(ws + WS_CTL) + CW_BAR, (volatile LAS unsigned*)(F.lds + MISC_OFF) + 8);
#define IN(k) (lo <= (k) && (k) < hi)
#define SEAM(k) do { if (IN(k) && IN((k) + 1)) xcd_barrier(bar); } while (0)
    bf16* XN = (bf16*)(ws + WS_XN); bf16* Yb = (bf16*)(ws + WS_Y); bf16* PROJ = (bf16*)(ws + WS_PROJ); bf16* ACT = (bf16*)(ws + WS_ACT); float* SS = (float*)(ws + WS_SS);

    if (IN(0)) { for (int rep = 0; rep < REP_P0; ++rep) { p0_prologue(F); if (rep + 1 < REP_P0) xcd_barrier(bar); } } SEAM(0);
    if (IN(1)) { pg8::Gemm g{XN, (const bf16*)(ws + WS_WIN0), SEQ, EVEN_IN, DM}; pg8::StaticOrder S; S.init(SEQ, EVEN_IN, F.G, (int)blockIdx.x);
        pg8::EpiBf16<0> E{PROJ, EVEN_IN, SS, 64, SEQ}; pg8::gemm_phase<pg8::EpiBf16<0>, pg8::StaticOrder, true, true>(F.lds + RING_OFF, g, S, E); } SEAM(1);
    if (IN(2)) { for (int rep = 0; rep < REP_LRU; ++rep) { lru_local(F); if (rep + 1 < REP_LRU) xcd_barrier(bar); } for (int rep = 0; rep < REP_SWA; ++rep) { swa_attn(F); if (rep + 1 < REP_SWA) xcd_barrier(bar); } } SEAM(2);
    if (IN(3)) { for (int rep = 0; rep < REP_FIX; ++rep) { lru_fix(F); if (rep + 1 < REP_FIX) xcd_barrier(bar); } } SEAM(3);
    if (IN(4)) { pg8::Gemm g{Yb, (const bf16*)(ws + WS_WOUT0), SEQ, DM, DM}; pg8::StaticOrder S; S.init(SEQ, DM, F.G, (int)blockIdx.x);
        pg8::EpiRes<true> E{F.in[IN_X], XN, SS, DM}; pg8::gemm_phase<pg8::EpiRes<true>, pg8::StaticOrder, false, true>(F.lds + RING_OFF, g, S, E); } SEAM(4);
    if (IN(5)) { pg8::Gemm g{XN, (const bf16*)(ws + WS_WUP0), SEQ, DFF, DM}; pg8::StaticOrder S; S.init(SEQ, DFF, F.G, (int)blockIdx.x);
        pg8::EpiBf16<1> E{ACT, DFF, SS, 0, 0}; pg8::gemm_phase<pg8::EpiBf16<1>, pg8::StaticOrder, true, true>(F.lds + RING_OFF, g, S, E); } SEAM(5);
    if (IN(6)) { pg8::Gemm g{ACT, (const bf16*)(ws + WS_WDN0), SEQ, DM, DFF}; pg8::StaticOrder S; S.init(SEQ, DM, F.G, (int)blockIdx.x);
        pg8::EpiRes<false> E{nullptr, XN, SS, DM}; pg8::gemm_phase<pg8::EpiRes<false>, pg8::StaticOrder, false, true>(F.lds + RING_OFF, g, S, E); } SEAM(6);
    if (IN(7)) { pg8::Gemm g{XN, (const bf16*)(ws + WS_WIN1), SEQ, ODD_IN, DM}; pg8::StaticOrder S; S.init(SEQ, ODD_IN, F.G, (int)blockIdx.x);
        pg8::EpiBf16<0> E{PROJ, ODD_IN, SS, 128, SEQ}; pg8::gemm_phase<pg8::EpiBf16<0>, pg8::StaticOrder, true, true>(F.lds + RING_OFF, g, S, E); } SEAM(7);
    if (IN(8)) { for (int rep = 0; rep < REP_SB; ++rep) { sb_attn(F); if (rep + 1 < REP_SB) xcd_barrier(bar); } } SEAM(8);
    if (IN(9)) { pg8::Gemm g{Yb, (const bf16*)(ws + WS_WOUT1), SEQ, DM, DM}; pg8::StaticOrder S; S.init(SEQ, DM, F.G, (int)blockIdx.x);
        pg8::EpiRes<false> E{nullptr, XN, SS, DM}; pg8::gemm_phase<pg8::EpiRes<false>, pg8::StaticOrder, false, true>(F.lds + RING_OFF, g, S, E); } SEAM(9);
    if (IN(10)) { pg8::Gemm g{XN, (const bf16*)(ws + WS_WUP1), SEQ, DFF, DM}; pg8::StaticOrder S; S.init(SEQ, DFF, F.G, (int)blockIdx.x);
        pg8::EpiBf16<1> E{ACT, DFF, SS, 0, 0}; pg8::gemm_phase<pg8::EpiBf16<1>, pg8::StaticOrder, true, true>(F.lds + RING_OFF, g, S, E); } SEAM(10);
    if (IN(11)) { pg8::Gemm g{ACT, (const bf16*)(ws + WS_WDN1), SEQ, DM, DFF}; pg8::StaticOrder S; S.init(SEQ, DM, F.G, (int)blockIdx.x);
        pg8::EpiRes<false> E{nullptr, XN, SS, DM}; pg8::gemm_phase<pg8::EpiRes<false>, pg8::StaticOrder, false, true>(F.lds + RING_OFF, g, S, E); } SEAM(11);
    if (IN(12)) { final_norm(F); }
#undef IN
#undef SEAM
}

extern "C" void kernel_launch(void* const* d_in, const int* in_sizes, int n_in, void* d_out, int out_size, void* d_ws, size_t ws_size, hipStream_t stream) {
    static int grid = 0;
    if (grid == 0) {
        if (n_in != 19 || in_sizes[0] != SEQ * DM || out_size != SEQ * DM || ws_size < WS_END) { fprintf(stderr, "kernel_launch: unexpected shapes (n_in %d, in0 %d, out %d, ws %zu); nothing launched\n", n_in, n_in > 0 ? in_sizes[0] : -1, out_size, ws_size); grid = -1; return; }
        int dev = 0, cus = 0, per_cu = 0;
        if (hipGetDevice(&dev) != hipSuccess || hipDeviceGetAttribute(&cus, hipDeviceAttributeMultiprocessorCount, dev) != hipSuccess) { fprintf(stderr, "kernel_launch: device query failed\n"); grid = -1; return; }
        if (hipFuncSetAttribute((const void*)hybrid_fwd, hipFuncAttributeMaxDynamicSharedMemorySize, LDS_BYTES) != hipSuccess) { fprintf(stderr, "kernel_launch: hipFuncSetAttribute failed\n"); grid = -1; return; }
        if (hipOccupancyMaxActiveBlocksPerMultiprocessor(&per_cu, (const void*)hybrid_fwd, NWAVES * 64, LDS_BYTES) != hipSuccess || per_cu < 1) { fprintf(stderr, "kernel_launch: occupancy query reports %d workgroups per CU\n", per_cu); per_cu = 1; }
        (void)hipGetLastError();
        grid = cus;
        if (grid != 256) fprintf(stderr, "kernel_launch: %d CUs; the residual GEMM phases need exactly 256 workgroups\n", grid);
    }
    if (grid < 0) return;
    (void)hipMemsetAsync((char*)d_ws + WS_CTL, 0, CTL_ZERO_BYTES, stream);
    Args a{};
    for (int i = 0; i < 19; ++i) a.in[i] = (const float*)d_in[i];
    a.out = (float*)d_out; a.ws = (unsigned char*)d_ws;
#if MK_N_LAUNCHES == 1
    a.ph_lo = 0; a.ph_hi = N_PHASES;
    hipLaunchKernelGGL(hybrid_fwd, dim3(grid), dim3(NWAVES * 64), LDS_BYTES, stream, a);
#else
    for (int p = 0; p < N_PHASES; ++p) { a.ph_lo = p; a.ph_hi = p + 1; hipLaunchKernelGGL(hybrid_fwd, dim3(grid), dim3(NWAVES * 64), LDS_BYTES, stream, a); }
#endif
}
```

```cpp
#include <hip/hip_runtime.h>
#include <cstdio>
#include <cstdint>
namespace pg8 {
#define PG8_LAS __attribute__((address_space(3)))
typedef unsigned short bf16_t;
typedef short bf16x8 __attribute__((ext_vector_type(8)));
typedef float f32x4 __attribute__((ext_vector_type(4)));
typedef unsigned u32x4 __attribute__((ext_vector_type(4)));
constexpr int BM = 256, BK = 64, HALF = 128, HTB = HALF * BK * 2  , STAGE_BYTES = 8 * HTB, NXCD = 8, WGM = 8;

__host__ __device__ __forceinline__ int lds_byte(int r, int c) { const int st = (r >> 4) * 2 + (c >> 5), rr = r & 15, cc = c & 31, ob = rr * 64 + cc * 2; return st * 1024 + (ob ^ (((ob >> 9) & 1) << 5)); }
__host__ __device__ __forceinline__ void stage_rc(int b, int& R, int& C) { const int st = b / 1024, sb = b % 1024, swz = sb ^ (((sb >> 9) & 1) << 5); R = (st >> 1) * 16 + swz / 64; C = (st & 1) * 32 + (swz % 64) / 2; }
__host__ __device__ __forceinline__ int perm32(int rho) { const int n = rho >> 4, i = rho & 15; return 8 * (i >> 2) + 4 * n + (i & 3); }

struct Unit { int pm, pn; };
struct Gemm { const bf16_t* A; const bf16_t* Bt; int M, N, K; };

struct StaticOrder {
    int nM, nN, nwg, G, c;
    __host__ __device__ void init(int M, int N, int G_, int c_) { nM = M / BM; nN = N / BM; nwg = nM * nN; G = G_; c = c_; }
    __host__ __device__ bool next(int i, Unit& u) const {
        const long L = (long)i * G + c; if (L >= nwg) return false;
        int wgid = (int)L; { const int q = nwg / NXCD, r = nwg % NXCD, xcd = wgid % NXCD, off = wgid / NXCD; wgid = (xcd < r ? xcd * (q + 1) : r * (q + 1) + (xcd - r) * q) + off; }
        const int nig = WGM * nN, gid = wgid / nig, fm = gid * WGM, gsz = (nM - fm) < WGM ? (nM - fm) : WGM;
        u.pm = fm + ((wgid % nig) % gsz); u.pn = (wgid % nig) / gsz; return true;
    }
    __device__ __forceinline__ void a_ready(const Unit&) const {}
    __device__ __forceinline__ void done(const Unit&) const {}
};

__device__ __forceinline__ unsigned cvt_pk_bf16(float lo, float hi) { unsigned r; asm volatile("v_cvt_pk_bf16_f32 %0, %1, %2" : "=v"(r) : "v"(lo), "v"(hi)); return r; }
constexpr float RMS_EPS = 1e-6f;
__device__ __forceinline__ float row_rstd(const float* ss, int r) {
    const f32x4 a = *(const f32x4*)(ss + (size_t)r * 8), b = *(const f32x4*)(ss + (size_t)r * 8 + 4);
    const float s = ((a[0] + a[1]) + (a[2] + a[3])) + ((b[0] + b[1]) + (b[2] + b[3]));
    return 1.0f / sqrtf(s * (1.0f / 2048.0f) + RMS_EPS);
}
template <int ACT> struct EpiBf16 {
    static constexpr bool PERM = true, AFTER_DRAIN = false;
    bf16_t* O; int ldc; const float* ss; int grp_w, nrows;
    __device__ __forceinline__ void operator()(const f32x4 (&acc)[2][2][4][2], const Unit& u, int wr, int wc, int fr, int fq) const {
        const int row0 = u.pm * BM + wr * 64 + fr, col0 = u.pn * BM + wc * 32 + 8 * fq;
#pragma unroll
        for (int ai = 0; ai < 2; ++ai)
#pragma unroll
            for (int m = 0; m < 4; ++m) { const int r = row0 + ai * HALF + m * 16; const float rs = ss ? row_rstd(ss, r) : 1.0f;
                bf16_t* rowp = grp_w ? O + ((size_t)(col0 / grp_w) * nrows + r) * grp_w + (col0 % grp_w) : O + (size_t)r * ldc + col0;
                const size_t bjstep = grp_w ? (size_t)(HALF / grp_w) * nrows * grp_w : (size_t)HALF;
#pragma unroll
                for (int bj = 0; bj < 2; ++bj) { f32x4 v0 = acc[ai][bj][m][0] * rs, v1 = acc[ai][bj][m][1] * rs;
                    if (ACT == 1) {
#pragma unroll
                        for (int j = 0; j < 4; ++j) { const float a = fmaxf(v0[j], 0.f), b = fmaxf(v1[j], 0.f); v0[j] = a * a; v1[j] = b * b; } }
                    u32x4 w; w.x = cvt_pk_bf16(v0[0], v0[1]); w.y = cvt_pk_bf16(v0[2], v0[3]); w.z = cvt_pk_bf16(v1[0], v1[1]); w.w = cvt_pk_bf16(v1[2], v1[3]);
                    *(u32x4*)(rowp + bj * bjstep) = w; } }
    }
};
template <bool BASE_F32> struct EpiRes {
    static constexpr bool PERM = true, AFTER_DRAIN = true;
    const float* base; bf16_t* xn; float* ss; int ldc;
    __device__ __forceinline__ void operator()(const f32x4 (&)[2][2][4][2], const Unit&, int, int, int, int) const {}
    __device__ __forceinline__ void fused(f32x4 (&acc)[2][2][4][2], const Unit& u, int wr, int wc, int fr, int fq, PG8_LAS unsigned char* lds, int wid, int lane) const {
        PG8_LAS float* P = (PG8_LAS float*)lds;
#pragma unroll
        for (int ai = 0; ai < 2; ++ai)
#pragma unroll
            for (int m = 0; m < 4; ++m) { const int rl = ai * HALF + wr * 64 + m * 16 + fr; const size_t off = (size_t)(u.pm * BM + rl) * ldc + u.pn * BM + wc * 32 + 8 * fq; float s = 0.f;
#pragma unroll
                for (int bj = 0; bj < 2; ++bj) { f32x4 b0, b1;
                    if (BASE_F32) { b0 = *(const f32x4*)(base + off + bj * HALF); b1 = *(const f32x4*)(base + off + bj * HALF + 4); }
                    else { const u32x4 q = *(const u32x4*)(xn + off + bj * HALF);
                        b0 = (f32x4){__builtin_bit_cast(float, q.x << 16), __builtin_bit_cast(float, q.x & 0xffff0000u), __builtin_bit_cast(float, q.y << 16), __builtin_bit_cast(float, q.y & 0xffff0000u)};
                        b1 = (f32x4){__builtin_bit_cast(float, q.z << 16), __builtin_bit_cast(float, q.z & 0xffff0000u), __builtin_bit_cast(float, q.w << 16), __builtin_bit_cast(float, q.w & 0xffff0000u)}; }
                    const f32x4 v0 = acc[ai][bj][m][0] + b0, v1 = acc[ai][bj][m][1] + b1;
                    u32x4 w; w.x = cvt_pk_bf16(v0[0], v0[1]); w.y = cvt_pk_bf16(v0[2], v0[3]); w.z = cvt_pk_bf16(v1[0], v1[1]); w.w = cvt_pk_bf16(v1[2], v1[3]);
                    *(u32x4*)(xn + off + bj * HALF) = w;
                    s += ((v0[0] * v0[0] + v0[1] * v0[1]) + (v0[2] * v0[2] + v0[3] * v0[3])) + ((v1[0] * v1[0] + v1[1] * v1[1]) + (v1[2] * v1[2] + v1[3] * v1[3])); }
                s += __shfl_xor(s, 16); s += __shfl_xor(s, 32);
                if (fq == 0) P[rl * 4 + wc] = s; }
        asm volatile("s_waitcnt lgkmcnt(0)" ::: "memory"); __builtin_amdgcn_s_barrier(); asm volatile("" ::: "memory");
        const int t = wid * 64 + lane;
        if (t < 256) { const f32x4 p = *(const PG8_LAS f32x4*)(P + t * 4); ss[(size_t)(u.pm * BM + t) * 8 + u.pn] = (p[0] + p[1]) + (p[2] + p[3]); }
        asm volatile("s_waitcnt lgkmcnt(0)" ::: "memory"); __builtin_amdgcn_s_barrier(); asm volatile("" ::: "memory");
    }
};

template <class Epi, class Sched, bool ALIGN_EPI = false, bool SP2 = false>
__device__ __forceinline__ void gemm_phase(PG8_LAS unsigned char* lds, const Gemm g, const Sched& S, const Epi& E) {
    const int tid = threadIdx.x, wid = __builtin_amdgcn_readfirstlane(tid >> 6), lane = tid & 63, wr = wid >> 2, wc = wid & 3, fr = lane & 15, fq = lane >> 4;
    const int K = g.K, nt = K / BK;
    unsigned voffA[2], voffB[2];
#pragma unroll
    for (int i = 0; i < 2; ++i) { int R, C; stage_rc(tid * 16 + i * 8192, R, C); const int Rb = Epi::PERM ? ((R & ~31) + perm32(R & 31)) : R;
        voffA[i] = (unsigned)(R * K + C) * 2u; voffB[i] = (unsigned)(Rb * K + C) * 2u; }
    const size_t kstep = (size_t)(BK * 2);
    const size_t hstep = (size_t)HALF * K * 2;
    const size_t tstep = 2 * hstep;
    const unsigned ldsw = (unsigned)wid * 1024u;
    const int aoff = lds_byte(wr * 64 + fr, fq * 8), boff = lds_byte(wc * 32 + fr, fq * 8);
#define PG8_SA(b, h) (((b) * 2 + (h)) * HTB)
#define PG8_SB(b, h) ((4 + (b) * 2 + (h)) * HTB)
#define PG8_STAGE(bufoff, gbase, voff) do { _Pragma("unroll") for (int _i = 0; _i < 2; ++_i) \
        __builtin_amdgcn_global_load_lds((const unsigned*)((const char*)(gbase) + (voff)[_i]), (PG8_LAS unsigned*)(lds + (bufoff) + ldsw + _i * 8192), 16, 0, 0); } while (0)
#define PG8_LDA(dst, b, h) do { _Pragma("unroll") for (int m = 0; m < 4; ++m) _Pragma("unroll") for (int k = 0; k < 2; ++k) dst[m][k] = *(const PG8_LAS bf16x8*)(lds + PG8_SA(b, h) + aoff + m * 2048 + k * 1024); } while (0)
#define PG8_LDB(dst, b, h) do { _Pragma("unroll") for (int n = 0; n < 2; ++n) _Pragma("unroll") for (int k = 0; k < 2; ++k) dst[n][k] = *(const PG8_LAS bf16x8*)(lds + PG8_SB(b, h) + boff + n * 2048 + k * 1024); } while (0)
#define PG8_MMA(ai, bj, At, Bt) do { __builtin_amdgcn_s_setprio(1); _Pragma("unroll") for (int m = 0; m < 4; ++m) _Pragma("unroll") for (int n = 0; n < 2; ++n) _Pragma("unroll") for (int k = 0; k < 2; ++k) \
        acc[ai][bj][m][n] = __builtin_amdgcn_mfma_f32_16x16x32_bf16(Bt[n][k], At[m][k], acc[ai][bj][m][n], 0, 0, 0); __builtin_amdgcn_s_setprio(0); } while (0)
#define PG8_WAIT_V(n) asm volatile("s_waitcnt vmcnt(" #n ")" ::: "memory")
#define PG8_WAIT_L(n) asm volatile("s_waitcnt lgkmcnt(" #n ")" ::: "memory")
#define PG8_BAR __builtin_amdgcn_s_barrier()
#define PG8_SCHED __builtin_amdgcn_sched_barrier(0)
    Unit cur, nxt; int ui = 0;
    if (!S.next(0, cur)) return;
    f32x4 acc[2][2][4][2];
#pragma unroll
    for (int a = 0; a < 2; ++a)
#pragma unroll
        for (int b = 0; b < 2; ++b)
#pragma unroll
            for (int m = 0; m < 4; ++m)
#pragma unroll
                for (int n = 0; n < 2; ++n) acc[a][b][m][n] = (f32x4){0.f, 0.f, 0.f, 0.f};
    bf16x8 At[4][2], B0[2][2], B1[2][2];
    const char* cA = (const char*)g.A + (size_t)cur.pm * tstep; const char* cB = (const char*)g.Bt + (size_t)cur.pn * tstep;
    S.a_ready(cur);
    if constexpr (SP2) {
        PG8_STAGE(PG8_SB(0, 0), cB, voffB); PG8_STAGE(PG8_SB(0, 1), cB + hstep, voffB); PG8_STAGE(PG8_SA(0, 0), cA, voffA); PG8_STAGE(PG8_SA(0, 1), cA + hstep, voffA);
        if (wr == 1) PG8_BAR;
        PG8_WAIT_V(2); PG8_BAR;
        PG8_STAGE(PG8_SB(1, 0), cB + kstep, voffB); PG8_STAGE(PG8_SA(1, 0), cA + kstep, voffA); PG8_STAGE(PG8_SB(1, 1), cB + hstep + kstep, voffB);
        PG8_WAIT_V(6); PG8_BAR;
    } else {
        PG8_STAGE(PG8_SB(0, 0), cB, voffB); PG8_STAGE(PG8_SA(0, 0), cA, voffA); PG8_STAGE(PG8_SB(0, 1), cB + hstep, voffB); PG8_STAGE(PG8_SA(0, 1), cA + hstep, voffA);
        if (wr == 1) PG8_BAR;
        PG8_WAIT_V(4); PG8_BAR;
        PG8_STAGE(PG8_SB(1, 0), cB + kstep, voffB); PG8_STAGE(PG8_SA(1, 0), cA + kstep, voffA); PG8_STAGE(PG8_SB(1, 1), cB + hstep + kstep, voffB);
        PG8_WAIT_V(6); PG8_BAR;
    }
    for (;;) {
        const bool has_next = S.next(ui + 1, nxt);
        const char* nA = has_next ? (const char*)g.A + (size_t)nxt.pm * tstep : cA; const char* nB = has_next ? (const char*)g.Bt + (size_t)nxt.pn * tstep : cB;
        for (int t = 0; t < nt; t += 2) {
            const bool last = (t == nt - 2);
            const char* a1 = cA + (size_t)(t + 1) * kstep;
            const char* a2 = last ? nA : cA + (size_t)(t + 2) * kstep; const char* b2 = last ? nB : cB + (size_t)(t + 2) * kstep;
            const char* a3 = a2 + kstep; const char* b3 = b2 + kstep;
            if (last && has_next) S.a_ready(nxt);
            if constexpr (SP2) {
            PG8_LDB(B0, 0, 0); PG8_LDB(B1, 0, 1); PG8_SCHED; PG8_LDA(At, 0, 0); PG8_STAGE(PG8_SA(1, 1), a1 + hstep, voffA);
            PG8_WAIT_V(8); PG8_WAIT_L(0); PG8_BAR; PG8_MMA(0, 0, At, B0); PG8_MMA(0, 1, At, B1); PG8_BAR; PG8_SCHED;
            PG8_LDA(At, 0, 1); PG8_STAGE(PG8_SB(0, 0), b2, voffB); PG8_STAGE(PG8_SB(0, 1), b2 + hstep, voffB); PG8_STAGE(PG8_SA(0, 0), a2, voffA);
            PG8_WAIT_V(8); PG8_WAIT_L(0); PG8_BAR; PG8_MMA(1, 0, At, B0); PG8_MMA(1, 1, At, B1); PG8_BAR; PG8_SCHED;
            PG8_LDB(B0, 1, 0); PG8_LDB(B1, 1, 1); PG8_SCHED; PG8_LDA(At, 1, 0); PG8_STAGE(PG8_SA(0, 1), a2 + hstep, voffA);
            PG8_WAIT_V(8); PG8_WAIT_L(0); PG8_BAR; PG8_MMA(0, 0, At, B0); PG8_MMA(0, 1, At, B1); PG8_BAR; PG8_SCHED;
            PG8_LDA(At, 1, 1); PG8_STAGE(PG8_SB(1, 0), b3, voffB); PG8_STAGE(PG8_SB(1, 1), b3 + hstep, voffB); PG8_STAGE(PG8_SA(1, 0), a3, voffA);
            PG8_WAIT_V(8); PG8_WAIT_L(0); PG8_BAR; PG8_MMA(1, 0, At, B0); PG8_MMA(1, 1, At, B1); PG8_BAR; PG8_SCHED;
            } else {
            PG8_LDB(B0, 0, 0); PG8_SCHED; PG8_LDA(At, 0, 0); PG8_STAGE(PG8_SA(1, 1), a1 + hstep, voffA);
            PG8_WAIT_L(8); PG8_BAR; PG8_WAIT_L(0); PG8_MMA(0, 0, At, B0); PG8_BAR; PG8_SCHED;
            PG8_LDB(B1, 0, 1); PG8_STAGE(PG8_SB(0, 0), b2, voffB);
            PG8_BAR; PG8_WAIT_L(0); PG8_MMA(0, 1, At, B1); PG8_BAR;
            PG8_LDA(At, 0, 1); PG8_STAGE(PG8_SA(0, 0), a2, voffA);
            PG8_BAR; PG8_WAIT_L(0); PG8_MMA(1, 0, At, B0); PG8_BAR; PG8_SCHED;
            PG8_STAGE(PG8_SB(0, 1), b2 + hstep, voffB);
            PG8_WAIT_V(6); PG8_BAR; PG8_MMA(1, 1, At, B1); PG8_BAR;
            PG8_LDB(B0, 1, 0); PG8_SCHED; PG8_LDA(At, 1, 0); PG8_STAGE(PG8_SA(0, 1), a2 + hstep, voffA);
            PG8_WAIT_L(8); PG8_BAR; PG8_WAIT_L(0); PG8_MMA(0, 0, At, B0); PG8_BAR; PG8_SCHED;
            PG8_LDB(B1, 1, 1); PG8_STAGE(PG8_SB(1, 0), b3, voffB);
            PG8_BAR; PG8_WAIT_L(0); PG8_MMA(0, 1, At, B1); PG8_BAR;
            PG8_LDA(At, 1, 1); PG8_STAGE(PG8_SA(1, 0), a3, voffA);
            PG8_BAR; PG8_WAIT_L(0); PG8_MMA(1, 0, At, B0); PG8_BAR; PG8_SCHED;
            PG8_STAGE(PG8_SB(1, 1), b3 + hstep, voffB);
            PG8_WAIT_V(6); PG8_BAR; PG8_MMA(1, 1, At, B1); PG8_BAR;
            }
        }
        if constexpr (ALIGN_EPI) { if (wr == 0) PG8_BAR; }
        if constexpr (!Epi::AFTER_DRAIN) { E(acc, cur, wr, wc, fr, fq); S.done(cur); }
        if (!has_next) break;
#pragma unroll
        for (int a = 0; a < 2; ++a)
#pragma unroll
            for (int b = 0; b < 2; ++b)
#pragma unroll
                for (int m = 0; m < 4; ++m)
#pragma unroll
                    for (int n = 0; n < 2; ++n) acc[a][b][m][n] = (f32x4){0.f, 0.f, 0.f, 0.f};
        cur = nxt; cA = nA; cB = nB; ++ui;
        if constexpr (ALIGN_EPI) { if (wr == 1) PG8_BAR; }
    }
    PG8_WAIT_V(0);
    if constexpr (!ALIGN_EPI) { if (wr == 0) PG8_BAR; }
    PG8_BAR;
    if constexpr (Epi::AFTER_DRAIN) { E.fused(acc, cur, wr, wc, fr, fq, lds, wid, lane); S.done(cur); }
#undef PG8_SA
#undef PG8_SB
#undef PG8_STAGE
#undef PG8_LDA
#undef PG8_LDB
#undef PG8_MMA
#undef PG8_WAIT_V
#undef PG8_WAIT_L
#undef PG8_BAR
#undef PG8_SCHED
}
}

constexpr int NWAVES = 8;
constexpr int SEQ = 8192, DM = 2048, DFF = 8192, EVEN_IN = 3584, ODD_IN = 6144;
constexpr int OFF_K = 1024, OFF_V = 1280, OFF_X = 1536, OFF_G = 2560;
#ifndef MK_N_LAUNCHES
#define MK_N_LAUNCHES 1
#endif
constexpr int N_PHASES = 13;
constexpr size_t MiB = 1u << 20;
constexpr size_t WS_CTL = 0, CTL_ZERO_BYTES = 64 * 1024;
constexpr size_t WS_SS = 1 * MiB;
constexpr size_t WS_BT = 1 * MiB + 512 * 1024;
constexpr size_t WS_GWT = 1 * MiB + 768 * 1024;
constexpr size_t WS_WIN0 = 2 * MiB, WS_WOUT0 = 16 * MiB, WS_WUP0 = 24 * MiB, WS_WDN0 = 56 * MiB, WS_WIN1 = 88 * MiB, WS_WOUT1 = 112 * MiB, WS_WUP1 = 120 * MiB, WS_WDN1 = 152 * MiB;
constexpr size_t WS_XN = 184 * MiB;
constexpr size_t WS_Y = 216 * MiB;
constexpr size_t WS_PROJ = 248 * MiB;
constexpr size_t WS_HL = 344 * MiB, WS_PA = 376 * MiB;
constexpr size_t WS_ACT = 248 * MiB;
constexpr size_t WS_END = 408 * MiB;
constexpr int CW_BAR = 1024;

constexpr int RING_OFF = 0, RING_BYTES = 131072;
constexpr int LDSCTL_OFF = RING_BYTES, MISC_OFF = LDSCTL_OFF + 320;
constexpr int LDS_BYTES = 147456;

#define GAS __attribute__((address_space(1)))
#define LAS __attribute__((address_space(3)))
typedef unsigned short bf16;
typedef unsigned v4u __attribute__((ext_vector_type(4)));
typedef unsigned v2u __attribute__((ext_vector_type(2)));
typedef float f32x4 __attribute__((ext_vector_type(4)));
#define LDS_WAIT() asm volatile("s_waitcnt lgkmcnt(0)" ::: "memory")
#define VM_WAIT() asm volatile("s_waitcnt vmcnt(0)" ::: "memory")
__device__ __forceinline__ unsigned f2bf(float f) { unsigned u = __builtin_bit_cast(unsigned, f); return (u + 0x7fffu + ((u >> 16) & 1u)) >> 16; }
__device__ __forceinline__ unsigned pk2(float lo, float hi) { return f2bf(lo) | (f2bf(hi) << 16); }
__device__ __forceinline__ float bflo(unsigned w) { return __builtin_bit_cast(float, w << 16); }
__device__ __forceinline__ float bfhi(unsigned w) { return __builtin_bit_cast(float, w & 0xffff0000u); }

#define XB_TMO      128
#define XB_XCNT(j)  (256  + 64 * (j))
#define XB_XSUB(j)  (1280 + 64 * (j))
#define XB_XGEN(j)  (2304 + 64 * (j))
#define XB_TOP      3328
#define XB_TOPGEN   3392
#define XCD_BAR_WORDS 3456
#define XB_SPIN_CAP (1u << 22)

__device__ __forceinline__ unsigned xb_ld(unsigned* p)              { return __hip_atomic_load(p, __ATOMIC_RELAXED, __HIP_MEMORY_SCOPE_AGENT); }
__device__ __forceinline__ unsigned xb_add(unsigned* p, unsigned v) { return __hip_atomic_fetch_add(p, v, __ATOMIC_RELAXED, __HIP_MEMORY_SCOPE_AGENT); }
__device__ __forceinline__ unsigned xb_xcc_id() { return (unsigned)__builtin_amdgcn_s_getreg((3 << 11) | 20) & 0xFu; }
#define XB_SPIN(cond, bar) do { unsigned _sp = 0; while (cond) { __builtin_amdgcn_s_sleep(1); \
    if ((++_sp & 255u) == 0u) { if (xb_ld(&(bar)[XB_TMO])) break; if (_sp > XB_SPIN_CAP) { atomicAdd(&(bar)[XB_TMO], 1u); break; } } } } while (0)

struct XcdBarrier {
    unsigned* bar; unsigned x;
    volatile LAS unsigned* st;
};

__device__ __forceinline__ XcdBarrier xcd_barrier_post(unsigned* bar, volatile LAS unsigned* st) {
    XcdBarrier b; b.bar = bar; b.x = xb_xcc_id(); b.st = st;
    if (threadIdx.x == 0) (void)xb_add(&bar[XB_XCNT(b.x)], 1u);
    return b;
}
__device__ __forceinline__ void xcd_barrier_complete(unsigned* bar, unsigned x, unsigned& nloc, unsigned& nx) {
    const unsigned G = gridDim.x * gridDim.y * gridDim.z;
    unsigned sum, cnt, mine, sp = 0u;
    for (;;) {
        sum = 0u; cnt = 0u; mine = 0u;
#pragma unroll
        for (unsigned j = 0; j < 16; ++j) { const unsigned c = xb_ld(&bar[XB_XCNT(j)]); sum += c; cnt += (c > 0u) ? 1u : 0u; mine = (j == x) ? c : mine; }
        if (sum == G) break;
        __builtin_amdgcn_s_sleep(1);
        if ((++sp & 255u) == 0u) { if (xb_ld(&bar[XB_TMO])) break; if (sp > XB_SPIN_CAP) { atomicAdd(&bar[XB_TMO], 1u); break; } }
    }
    nloc = mine > 0u ? mine : 1u; nx = cnt > 0u ? cnt : 1u;
}

__device__ __forceinline__ void xcd_barrier(const XcdBarrier& b) {
    asm volatile("s_waitcnt vmcnt(0)" ::: "memory");
    __syncthreads();
    if (threadIdx.x == 0) {
        unsigned* bar = b.bar;
        __builtin_amdgcn_s_waitcnt(0);
        unsigned nloc = b.st[0], nx = b.st[1];
        if (nloc == 0u) { xcd_barrier_complete(bar, b.x, nloc, nx); b.st[0] = nloc; b.st[1] = nx; }
        const unsigned old = xb_add(&bar[XB_XSUB(b.x)], 1u);
        const unsigned gen = old / nloc;
        if (old + 1u == (gen + 1u) * nloc) {
            __builtin_amdgcn_fence(__ATOMIC_RELEASE, "agent");
            asm volatile("s_waitcnt vmcnt(0)" ::: "memory");
            const unsigned og = xb_add(&bar[XB_TOP], 1u);
            const unsigned tg = og / nx;
            if (og + 1u == (tg + 1u) * nx) xb_add(&bar[XB_TOPGEN], 1u);
            else XB_SPIN(xb_ld(&bar[XB_TOPGEN]) == tg, bar);
            __builtin_amdgcn_fence(__ATOMIC_ACQUIRE, "agent");
            xb_add(&bar[XB_XGEN(b.x)], 1u);
            asm volatile("s_waitcnt vmcnt(0)" ::: "memory");
        } else {
            XB_SPIN(xb_ld(&bar[XB_XGEN(b.x)]) == gen, bar);
            __builtin_amdgcn_fence(__ATOMIC_ACQUIRE, "agent");
            asm volatile("s_waitcnt vmcnt(0)" ::: "memory");
        }
    }
    __syncthreads();
}
struct Frame {
    LAS unsigned char* lds;
    int tid, lane, wave, G;
    const float* in[19]; float* out; unsigned char* ws;
};
#define IN_X 0
#define IN_RELB 1
#define IN_NMIX 2
#define IN_EWIN 3
#define IN_CONVW 4
#define IN_CONVB 5
#define IN_GAW 6
#define IN_GAB 7
#define IN_GXW 8
#define IN_GXB 9
#define IN_LAMBDA 10
#define IN_SINKS 11
#define IN_EWOUT 12
#define IN_OWIN 13
#define IN_OWOUT 14
#define IN_NMLP 15
#define IN_WUP 16
#define IN_WDOWN 17
#define IN_FNORM 18

__device__ __forceinline__ float wave_sum(float v) {
#pragma unroll
    for (int o = 1; o < 64; o <<= 1) v += __shfl_xor(v, o);
    return v;
}
struct P0Tile { const float* W; const float* gain; bf16* WT; int K, N, k0, n0; };
__device__ __forceinline__ void p0_tile_load(const P0Tile& t, int lane, f32x4 (&v)[16]) {
    const GAS f32x4* p = (const GAS f32x4*)(t.W + (size_t)(t.k0 + (lane >> 4)) * t.N + t.n0 + 4 * (lane & 15));
#pragma unroll
    for (int i = 0; i < 16; ++i) v[i] = p[(size_t)i * t.N];
}
__device__ __forceinline__ void p0_tile_store(const P0Tile& t, int lane, const f32x4 (&v)[16], LAS float* scr) {
#pragma unroll
    for (int i = 0; i < 16; ++i) { const int kk = (lane >> 4) + 4 * i; *(LAS f32x4*)(scr + kk * 64 + ((4 * (lane & 15)) ^ (4 * ((kk >> 3) & 7)))) = v[i]; }
    LDS_WAIT(); asm volatile("" ::: "memory");
    const int kc = lane & 7;
    float g[8];
    if (t.gain) { const f32x4 a = *(const GAS f32x4*)(t.gain + t.k0 + 8 * kc), b = *(const GAS f32x4*)(t.gain + t.k0 + 8 * kc + 4); g[0] = a[0]; g[1] = a[1]; g[2] = a[2]; g[3] = a[3]; g[4] = b[0]; g[5] = b[1]; g[6] = b[2]; g[7] = b[3]; }
    else {
#pragma unroll
        for (int e = 0; e < 8; ++e) g[e] = 1.0f; }
#pragma unroll
    for (int j = 0; j < 8; ++j) { const int n = (lane >> 3) + 8 * j; const LAS float* s = scr + (8 * kc) * 64 + (n ^ (4 * kc));
        v4u o; o.x = pk2(s[0] * g[0], s[64] * g[1]); o.y = pk2(s[128] * g[2], s[192] * g[3]); o.z = pk2(s[256] * g[4], s[320] * g[5]); o.w = pk2(s[384] * g[6], s[448] * g[7]);
        *(GAS v4u*)(t.WT + (size_t)(t.n0 + n) * t.K + t.k0 + 8 * kc) = o; }
    LDS_WAIT(); asm volatile("" ::: "memory");
}
__device__ __forceinline__ int t5_bucket(int rel) {
    const int ret = rel > 0 ? 16 : 0, n = rel < 0 ? -rel : rel;
    if (n < 8) return ret + n;
    int large = 8 + (31 - __builtin_clz((unsigned)(n * n))) - 6; if (large > 15) large = 15;
    return ret + large;
}
__device__ __forceinline__ void p0_prologue(Frame& F) {
    LAS float* scr = (LAS float*)(F.lds + RING_OFF + F.wave * 16384);
    const int gw = blockIdx.x * NWAVES + F.wave, NGW = F.G * NWAVES;
    unsigned char* ws = F.ws;
    constexpr int T_IN0 = (DM / 64) * (EVEN_IN / 64), T_OUT = (DM / 64) * (DM / 64), T_UP = (DM / 64) * (DFF / 64), T_DN = (DFF / 64) * (DM / 64), T_IN1 = (DM / 64) * (ODD_IN / 64);
    constexpr int NTILES = T_IN0 + T_IN1 + 2 * T_OUT + 2 * T_UP + 2 * T_DN;
#define P0_DESC(it, t) do { int r_ = (it); \
        if (r_ < T_IN0) { t.W = F.in[IN_EWIN]; t.gain = F.in[IN_NMIX]; t.WT = (bf16*)(ws + WS_WIN0); t.K = DM; t.N = EVEN_IN; } else { r_ -= T_IN0; \
        if (r_ < T_OUT) { t.W = F.in[IN_EWOUT]; t.gain = nullptr; t.WT = (bf16*)(ws + WS_WOUT0); t.K = DM; t.N = DM; } else { r_ -= T_OUT; \
        if (r_ < T_UP) { t.W = F.in[IN_WUP]; t.gain = F.in[IN_NMLP]; t.WT = (bf16*)(ws + WS_WUP0); t.K = DM; t.N = DFF; } else { r_ -= T_UP; \
        if (r_ < T_DN) { t.W = F.in[IN_WDOWN]; t.gain = nullptr; t.WT = (bf16*)(ws + WS_WDN0); t.K = DFF; t.N = DM; } else { r_ -= T_DN; \
        if (r_ < T_IN1) { t.W = F.in[IN_OWIN]; t.gain = F.in[IN_NMIX] + DM; t.WT = (bf16*)(ws + WS_WIN1); t.K = DM; t.N = ODD_IN; } else { r_ -= T_IN1; \
        if (r_ < T_OUT) { t.W = F.in[IN_OWOUT]; t.gain = nullptr; t.WT = (bf16*)(ws + WS_WOUT1); t.K = DM; t.N = DM; } else { r_ -= T_OUT; \
        if (r_ < T_UP) { t.W = F.in[IN_WUP] + (size_t)DM * DFF; t.gain = F.in[IN_NMLP] + DM; t.WT = (bf16*)(ws + WS_WUP1); t.K = DM; t.N = DFF; } else { r_ -= T_UP; \
        t.W = F.in[IN_WDOWN] + (size_t)DFF * DM; t.gain = nullptr; t.WT = (bf16*)(ws + WS_WDN1); t.K = DFF; t.N = DM; } } } } } } } \
        const int nb_ = t.N / 64; t.k0 = 64 * (r_ / nb_); t.n0 = 64 * (r_ % nb_); } while (0)
    {
        f32x4 va[16], vb[16]; P0Tile ta, tb;
        int it = gw;
        if (it < NTILES) { P0_DESC(it, ta); p0_tile_load(ta, F.lane, va); }
        while (it < NTILES) {
            const int itn = it + NGW; const bool more = itn < NTILES;
            if (more) { P0_DESC(itn, tb); p0_tile_load(tb, F.lane, vb); }
            p0_tile_store(ta, F.lane, va, scr);
            if (more) { ta = tb;
#pragma unroll
                for (int i = 0; i < 16; ++i) va[i] = vb[i]; }
            it = itn;
        }
    }
#undef P0_DESC
    bf16* XN = (bf16*)(ws + WS_XN); float* SS = (float*)(ws + WS_SS);
    for (int m = gw; m < SEQ; m += NGW) {
        const GAS f32x4* xr = (const GAS f32x4*)(F.in[IN_X] + (size_t)m * DM) + F.lane;
        f32x4 v[8]; float s = 0.f;
#pragma unroll
        for (int j = 0; j < 8; ++j) { v[j] = xr[64 * j]; s += (v[j].x * v[j].x + v[j].y * v[j].y) + (v[j].z * v[j].z + v[j].w * v[j].w); }
        s = wave_sum(s);
        GAS v2u* o8 = (GAS v2u*)(XN + (size_t)m * DM) + F.lane;
#pragma unroll
        for (int j = 0; j < 8; ++j) { v2u w; w.x = pk2(v[j].x, v[j].y); w.y = pk2(v[j].z, v[j].w); o8[64 * j] = w; }
        if (F.lane < 8) SS[(size_t)m * 8 + F.lane] = F.lane == 0 ? s : 0.f;
    }
    float* BT = (float*)(ws + WS_BT);
    for (int i = blockIdx.x * 512 + F.tid; i < 16 * 256; i += F.G * 512) { const int head = i >> 8, rel = (i & 255) - 191; BT[i] = F.in[IN_RELB][t5_bucket(rel) * 16 + head]; }
    bf16* GWT = (bf16*)(ws + WS_GWT);
    for (int i = blockIdx.x * 512 + F.tid; i < 2 * 16 * 64 * 64; i += F.G * 512) { const int gate = i >> 16, hb = (i >> 12) & 15, jo = (i >> 6) & 63, ii = i & 63;
        GWT[i] = (bf16)f2bf(F.in[gate ? IN_GXW : IN_GAW][(size_t)(hb * 64 + ii) * 64 + jo]); }
}

__device__ __forceinline__ void ld8(const bf16* p, float (&o)[8]) { const v4u w = *(const GAS v4u*)p; o[0] = bflo(w.x); o[1] = bfhi(w.x); o[2] = bflo(w.y); o[3] = bfhi(w.y); o[4] = bflo(w.z); o[5] = bfhi(w.z); o[6] = bflo(w.w); o[7] = bfhi(w.w); }
__device__ __forceinline__ void swa_naive(Frame& F) {
    const bf16* PROJ = (const bf16*)(F.ws + WS_PROJ); bf16* Y = (bf16*)(F.ws + WS_Y); const float* BT = (const float*)(F.ws + WS_BT);
    for (int idx = blockIdx.x * 512 + F.tid; idx < SEQ * 16; idx += F.G * 512) {
        const int head = idx >> 13, tok = idx & (SEQ - 1), kvh = head >> 2, c = tok >> 6;
        float q[64], acc[64];
#pragma unroll
        for (int i = 0; i < 8; ++i) { float t[8]; ld8(PROJ + (size_t)tok * EVEN_IN + head * 64 + 8 * i, t);
#pragma unroll
            for (int j = 0; j < 8; ++j) { q[8 * i + j] = t[j] * 0.125f; acc[8 * i + j] = 0.f; } }
        float m = F.in[IN_SINKS][head], l = 1.0f;
        const int k0 = c >= 2 ? (c - 2) * 64 : 0, k1 = (c + 1) * 64;
        const float* bt = BT + head * 256;
        for (int j = k0; j < k1; ++j) {
            const bf16* kp = PROJ + (size_t)j * EVEN_IN + OFF_K + kvh * 64; float s = 0.f;
#pragma unroll
            for (int i = 0; i < 8; ++i) { float t[8]; ld8(kp + 8 * i, t);
#pragma unroll
                for (int e = 0; e < 8; ++e) s += q[8 * i + e] * t[e]; }
            s += bt[j - tok + 191];
            const float mn = fmaxf(m, s), corr = expf(m - mn), p = expf(s - mn);
            l = l * corr + p; m = mn;
            const bf16* vp = PROJ + (size_t)j * EVEN_IN + OFF_V + kvh * 64;
#pragma unroll
            for (int i = 0; i < 8; ++i) { float t[8]; ld8(vp + 8 * i, t);
#pragma unroll
                for (int e = 0; e < 8; ++e) acc[8 * i + e] = acc[8 * i + e] * corr + p * t[e]; }
        }
        const float inv = 1.0f / l;
#pragma unroll
        for (int i = 0; i < 8; ++i) { v4u w; w.x = pk2(acc[8 * i] * inv, acc[8 * i + 1] * inv); w.y = pk2(acc[8 * i + 2] * inv, acc[8 * i + 3] * inv); w.z = pk2(acc[8 * i + 4] * inv, acc[8 * i + 5] * inv); w.w = pk2(acc[8 * i + 6] * inv, acc[8 * i + 7] * inv);
            *(GAS v4u*)(Y + (size_t)tok * DM + head * 64 + 8 * i) = w; }
    }
}
__device__ __forceinline__ float softplusf(float z) { return fmaxf(z, 0.f) + log1pf(expf(-fabsf(z))); }
__device__ __forceinline__ float sigmoidf_(float z) { return 1.0f / (1.0f + expf(-z)); }
__device__ __forceinline__ float gelu_tanh(float x) { const float u = 0.7978845608028654f * (x + 0.044715f * x * x * x); return 0.5f * x * (1.0f + tanhf(u)); }
__device__ __forceinline__ void lru_naive(Frame& F) {
    if (blockIdx.x >= 16 || F.wave != 0) return;
    const bf16* PROJ = (const bf16*)(F.ws + WS_PROJ); bf16* Y = (bf16*)(F.ws + WS_Y);
    const int hb = blockIdx.x, lane = F.lane, c = hb * 64 + lane;
    float Wa[64], Wx[64];
#pragma unroll
    for (int i = 0; i < 64; ++i) { Wa[i] = F.in[IN_GAW][(size_t)(hb * 64 + i) * 64 + lane]; Wx[i] = F.in[IN_GXW][(size_t)(hb * 64 + i) * 64 + lane]; }
    const float ba = F.in[IN_GAB][c], bx = F.in[IN_GXB][c], cb = F.in[IN_CONVB][c];
    const float cw0 = F.in[IN_CONVW][c], cw1 = F.in[IN_CONVW][1024 + c], cw2 = F.in[IN_CONVW][2048 + c], cw3 = F.in[IN_CONVW][3072 + c];
    const float sp8 = 8.0f * softplusf(-F.in[IN_LAMBDA][c]);
    float x1 = 0.f, x2 = 0.f, x3 = 0.f, h = 0.f;
    for (int t0 = 0; t0 < SEQ; t0 += 8) {
        float xb[8], g[8];
#pragma unroll
        for (int u = 0; u < 8; ++u) { xb[u] = bflo((unsigned)PROJ[(size_t)(t0 + u) * EVEN_IN + OFF_X + c]); g[u] = bflo((unsigned)PROJ[(size_t)(t0 + u) * EVEN_IN + OFF_G + c]); }
#pragma unroll
        for (int u = 0; u < 8; ++u) {
            const float xt = xb[u], xc = cb + cw0 * x3 + cw1 * x2 + cw2 * x1 + cw3 * xt; x3 = x2; x2 = x1; x1 = xt;
            float ra = ba, rx = bx; const int xci = __builtin_bit_cast(int, xc);
#pragma unroll
            for (int i = 0; i < 64; ++i) { const float xi = __builtin_bit_cast(float, __builtin_amdgcn_readlane(xci, i)); ra += xi * Wa[i]; rx += xi * Wx[i]; }
            const float r = sigmoidf_(ra), ig = sigmoidf_(rx), log_a = -r * sp8, a = expf(log_a), mult = sqrtf(-expm1f(2.0f * log_a));
            h = a * h + mult * (ig * xc);
            Y[(size_t)(t0 + u) * DM + 1024 + c] = (bf16)f2bf(gelu_tanh(g[u]) * h);
        }
    }
}
__device__ __forceinline__ void sb_naive(Frame& F) {
    const bf16* PROJ = (const bf16*)(F.ws + WS_PROJ); bf16* Y = (bf16*)(F.ws + WS_Y);
    const int gt = blockIdx.x * 512 + F.tid, half = gt & 1;
    for (int pidx = gt >> 1; pidx < SEQ * 16; pidx += (F.G * 512) >> 1) {
        const int head = pidx >> 13, tok = pidx & (SEQ - 1);
        float q[64], acc[64];
#pragma unroll
        for (int i = 0; i < 8; ++i) { float t[8]; ld8(PROJ + (size_t)tok * ODD_IN + head * 128 + half * 64 + 8 * i, t);
#pragma unroll
            for (int j = 0; j < 8; ++j) { q[8 * i + j] = t[j] * 0.08838834764831845f; acc[8 * i + j] = 0.f; } }
        float stick = 0.f;
        for (int j = tok - 1; j >= 0; --j) {
            const bf16* kp = PROJ + (size_t)j * ODD_IN + 2048 + head * 128 + half * 64; float s = 0.f;
#pragma unroll
            for (int i = 0; i < 8; ++i) { float t[8]; ld8(kp + 8 * i, t);
#pragma unroll
                for (int e = 0; e < 8; ++e) s += q[8 * i + e] * t[e]; }
            const float z = s + __shfl_xor(s, 1);
            const float lk = -softplusf(z), w = expf(z + lk + stick);
            const bf16* vp = PROJ + (size_t)j * ODD_IN + 4096 + head * 128 + half * 64;
#pragma unroll
            for (int i = 0; i < 8; ++i) { float t[8]; ld8(vp + 8 * i, t);
#pragma unroll
                for (int e = 0; e < 8; ++e) acc[8 * i + e] += w * t[e]; }
            stick += lk;
            if (stick < -104.0f) break;
        }
#pragma unroll
        for (int i = 0; i < 8; ++i) { v4u w; w.x = pk2(acc[8 * i], acc[8 * i + 1]); w.y = pk2(acc[8 * i + 2], acc[8 * i + 3]); w.z = pk2(acc[8 * i + 4], acc[8 * i + 5]); w.w = pk2(acc[8 * i + 6], acc[8 * i + 7]);
            *(GAS v4u*)(Y + (size_t)tok * DM + head * 128 + half * 64 + 8 * i) = w; }
    }
}
__device__ __forceinline__ void final_norm(Frame& F) {
    const int gw = blockIdx.x * NWAVES + F.wave, NGW = F.G * NWAVES;
    const bf16* XN = (const bf16*)(F.ws + WS_XN); const float* SS = (const float*)(F.ws + WS_SS);
    const GAS f32x4* gp = (const GAS f32x4*)F.in[IN_FNORM] + 2 * F.lane;
    for (int m = gw; m < SEQ; m += NGW) {
        const GAS v4u* xr = (const GAS v4u*)(XN + (size_t)m * DM) + F.lane;
        GAS f32x4* orow = (GAS f32x4*)(F.out + (size_t)m * DM) + 2 * F.lane;
        const f32x4 sa = *(const GAS f32x4*)(SS + (size_t)m * 8), sb = *(const GAS f32x4*)(SS + (size_t)m * 8 + 4);
        const float rstd = 1.0f / sqrtf((((sa[0] + sa[1]) + (sa[2] + sa[3])) + ((sb[0] + sb[1]) + (sb[2] + sb[3]))) * (1.0f / DM) + 1e-6f);
        v4u v[4];
#pragma unroll
        for (int j = 0; j < 4; ++j) v[j] = xr[64 * j];
#pragma unroll
        for (int j = 0; j < 4; ++j) { const f32x4 g0 = gp[128 * j], g1 = gp[128 * j + 1];
            orow[128 * j] = (f32x4){bflo(v[j].x) * rstd * g0[0], bfhi(v[j].x) * rstd * g0[1], bflo(v[j].y) * rstd * g0[2], bfhi(v[j].y) * rstd * g0[3]};
            orow[128 * j + 1] = (f32x4){bflo(v[j].z) * rstd * g1[0], bfhi(v[j].z) * rstd * g1[1], bflo(v[j].w) * rstd * g1[2], bfhi(v[j].w) * rstd * g1[3]}; }
    }
}
typedef float f32x16 __attribute__((ext_vector_type(16)));
typedef short s16x8 __attribute__((ext_vector_type(8)));
typedef short s16x4 __attribute__((ext_vector_type(4)));
typedef __bf16 bf16x2v __attribute__((ext_vector_type(2)));
#define MFMA32(a, b, c) __builtin_amdgcn_mfma_f32_32x32x16_bf16((a), (b), (c), 0, 0, 0)
__device__ __forceinline__ int crow(int i, int h) { return (i & 3) + 8 * (i >> 2) + 4 * h; }
__device__ __forceinline__ unsigned pkbf(float a, float b) { bf16x2v v; v.x = (__bf16)a; v.y = (__bf16)b; return __builtin_bit_cast(unsigned, v); }
__device__ __forceinline__ s16x8 pack8(const float (&p)[16], int s) {
    v4u w; w.x = pkbf(p[8 * s], p[8 * s + 1]); w.y = pkbf(p[8 * s + 2], p[8 * s + 3]); w.z = pkbf(p[8 * s + 4], p[8 * s + 5]); w.w = pkbf(p[8 * s + 6], p[8 * s + 7]);
    return __builtin_bit_cast(s16x8, w);
}
__device__ __forceinline__ s16x8 tr_frag(const LAS unsigned char* p0, const LAS unsigned char* p1) {
    const s16x4 lo = __builtin_amdgcn_ds_read_tr16_b64_v4i16((LAS s16x4*)p0), hi = __builtin_amdgcn_ds_read_tr16_b64_v4i16((LAS s16x4*)p1);
    return __builtin_shufflevector(lo, hi, 0, 1, 2, 3, 4, 5, 6, 7);
}
__device__ __forceinline__ float ex2(float x) { return __builtin_amdgcn_exp2f(x); }
__device__ __forceinline__ float lg2(float x) { return __builtin_amdgcn_logf(x); }
__device__ __forceinline__ float fast_exp(float x) { return ex2(x * 1.4426950408889634f); }
__device__ __forceinline__ float fast_softplus(float z) { return fmaxf(z, 0.f) + 0.6931471805599453f * lg2(1.0f + ex2(-1.4426950408889634f * fabsf(z))); }
__device__ __forceinline__ float fast_sigmoid(float z) { return __builtin_amdgcn_rcpf(1.0f + ex2(-1.4426950408889634f * z)); }
#define G0(g, tok) (PROJ + ((size_t)(g) * SEQ + (tok)) * 64)
#define G1(g, tok) (PROJ + ((size_t)(g) * SEQ + (tok)) * 128)

__device__ __forceinline__ float neg_expm1(float x) {
    const float p = -x * (1.0f + x * (0.5f + x * (0.16666667f + x * (0.041666668f + x * (0.0083333338f + x * 0.0013888889f)))));
    return x > -0.25f ? p : 1.0f - fast_exp(x);
}
__device__ __forceinline__ void lru_local(Frame& F) {
    const bf16* PROJ = (const bf16*)(F.ws + WS_PROJ); float* HL = (float*)(F.ws + WS_HL); float* PA = (float*)(F.ws + WS_PA); const bf16* GWT = (const bf16*)(F.ws + WS_GWT);
    LAS unsigned char* xc16 = F.lds;
    LAS float* xc32 = (LAS float*)(F.lds + 18432);
    LAS float* comp = (LAS float*)(F.lds + 18432 + 34816);
    const int tid = F.tid, lane = F.lane, w = F.wave, ts = w & 3, ch = w >> 2, r = lane & 31, h = lane >> 5;
    const int hb = blockIdx.x & 15;
    const int tp = tid >> 3, cg = tid & 7, cb8 = hb * 64 + cg * 8;
    float cw[4][8], cbias[8];
#pragma unroll
    for (int d = 0; d < 4; ++d) { const f32x4 a = *(const GAS f32x4*)(F.in[IN_CONVW] + d * 1024 + cb8), b = *(const GAS f32x4*)(F.in[IN_CONVW] + d * 1024 + cb8 + 4);
        cw[d][0] = a[0]; cw[d][1] = a[1]; cw[d][2] = a[2]; cw[d][3] = a[3]; cw[d][4] = b[0]; cw[d][5] = b[1]; cw[d][6] = b[2]; cw[d][7] = b[3]; }
    { const f32x4 a = *(const GAS f32x4*)(F.in[IN_CONVB] + cb8), b = *(const GAS f32x4*)(F.in[IN_CONVB] + cb8 + 4);
      cbias[0] = a[0]; cbias[1] = a[1]; cbias[2] = a[2]; cbias[3] = a[3]; cbias[4] = b[0]; cbias[5] = b[1]; cbias[6] = b[2]; cbias[7] = b[3]; }
    s16x8 wa[4], wx[4];
#pragma unroll
    for (int s = 0; s < 4; ++s) { wa[s] = *(const GAS s16x8*)(GWT + (size_t)((0 * 16 + hb) * 64 + ch * 32 + r) * 64 + 16 * s + 8 * h); wx[s] = *(const GAS s16x8*)(GWT + (size_t)((1 * 16 + hb) * 64 + ch * 32 + r) * 64 + 16 * s + 8 * h); }
    const int c = hb * 64 + ch * 32 + r;
    const float gab = F.in[IN_GAB][c], gxb = F.in[IN_GXB][c], sp8 = 8.0f * softplusf(-F.in[IN_LAMBDA][c]);
    const int nun = (1024 - (int)blockIdx.x + F.G - 1) / F.G;
    v4u xin[5];
#define LRU_LOAD(kk) do { const int t_ = (kk) * 128 + 2 * tp; _Pragma("unroll") for (int d = 0; d < 5; ++d) { const int row_ = t_ - 3 + d; xin[d] = *(const GAS v4u*)(G0(24 + hb, row_ < 0 ? 0 : row_) + cg * 8); if (row_ < 0) xin[d] = (v4u){0u, 0u, 0u, 0u}; } } while (0)
    LRU_LOAD((int)blockIdx.x >> 4);
    for (int ui = 0; ui < nun; ++ui) {
        const int k = ((int)blockIdx.x + ui * F.G) >> 4, t0 = k * 128;
        {
            float xv[5][8];
#pragma unroll
            for (int d = 0; d < 5; ++d) { xv[d][0] = bflo(xin[d].x); xv[d][1] = bfhi(xin[d].x); xv[d][2] = bflo(xin[d].y); xv[d][3] = bfhi(xin[d].y); xv[d][4] = bflo(xin[d].z); xv[d][5] = bfhi(xin[d].z); xv[d][6] = bflo(xin[d].w); xv[d][7] = bfhi(xin[d].w); }
#pragma unroll
            for (int tk = 0; tk < 2; ++tk) { float xc[8];
#pragma unroll
                for (int e = 0; e < 8; ++e) xc[e] = cbias[e] + cw[0][e] * xv[tk][e] + cw[1][e] * xv[tk + 1][e] + cw[2][e] * xv[tk + 2][e] + cw[3][e] * xv[tk + 3][e];
                const int tt = 2 * tp + tk;
                *(LAS f32x4*)(xc32 + tt * 68 + cg * 8) = (f32x4){xc[0], xc[1], xc[2], xc[3]}; *(LAS f32x4*)(xc32 + tt * 68 + cg * 8 + 4) = (f32x4){xc[4], xc[5], xc[6], xc[7]};
                v4u o; o.x = pkbf(xc[0], xc[1]); o.y = pkbf(xc[2], xc[3]); o.z = pkbf(xc[4], xc[5]); o.w = pkbf(xc[6], xc[7]);
                *(LAS v4u*)(xc16 + tt * 144 + cg * 16) = o; }
        }
        __syncthreads();
        if (ui + 1 < nun) LRU_LOAD(((int)blockIdx.x + (ui + 1) * F.G) >> 4);
        __builtin_amdgcn_sched_barrier(0);
        f32x16 acc_a, acc_x;
#pragma unroll
        for (int i = 0; i < 16; ++i) { acc_a[i] = 0.f; acc_x[i] = 0.f; }
#pragma unroll
        for (int s = 0; s < 4; ++s) { const s16x8 af = *(const LAS s16x8*)(xc16 + (ts * 32 + r) * 144 + (16 * s + 8 * h) * 2); acc_a = MFMA32(af, wa[s], acc_a); acc_x = MFMA32(af, wx[s], acc_x); }
        float pa[16], hl[16], gA[4], gU[4];
#pragma unroll
        for (int g = 0; g < 4; ++g) { float A = 1.f, U = 0.f;
#pragma unroll
            for (int e = 0; e < 4; ++e) { const int i = 4 * g + e; const float xcv = xc32[(ts * 32 + crow(i, h)) * 68 + ch * 32 + r];
                const float rg = fast_sigmoid(acc_a[i] + gab), ig = fast_sigmoid(acc_x[i] + gxb), log_a = -rg * sp8, a = fast_exp(log_a), mult = sqrtf(neg_expm1(2.0f * log_a));
                U = a * U + mult * (ig * xcv); A *= a; pa[i] = A; hl[i] = U; }
            gA[g] = A; gU[g] = U; }
        float PAc = 1.f, Hc = 0.f;
#pragma unroll
        for (int g = 0; g < 4; ++g) { const float oA = __shfl_xor(gA[g], 32), oU = __shfl_xor(gU[g], 32);
            const float fA = h ? oA : gA[g], fU = h ? oU : gU[g], sA = h ? gA[g] : oA, sU = h ? gU[g] : oU;
            const float c0P = PAc, c0H = Hc; Hc = fA * Hc + fU; PAc *= fA; const float c1P = PAc, c1H = Hc; Hc = sA * Hc + sU; PAc *= sA;
            const float ciP = h ? c1P : c0P, ciH = h ? c1H : c0H;
#pragma unroll
            for (int e = 0; e < 4; ++e) { const int i = 4 * g + e; hl[i] += pa[i] * ciH; pa[i] *= ciP; } }
        if (h == 0) { comp[(ts * 64 + ch * 32 + r) * 2] = PAc; comp[(ts * 64 + ch * 32 + r) * 2 + 1] = Hc; }
        __syncthreads();
        float PAin = 1.f, Hin = 0.f;
        for (int t2 = 0; t2 < ts; ++t2) { const float A2 = comp[(t2 * 64 + ch * 32 + r) * 2], U2 = comp[(t2 * 64 + ch * 32 + r) * 2 + 1]; Hin = A2 * Hin + U2; PAin *= A2; }
#pragma unroll
        for (int i = 0; i < 16; ++i) { const size_t o = ((size_t)hb * SEQ + t0 + ts * 32 + crow(i, h)) * 64 + ch * 32 + r; HL[o] = hl[i] + pa[i] * Hin; PA[o] = pa[i] * PAin; }
        __syncthreads();
    }
#undef LRU_LOAD
}
__device__ __forceinline__ void lru_fix(Frame& F) {
    const bf16* PROJ = (const bf16*)(F.ws + WS_PROJ); const float* HL = (const float*)(F.ws + WS_HL); const float* PA = (const float*)(F.ws + WS_PA); bf16* Y = (bf16*)(F.ws + WS_Y);
    const int gw = blockIdx.x * NWAVES + F.wave, NGW = F.G * NWAVES;
    for (int it = gw; it < 2048; it += NGW) {
        const int cgp = it & 15, sub = (it >> 4) & 1, k = it >> 5, c = cgp * 64 + F.lane;
        float H = 0.f;
        for (int kb = 0; kb < k; kb += 16) {
            float a[16], u[16];
#pragma unroll
            for (int j = 0; j < 16; ++j) { const int kk = (kb + j < k) ? kb + j : 0; const size_t row = ((size_t)cgp * SEQ + kk * 128 + 127) * 64 + F.lane; a[j] = PA[row]; u[j] = HL[row]; }
#pragma unroll
            for (int j = 0; j < 16; ++j) { const bool on = kb + j < k; H = on ? a[j] * H + u[j] : H; }
        }
#pragma unroll
        for (int tb = 0; tb < 64; tb += 32) {
            float hv[32], pv[32], gv[32];
#pragma unroll
            for (int tt = 0; tt < 32; ++tt) { const int t = k * 128 + sub * 64 + tb + tt; const size_t o = ((size_t)cgp * SEQ + t) * 64 + F.lane; hv[tt] = HL[o]; pv[tt] = PA[o]; gv[tt] = bflo((unsigned)G0(40 + cgp, t)[F.lane]); }
#pragma unroll
            for (int tt = 0; tt < 32; ++tt) { const int t = k * 128 + sub * 64 + tb + tt; const float g = gv[tt], u2 = 1.5957691216057308f * (g + 0.044715f * g * g * g), ge = g * fast_sigmoid(u2);
                Y[(size_t)t * DM + 1024 + c] = (bf16)f2bf(ge * (hv[tt] + pv[tt] * H)); }
        }
    }
}
template <bool DIAG> __device__ __forceinline__ void sb_tile(const f32x16& sacc, int r, int h, float& run, float (&pw)[16]) {
    float q[16], sp[16], G[4];
#pragma unroll
    for (int g = 0; g < 4; ++g) { float gs = 0.f;
#pragma unroll
        for (int e = 0; e < 4; ++e) { const int i = 4 * g + e; const float y = sacc[i] * 0.12751743082459868f;
            const float lg = lg2(1.0f + ex2(-fabsf(y))); float s_ = fmaxf(y, 0.f) + lg, q_ = fminf(y, 0.f) - lg;
            if (DIAG) { const bool valid = crow(i, h) < r; s_ = valid ? s_ : 0.f; q_ = valid ? q_ : -1e30f; }
            sp[i] = s_; q[i] = q_; gs += s_; }
        G[g] = gs; }
#pragma unroll
    for (int g = 3; g >= 0; --g) { const float og = __shfl_xor(G[g], 32);
        const float s1 = run; run += h ? G[g] : og;
        const float s0 = run; run += h ? og : G[g];
        float ex = h ? s1 : s0;
#pragma unroll
        for (int e = 3; e >= 0; --e) { const int i = 4 * g + e; pw[i] = ex2(q[i] - ex); ex += sp[i]; } }
}
__device__ __forceinline__ void sb_attn(Frame& F) {
    const bf16* PROJ = (const bf16*)(F.ws + WS_PROJ); bf16* Y = (bf16*)(F.ws + WS_Y);
    LAS unsigned char* kl = F.lds + F.wave * 16384;
    LAS unsigned char* vl = kl + 8192;
    const int lane = F.lane, r = lane & 31, h = lane >> 5;
    const int gw = blockIdx.x * NWAVES + F.wave, NGW = F.G * NWAVES;
    const int troff = (4 * h + ((lane & 15) >> 2)) * 256 + (16 * ((lane >> 4) & 1) + 4 * (lane & 3)) * 2;
    int kwoff[8];
#pragma unroll
    for (int i = 0; i < 8; ++i) { const int p = lane + 64 * i, row = p >> 4, c = p & 15; kwoff[i] = row * 256 + ((c ^ (row & 15)) << 4); }
    for (int it = gw; it < 4096; it += NGW) {
        const int head = (it >> 3) & 15, qb = ((it >> 7) << 3) + (it & 7), q0 = qb * 32;
        s16x8 qf[8];
#pragma unroll
        for (int s = 0; s < 8; ++s) qf[s] = *(const GAS s16x8*)(G1(head, q0 + r) + 16 * s + 8 * h);
        f32x16 o[4];
#pragma unroll
        for (int db = 0; db < 4; ++db)
#pragma unroll
            for (int i = 0; i < 16; ++i) o[db][i] = 0.f;
        float carry = 0.f;
        v4u kreg[8], vreg[8];
#pragma unroll
        for (int i = 0; i < 8; ++i) { kreg[i] = *(const GAS v4u*)(G1(16 + head, q0) + (lane + 64 * i) * 8); vreg[i] = *(const GAS v4u*)(G1(32 + head, q0) + (lane + 64 * i) * 8); }
#pragma unroll
        for (int i = 0; i < 8; ++i) { *(LAS v4u*)(kl + kwoff[i]) = kreg[i]; *(LAS v4u*)(vl + (lane + 64 * i) * 16) = vreg[i]; }
        LDS_WAIT();
        for (int kt = qb; kt >= 0; --kt) {
            const int kbn = (kt > 0 ? kt - 1 : 0) * 32;
            f32x16 sacc;
#pragma unroll
            for (int i = 0; i < 16; ++i) sacc[i] = 0.f;
#pragma unroll
            for (int s = 0; s < 8; ++s) { const s16x8 kf = *(const LAS s16x8*)(kl + r * 256 + (((2 * s + h) ^ (r & 15)) << 4)); sacc = MFMA32(kf, qf[s], sacc); }
#pragma unroll
            for (int i = 0; i < 8; ++i) { kreg[i] = *(const GAS v4u*)(G1(16 + head, kbn) + (lane + 64 * i) * 8); vreg[i] = *(const GAS v4u*)(G1(32 + head, kbn) + (lane + 64 * i) * 8); }
            __builtin_amdgcn_sched_barrier(0);
            float pw[16];
            if (kt == qb) sb_tile<true>(sacc, r, h, carry, pw); else sb_tile<false>(sacc, r, h, carry, pw);
            const s16x8 p0 = pack8(pw, 0), p1 = pack8(pw, 1);
            const LAS unsigned char* trb = vl + troff;
#pragma unroll
            for (int db = 0; db < 4; ++db) {
                const s16x8 v0 = tr_frag(trb + db * 64, trb + 8 * 256 + db * 64);
                const s16x8 v1 = tr_frag(trb + 16 * 256 + db * 64, trb + 24 * 256 + db * 64);
                o[db] = MFMA32(v0, p0, o[db]); o[db] = MFMA32(v1, p1, o[db]); }
#pragma unroll
            for (int i = 0; i < 8; ++i) { *(LAS v4u*)(kl + kwoff[i]) = kreg[i]; *(LAS v4u*)(vl + (lane + 64 * i) * 16) = vreg[i]; }
            LDS_WAIT();
            if (__all(carry > 150.04f)) break;
        }
#pragma unroll
        for (int db = 0; db < 4; ++db)
#pragma unroll
            for (int g = 0; g < 4; ++g) { v2u w; w.x = pkbf(o[db][4 * g], o[db][4 * g + 1]); w.y = pkbf(o[db][4 * g + 2], o[db][4 * g + 3]);
                *(GAS v2u*)(Y + (size_t)(q0 + r) * DM + head * 128 + db * 32 + 8 * g + 4 * h) = w; }
    }
}
__device__ __forceinline__ void swa_attn(Frame& F) {
    const bf16* PROJ = (const bf16*)(F.ws + WS_PROJ); bf16* Y = (bf16*)(F.ws + WS_Y); const float* BT = (const float*)(F.ws + WS_BT);
    LAS unsigned char* KL = F.lds + 57344;
    LAS unsigned char* VL = KL + 27648;
    LAS float* btl = (LAS float*)(VL + 36864);
    const int tid = F.tid, lane = F.lane, w = F.wave, r = lane & 31, h = lane >> 5;
    const int kvh = blockIdx.x & 3;
    btl[tid] = BT[kvh * 1024 + tid]; btl[tid + 512] = BT[kvh * 1024 + 512 + tid];
    const int head = kvh * 4 + (w & 3);
    const float sink = F.in[IN_SINKS][head];
    const LAS float* bth = btl + (w & 3) * 256;
    const LAS unsigned char* trb = VL + (4 * h + ((lane & 15) >> 2)) * 192 + (16 * ((lane >> 4) & 1) + 4 * (lane & 3)) * 2;
    v4u kreg[3], vreg[3];
    const int nun = (512 - (int)blockIdx.x + F.G - 1) / F.G;
    {   const int c = blockIdx.x >> 2, kbase = (c - 2) * 64;
#pragma unroll
        for (int i = 0; i < 3; ++i) { const int j = tid + 512 * i; int row = kbase + (j >> 3); row = row < 0 ? 0 : row;
            kreg[i] = *(const GAS v4u*)(G0(16 + kvh, row) + (j & 7) * 8); vreg[i] = *(const GAS v4u*)(G0(20 + kvh, row) + (j & 7) * 8); } }
    for (int ui = 0; ui < nun; ++ui) {
        const int wu = blockIdx.x + ui * F.G, c = wu >> 2, q0 = c * 64 + (w >> 2) * 32, kbase = (c - 2) * 64, kt0 = c >= 2 ? 0 : (2 - c) * 2;
#pragma unroll
        for (int i = 0; i < 3; ++i) { const int j = tid + 512 * i; *(LAS v4u*)(KL + (j >> 3) * 144 + (j & 7) * 16) = kreg[i]; *(LAS v4u*)(VL + (j >> 3) * 192 + (j & 7) * 16) = vreg[i]; }
        __syncthreads();
        if (ui + 1 < nun) { const int c2 = (wu + F.G) >> 2, kb2 = (c2 - 2) * 64;
#pragma unroll
            for (int i = 0; i < 3; ++i) { const int j = tid + 512 * i; int row = kb2 + (j >> 3); row = row < 0 ? 0 : row;
                kreg[i] = *(const GAS v4u*)(G0(16 + kvh, row) + (j & 7) * 8); vreg[i] = *(const GAS v4u*)(G0(20 + kvh, row) + (j & 7) * 8); } }
        s16x8 qf[4];
#pragma unroll
        for (int s = 0; s < 4; ++s) qf[s] = *(const GAS s16x8*)(G0(head, q0 + r) + 16 * s + 8 * h);
        __builtin_amdgcn_sched_barrier(0);
        float sc[6][16]; float m = sink;
#pragma unroll
        for (int kt = 0; kt < 6; ++kt) {
            f32x16 sacc;
#pragma unroll
            for (int i = 0; i < 16; ++i) sacc[i] = 0.f;
#pragma unroll
            for (int s = 0; s < 4; ++s) { const s16x8 kf = *(const LAS s16x8*)(KL + (kt * 32 + r) * 144 + (16 * s + 8 * h) * 2); sacc = MFMA32(kf, qf[s], sacc); }
            const bool on = kt >= kt0;
#pragma unroll
            for (int i = 0; i < 16; ++i) { const float v = sacc[i] * 0.125f + bth[kt * 32 + crow(i, h) - 128 - (w >> 2) * 32 - r + 191]; sc[kt][i] = on ? v : -1e30f; m = fmaxf(m, sc[kt][i]); }
        }
        m = fmaxf(m, __shfl_xor(m, 32));
        float l = 0.f;
#pragma unroll
        for (int kt = 0; kt < 6; ++kt)
#pragma unroll
            for (int i = 0; i < 16; ++i) { const float p = fast_exp(sc[kt][i] - m); sc[kt][i] = p; l += p; }
        l += __shfl_xor(l, 32); l += fast_exp(sink - m);
        f32x16 o[2];
#pragma unroll
        for (int db = 0; db < 2; ++db)
#pragma unroll
            for (int i = 0; i < 16; ++i) o[db][i] = 0.f;
#pragma unroll
        for (int kt = 0; kt < 6; ++kt) {
            const s16x8 p0 = pack8(sc[kt], 0), p1 = pack8(sc[kt], 1);
#pragma unroll
            for (int db = 0; db < 2; ++db) {
                const LAS unsigned char* tb = trb + kt * 32 * 192 + db * 64;
                const s16x8 v0 = tr_frag(tb, tb + 8 * 192);
                const s16x8 v1 = tr_frag(tb + 16 * 192, tb + 24 * 192);
                o[db] = MFMA32(v0, p0, o[db]); o[db] = MFMA32(v1, p1, o[db]); }
        }
        const float inv = 1.0f / l;
#pragma unroll
        for (int db = 0; db < 2; ++db)
#pragma unroll
            for (int g = 0; g < 4; ++g) { v2u wv; wv.x = pkbf(o[db][4 * g] * inv, o[db][4 * g + 1] * inv); wv.y = pkbf(o[db][4 * g + 2] * inv, o[db][4 * g + 3] * inv);
                *(GAS v2u*)(Y + (size_t)(q0 + r) * DM + head * 64 + db * 32 + 8 * g + 4 * h) = wv; }
        __syncthreads();
    }
}

#ifndef REP_P0
#define REP_P0 1
#endif
#define REP_LRU 1
#define REP_SWA 1
#define REP_FIX 1
#define REP_SB 1
struct Args { const float* in[19]; float* out; unsigned char* ws; int ph_lo, ph_hi; };
__global__ void __launch_bounds__(NWAVES * 64, 2) hybrid_fwd(Args args) {
    extern __shared__ __attribute__((aligned(16))) unsigned char lds[];
    Frame F;
    F.lds = (LAS unsigned char*)lds;
    F.tid = threadIdx.x; F.lane = F.tid & 63; F.wave = __builtin_amdgcn_readfirstlane(F.tid >> 6);
    F.G = gridDim.x;
#pragma unroll
    for (int i = 0; i < 19; ++i) F.in[i] = args.in[i];
    F.out = args.out; F.ws = args.ws;
    unsigned char* ws = args.ws;
    for (int u = F.tid; u < (LDS_BYTES - LDSCTL_OFF) / 4; u += NWAVES * 64) ((LAS unsigned*)(F.lds + LDSCTL_OFF))[u] = 0u;
    __syncthreads();
    const int lo = args.ph_lo, hi = args.ph_hi;
    XcdBarrier bar; bar.bar = (unsigned*)(ws + WS_CTL) + CW_BAR; bar.x = 0; bar.st = nullptr;
    if (hi - lo > 1) bar = xcd_barrier_post((unsigned*)(ws + WS_CTL) + CW_BAR, (volatile LAS unsigned*)(F.lds + MISC_OFF) + 8);
#define IN(k) (lo <= (k) && (k) < hi)
#define SEAM(k) do { if (IN(k) && IN((k) + 1)) xcd_barrier(bar); } while (0)
    bf16* XN = (bf16*)(ws + WS_XN); bf16* Yb = (bf16*)(ws + WS_Y); bf16* PROJ = (bf16*)(ws + WS_PROJ); bf16* ACT = (bf16*)(ws + WS_ACT); float* SS = (float*)(ws + WS_SS);

    if (IN(0)) { for (int rep = 0; rep < REP_P0; ++rep) { p0_prologue(F); if (rep + 1 < REP_P0) xcd_barrier(bar); } } SEAM(0);
    if (IN(1)) { pg8::Gemm g{XN, (const bf16*)(ws + WS_WIN0), SEQ, EVEN_IN, DM}; pg8::StaticOrder S; S.init(SEQ, EVEN_IN, F.G, (int)blockIdx.x);
        pg8::EpiBf16<0> E{PROJ, EVEN_IN, SS, 64, SEQ}; pg8::gemm_phase<pg8::EpiBf16<0>, pg8::StaticOrder, true, true>(F.lds + RING_OFF, g, S, E); } SEAM(1);
    if (IN(2)) { for (int rep = 0; rep < REP_LRU; ++rep) { lru_local(F); if (rep + 1 < REP_LRU) xcd_barrier(bar); } for (int rep = 0; rep < REP_SWA; ++rep) { swa_attn(F); if (rep + 1 < REP_SWA) xcd_barrier(bar); } } SEAM(2);
    if (IN(3)) { for (int rep = 0; rep < REP_FIX; ++rep) { lru_fix(F); if (rep + 1 < REP_FIX) xcd_barrier(bar); } } SEAM(3);
    if (IN(4)) { pg8::Gemm g{Yb, (const bf16*)(ws + WS_WOUT0), SEQ, DM, DM}; pg8::StaticOrder S; S.init(SEQ, DM, F.G, (int)blockIdx.x);
        pg8::EpiRes<true> E{F.in[IN_X], XN, SS, DM}; pg8::gemm_phase<pg8::EpiRes<true>, pg8::StaticOrder, false, true>(F.lds + RING_OFF, g, S, E); } SEAM(4);
    if (IN(5)) { pg8::Gemm g{XN, (const bf16*)(ws + WS_WUP0), SEQ, DFF, DM}; pg8::StaticOrder S; S.init(SEQ, DFF, F.G, (int)blockIdx.x);
        pg8::EpiBf16<1> E{ACT, DFF, SS, 0, 0}; pg8::gemm_phase<pg8::EpiBf16<1>, pg8::StaticOrder, true, true>(F.lds + RING_OFF, g, S, E); } SEAM(5);
    if (IN(6)) { pg8::Gemm g{ACT, (const bf16*)(ws + WS_WDN0), SEQ, DM, DFF}; pg8::StaticOrder S; S.init(SEQ, DM, F.G, (int)blockIdx.x);
        pg8::EpiRes<false> E{nullptr, XN, SS, DM}; pg8::gemm_phase<pg8::EpiRes<false>, pg8::StaticOrder, false, true>(F.lds + RING_OFF, g, S, E); } SEAM(6);
    if (IN(7)) { pg8::Gemm g{XN, (const bf16*)(ws + WS_WIN1), SEQ, ODD_IN, DM}; pg8::StaticOrder S; S.init(SEQ, ODD_IN, F.G, (int)blockIdx.x);
        pg8::EpiBf16<0> E{PROJ, ODD_IN, SS, 128, SEQ}; pg8::gemm_phase<pg8::EpiBf16<0>, pg8::StaticOrder, true, true>(F.lds + RING_OFF, g, S, E); } SEAM(7);
    if (IN(8)) { for (int rep = 0; rep < REP_SB; ++rep) { sb_attn(F); if (rep + 1 < REP_SB) xcd_barrier(bar); } } SEAM(8);
    if (IN(9)) { pg8::Gemm g{Yb, (const bf16*)(ws + WS_WOUT1), SEQ, DM, DM}; pg8::StaticOrder S; S.init(SEQ, DM, F.G, (int)blockIdx.x);
        pg8::EpiRes<false> E{nullptr, XN, SS, DM}; pg8::gemm_phase<pg8::EpiRes<false>, pg8::StaticOrder, false, true>(F.lds + RING_OFF, g, S, E); } SEAM(9);
    if (IN(10)) { pg8::Gemm g{XN, (const bf16*)(ws + WS_WUP1), SEQ, DFF, DM}; pg8::StaticOrder S; S.init(SEQ, DFF, F.G, (int)blockIdx.x);
        pg8::EpiBf16<1> E{ACT, DFF, SS, 0, 0}; pg8::gemm_phase<pg8::EpiBf16<1>, pg8::StaticOrder, true, true>(F.lds + RING_OFF, g, S, E); } SEAM(10);
    if (IN(11)) { pg8::Gemm g{ACT, (const bf16*)(ws + WS_WDN1), SEQ, DM, DFF}; pg8::StaticOrder S; S.init(SEQ, DM, F.G, (int)blockIdx.x);
        pg8::EpiRes<false> E{nullptr, XN, SS, DM}; pg8::gemm_phase<pg8::EpiRes<false>, pg8::StaticOrder, false, true>(F.lds + RING_OFF, g, S, E); } SEAM(11);
    if (IN(12)) { final_norm(F); }
#undef IN
#undef SEAM
}

extern "C" void kernel_launch(void* const* d_in, const int* in_sizes, int n_in, void* d_out, int out_size, void* d_ws, size_t ws_size, hipStream_t stream) {
    static int grid = 0;
    if (grid == 0) {
        if (n_in != 19 || in_sizes[0] != SEQ * DM || out_size != SEQ * DM || ws_size < WS_END) { fprintf(stderr, "kernel_launch: unexpected shapes (n_in %d, in0 %d, out %d, ws %zu); nothing launched\n", n_in, n_in > 0 ? in_sizes[0] : -1, out_size, ws_size); grid = -1; return; }
        int dev = 0, cus = 0, per_cu = 0;
        if (hipGetDevice(&dev) != hipSuccess || hipDeviceGetAttribute(&cus, hipDeviceAttributeMultiprocessorCount, dev) != hipSuccess) { fprintf(stderr, "kernel_launch: device query failed\n"); grid = -1; return; }
        if (hipFuncSetAttribute((const void*)hybrid_fwd, hipFuncAttributeMaxDynamicSharedMemorySize, LDS_BYTES) != hipSuccess) { fprintf(stderr, "kernel_launch: hipFuncSetAttribute failed\n"); grid = -1; return; }
        if (hipOccupancyMaxActiveBlocksPerMultiprocessor(&per_cu, (const void*)hybrid_fwd, NWAVES * 64, LDS_BYTES) != hipSuccess || per_cu < 1) { fprintf(stderr, "kernel_launch: occupancy query reports %d workgroups per CU\n", per_cu); per_cu = 1; }
        (void)hipGetLastError();
        grid = cus;
        if (grid != 256) fprintf(stderr, "kernel_launch: %d CUs; the residual GEMM phases need exactly 256 workgroups\n", grid);
    }
    if (grid < 0) return;
    (void)hipMemsetAsync((char*)d_ws + WS_CTL, 0, CTL_ZERO_BYTES, stream);
    Args a{};
    for (int i = 0; i < 19; ++i) a.in[i] = (const float*)d_in[i];
    a.out = (float*)d_out; a.ws = (unsigned char*)d_ws;
#if MK_N_LAUNCHES == 1
    a.ph_lo = 0; a.ph_hi = N_PHASES;
    hipLaunchKernelGGL(hybrid_fwd, dim3(grid), dim3(NWAVES * 64), LDS_BYTES, stream, a);
#else
    for (int p = 0; p < N_PHASES; ++p) { a.ph_lo = p; a.ph_hi = p + 1; hipLaunchKernelGGL(hybrid_fwd, dim3(grid), dim3(NWAVES * 64), LDS_BYTES, stream, a); }
#endif
}
```

```cpp
#include <hip/hip_runtime.h>
#include <cstdio>
#include <cstdint>
namespace pg8 {
#define PG8_LAS __attribute__((address_space(3)))
typedef unsigned short bf16_t;
typedef short bf16x8 __attribute__((ext_vector_type(8)));
typedef float f32x4 __attribute__((ext_vector_type(4)));
typedef unsigned u32x4 __attribute__((ext_vector_type(4)));
constexpr int BM = 256, BK = 64, HALF = 128, HTB = HALF * BK * 2  , STAGE_BYTES = 8 * HTB, NXCD = 8, WGM = 8;

__host__ __device__ __forceinline__ int lds_byte(int r, int c) { const int st = (r >> 4) * 2 + (c >> 5), rr = r & 15, cc = c & 31, ob = rr * 64 + cc * 2; return st * 1024 + (ob ^ (((ob >> 9) & 1) << 5)); }
__host__ __device__ __forceinline__ void stage_rc(int b, int& R, int& C) { const int st = b / 1024, sb = b % 1024, swz = sb ^ (((sb >> 9) & 1) << 5); R = (st >> 1) * 16 + swz / 64; C = (st & 1) * 32 + (swz % 64) / 2; }
__host__ __device__ __forceinline__ int perm32(int rho) { const int n = rho >> 4, i = rho & 15; return 8 * (i >> 2) + 4 * n + (i & 3); }

struct Unit { int pm, pn; };
struct Gemm { const bf16_t* A; const bf16_t* Bt; int M, N, K; };

struct StaticOrder {
    int nM, nN, nwg, G, c;
    __host__ __device__ void init(int M, int N, int G_, int c_) { nM = M / BM; nN = N / BM; nwg = nM * nN; G = G_; c = c_; }
    __host__ __device__ bool next(int i, Unit& u) const {
        const long L = (long)i * G + c; if (L >= nwg) return false;
        int wgid = (int)L; { const int q = nwg / NXCD, r = nwg % NXCD, xcd = wgid % NXCD, off = wgid / NXCD; wgid = (xcd < r ? xcd * (q + 1) : r * (q + 1) + (xcd - r) * q) + off; }
        const int nig = WGM * nN, gid = wgid / nig, fm = gid * WGM, gsz = (nM - fm) < WGM ? (nM - fm) : WGM;
        u.pm = fm + ((wgid % nig) % gsz); u.pn = (wgid % nig) / gsz; return true;
    }
    __device__ __forceinline__ void a_ready(const Unit&) const {}
    __device__ __forceinline__ void done(const Unit&) const {}
};

__device__ __forceinline__ unsigned cvt_pk_bf16(float lo, float hi) { unsigned r; asm volatile("v_cvt_pk_bf16_f32 %0, %1, %2" : "=v"(r) : "v"(lo), "v"(hi)); return r; }
constexpr float RMS_EPS = 1e-6f;
__device__ __forceinline__ float row_rstd(const float* ss, int r) {
    const f32x4 a = *(const f32x4*)(ss + (size_t)r * 8), b = *(const f32x4*)(ss + (size_t)r * 8 + 4);
    const float s = ((a[0] + a[1]) + (a[2] + a[3])) + ((b[0] + b[1]) + (b[2] + b[3]));
    return 1.0f / sqrtf(s * (1.0f / 2048.0f) + RMS_EPS);
}
template <int ACT> struct EpiBf16 {
    static constexpr bool PERM = true, AFTER_DRAIN = false;
    bf16_t* O; int ldc; const float* ss; int grp_w, nrows; mutable float rsc[2][4]; mutable int cpm;
    __device__ __forceinline__ void operator()(const f32x4 (&acc)[2][2][4][2], const Unit& u, int wr, int wc, int fr, int fq) const {
        const int row0 = u.pm * BM + wr * 64 + fr, col0 = u.pn * BM + wc * 32 + 8 * fq;
        if (u.pm != cpm) { cpm = u.pm;
#pragma unroll
            for (int ai = 0; ai < 2; ++ai)
#pragma unroll
                for (int m = 0; m < 4; ++m) rsc[ai][m] = ss ? row_rstd(ss, row0 + ai * HALF + m * 16) : 1.0f; }
#pragma unroll
        for (int ai = 0; ai < 2; ++ai)
#pragma unroll
            for (int m = 0; m < 4; ++m) { const int r = row0 + ai * HALF + m * 16; const float rs = rsc[ai][m];
                bf16_t* rowp = grp_w ? O + ((size_t)(col0 / grp_w) * nrows + r) * grp_w + (col0 % grp_w) : O + (size_t)r * ldc + col0;
                const size_t bjstep = grp_w ? (size_t)(HALF / grp_w) * nrows * grp_w : (size_t)HALF;
#pragma unroll
                for (int bj = 0; bj < 2; ++bj) { f32x4 v0 = acc[ai][bj][m][0] * rs, v1 = acc[ai][bj][m][1] * rs;
                    if (ACT == 1) {
#pragma unroll
                        for (int j = 0; j < 4; ++j) { const float a = fmaxf(v0[j], 0.f), b = fmaxf(v1[j], 0.f); v0[j] = a * a; v1[j] = b * b; } }
                    u32x4 w; w.x = cvt_pk_bf16(v0[0], v0[1]); w.y = cvt_pk_bf16(v0[2], v0[3]); w.z = cvt_pk_bf16(v1[0], v1[1]); w.w = cvt_pk_bf16(v1[2], v1[3]);
                    *(u32x4*)(rowp + bj * bjstep) = w; } }
    }
};
template <bool BASE_F32> struct EpiRes {
    static constexpr bool PERM = true, AFTER_DRAIN = true;
    const float* base; bf16_t* xn; float* ss; int ldc;
    __device__ __forceinline__ void operator()(const f32x4 (&)[2][2][4][2], const Unit&, int, int, int, int) const {}
    __device__ __forceinline__ void fused(f32x4 (&acc)[2][2][4][2], const Unit& u, int wr, int wc, int fr, int fq, PG8_LAS unsigned char* lds, int wid, int lane) const {
        PG8_LAS float* P = (PG8_LAS float*)lds;
#pragma unroll
        for (int ai = 0; ai < 2; ++ai)
#pragma unroll
            for (int m = 0; m < 4; ++m) { const int rl = ai * HALF + wr * 64 + m * 16 + fr; const size_t off = (size_t)(u.pm * BM + rl) * ldc + u.pn * BM + wc * 32 + 8 * fq; float s = 0.f;
#pragma unroll
                for (int bj = 0; bj < 2; ++bj) { f32x4 b0, b1;
                    if (BASE_F32) { b0 = *(const f32x4*)(base + off + bj * HALF); b1 = *(const f32x4*)(base + off + bj * HALF + 4); }
                    else { const u32x4 q = *(const u32x4*)(xn + off + bj * HALF);
                        b0 = (f32x4){__builtin_bit_cast(float, q.x << 16), __builtin_bit_cast(float, q.x & 0xffff0000u), __builtin_bit_cast(float, q.y << 16), __builtin_bit_cast(float, q.y & 0xffff0000u)};
                        b1 = (f32x4){__builtin_bit_cast(float, q.z << 16), __builtin_bit_cast(float, q.z & 0xffff0000u), __builtin_bit_cast(float, q.w << 16), __builtin_bit_cast(float, q.w & 0xffff0000u)}; }
                    const f32x4 v0 = acc[ai][bj][m][0] + b0, v1 = acc[ai][bj][m][1] + b1;
                    u32x4 w; w.x = cvt_pk_bf16(v0[0], v0[1]); w.y = cvt_pk_bf16(v0[2], v0[3]); w.z = cvt_pk_bf16(v1[0], v1[1]); w.w = cvt_pk_bf16(v1[2], v1[3]);
                    *(u32x4*)(xn + off + bj * HALF) = w;
                    s += ((v0[0] * v0[0] + v0[1] * v0[1]) + (v0[2] * v0[2] + v0[3] * v0[3])) + ((v1[0] * v1[0] + v1[1] * v1[1]) + (v1[2] * v1[2] + v1[3] * v1[3])); }
                s += __shfl_xor(s, 16); s += __shfl_xor(s, 32);
                if (fq == 0) P[rl * 4 + wc] = s; }
        asm volatile("s_waitcnt lgkmcnt(0)" ::: "memory"); __builtin_amdgcn_s_barrier(); asm volatile("" ::: "memory");
        const int t = wid * 64 + lane;
        if (t < 256) { const f32x4 p = *(const PG8_LAS f32x4*)(P + t * 4); ss[(size_t)(u.pm * BM + t) * 8 + u.pn] = (p[0] + p[1]) + (p[2] + p[3]); }
        asm volatile("s_waitcnt lgkmcnt(0)" ::: "memory"); __builtin_amdgcn_s_barrier(); asm volatile("" ::: "memory");
    }
};

template <class Epi, class Sched, bool ALIGN_EPI = false, bool SP2 = false>
__device__ __forceinline__ void gemm_phase(PG8_LAS unsigned char* lds, const Gemm g, const Sched& S, const Epi& E) {
    const int tid = threadIdx.x, wid = __builtin_amdgcn_readfirstlane(tid >> 6), lane = tid & 63, wr = wid >> 2, wc = wid & 3, fr = lane & 15, fq = lane >> 4;
    const int K = g.K, nt = K / BK;
    unsigned voffA[2], voffB[2];
#pragma unroll
    for (int i = 0; i < 2; ++i) { int R, C; stage_rc(tid * 16 + i * 8192, R, C); const int Rb = Epi::PERM ? ((R & ~31) + perm32(R & 31)) : R;
        voffA[i] = (unsigned)(R * K + C) * 2u; voffB[i] = (unsigned)(Rb * K + C) * 2u; }
    const size_t kstep = (size_t)(BK * 2);
    const size_t hstep = (size_t)HALF * K * 2;
    const size_t tstep = 2 * hstep;
    const unsigned ldsw = (unsigned)wid * 1024u;
    const int aoff = lds_byte(wr * 64 + fr, fq * 8), boff = lds_byte(wc * 32 + fr, fq * 8);
#define PG8_SA(b, h) (((b) * 2 + (h)) * HTB)
#define PG8_SB(b, h) ((4 + (b) * 2 + (h)) * HTB)
#define PG8_STAGE(bufoff, gbase, voff) do { _Pragma("unroll") for (int _i = 0; _i < 2; ++_i) \
        __builtin_amdgcn_global_load_lds((const unsigned*)((const char*)(gbase) + (voff)[_i]), (PG8_LAS unsigned*)(lds + (bufoff) + ldsw + _i * 8192), 16, 0, 0); } while (0)
#define PG8_LDA(dst, b, h) do { _Pragma("unroll") for (int m = 0; m < 4; ++m) _Pragma("unroll") for (int k = 0; k < 2; ++k) dst[m][k] = *(const PG8_LAS bf16x8*)(lds + PG8_SA(b, h) + aoff + m * 2048 + k * 1024); } while (0)
#define PG8_LDB(dst, b, h) do { _Pragma("unroll") for (int n = 0; n < 2; ++n) _Pragma("unroll") for (int k = 0; k < 2; ++k) dst[n][k] = *(const PG8_LAS bf16x8*)(lds + PG8_SB(b, h) + boff + n * 2048 + k * 1024); } while (0)
#define PG8_MMA(ai, bj, At, Bt) do { __builtin_amdgcn_s_setprio(1); _Pragma("unroll") for (int m = 0; m < 4; ++m) _Pragma("unroll") for (int n = 0; n < 2; ++n) _Pragma("unroll") for (int k = 0; k < 2; ++k) \
        acc[ai][bj][m][n] = __builtin_amdgcn_mfma_f32_16x16x32_bf16(Bt[n][k], At[m][k], acc[ai][bj][m][n], 0, 0, 0); __builtin_amdgcn_s_setprio(0); } while (0)
#define PG8_WAIT_V(n) asm volatile("s_waitcnt vmcnt(" #n ")" ::: "memory")
#define PG8_WAIT_L(n) asm volatile("s_waitcnt lgkmcnt(" #n ")" ::: "memory")
#define PG8_BAR __builtin_amdgcn_s_barrier()
#define PG8_SCHED __builtin_amdgcn_sched_barrier(0)
    Unit cur, nxt; int ui = 0;
    if (!S.next(0, cur)) return;
    f32x4 acc[2][2][4][2];
#pragma unroll
    for (int a = 0; a < 2; ++a)
#pragma unroll
        for (int b = 0; b < 2; ++b)
#pragma unroll
            for (int m = 0; m < 4; ++m)
#pragma unroll
                for (int n = 0; n < 2; ++n) acc[a][b][m][n] = (f32x4){0.f, 0.f, 0.f, 0.f};
    bf16x8 At[4][2], B0[2][2], B1[2][2];
    const char* cA = (const char*)g.A + (size_t)cur.pm * tstep; const char* cB = (const char*)g.Bt + (size_t)cur.pn * tstep;
    S.a_ready(cur);
    if constexpr (SP2) {
        PG8_STAGE(PG8_SB(0, 0), cB, voffB); PG8_STAGE(PG8_SB(0, 1), cB + hstep, voffB); PG8_STAGE(PG8_SA(0, 0), cA, voffA); PG8_STAGE(PG8_SA(0, 1), cA + hstep, voffA);
        if (wr == 1) PG8_BAR;
        PG8_WAIT_V(2); PG8_BAR;
        PG8_STAGE(PG8_SB(1, 0), cB + kstep, voffB); PG8_STAGE(PG8_SA(1, 0), cA + kstep, voffA); PG8_STAGE(PG8_SB(1, 1), cB + hstep + kstep, voffB);
        PG8_WAIT_V(6); PG8_BAR;
    } else {
        PG8_STAGE(PG8_SB(0, 0), cB, voffB); PG8_STAGE(PG8_SA(0, 0), cA, voffA); PG8_STAGE(PG8_SB(0, 1), cB + hstep, voffB); PG8_STAGE(PG8_SA(0, 1), cA + hstep, voffA);
        if (wr == 1) PG8_BAR;
        PG8_WAIT_V(4); PG8_BAR;
        PG8_STAGE(PG8_SB(1, 0), cB + kstep, voffB); PG8_STAGE(PG8_SA(1, 0), cA + kstep, voffA); PG8_STAGE(PG8_SB(1, 1), cB + hstep + kstep, voffB);
        PG8_WAIT_V(6); PG8_BAR;
    }
    for (;;) {
        const bool has_next = S.next(ui + 1, nxt);
        const char* nA = has_next ? (const char*)g.A + (size_t)nxt.pm * tstep : cA; const char* nB = has_next ? (const char*)g.Bt + (size_t)nxt.pn * tstep : cB;
        for (int t = 0; t < nt; t += 2) {
            const bool last = (t == nt - 2);
            const char* a1 = cA + (size_t)(t + 1) * kstep;
            const char* a2 = last ? nA : cA + (size_t)(t + 2) * kstep; const char* b2 = last ? nB : cB + (size_t)(t + 2) * kstep;
            const char* a3 = a2 + kstep; const char* b3 = b2 + kstep;
            if (last && has_next) S.a_ready(nxt);
            if constexpr (SP2) {
            PG8_LDB(B0, 0, 0); PG8_LDB(B1, 0, 1); PG8_SCHED; PG8_LDA(At, 0, 0); PG8_STAGE(PG8_SA(1, 1), a1 + hstep, voffA);
            PG8_WAIT_V(8); PG8_WAIT_L(0); PG8_BAR; PG8_MMA(0, 0, At, B0); PG8_MMA(0, 1, At, B1); PG8_BAR; PG8_SCHED;
            PG8_LDA(At, 0, 1); PG8_STAGE(PG8_SB(0, 0), b2, voffB); PG8_STAGE(PG8_SB(0, 1), b2 + hstep, voffB); PG8_STAGE(PG8_SA(0, 0), a2, voffA);
            PG8_WAIT_V(8); PG8_WAIT_L(0); PG8_BAR; PG8_MMA(1, 0, At, B0); PG8_MMA(1, 1, At, B1); PG8_BAR; PG8_SCHED;
            PG8_LDB(B0, 1, 0); PG8_LDB(B1, 1, 1); PG8_SCHED; PG8_LDA(At, 1, 0); PG8_STAGE(PG8_SA(0, 1), a2 + hstep, voffA);
            PG8_WAIT_V(8); PG8_WAIT_L(0); PG8_BAR; PG8_MMA(0, 0, At, B0); PG8_MMA(0, 1, At, B1); PG8_BAR; PG8_SCHED;
            PG8_LDA(At, 1, 1); PG8_STAGE(PG8_SB(1, 0), b3, voffB); PG8_STAGE(PG8_SB(1, 1), b3 + hstep, voffB); PG8_STAGE(PG8_SA(1, 0), a3, voffA);
            PG8_WAIT_V(8); PG8_WAIT_L(0); PG8_BAR; PG8_MMA(1, 0, At, B0); PG8_MMA(1, 1, At, B1); PG8_BAR; PG8_SCHED;
            } else {
            PG8_LDB(B0, 0, 0); PG8_SCHED; PG8_LDA(At, 0, 0); PG8_STAGE(PG8_SA(1, 1), a1 + hstep, voffA);
            PG8_WAIT_L(8); PG8_BAR; PG8_WAIT_L(0); PG8_MMA(0, 0, At, B0); PG8_BAR; PG8_SCHED;
            PG8_LDB(B1, 0, 1); PG8_STAGE(PG8_SB(0, 0), b2, voffB);
            PG8_BAR; PG8_WAIT_L(0); PG8_MMA(0, 1, At, B1); PG8_BAR;
            PG8_LDA(At, 0, 1); PG8_STAGE(PG8_SA(0, 0), a2, voffA);
            PG8_BAR; PG8_WAIT_L(0); PG8_MMA(1, 0, At, B0); PG8_BAR; PG8_SCHED;
            PG8_STAGE(PG8_SB(0, 1), b2 + hstep, voffB);
            PG8_WAIT_V(6); PG8_BAR; PG8_MMA(1, 1, At, B1); PG8_BAR;
            PG8_LDB(B0, 1, 0); PG8_SCHED; PG8_LDA(At, 1, 0); PG8_STAGE(PG8_SA(0, 1), a2 + hstep, voffA);
            PG8_WAIT_L(8); PG8_BAR; PG8_WAIT_L(0); PG8_MMA(0, 0, At, B0); PG8_BAR; PG8_SCHED;
            PG8_LDB(B1, 1, 1); PG8_STAGE(PG8_SB(1, 0), b3, voffB);
            PG8_BAR; PG8_WAIT_L(0); PG8_MMA(0, 1, At, B1); PG8_BAR;
            PG8_LDA(At, 1, 1); PG8_STAGE(PG8_SA(1, 0), a3, voffA);
            PG8_BAR; PG8_WAIT_L(0); PG8_MMA(1, 0, At, B0); PG8_BAR; PG8_SCHED;
            PG8_STAGE(PG8_SB(1, 1), b3 + hstep, voffB);
            PG8_WAIT_V(6); PG8_BAR; PG8_MMA(1, 1, At, B1); PG8_BAR;
            }
        }
        if constexpr (ALIGN_EPI) { if (wr == 0) PG8_BAR; }
        if constexpr (!Epi::AFTER_DRAIN) { E(acc, cur, wr, wc, fr, fq); S.done(cur); }
        if (!has_next) break;
#pragma unroll
        for (int a = 0; a < 2; ++a)
#pragma unroll
            for (int b = 0; b < 2; ++b)
#pragma unroll
                for (int m = 0; m < 4; ++m)
#pragma unroll
                    for (int n = 0; n < 2; ++n) acc[a][b][m][n] = (f32x4){0.f, 0.f, 0.f, 0.f};
        cur = nxt; cA = nA; cB = nB; ++ui;
        if constexpr (ALIGN_EPI) { if (wr == 1) PG8_BAR; }
    }
    PG8_WAIT_V(0);
    if constexpr (!ALIGN_EPI) { if (wr == 0) PG8_BAR; }
    PG8_BAR;
    if constexpr (Epi::AFTER_DRAIN) { E.fused(acc, cur, wr, wc, fr, fq, lds, wid, lane); S.done(cur); }
#undef PG8_SA
#undef PG8_SB
#undef PG8_STAGE
#undef PG8_LDA
#undef PG8_LDB
#undef PG8_MMA
#undef PG8_WAIT_V
#undef PG8_WAIT_L
#undef PG8_BAR
#undef PG8_SCHED
}
}

constexpr int NWAVES = 8;
constexpr int SEQ = 8192, DM = 2048, DFF = 8192, EVEN_IN = 3584, ODD_IN = 6144;
constexpr int OFF_K = 1024, OFF_V = 1280, OFF_X = 1536, OFF_G = 2560;
#ifndef MK_N_LAUNCHES
#define MK_N_LAUNCHES 1
#endif
constexpr int N_PHASES = 13;
constexpr size_t MiB = 1u << 20;
constexpr size_t WS_CTL = 0, CTL_ZERO_BYTES = 64 * 1024;
constexpr size_t WS_SS = 1 * MiB;
constexpr size_t WS_BT = 1 * MiB + 512 * 1024;
constexpr size_t WS_GWT = 1 * MiB + 768 * 1024;
constexpr size_t WS_WIN0 = 2 * MiB, WS_WOUT0 = 16 * MiB, WS_WUP0 = 24 * MiB, WS_WDN0 = 56 * MiB, WS_WIN1 = 88 * MiB, WS_WOUT1 = 112 * MiB, WS_WUP1 = 120 * MiB, WS_WDN1 = 152 * MiB;
constexpr size_t WS_XN = 184 * MiB;
constexpr size_t WS_Y = 216 * MiB;
constexpr size_t WS_PROJ = 248 * MiB;
constexpr size_t WS_HL = 344 * MiB, WS_PA = 376 * MiB;
constexpr size_t WS_ACT = 248 * MiB;
constexpr size_t WS_END = 408 * MiB;
constexpr int CW_BAR = 1024;

constexpr int RING_OFF = 0, RING_BYTES = 131072;
constexpr int LDSCTL_OFF = RING_BYTES, MISC_OFF = LDSCTL_OFF + 320;
constexpr int LDS_BYTES = 147456;

#define GAS __attribute__((address_space(1)))
#define LAS __attribute__((address_space(3)))
typedef unsigned short bf16;
typedef unsigned v4u __attribute__((ext_vector_type(4)));
typedef unsigned v2u __attribute__((ext_vector_type(2)));
typedef float f32x4 __attribute__((ext_vector_type(4)));
#define LDS_WAIT() asm volatile("s_waitcnt lgkmcnt(0)" ::: "memory")
#define VM_WAIT() asm volatile("s_waitcnt vmcnt(0)" ::: "memory")
__device__ __forceinline__ unsigned f2bf(float f) { unsigned u = __builtin_bit_cast(unsigned, f); return (u + 0x7fffu + ((u >> 16) & 1u)) >> 16; }
__device__ __forceinline__ unsigned pk2(float lo, float hi) { return f2bf(lo) | (f2bf(hi) << 16); }
__device__ __forceinline__ float bflo(unsigned w) { return __builtin_bit_cast(float, w << 16); }
__device__ __forceinline__ float bfhi(unsigned w) { return __builtin_bit_cast(float, w & 0xffff0000u); }

#define XB_TMO      128
#define XB_XCNT(j)  (256  + 64 * (j))
#define XB_XSUB(j)  (1280 + 64 * (j))
#define XB_XGEN(j)  (2304 + 64 * (j))
#define XB_TOP      3328
#define XB_TOPGEN   3392
#define XCD_BAR_WORDS 3456
#define XB_SPIN_CAP (1u << 22)

__device__ __forceinline__ unsigned xb_ld(unsigned* p)              { return __hip_atomic_load(p, __ATOMIC_RELAXED, __HIP_MEMORY_SCOPE_AGENT); }
__device__ __forceinline__ unsigned xb_add(unsigned* p, unsigned v) { return __hip_atomic_fetch_add(p, v, __ATOMIC_RELAXED, __HIP_MEMORY_SCOPE_AGENT); }
__device__ __forceinline__ unsigned xb_xcc_id() { return (unsigned)__builtin_amdgcn_s_getreg((3 << 11) | 20) & 0xFu; }
#define XB_SPIN(cond, bar) do { unsigned _sp = 0; while (cond) { __builtin_amdgcn_s_sleep(1); \
    if ((++_sp & 255u) == 0u) { if (xb_ld(&(bar)[XB_TMO])) break; if (_sp > XB_SPIN_CAP) { atomicAdd(&(bar)[XB_TMO], 1u); break; } } } } while (0)

struct XcdBarrier {
    unsigned* bar; unsigned x;
    volatile LAS unsigned* st;
};

__device__ __forceinline__ XcdBarrier xcd_barrier_post(unsigned* bar, volatile LAS unsigned* st) {
    XcdBarrier b; b.bar = bar; b.x = xb_xcc_id(); b.st = st;
    if (threadIdx.x == 0) (void)xb_add(&bar[XB_XCNT(b.x)], 1u);
    return b;
}
__device__ __forceinline__ void xcd_barrier_complete(unsigned* bar, unsigned x, unsigned& nloc, unsigned& nx) {
    const unsigned G = gridDim.x * gridDim.y * gridDim.z;
    unsigned sum, cnt, mine, sp = 0u;
    for (;;) {
        sum = 0u; cnt = 0u; mine = 0u;
#pragma unroll
        for (unsigned j = 0; j < 16; ++j) { const unsigned c = xb_ld(&bar[XB_XCNT(j)]); sum += c; cnt += (c > 0u) ? 1u : 0u; mine = (j == x) ? c : mine; }
        if (sum == G) break;
        __builtin_amdgcn_s_sleep(1);
        if ((++sp & 255u) == 0u) { if (xb_ld(&bar[XB_TMO])) break; if (sp > XB_SPIN_CAP) { atomicAdd(&bar[XB_TMO], 1u); break; } }
    }
    nloc = mine > 0u ? mine : 1u; nx = cnt > 0u ? cnt : 1u;
}

__device__ __forceinline__ void xcd_barrier(const XcdBarrier& b) {
    asm volatile("s_waitcnt vmcnt(0)" ::: "memory");
    __syncthreads();
    if (threadIdx.x == 0) {
        unsigned* bar = b.bar;
        __builtin_amdgcn_s_waitcnt(0);
        unsigned nloc = b.st[0], nx = b.st[1];
        if (nloc == 0u) { xcd_barrier_complete(bar, b.x, nloc, nx); b.st[0] = nloc; b.st[1] = nx; }
        const unsigned old = xb_add(&bar[XB_XSUB(b.x)], 1u);
        const unsigned gen = old / nloc;
        if (old + 1u == (gen + 1u) * nloc) {
            __builtin_amdgcn_fence(__ATOMIC_RELEASE, "agent");
            asm volatile("s_waitcnt vmcnt(0)" ::: "memory");
            const unsigned og = xb_add(&bar[XB_TOP], 1u);
            const unsigned tg = og / nx;
            if (og + 1u == (tg + 1u) * nx) xb_add(&bar[XB_TOPGEN], 1u);
            else XB_SPIN(xb_ld(&bar[XB_TOPGEN]) == tg, bar);
            __builtin_amdgcn_fence(__ATOMIC_ACQUIRE, "agent");
            xb_add(&bar[XB_XGEN(b.x)], 1u);
            asm volatile("s_waitcnt vmcnt(0)" ::: "memory");
        } else {
            XB_SPIN(xb_ld(&bar[XB_XGEN(b.x)]) == gen, bar);
            __builtin_amdgcn_fence(__ATOMIC_ACQUIRE, "agent");
            asm volatile("s_waitcnt vmcnt(0)" ::: "memory");
        }
    }
    __syncthreads();
}
struct Frame {
    LAS unsigned char* lds;
    int tid, lane, wave, G;
    const float* in[19]; float* out; unsigned char* ws;
};
#define IN_X 0
#define IN_RELB 1
#define IN_NMIX 2
#define IN_EWIN 3
#define IN_CONVW 4
#define IN_CONVB 5
#define IN_GAW 6
#define IN_GAB 7
#define IN_GXW 8
#define IN_GXB 9
#define IN_LAMBDA 10
#define IN_SINKS 11
#define IN_EWOUT 12
#define IN_OWIN 13
#define IN_OWOUT 14
#define IN_NMLP 15
#define IN_WUP 16
#define IN_WDOWN 17
#define IN_FNORM 18

__device__ __forceinline__ float wave_sum(float v) {
#pragma unroll
    for (int o = 1; o < 64; o <<= 1) v += __shfl_xor(v, o);
    return v;
}
struct P0Tile { const float* W; const float* gain; bf16* WT; int K, N, k0, n0; };
__device__ __forceinline__ void p0_tile_load(const P0Tile& t, int lane, f32x4 (&v)[16]) {
    const GAS f32x4* p = (const GAS f32x4*)(t.W + (size_t)(t.k0 + (lane >> 4)) * t.N + t.n0 + 4 * (lane & 15));
#pragma unroll
    for (int i = 0; i < 16; ++i) v[i] = p[(size_t)i * t.N];
}
__device__ __forceinline__ void p0_tile_store(const P0Tile& t, int lane, const f32x4 (&v)[16], LAS float* scr) {
#pragma unroll
    for (int i = 0; i < 16; ++i) { const int kk = (lane >> 4) + 4 * i; *(LAS f32x4*)(scr + kk * 64 + ((4 * (lane & 15)) ^ (4 * ((kk >> 3) & 7)))) = v[i]; }
    LDS_WAIT(); asm volatile("" ::: "memory");
    const int kc = lane & 7;
    float g[8];
    if (t.gain) { const f32x4 a = *(const GAS f32x4*)(t.gain + t.k0 + 8 * kc), b = *(const GAS f32x4*)(t.gain + t.k0 + 8 * kc + 4); g[0] = a[0]; g[1] = a[1]; g[2] = a[2]; g[3] = a[3]; g[4] = b[0]; g[5] = b[1]; g[6] = b[2]; g[7] = b[3]; }
    else {
#pragma unroll
        for (int e = 0; e < 8; ++e) g[e] = 1.0f; }
#pragma unroll
    for (int j = 0; j < 8; ++j) { const int n = (lane >> 3) + 8 * j; const LAS float* s = scr + (8 * kc) * 64 + (n ^ (4 * kc));
        v4u o; o.x = pk2(s[0] * g[0], s[64] * g[1]); o.y = pk2(s[128] * g[2], s[192] * g[3]); o.z = pk2(s[256] * g[4], s[320] * g[5]); o.w = pk2(s[384] * g[6], s[448] * g[7]);
        *(GAS v4u*)(t.WT + (size_t)(t.n0 + n) * t.K + t.k0 + 8 * kc) = o; }
    LDS_WAIT(); asm volatile("" ::: "memory");
}
__device__ __forceinline__ int t5_bucket(int rel) {
    const int ret = rel > 0 ? 16 : 0, n = rel < 0 ? -rel : rel;
    if (n < 8) return ret + n;
    int large = 8 + (31 - __builtin_clz((unsigned)(n * n))) - 6; if (large > 15) large = 15;
    return ret + large;
}
__device__ __forceinline__ void p0_prologue(Frame& F) {
    LAS float* scr = (LAS float*)(F.lds + RING_OFF + F.wave * 16384);
    const int gw = blockIdx.x * NWAVES + F.wave, NGW = F.G * NWAVES;
    unsigned char* ws = F.ws;
    constexpr int T_IN0 = (DM / 64) * (EVEN_IN / 64), T_OUT = (DM / 64) * (DM / 64), T_UP = (DM / 64) * (DFF / 64), T_DN = (DFF / 64) * (DM / 64), T_IN1 = (DM / 64) * (ODD_IN / 64);
    constexpr int NTILES = T_IN0 + T_IN1 + 2 * T_OUT + 2 * T_UP + 2 * T_DN;
#define P0_DESC(it, t) do { int r_ = (it); \
        if (r_ < T_IN0) { t.W = F.in[IN_EWIN]; t.gain = F.in[IN_NMIX]; t.WT = (bf16*)(ws + WS_WIN0); t.K = DM; t.N = EVEN_IN; } else { r_ -= T_IN0; \
        if (r_ < T_OUT) { t.W = F.in[IN_EWOUT]; t.gain = nullptr; t.WT = (bf16*)(ws + WS_WOUT0); t.K = DM; t.N = DM; } else { r_ -= T_OUT; \
        if (r_ < T_UP) { t.W = F.in[IN_WUP]; t.gain = F.in[IN_NMLP]; t.WT = (bf16*)(ws + WS_WUP0); t.K = DM; t.N = DFF; } else { r_ -= T_UP; \
        if (r_ < T_DN) { t.W = F.in[IN_WDOWN]; t.gain = nullptr; t.WT = (bf16*)(ws + WS_WDN0); t.K = DFF; t.N = DM; } else { r_ -= T_DN; \
        if (r_ < T_IN1) { t.W = F.in[IN_OWIN]; t.gain = F.in[IN_NMIX] + DM; t.WT = (bf16*)(ws + WS_WIN1); t.K = DM; t.N = ODD_IN; } else { r_ -= T_IN1; \
        if (r_ < T_OUT) { t.W = F.in[IN_OWOUT]; t.gain = nullptr; t.WT = (bf16*)(ws + WS_WOUT1); t.K = DM; t.N = DM; } else { r_ -= T_OUT; \
        if (r_ < T_UP) { t.W = F.in[IN_WUP] + (size_t)DM * DFF; t.gain = F.in[IN_NMLP] + DM; t.WT = (bf16*)(ws + WS_WUP1); t.K = DM; t.N = DFF; } else { r_ -= T_UP; \
        t.W = F.in[IN_WDOWN] + (size_t)DFF * DM; t.gain = nullptr; t.WT = (bf16*)(ws + WS_WDN1); t.K = DFF; t.N = DM; } } } } } } } \
        const int nb_ = t.N / 64; t.k0 = 64 * (r_ / nb_); t.n0 = 64 * (r_ % nb_); } while (0)
    {
        f32x4 va[16], vb[16]; P0Tile ta, tb;
        int it = gw;
        if (it < NTILES) { P0_DESC(it, ta); p0_tile_load(ta, F.lane, va); }
        while (it < NTILES) {
            const int itn = it + NGW; const bool more = itn < NTILES;
            if (more) { P0_DESC(itn, tb); p0_tile_load(tb, F.lane, vb); }
            p0_tile_store(ta, F.lane, va, scr);
            if (more) { ta = tb;
#pragma unroll
                for (int i = 0; i < 16; ++i) va[i] = vb[i]; }
            it = itn;
        }
    }
#undef P0_DESC
    bf16* XN = (bf16*)(ws + WS_XN); float* SS = (float*)(ws + WS_SS);
    for (int m = gw; m < SEQ; m += NGW) {
        const GAS f32x4* xr = (const GAS f32x4*)(F.in[IN_X] + (size_t)m * DM) + F.lane;
        f32x4 v[8]; float s = 0.f;
#pragma unroll
        for (int j = 0; j < 8; ++j) { v[j] = xr[64 * j]; s += (v[j].x * v[j].x + v[j].y * v[j].y) + (v[j].z * v[j].z + v[j].w * v[j].w); }
        s = wave_sum(s);
        GAS v2u* o8 = (GAS v2u*)(XN + (size_t)m * DM) + F.lane;
#pragma unroll
        for (int j = 0; j < 8; ++j) { v2u w; w.x = pk2(v[j].x, v[j].y); w.y = pk2(v[j].z, v[j].w); o8[64 * j] = w; }
        if (F.lane < 8) SS[(size_t)m * 8 + F.lane] = F.lane == 0 ? s : 0.f;
    }
    float* BT = (float*)(ws + WS_BT);
    for (int i = blockIdx.x * 512 + F.tid; i < 16 * 256; i += F.G * 512) { const int head = i >> 8, rel = (i & 255) - 191; BT[i] = F.in[IN_RELB][t5_bucket(rel) * 16 + head]; }
    bf16* GWT = (bf16*)(ws + WS_GWT);
    for (int i = blockIdx.x * 512 + F.tid; i < 2 * 16 * 64 * 64; i += F.G * 512) { const int gate = i >> 16, hb = (i >> 12) & 15, jo = (i >> 6) & 63, ii = i & 63;
        GWT[i] = (bf16)f2bf(F.in[gate ? IN_GXW : IN_GAW][(size_t)(hb * 64 + ii) * 64 + jo]); }
}

__device__ __forceinline__ void ld8(const bf16* p, float (&o)[8]) { const v4u w = *(const GAS v4u*)p; o[0] = bflo(w.x); o[1] = bfhi(w.x); o[2] = bflo(w.y); o[3] = bfhi(w.y); o[4] = bflo(w.z); o[5] = bfhi(w.z); o[6] = bflo(w.w); o[7] = bfhi(w.w); }
__device__ __forceinline__ void swa_naive(Frame& F) {
    const bf16* PROJ = (const bf16*)(F.ws + WS_PROJ); bf16* Y = (bf16*)(F.ws + WS_Y); const float* BT = (const float*)(F.ws + WS_BT);
    for (int idx = blockIdx.x * 512 + F.tid; idx < SEQ * 16; idx += F.G * 512) {
        const int head = idx >> 13, tok = idx & (SEQ - 1), kvh = head >> 2, c = tok >> 6;
        float q[64], acc[64];
#pragma unroll
        for (int i = 0; i < 8; ++i) { float t[8]; ld8(PROJ + (size_t)tok * EVEN_IN + head * 64 + 8 * i, t);
#pragma unroll
            for (int j = 0; j < 8; ++j) { q[8 * i + j] = t[j] * 0.125f; acc[8 * i + j] = 0.f; } }
        float m = F.in[IN_SINKS][head], l = 1.0f;
        const int k0 = c >= 2 ? (c - 2) * 64 : 0, k1 = (c + 1) * 64;
        const float* bt = BT + head * 256;
        for (int j = k0; j < k1; ++j) {
            const bf16* kp = PROJ + (size_t)j * EVEN_IN + OFF_K + kvh * 64; float s = 0.f;
#pragma unroll
            for (int i = 0; i < 8; ++i) { float t[8]; ld8(kp + 8 * i, t);
#pragma unroll
                for (int e = 0; e < 8; ++e) s += q[8 * i + e] * t[e]; }
            s += bt[j - tok + 191];
            const float mn = fmaxf(m, s), corr = expf(m - mn), p = expf(s - mn);
            l = l * corr + p; m = mn;
            const bf16* vp = PROJ + (size_t)j * EVEN_IN + OFF_V + kvh * 64;
#pragma unroll
            for (int i = 0; i < 8; ++i) { float t[8]; ld8(vp + 8 * i, t);
#pragma unroll
                for (int e = 0; e < 8; ++e) acc[8 * i + e] = acc[8 * i + e] * corr + p * t[e]; }
        }
        const float inv = 1.0f / l;
#pragma unroll
        for (int i = 0; i < 8; ++i) { v4u w; w.x = pk2(acc[8 * i] * inv, acc[8 * i + 1] * inv); w.y = pk2(acc[8 * i + 2] * inv, acc[8 * i + 3] * inv); w.z = pk2(acc[8 * i + 4] * inv, acc[8 * i + 5] * inv); w.w = pk2(acc[8 * i + 6] * inv, acc[8 * i + 7] * inv);
            *(GAS v4u*)(Y + (size_t)tok * DM + head * 64 + 8 * i) = w; }
    }
}
__device__ __forceinline__ float softplusf(float z) { return fmaxf(z, 0.f) + log1pf(expf(-fabsf(z))); }
__device__ __forceinline__ float sigmoidf_(float z) { return 1.0f / (1.0f + expf(-z)); }
__device__ __forceinline__ float gelu_tanh(float x) { const float u = 0.7978845608028654f * (x + 0.044715f * x * x * x); return 0.5f * x * (1.0f + tanhf(u)); }
__device__ __forceinline__ void lru_naive(Frame& F) {
    if (blockIdx.x >= 16 || F.wave != 0) return;
    const bf16* PROJ = (const bf16*)(F.ws + WS_PROJ); bf16* Y = (bf16*)(F.ws + WS_Y);
    const int hb = blockIdx.x, lane = F.lane, c = hb * 64 + lane;
    float Wa[64], Wx[64];
#pragma unroll
    for (int i = 0; i < 64; ++i) { Wa[i] = F.in[IN_GAW][(size_t)(hb * 64 + i) * 64 + lane]; Wx[i] = F.in[IN_GXW][(size_t)(hb * 64 + i) * 64 + lane]; }
    const float ba = F.in[IN_GAB][c], bx = F.in[IN_GXB][c], cb = F.in[IN_CONVB][c];
    const float cw0 = F.in[IN_CONVW][c], cw1 = F.in[IN_CONVW][1024 + c], cw2 = F.in[IN_CONVW][2048 + c], cw3 = F.in[IN_CONVW][3072 + c];
    const float sp8 = 8.0f * softplusf(-F.in[IN_LAMBDA][c]);
    float x1 = 0.f, x2 = 0.f, x3 = 0.f, h = 0.f;
    for (int t0 = 0; t0 < SEQ; t0 += 8) {
        float xb[8], g[8];
#pragma unroll
        for (int u = 0; u < 8; ++u) { xb[u] = bflo((unsigned)PROJ[(size_t)(t0 + u) * EVEN_IN + OFF_X + c]); g[u] = bflo((unsigned)PROJ[(size_t)(t0 + u) * EVEN_IN + OFF_G + c]); }
#pragma unroll
        for (int u = 0; u < 8; ++u) {
            const float xt = xb[u], xc = cb + cw0 * x3 + cw1 * x2 + cw2 * x1 + cw3 * xt; x3 = x2; x2 = x1; x1 = xt;
            float ra = ba, rx = bx; const int xci = __builtin_bit_cast(int, xc);
#pragma unroll
            for (int i = 0; i < 64; ++i) { const float xi = __builtin_bit_cast(float, __builtin_amdgcn_readlane(xci, i)); ra += xi * Wa[i]; rx += xi * Wx[i]; }
            const float r = sigmoidf_(ra), ig = sigmoidf_(rx), log_a = -r * sp8, a = expf(log_a), mult = sqrtf(-expm1f(2.0f * log_a));
            h = a * h + mult * (ig * xc);
            Y[(size_t)(t0 + u) * DM + 1024 + c] = (bf16)f2bf(gelu_tanh(g[u]) * h);
        }
    }
}
__device__ __forceinline__ void sb_naive(Frame& F) {
    const bf16* PROJ = (const bf16*)(F.ws + WS_PROJ); bf16* Y = (bf16*)(F.ws + WS_Y);
    const int gt = blockIdx.x * 512 + F.tid, half = gt & 1;
    for (int pidx = gt >> 1; pidx < SEQ * 16; pidx += (F.G * 512) >> 1) {
        const int head = pidx >> 13, tok = pidx & (SEQ - 1);
        float q[64], acc[64];
#pragma unroll
        for (int i = 0; i < 8; ++i) { float t[8]; ld8(PROJ + (size_t)tok * ODD_IN + head * 128 + half * 64 + 8 * i, t);
#pragma unroll
            for (int j = 0; j < 8; ++j) { q[8 * i + j] = t[j] * 0.08838834764831845f; acc[8 * i + j] = 0.f; } }
        float stick = 0.f;
        for (int j = tok - 1; j >= 0; --j) {
            const bf16* kp = PROJ + (size_t)j * ODD_IN + 2048 + head * 128 + half * 64; float s = 0.f;
#pragma unroll
            for (int i = 0; i < 8; ++i) { float t[8]; ld8(kp + 8 * i, t);
#pragma unroll
                for (int e = 0; e < 8; ++e) s += q[8 * i + e] * t[e]; }
            const float z = s + __shfl_xor(s, 1);
            const float lk = -softplusf(z), w = expf(z + lk + stick);
            const bf16* vp = PROJ + (size_t)j * ODD_IN + 4096 + head * 128 + half * 64;
#pragma unroll
            for (int i = 0; i < 8; ++i) { float t[8]; ld8(vp + 8 * i, t);
#pragma unroll
                for (int e = 0; e < 8; ++e) acc[8 * i + e] += w * t[e]; }
            stick += lk;
            if (stick < -104.0f) break;
        }
#pragma unroll
        for (int i = 0; i < 8; ++i) { v4u w; w.x = pk2(acc[8 * i], acc[8 * i + 1]); w.y = pk2(acc[8 * i + 2], acc[8 * i + 3]); w.z = pk2(acc[8 * i + 4], acc[8 * i + 5]); w.w = pk2(acc[8 * i + 6], acc[8 * i + 7]);
            *(GAS v4u*)(Y + (size_t)tok * DM + head * 128 + half * 64 + 8 * i) = w; }
    }
}
__device__ __forceinline__ void final_norm(Frame& F) {
    const int gw = blockIdx.x * NWAVES + F.wave, NGW = F.G * NWAVES;
    const bf16* XN = (const bf16*)(F.ws + WS_XN); const float* SS = (const float*)(F.ws + WS_SS);
    const GAS f32x4* gp = (const GAS f32x4*)F.in[IN_FNORM] + 2 * F.lane;
    for (int m = gw; m < SEQ; m += NGW) {
        const GAS v4u* xr = (const GAS v4u*)(XN + (size_t)m * DM) + F.lane;
        GAS f32x4* orow = (GAS f32x4*)(F.out + (size_t)m * DM) + 2 * F.lane;
        const f32x4 sa = *(const GAS f32x4*)(SS + (size_t)m * 8), sb = *(const GAS f32x4*)(SS + (size_t)m * 8 + 4);
        const float rstd = 1.0f / sqrtf((((sa[0] + sa[1]) + (sa[2] + sa[3])) + ((sb[0] + sb[1]) + (sb[2] + sb[3]))) * (1.0f / DM) + 1e-6f);
        v4u v[4];
#pragma unroll
        for (int j = 0; j < 4; ++j) v[j] = xr[64 * j];
#pragma unroll
        for (int j = 0; j < 4; ++j) { const f32x4 g0 = gp[128 * j], g1 = gp[128 * j + 1];
            orow[128 * j] = (f32x4){bflo(v[j].x) * rstd * g0[0], bfhi(v[j].x) * rstd * g0[1], bflo(v[j].y) * rstd * g0[2], bfhi(v[j].y) * rstd * g0[3]};
            orow[128 * j + 1] = (f32x4){bflo(v[j].z) * rstd * g1[0], bfhi(v[j].z) * rstd * g1[1], bflo(v[j].w) * rstd * g1[2], bfhi(v[j].w) * rstd * g1[3]}; }
    }
}
typedef float f32x16 __attribute__((ext_vector_type(16)));
typedef short s16x8 __attribute__((ext_vector_type(8)));
typedef short s16x4 __attribute__((ext_vector_type(4)));
typedef __bf16 bf16x2v __attribute__((ext_vector_type(2)));
#define MFMA32(a, b, c) __builtin_amdgcn_mfma_f32_32x32x16_bf16((a), (b), (c), 0, 0, 0)
__device__ __forceinline__ int crow(int i, int h) { return (i & 3) + 8 * (i >> 2) + 4 * h; }
__device__ __forceinline__ unsigned pkbf(float a, float b) { bf16x2v v; v.x = (__bf16)a; v.y = (__bf16)b; return __builtin_bit_cast(unsigned, v); }
__device__ __forceinline__ s16x8 pack8(const float (&p)[16], int s) {
    v4u w; w.x = pkbf(p[8 * s], p[8 * s + 1]); w.y = pkbf(p[8 * s + 2], p[8 * s + 3]); w.z = pkbf(p[8 * s + 4], p[8 * s + 5]); w.w = pkbf(p[8 * s + 6], p[8 * s + 7]);
    return __builtin_bit_cast(s16x8, w);
}
__device__ __forceinline__ s16x8 tr_frag(const LAS unsigned char* p0, const LAS unsigned char* p1) {
    const s16x4 lo = __builtin_amdgcn_ds_read_tr16_b64_v4i16((LAS s16x4*)p0), hi = __builtin_amdgcn_ds_read_tr16_b64_v4i16((LAS s16x4*)p1);
    return __builtin_shufflevector(lo, hi, 0, 1, 2, 3, 4, 5, 6, 7);
}
__device__ __forceinline__ float ex2(float x) { return __builtin_amdgcn_exp2f(x); }
__device__ __forceinline__ float lg2(float x) { return __builtin_amdgcn_logf(x); }
__device__ __forceinline__ float fast_exp(float x) { return ex2(x * 1.4426950408889634f); }
__device__ __forceinline__ float fast_softplus(float z) { return fmaxf(z, 0.f) + 0.6931471805599453f * lg2(1.0f + ex2(-1.4426950408889634f * fabsf(z))); }
__device__ __forceinline__ float fast_sigmoid(float z) { return __builtin_amdgcn_rcpf(1.0f + ex2(-1.4426950408889634f * z)); }
#define G0(g, tok) (PROJ + ((size_t)(g) * SEQ + (tok)) * 64)
#define G1(g, tok) (PROJ + ((size_t)(g) * SEQ + (tok)) * 128)

__device__ __forceinline__ float neg_expm1(float x) {
    const float p = -x * (1.0f + x * (0.5f + x * (0.16666667f + x * (0.041666668f + x * (0.0083333338f + x * 0.0013888889f)))));
    return x > -0.25f ? p : 1.0f - fast_exp(x);
}
__device__ __forceinline__ void lru_local(Frame& F) {
    const bf16* PROJ = (const bf16*)(F.ws + WS_PROJ); float* HL = (float*)(F.ws + WS_HL); float* PA = (float*)(F.ws + WS_PA); const bf16* GWT = (const bf16*)(F.ws + WS_GWT);
    LAS unsigned char* xc16 = F.lds;
    LAS float* xc32 = (LAS float*)(F.lds + 18432);
    LAS float* comp = (LAS float*)(F.lds + 18432 + 34816);
    const int tid = F.tid, lane = F.lane, w = F.wave, ts = w & 3, ch = w >> 2, r = lane & 31, h = lane >> 5;
    const int hb = blockIdx.x & 15;
    const int tp = tid >> 3, cg = tid & 7, cb8 = hb * 64 + cg * 8;
    float cw[4][8], cbias[8];
#pragma unroll
    for (int d = 0; d < 4; ++d) { const f32x4 a = *(const GAS f32x4*)(F.in[IN_CONVW] + d * 1024 + cb8), b = *(const GAS f32x4*)(F.in[IN_CONVW] + d * 1024 + cb8 + 4);
        cw[d][0] = a[0]; cw[d][1] = a[1]; cw[d][2] = a[2]; cw[d][3] = a[3]; cw[d][4] = b[0]; cw[d][5] = b[1]; cw[d][6] = b[2]; cw[d][7] = b[3]; }
    { const f32x4 a = *(const GAS f32x4*)(F.in[IN_CONVB] + cb8), b = *(const GAS f32x4*)(F.in[IN_CONVB] + cb8 + 4);
      cbias[0] = a[0]; cbias[1] = a[1]; cbias[2] = a[2]; cbias[3] = a[3]; cbias[4] = b[0]; cbias[5] = b[1]; cbias[6] = b[2]; cbias[7] = b[3]; }
    s16x8 wa[4], wx[4];
#pragma unroll
    for (int s = 0; s < 4; ++s) { wa[s] = *(const GAS s16x8*)(GWT + (size_t)((0 * 16 + hb) * 64 + ch * 32 + r) * 64 + 16 * s + 8 * h); wx[s] = *(const GAS s16x8*)(GWT + (size_t)((1 * 16 + hb) * 64 + ch * 32 + r) * 64 + 16 * s + 8 * h); }
    const int c = hb * 64 + ch * 32 + r;
    const float gab = F.in[IN_GAB][c], gxb = F.in[IN_GXB][c], sp8 = 8.0f * softplusf(-F.in[IN_LAMBDA][c]);
    const int nun = (1024 - (int)blockIdx.x + F.G - 1) / F.G;
    v4u xin[5];
#define LRU_LOAD(kk) do { const int t_ = (kk) * 128 + 2 * tp; _Pragma("unroll") for (int d = 0; d < 5; ++d) { const int row_ = t_ - 3 + d; xin[d] = *(const GAS v4u*)(G0(24 + hb, row_ < 0 ? 0 : row_) + cg * 8); if (row_ < 0) xin[d] = (v4u){0u, 0u, 0u, 0u}; } } while (0)
    LRU_LOAD((int)blockIdx.x >> 4);
    for (int ui = 0; ui < nun; ++ui) {
        const int k = ((int)blockIdx.x + ui * F.G) >> 4, t0 = k * 128;
        {
            float xv[5][8];
#pragma unroll
            for (int d = 0; d < 5; ++d) { xv[d][0] = bflo(xin[d].x); xv[d][1] = bfhi(xin[d].x); xv[d][2] = bflo(xin[d].y); xv[d][3] = bfhi(xin[d].y); xv[d][4] = bflo(xin[d].z); xv[d][5] = bfhi(xin[d].z); xv[d][6] = bflo(xin[d].w); xv[d][7] = bfhi(xin[d].w); }
#pragma unroll
            for (int tk = 0; tk < 2; ++tk) { float xc[8];
#pragma unroll
                for (int e = 0; e < 8; ++e) xc[e] = cbias[e] + cw[0][e] * xv[tk][e] + cw[1][e] * xv[tk + 1][e] + cw[2][e] * xv[tk + 2][e] + cw[3][e] * xv[tk + 3][e];
                const int tt = 2 * tp + tk;
                *(LAS f32x4*)(xc32 + tt * 68 + cg * 8) = (f32x4){xc[0], xc[1], xc[2], xc[3]}; *(LAS f32x4*)(xc32 + tt * 68 + cg * 8 + 4) = (f32x4){xc[4], xc[5], xc[6], xc[7]};
                v4u o; o.x = pkbf(xc[0], xc[1]); o.y = pkbf(xc[2], xc[3]); o.z = pkbf(xc[4], xc[5]); o.w = pkbf(xc[6], xc[7]);
                *(LAS v4u*)(xc16 + tt * 144 + cg * 16) = o; }
        }
        __syncthreads();
        if (ui + 1 < nun) LRU_LOAD(((int)blockIdx.x + (ui + 1) * F.G) >> 4);
        __builtin_amdgcn_sched_barrier(0);
        f32x16 acc_a, acc_x;
#pragma unroll
        for (int i = 0; i < 16; ++i) { acc_a[i] = 0.f; acc_x[i] = 0.f; }
#pragma unroll
        for (int s = 0; s < 4; ++s) { const s16x8 af = *(const LAS s16x8*)(xc16 + (ts * 32 + r) * 144 + (16 * s + 8 * h) * 2); acc_a = MFMA32(af, wa[s], acc_a); acc_x = MFMA32(af, wx[s], acc_x); }
        float pa[16], hl[16], gA[4], gU[4];
#pragma unroll
        for (int g = 0; g < 4; ++g) { float A = 1.f, U = 0.f;
#pragma unroll
            for (int e = 0; e < 4; ++e) { const int i = 4 * g + e; const float xcv = xc32[(ts * 32 + crow(i, h)) * 68 + ch * 32 + r];
                const float rg = fast_sigmoid(acc_a[i] + gab), ig = fast_sigmoid(acc_x[i] + gxb), log_a = -rg * sp8, a = fast_exp(log_a), mult = sqrtf(neg_expm1(2.0f * log_a));
                U = a * U + mult * (ig * xcv); A *= a; pa[i] = A; hl[i] = U; }
            gA[g] = A; gU[g] = U; }
        float PAc = 1.f, Hc = 0.f;
#pragma unroll
        for (int g = 0; g < 4; ++g) { const float oA = __shfl_xor(gA[g], 32), oU = __shfl_xor(gU[g], 32);
            const float fA = h ? oA : gA[g], fU = h ? oU : gU[g], sA = h ? gA[g] : oA, sU = h ? gU[g] : oU;
            const float c0P = PAc, c0H = Hc; Hc = fA * Hc + fU; PAc *= fA; const float c1P = PAc, c1H = Hc; Hc = sA * Hc + sU; PAc *= sA;
            const float ciP = h ? c1P : c0P, ciH = h ? c1H : c0H;
#pragma unroll
            for (int e = 0; e < 4; ++e) { const int i = 4 * g + e; hl[i] += pa[i] * ciH; pa[i] *= ciP; } }
        if (h == 0) { comp[(ts * 64 + ch * 32 + r) * 2] = PAc; comp[(ts * 64 + ch * 32 + r) * 2 + 1] = Hc; }
        __syncthreads();
        float PAin = 1.f, Hin = 0.f;
        for (int t2 = 0; t2 < ts; ++t2) { const float A2 = comp[(t2 * 64 + ch * 32 + r) * 2], U2 = comp[(t2 * 64 + ch * 32 + r) * 2 + 1]; Hin = A2 * Hin + U2; PAin *= A2; }
#pragma unroll
        for (int i = 0; i < 16; ++i) { const size_t o = ((size_t)hb * SEQ + t0 + ts * 32 + crow(i, h)) * 64 + ch * 32 + r; HL[o] = hl[i] + pa[i] * Hin; PA[o] = pa[i] * PAin; }
        __syncthreads();
    }
#undef LRU_LOAD
}
__device__ __forceinline__ void lru_fix(Frame& F) {
    const bf16* PROJ = (const bf16*)(F.ws + WS_PROJ); const float* HL = (const float*)(F.ws + WS_HL); const float* PA = (const float*)(F.ws + WS_PA); bf16* Y = (bf16*)(F.ws + WS_Y);
    const int gw = blockIdx.x * NWAVES + F.wave, NGW = F.G * NWAVES;
    for (int it = gw; it < 2048; it += NGW) {
        const int cgp = it & 15, sub = (it >> 4) & 1, k = it >> 5, c = cgp * 64 + F.lane;
        float H = 0.f;
        for (int kb = 0; kb < k; kb += 16) {
            float a[16], u[16];
#pragma unroll
            for (int j = 0; j < 16; ++j) { const int kk = (kb + j < k) ? kb + j : 0; const size_t row = ((size_t)cgp * SEQ + kk * 128 + 127) * 64 + F.lane; a[j] = PA[row]; u[j] = HL[row]; }
#pragma unroll
            for (int j = 0; j < 16; ++j) { const bool on = kb + j < k; H = on ? a[j] * H + u[j] : H; }
        }
#pragma unroll
        for (int tb = 0; tb < 64; tb += 32) {
            float hv[32], pv[32], gv[32];
#pragma unroll
            for (int tt = 0; tt < 32; ++tt) { const int t = k * 128 + sub * 64 + tb + tt; const size_t o = ((size_t)cgp * SEQ + t) * 64 + F.lane; hv[tt] = HL[o]; pv[tt] = PA[o]; gv[tt] = bflo((unsigned)G0(40 + cgp, t)[F.lane]); }
#pragma unroll
            for (int tt = 0; tt < 32; ++tt) { const int t = k * 128 + sub * 64 + tb + tt; const float g = gv[tt], u2 = 1.5957691216057308f * (g + 0.044715f * g * g * g), ge = g * fast_sigmoid(u2);
                Y[(size_t)t * DM + 1024 + c] = (bf16)f2bf(ge * (hv[tt] + pv[tt] * H)); }
        }
    }
}
template <bool DIAG> __device__ __forceinline__ void sb_tile(const f32x16& sacc, int r, int h, float& run, float (&pw)[16]) {
    float q[16], sp[16], G[4];
#pragma unroll
    for (int g = 0; g < 4; ++g) { float gs = 0.f;
#pragma unroll
        for (int e = 0; e < 4; ++e) { const int i = 4 * g + e; const float y = sacc[i] * 0.12751743082459868f;
            const float lg = lg2(1.0f + ex2(-fabsf(y))); float s_ = fmaxf(y, 0.f) + lg, q_ = fminf(y, 0.f) - lg;
            if (DIAG) { const bool valid = crow(i, h) < r; s_ = valid ? s_ : 0.f; q_ = valid ? q_ : -1e30f; }
            sp[i] = s_; q[i] = q_; gs += s_; }
        G[g] = gs; }
#pragma unroll
    for (int g = 3; g >= 0; --g) { const float og = __shfl_xor(G[g], 32);
        const float s1 = run; run += h ? G[g] : og;
        const float s0 = run; run += h ? og : G[g];
        float ex = h ? s1 : s0;
#pragma unroll
        for (int e = 3; e >= 0; --e) { const int i = 4 * g + e; pw[i] = ex2(q[i] - ex); ex += sp[i]; } }
}
__device__ __forceinline__ void sb_attn(Frame& F) {
    const bf16* PROJ = (const bf16*)(F.ws + WS_PROJ); bf16* Y = (bf16*)(F.ws + WS_Y);
    LAS unsigned char* kl = F.lds + F.wave * 16384;
    LAS unsigned char* vl = kl + 8192;
    const int lane = F.lane, r = lane & 31, h = lane >> 5;
    const int gw = blockIdx.x * NWAVES + F.wave, NGW = F.G * NWAVES;
    const int troff = (4 * h + ((lane & 15) >> 2)) * 256 + (16 * ((lane >> 4) & 1) + 4 * (lane & 3)) * 2;
    int kwoff[8];
#pragma unroll
    for (int i = 0; i < 8; ++i) { const int p = lane + 64 * i, row = p >> 4, c = p & 15; kwoff[i] = row * 256 + ((c ^ (row & 15)) << 4); }
    for (int it = gw; it < 4096; it += NGW) {
        const int head = (it >> 3) & 15, qb = ((it >> 7) << 3) + (it & 7), q0 = qb * 32;
        s16x8 qf[8];
#pragma unroll
        for (int s = 0; s < 8; ++s) qf[s] = *(const GAS s16x8*)(G1(head, q0 + r) + 16 * s + 8 * h);
        f32x16 o[4];
#pragma unroll
        for (int db = 0; db < 4; ++db)
#pragma unroll
            for (int i = 0; i < 16; ++i) o[db][i] = 0.f;
        float carry = 0.f;
        v4u kreg[8], vreg[8];
#pragma unroll
        for (int i = 0; i < 8; ++i) { kreg[i] = *(const GAS v4u*)(G1(16 + head, q0) + (lane + 64 * i) * 8); vreg[i] = *(const GAS v4u*)(G1(32 + head, q0) + (lane + 64 * i) * 8); }
#pragma unroll
        for (int i = 0; i < 8; ++i) { *(LAS v4u*)(kl + kwoff[i]) = kreg[i]; *(LAS v4u*)(vl + (lane + 64 * i) * 16) = vreg[i]; }
        LDS_WAIT();
        for (int kt = qb; kt >= 0; --kt) {
            const int kbn = (kt > 0 ? kt - 1 : 0) * 32;
            f32x16 sacc;
#pragma unroll
            for (int i = 0; i < 16; ++i) sacc[i] = 0.f;
#pragma unroll
            for (int s = 0; s < 8; ++s) { const s16x8 kf = *(const LAS s16x8*)(kl + r * 256 + (((2 * s + h) ^ (r & 15)) << 4)); sacc = MFMA32(kf, qf[s], sacc); }
#pragma unroll
            for (int i = 0; i < 8; ++i) { kreg[i] = *(const GAS v4u*)(G1(16 + head, kbn) + (lane + 64 * i) * 8); vreg[i] = *(const GAS v4u*)(G1(32 + head, kbn) + (lane + 64 * i) * 8); }
            __builtin_amdgcn_sched_barrier(0);
            float pw[16];
            if (kt == qb) sb_tile<true>(sacc, r, h, carry, pw); else sb_tile<false>(sacc, r, h, carry, pw);
            const s16x8 p0 = pack8(pw, 0), p1 = pack8(pw, 1);
            const LAS unsigned char* trb = vl + troff;
#pragma unroll
            for (int db = 0; db < 4; ++db) {
                const s16x8 v0 = tr_frag(trb + db * 64, trb + 8 * 256 + db * 64);
                const s16x8 v1 = tr_frag(trb + 16 * 256 + db * 64, trb + 24 * 256 + db * 64);
                o[db] = MFMA32(v0, p0, o[db]); o[db] = MFMA32(v1, p1, o[db]); }
#pragma unroll
            for (int i = 0; i < 8; ++i) { *(LAS v4u*)(kl + kwoff[i]) = kreg[i]; *(LAS v4u*)(vl + (lane + 64 * i) * 16) = vreg[i]; }
            LDS_WAIT();
            if (__all(carry > 150.04f)) break;
        }
#pragma unroll
        for (int db = 0; db < 4; ++db)
#pragma unroll
            for (int g = 0; g < 4; ++g) { v2u w; w.x = pkbf(o[db][4 * g], o[db][4 * g + 1]); w.y = pkbf(o[db][4 * g + 2], o[db][4 * g + 3]);
                *(GAS v2u*)(Y + (size_t)(q0 + r) * DM + head * 128 + db * 32 + 8 * g + 4 * h) = w; }
    }
}
__device__ __forceinline__ void swa_attn(Frame& F) {
    const bf16* PROJ = (const bf16*)(F.ws + WS_PROJ); bf16* Y = (bf16*)(F.ws + WS_Y); const float* BT = (const float*)(F.ws + WS_BT);
    LAS unsigned char* KL = F.lds + 57344;
    LAS unsigned char* VL = KL + 27648;
    LAS float* btl = (LAS float*)(VL + 36864);
    const int tid = F.tid, lane = F.lane, w = F.wave, r = lane & 31, h = lane >> 5;
    const int kvh = blockIdx.x & 3;
    btl[tid] = BT[kvh * 1024 + tid]; btl[tid + 512] = BT[kvh * 1024 + 512 + tid];
    const int head = kvh * 4 + (w & 3);
    const float sink = F.in[IN_SINKS][head];
    const LAS float* bth = btl + (w & 3) * 256;
    const LAS unsigned char* trb = VL + (4 * h + ((lane & 15) >> 2)) * 192 + (16 * ((lane >> 4) & 1) + 4 * (lane & 3)) * 2;
    v4u kreg[3], vreg[3];
    const int nun = (512 - (int)blockIdx.x + F.G - 1) / F.G;
    {   const int c = blockIdx.x >> 2, kbase = (c - 2) * 64;
#pragma unroll
        for (int i = 0; i < 3; ++i) { const int j = tid + 512 * i; int row = kbase + (j >> 3); row = row < 0 ? 0 : row;
            kreg[i] = *(const GAS v4u*)(G0(16 + kvh, row) + (j & 7) * 8); vreg[i] = *(const GAS v4u*)(G0(20 + kvh, row) + (j & 7) * 8); } }
    for (int ui = 0; ui < nun; ++ui) {
        const int wu = blockIdx.x + ui * F.G, c = wu >> 2, q0 = c * 64 + (w >> 2) * 32, kbase = (c - 2) * 64, kt0 = c >= 2 ? 0 : (2 - c) * 2;
#pragma unroll
        for (int i = 0; i < 3; ++i) { const int j = tid + 512 * i; *(LAS v4u*)(KL + (j >> 3) * 144 + (j & 7) * 16) = kreg[i]; *(LAS v4u*)(VL + (j >> 3) * 192 + (j & 7) * 16) = vreg[i]; }
        __syncthreads();
        if (ui + 1 < nun) { const int c2 = (wu + F.G) >> 2, kb2 = (c2 - 2) * 64;
#pragma unroll
            for (int i = 0; i < 3; ++i) { const int j = tid + 512 * i; int row = kb2 + (j >> 3); row = row < 0 ? 0 : row;
                kreg[i] = *(const GAS v4u*)(G0(16 + kvh, row) + (j & 7) * 8); vreg[i] = *(const GAS v4u*)(G0(20 + kvh, row) + (j & 7) * 8); } }
        s16x8 qf[4];
#pragma unroll
        for (int s = 0; s < 4; ++s) qf[s] = *(const GAS s16x8*)(G0(head, q0 + r) + 16 * s + 8 * h);
        __builtin_amdgcn_sched_barrier(0);
        float sc[6][16]; float m = sink;
#pragma unroll
        for (int kt = 0; kt < 6; ++kt) {
            f32x16 sacc;
#pragma unroll
            for (int i = 0; i < 16; ++i) sacc[i] = 0.f;
#pragma unroll
            for (int s = 0; s < 4; ++s) { const s16x8 kf = *(const LAS s16x8*)(KL + (kt * 32 + r) * 144 + (16 * s + 8 * h) * 2); sacc = MFMA32(kf, qf[s], sacc); }
            const bool on = kt >= kt0;
#pragma unroll
            for (int i = 0; i < 16; ++i) { const float v = sacc[i] * 0.125f + bth[kt * 32 + crow(i, h) - 128 - (w >> 2) * 32 - r + 191]; sc[kt][i] = on ? v : -1e30f; m = fmaxf(m, sc[kt][i]); }
        }
        m = fmaxf(m, __shfl_xor(m, 32));
        float l = 0.f;
#pragma unroll
        for (int kt = 0; kt < 6; ++kt)
#pragma unroll
            for (int i = 0; i < 16; ++i) { const float p = fast_exp(sc[kt][i] - m); sc[kt][i] = p; l += p; }
        l += __shfl_xor(l, 32); l += fast_exp(sink - m);
        f32x16 o[2];
#pragma unroll
        for (int db = 0; db < 2; ++db)
#pragma unroll
            for (int i = 0; i < 16; ++i) o[db][i] = 0.f;
#pragma unroll
        for (int kt = 0; kt < 6; ++kt) {
            const s16x8 p0 = pack8(sc[kt], 0), p1 = pack8(sc[kt], 1);
#pragma unroll
            for (int db = 0; db < 2; ++db) {
                const LAS unsigned char* tb = trb + kt * 32 * 192 + db * 64;
                const s16x8 v0 = tr_frag(tb, tb + 8 * 192);
                const s16x8 v1 = tr_frag(tb + 16 * 192, tb + 24 * 192);
                o[db] = MFMA32(v0, p0, o[db]); o[db] = MFMA32(v1, p1, o[db]); }
        }
        const float inv = 1.0f / l;
#pragma unroll
        for (int db = 0; db < 2; ++db)
#pragma unroll
            for (int g = 0; g < 4; ++g) { v2u wv; wv.x = pkbf(o[db][4 * g] * inv, o[db][4 * g + 1] * inv); wv.y = pkbf(o[db][4 * g + 2] * inv, o[db][4 * g + 3] * inv);
                *(GAS v2u*)(Y + (size_t)(q0 + r) * DM + head * 64 + db * 32 + 8 * g + 4 * h) = wv; }
        __syncthreads();
    }
}

#ifndef REP_P0
#define REP_P0 1
#endif
#define REP_LRU 1
#define REP_SWA 1
#define REP_FIX 1
#define REP_SB 1
struct Args { const float* in[19]; float* out; unsigned char* ws; int ph_lo, ph_hi; };
__global__ void __launch_bounds__(NWAVES * 64, 2) hybrid_fwd(Args args) {
    extern __shared__ __attribute__((aligned(16))) unsigned char lds[];
    Frame F;
    F.lds = (LAS unsigned char*)lds;
    F.tid = threadIdx.x; F.lane = F.tid & 63; F.wave = __builtin_amdgcn_readfirstlane(F.tid >> 6);
    F.G = gridDim.x;
#pragma unroll
    for (int i = 0; i < 19; ++i) F.in[i] = args.in[i];
    F.out = args.out; F.ws = args.ws;
    unsigned char* ws = args.ws;
    for (int u = F.tid; u < (LDS_BYTES - LDSCTL_OFF) / 4; u += NWAVES * 64) ((LAS unsigned*)(F.lds + LDSCTL_OFF))[u] = 0u;
    __syncthreads();
    const int lo = args.ph_lo, hi = args.ph_hi;
    XcdBarrier bar; bar.bar = (unsigned*)(ws + WS_CTL) + CW_BAR; bar.x = 0; bar.st = nullptr;
    if (hi - lo > 1) bar = xcd_barrier_post((unsigned*)(ws + WS_CTL) + CW_BAR, (volatile LAS unsigned*)(F.lds + MISC_OFF) + 8);
#define IN(k) (lo <= (k) && (k) < hi)
#define SEAM(k) do { if (IN(k) && IN((k) + 1)) xcd_barrier(bar); } while (0)
    bf16* XN = (bf16*)(ws + WS_XN); bf16* Yb = (bf16*)(ws + WS_Y); bf16* PROJ = (bf16*)(ws + WS_PROJ); bf16* ACT = (bf16*)(ws + WS_ACT); float* SS = (float*)(ws + WS_SS);

    if (IN(0)) { for (int rep = 0; rep < REP_P0; ++rep) { p0_prologue(F); if (rep + 1 < REP_P0) xcd_barrier(bar); } } SEAM(0);
    if (IN(1)) { pg8::Gemm g{XN, (const bf16*)(ws + WS_WIN0), SEQ, EVEN_IN, DM}; pg8::StaticOrder S; S.init(SEQ, EVEN_IN, F.G, (int)blockIdx.x);
        pg8::EpiBf16<0> E{PROJ, EVEN_IN, SS, 64, SEQ, {}, -1}; pg8::gemm_phase<pg8::EpiBf16<0>, pg8::StaticOrder, true, true>(F.lds + RING_OFF, g, S, E); } SEAM(1);
    if (IN(2)) { for (int rep = 0; rep < REP_LRU; ++rep) { lru_local(F); if (rep + 1 < REP_LRU) xcd_barrier(bar); } for (int rep = 0; rep < REP_SWA; ++rep) { swa_attn(F); if (rep + 1 < REP_SWA) xcd_barrier(bar); } } SEAM(2);
    if (IN(3)) { for (int rep = 0; rep < REP_FIX; ++rep) { lru_fix(F); if (rep + 1 < REP_FIX) xcd_barrier(bar); } } SEAM(3);
    if (IN(4)) { pg8::Gemm g{Yb, (const bf16*)(ws + WS_WOUT0), SEQ, DM, DM}; pg8::StaticOrder S; S.init(SEQ, DM, F.G, (int)blockIdx.x);
        pg8::EpiRes<true> E{F.in[IN_X], XN, SS, DM}; pg8::gemm_phase<pg8::EpiRes<true>, pg8::StaticOrder, false, true>(F.lds + RING_OFF, g, S, E); } SEAM(4);
    if (IN(5)) { pg8::Gemm g{XN, (const bf16*)(ws + WS_WUP0), SEQ, DFF, DM}; pg8::StaticOrder S; S.init(SEQ, DFF, F.G, (int)blockIdx.x);
        pg8::EpiBf16<1> E{ACT, DFF, SS, 0, 0, {}, -1}; pg8::gemm_phase<pg8::EpiBf16<1>, pg8::StaticOrder, true, true>(F.lds + RING_OFF, g, S, E); } SEAM(5);
    if (IN(6)) { pg8::Gemm g{ACT, (const bf16*)(ws + WS_WDN0), SEQ, DM, DFF}; pg8::StaticOrder S; S.init(SEQ, DM, F.G, (int)blockIdx.x);
        pg8::EpiRes<false> E{nullptr, XN, SS, DM}; pg8::gemm_phase<pg8::EpiRes<false>, pg8::StaticOrder, false, true>(F.lds + RING_OFF, g, S, E); } SEAM(6);
    if (IN(7)) { pg8::Gemm g{XN, (const bf16*)(ws + WS_WIN1), SEQ, ODD_IN, DM}; pg8::StaticOrder S; S.init(SEQ, ODD_IN, F.G, (int)blockIdx.x);
        pg8::EpiBf16<0> E{PROJ, ODD_IN, SS, 128, SEQ, {}, -1}; pg8::gemm_phase<pg8::EpiBf16<0>, pg8::StaticOrder, true, true>(F.lds + RING_OFF, g, S, E); } SEAM(7);
    if (IN(8)) { for (int rep = 0; rep < REP_SB; ++rep) { sb_attn(F); if (rep + 1 < REP_SB) xcd_barrier(bar); } } SEAM(8);
    if (IN(9)) { pg8::Gemm g{Yb, (const bf16*)(ws + WS_WOUT1), SEQ, DM, DM}; pg8::StaticOrder S; S.init(SEQ, DM, F.G, (int)blockIdx.x);
        pg8::EpiRes<false> E{nullptr, XN, SS, DM}; pg8::gemm_phase<pg8::EpiRes<false>, pg8::StaticOrder, false, true>(F.lds + RING_OFF, g, S, E); } SEAM(9);
    if (IN(10)) { pg8::Gemm g{XN, (const bf16*)(ws + WS_WUP1), SEQ, DFF, DM}; pg8::StaticOrder S; S.init(SEQ, DFF, F.G, (int)blockIdx.x);
        pg8::EpiBf16<1> E{ACT, DFF, SS, 0, 0, {}, -1}; pg8::gemm_phase<pg8::EpiBf16<1>, pg8::StaticOrder, true, true>(F.lds + RING_OFF, g, S, E); } SEAM(10);
    if (IN(11)) { pg8::Gemm g{ACT, (const bf16*)(ws + WS_WDN1), SEQ, DM, DFF}; pg8::StaticOrder S; S.init(SEQ, DM, F.G, (int)blockIdx.x);
        pg8::EpiRes<false> E{nullptr, XN, SS, DM}; pg8::gemm_phase<pg8::EpiRes<false>, pg8::StaticOrder, false, true>(F.lds + RING_OFF, g, S, E); } SEAM(11);
    if (IN(12)) { final_norm(F); }
#undef IN
#undef SEAM
}

extern "C" void kernel_launch(void* const* d_in, const int* in_sizes, int n_in, void* d_out, int out_size, void* d_ws, size_t ws_size, hipStream_t stream) {
    static int grid = 0;
    if (grid == 0) {
        if (n_in != 19 || in_sizes[0] != SEQ * DM || out_size != SEQ * DM || ws_size < WS_END) { fprintf(stderr, "kernel_launch: unexpected shapes (n_in %d, in0 %d, out %d, ws %zu); nothing launched\n", n_in, n_in > 0 ? in_sizes[0] : -1, out_size, ws_size); grid = -1; return; }
        int dev = 0, cus = 0, per_cu = 0;
        if (hipGetDevice(&dev) != hipSuccess || hipDeviceGetAttribute(&cus, hipDeviceAttributeMultiprocessorCount, dev) != hipSuccess) { fprintf(stderr, "kernel_launch: device query failed\n"); grid = -1; return; }
        if (hipFuncSetAttribute((const void*)hybrid_fwd, hipFuncAttributeMaxDynamicSharedMemorySize, LDS_BYTES) != hipSuccess) { fprintf(stderr, "kernel_launch: hipFuncSetAttribute failed\n"); grid = -1; return; }
        if (hipOccupancyMaxActiveBlocksPerMultiprocessor(&per_cu, (const void*)hybrid_fwd, NWAVES * 64, LDS_BYTES) != hipSuccess || per_cu < 1) { fprintf(stderr, "kernel_launch: occupancy query reports %d workgroups per CU\n", per_cu); per_cu = 1; }
        (void)hipGetLastError();
        grid = cus;
        if (grid != 256) fprintf(stderr, "kernel_launch: %d CUs; the residual GEMM phases need exactly 256 workgroups\n", grid);
    }
    if (grid < 0) return;
    (void)hipMemsetAsync((char*)d_ws + WS_CTL, 0, CTL_ZERO_BYTES, stream);
    Args a{};
    for (int i = 0; i < 19; ++i) a.in[i] = (const float*)d_in[i];
    a.out = (float*)d_out; a.ws = (unsigned char*)d_ws;
#if MK_N_LAUNCHES == 1
    a.ph_lo = 0; a.ph_hi = N_PHASES;
    hipLaunchKernelGGL(hybrid_fwd, dim3(grid), dim3(NWAVES * 64), LDS_BYTES, stream, a);
#else
    for (int p = 0; p < N_PHASES; ++p) { a.ph_lo = p; a.ph_hi = p + 1; hipLaunchKernelGGL(hybrid_fwd, dim3(grid), dim3(NWAVES * 64), LDS_BYTES, stream, a); }
#endif
}
```

```cpp
#include <hip/hip_runtime.h>
#include <cstdio>
#include <cstdint>
namespace pg8 {
#define PG8_LAS __attribute__((address_space(3)))
typedef unsigned short bf16_t;
typedef short bf16x8 __attribute__((ext_vector_type(8)));
typedef float f32x4 __attribute__((ext_vector_type(4)));
typedef unsigned u32x4 __attribute__((ext_vector_type(4)));
constexpr int BM = 256, BK = 64, HALF = 128, HTB = HALF * BK * 2  , STAGE_BYTES = 8 * HTB, NXCD = 8, WGM = 8;

__host__ __device__ __forceinline__ int lds_byte(int r, int c) { const int st = (r >> 4) * 2 + (c >> 5), rr = r & 15, cc = c & 31, ob = rr * 64 + cc * 2; return st * 1024 + (ob ^ (((ob >> 9) & 1) << 5)); }
__host__ __device__ __forceinline__ void stage_rc(int b, int& R, int& C) { const int st = b / 1024, sb = b % 1024, swz = sb ^ (((sb >> 9) & 1) << 5); R = (st >> 1) * 16 + swz / 64; C = (st & 1) * 32 + (swz % 64) / 2; }
__host__ __device__ __forceinline__ int perm32(int rho) { const int n = rho >> 4, i = rho & 15; return 8 * (i >> 2) + 4 * n + (i & 3); }

struct Unit { int pm, pn; };
struct Gemm { const bf16_t* A; const bf16_t* Bt; int M, N, K; };

struct StaticOrder {
    int nM, nN, nwg, G, c;
    __host__ __device__ void init(int M, int N, int G_, int c_) { nM = M / BM; nN = N / BM; nwg = nM * nN; G = G_; c = c_; }
    __host__ __device__ bool next(int i, Unit& u) const {
        const long L = (long)i * G + c; if (L >= nwg) return false;
        int wgid = (int)L; { const int q = nwg / NXCD, r = nwg % NXCD, xcd = wgid % NXCD, off = wgid / NXCD; wgid = (xcd < r ? xcd * (q + 1) : r * (q + 1) + (xcd - r) * q) + off; }
        const int nig = WGM * nN, gid = wgid / nig, fm = gid * WGM, gsz = (nM - fm) < WGM ? (nM - fm) : WGM;
        u.pm = fm + ((wgid % nig) % gsz); u.pn = (wgid % nig) / gsz; return true;
    }
    __device__ __forceinline__ void a_ready(const Unit&) const {}
    __device__ __forceinline__ void done(const Unit&) const {}
};

__device__ __forceinline__ unsigned cvt_pk_bf16(float lo, float hi) { unsigned r; asm volatile("v_cvt_pk_bf16_f32 %0, %1, %2" : "=v"(r) : "v"(lo), "v"(hi)); return r; }
constexpr float RMS_EPS = 1e-6f;
__device__ __forceinline__ float row_rstd(const float* ss, int r) {
    const f32x4 a = *(const f32x4*)(ss + (size_t)r * 8), b = *(const f32x4*)(ss + (size_t)r * 8 + 4);
    const float s = ((a[0] + a[1]) + (a[2] + a[3])) + ((b[0] + b[1]) + (b[2] + b[3]));
    return 1.0f / sqrtf(s * (1.0f / 2048.0f) + RMS_EPS);
}
template <int ACT> struct EpiBf16 {
    static constexpr bool PERM = true, AFTER_DRAIN = false;
    bf16_t* O; int ldc; const float* ss; int grp_w, nrows; int frag_groups;
    struct State { f32x4 rsA, rsB; int cpm; __device__ __forceinline__ void init() { cpm = -1; rsA = (f32x4){1.f, 1.f, 1.f, 1.f}; rsB = rsA; } };
    __device__ __forceinline__ void operator()(const f32x4 (&acc)[2][2][4][2], const Unit& u, int wr, int wc, int fr, int fq, State& st) const {
        const int row0 = u.pm * BM + wr * 64 + fr, col0 = u.pn * BM + wc * 32 + 8 * fq;
        if (u.pm != st.cpm) { st.cpm = u.pm;
            if (ss) { st.rsA = (f32x4){row_rstd(ss, row0), row_rstd(ss, row0 + 16), row_rstd(ss, row0 + 32), row_rstd(ss, row0 + 48)};
                      st.rsB = (f32x4){row_rstd(ss, row0 + HALF), row_rstd(ss, row0 + HALF + 16), row_rstd(ss, row0 + HALF + 32), row_rstd(ss, row0 + HALF + 48)}; } }
#pragma unroll
        for (int ai = 0; ai < 2; ++ai)
#pragma unroll
            for (int m = 0; m < 4; ++m) { const int r = row0 + ai * HALF + m * 16; const float rs = ai ? st.rsB[m] : st.rsA[m];
                bf16_t* rowp = grp_w ? O + ((size_t)(col0 / grp_w) * nrows + r) * grp_w + (col0 % grp_w) : O + (size_t)r * ldc + col0;
                if (frag_groups && (col0 >> 7) < frag_groups) { const int d0 = col0 & 127; rowp = O + (size_t)(col0 >> 7) * nrows * 128 + ((size_t)((((r >> 5) * 8 + (d0 >> 4)) * 2 + ((d0 >> 3) & 1)) * 32 + (r & 31))) * 8; }
                const size_t bjstep = grp_w ? (size_t)(HALF / grp_w) * nrows * grp_w : (size_t)HALF;
#pragma unroll
                for (int bj = 0; bj < 2; ++bj) { f32x4 v0 = acc[ai][bj][m][0] * rs, v1 = acc[ai][bj][m][1] * rs;
                    if (ACT == 1) {
#pragma unroll
                        for (int j = 0; j < 4; ++j) { const float a = fmaxf(v0[j], 0.f), b = fmaxf(v1[j], 0.f); v0[j] = a * a; v1[j] = b * b; } }
                    u32x4 w; w.x = cvt_pk_bf16(v0[0], v0[1]); w.y = cvt_pk_bf16(v0[2], v0[3]); w.z = cvt_pk_bf16(v1[0], v1[1]); w.w = cvt_pk_bf16(v1[2], v1[3]);
                    *(u32x4*)(rowp + bj * bjstep) = w; } }
    }
};
template <bool BASE_F32> struct EpiRes {
    static constexpr bool PERM = true, AFTER_DRAIN = true;
    const float* base; bf16_t* xn; float* ss; int ldc;
    struct State { __device__ __forceinline__ void init() {} };
    __device__ __forceinline__ void operator()(const f32x4 (&)[2][2][4][2], const Unit&, int, int, int, int, State&) const {}
    __device__ __forceinline__ void fused(f32x4 (&acc)[2][2][4][2], const Unit& u, int wr, int wc, int fr, int fq, PG8_LAS unsigned char* lds, int wid, int lane) const {
        PG8_LAS float* P = (PG8_LAS float*)lds;
#pragma unroll
        for (int ai = 0; ai < 2; ++ai)
#pragma unroll
            for (int m = 0; m < 4; ++m) { const int rl = ai * HALF + wr * 64 + m * 16 + fr; const size_t off = (size_t)(u.pm * BM + rl) * ldc + u.pn * BM + wc * 32 + 8 * fq; float s = 0.f;
#pragma unroll
                for (int bj = 0; bj < 2; ++bj) { f32x4 b0, b1;
                    if (BASE_F32) { b0 = *(const f32x4*)(base + off + bj * HALF); b1 = *(const f32x4*)(base + off + bj * HALF + 4); }
                    else { const u32x4 q = *(const u32x4*)(xn + off + bj * HALF);
                        b0 = (f32x4){__builtin_bit_cast(float, q.x << 16), __builtin_bit_cast(float, q.x & 0xffff0000u), __builtin_bit_cast(float, q.y << 16), __builtin_bit_cast(float, q.y & 0xffff0000u)};
                        b1 = (f32x4){__builtin_bit_cast(float, q.z << 16), __builtin_bit_cast(float, q.z & 0xffff0000u), __builtin_bit_cast(float, q.w << 16), __builtin_bit_cast(float, q.w & 0xffff0000u)}; }
                    const f32x4 v0 = acc[ai][bj][m][0] + b0, v1 = acc[ai][bj][m][1] + b1;
                    u32x4 w; w.x = cvt_pk_bf16(v0[0], v0[1]); w.y = cvt_pk_bf16(v0[2], v0[3]); w.z = cvt_pk_bf16(v1[0], v1[1]); w.w = cvt_pk_bf16(v1[2], v1[3]);
                    *(u32x4*)(xn + off + bj * HALF) = w;
                    s += ((v0[0] * v0[0] + v0[1] * v0[1]) + (v0[2] * v0[2] + v0[3] * v0[3])) + ((v1[0] * v1[0] + v1[1] * v1[1]) + (v1[2] * v1[2] + v1[3] * v1[3])); }
                s += __shfl_xor(s, 16); s += __shfl_xor(s, 32);
                if (fq == 0) P[rl * 4 + wc] = s; }
        asm volatile("s_waitcnt lgkmcnt(0)" ::: "memory"); __builtin_amdgcn_s_barrier(); asm volatile("" ::: "memory");
        const int t = wid * 64 + lane;
        if (t < 256) { const f32x4 p = *(const PG8_LAS f32x4*)(P + t * 4); ss[(size_t)(u.pm * BM + t) * 8 + u.pn] = (p[0] + p[1]) + (p[2] + p[3]); }
        asm volatile("s_waitcnt lgkmcnt(0)" ::: "memory"); __builtin_amdgcn_s_barrier(); asm volatile("" ::: "memory");
    }
};

template <class Epi, class Sched, bool ALIGN_EPI = false, bool SP2 = false>
__device__ __forceinline__ void gemm_phase(PG8_LAS unsigned char* lds, const Gemm g, const Sched& S, const Epi& E) {
    const int tid = threadIdx.x, wid = __builtin_amdgcn_readfirstlane(tid >> 6), lane = tid & 63, wr = wid >> 2, wc = wid & 3, fr = lane & 15, fq = lane >> 4;
    const int K = g.K, nt = K / BK;
    unsigned voffA[2], voffB[2];
#pragma unroll
    for (int i = 0; i < 2; ++i) { int R, C; stage_rc(tid * 16 + i * 8192, R, C); const int Rb = Epi::PERM ? ((R & ~31) + perm32(R & 31)) : R;
        voffA[i] = (unsigned)(R * K + C) * 2u; voffB[i] = (unsigned)(Rb * K + C) * 2u; }
    const size_t kstep = (size_t)(BK * 2);
    const size_t hstep = (size_t)HALF * K * 2;
    const size_t tstep = 2 * hstep;
    const unsigned ldsw = (unsigned)wid * 1024u;
    const int aoff = lds_byte(wr * 64 + fr, fq * 8), boff = lds_byte(wc * 32 + fr, fq * 8);
#define PG8_SA(b, h) (((b) * 2 + (h)) * HTB)
#define PG8_SB(b, h) ((4 + (b) * 2 + (h)) * HTB)
#define PG8_STAGE(bufoff, gbase, voff) do { _Pragma("unroll") for (int _i = 0; _i < 2; ++_i) \
        __builtin_amdgcn_global_load_lds((const unsigned*)((const char*)(gbase) + (voff)[_i]), (PG8_LAS unsigned*)(lds + (bufoff) + ldsw + _i * 8192), 16, 0, 0); } while (0)
#define PG8_LDA(dst, b, h) do { _Pragma("unroll") for (int m = 0; m < 4; ++m) _Pragma("unroll") for (int k = 0; k < 2; ++k) dst[m][k] = *(const PG8_LAS bf16x8*)(lds + PG8_SA(b, h) + aoff + m * 2048 + k * 1024); } while (0)
#define PG8_LDB(dst, b, h) do { _Pragma("unroll") for (int n = 0; n < 2; ++n) _Pragma("unroll") for (int k = 0; k < 2; ++k) dst[n][k] = *(const PG8_LAS bf16x8*)(lds + PG8_SB(b, h) + boff + n * 2048 + k * 1024); } while (0)
#define PG8_MMA(ai, bj, At, Bt) do { __builtin_amdgcn_s_setprio(1); _Pragma("unroll") for (int m = 0; m < 4; ++m) _Pragma("unroll") for (int n = 0; n < 2; ++n) _Pragma("unroll") for (int k = 0; k < 2; ++k) \
        acc[ai][bj][m][n] = __builtin_amdgcn_mfma_f32_16x16x32_bf16(Bt[n][k], At[m][k], acc[ai][bj][m][n], 0, 0, 0); __builtin_amdgcn_s_setprio(0); } while (0)
#define PG8_WAIT_V(n) asm volatile("s_waitcnt vmcnt(" #n ")" ::: "memory")
#define PG8_WAIT_L(n) asm volatile("s_waitcnt lgkmcnt(" #n ")" ::: "memory")
#define PG8_BAR __builtin_amdgcn_s_barrier()
#define PG8_SCHED __builtin_amdgcn_sched_barrier(0)
    Unit cur, nxt; int ui = 0;
    if (!S.next(0, cur)) return;
    typename Epi::State est; est.init();
    f32x4 acc[2][2][4][2];
#pragma unroll
    for (int a = 0; a < 2; ++a)
#pragma unroll
        for (int b = 0; b < 2; ++b)
#pragma unroll
            for (int m = 0; m < 4; ++m)
#pragma unroll
                for (int n = 0; n < 2; ++n) acc[a][b][m][n] = (f32x4){0.f, 0.f, 0.f, 0.f};
    bf16x8 At[4][2], B0[2][2], B1[2][2];
    const char* cA = (const char*)g.A + (size_t)cur.pm * tstep; const char* cB = (const char*)g.Bt + (size_t)cur.pn * tstep;
    S.a_ready(cur);
    if constexpr (SP2) {
        PG8_STAGE(PG8_SB(0, 0), cB, voffB); PG8_STAGE(PG8_SB(0, 1), cB + hstep, voffB); PG8_STAGE(PG8_SA(0, 0), cA, voffA); PG8_STAGE(PG8_SA(0, 1), cA + hstep, voffA);
        if (wr == 1) PG8_BAR;
        PG8_WAIT_V(2); PG8_BAR;
        PG8_STAGE(PG8_SB(1, 0), cB + kstep, voffB); PG8_STAGE(PG8_SA(1, 0), cA + kstep, voffA); PG8_STAGE(PG8_SB(1, 1), cB + hstep + kstep, voffB);
        PG8_WAIT_V(6); PG8_BAR;
    } else {
        PG8_STAGE(PG8_SB(0, 0), cB, voffB); PG8_STAGE(PG8_SA(0, 0), cA, voffA); PG8_STAGE(PG8_SB(0, 1), cB + hstep, voffB); PG8_STAGE(PG8_SA(0, 1), cA + hstep, voffA);
        if (wr == 1) PG8_BAR;
        PG8_WAIT_V(4); PG8_BAR;
        PG8_STAGE(PG8_SB(1, 0), cB + kstep, voffB); PG8_STAGE(PG8_SA(1, 0), cA + kstep, voffA); PG8_STAGE(PG8_SB(1, 1), cB + hstep + kstep, voffB);
        PG8_WAIT_V(6); PG8_BAR;
    }
    for (;;) {
        const bool has_next = S.next(ui + 1, nxt);
        const char* nA = has_next ? (const char*)g.A + (size_t)nxt.pm * tstep : cA; const char* nB = has_next ? (const char*)g.Bt + (size_t)nxt.pn * tstep : cB;
        for (int t = 0; t < nt; t += 2) {
            const bool last = (t == nt - 2);
            const char* a1 = cA + (size_t)(t + 1) * kstep;
            const char* a2 = last ? nA : cA + (size_t)(t + 2) * kstep; const char* b2 = last ? nB : cB + (size_t)(t + 2) * kstep;
            const char* a3 = a2 + kstep; const char* b3 = b2 + kstep;
            if (last && has_next) S.a_ready(nxt);
            if constexpr (SP2) {
            PG8_LDB(B0, 0, 0); PG8_LDB(B1, 0, 1); PG8_SCHED; PG8_LDA(At, 0, 0); PG8_STAGE(PG8_SA(1, 1), a1 + hstep, voffA);
            PG8_WAIT_V(8); PG8_WAIT_L(0); PG8_BAR; PG8_MMA(0, 0, At, B0); PG8_MMA(0, 1, At, B1); PG8_BAR; PG8_SCHED;
            PG8_LDA(At, 0, 1); PG8_STAGE(PG8_SB(0, 0), b2, voffB); PG8_STAGE(PG8_SB(0, 1), b2 + hstep, voffB); PG8_STAGE(PG8_SA(0, 0), a2, voffA);
            PG8_WAIT_V(8); PG8_WAIT_L(0); PG8_BAR; PG8_MMA(1, 0, At, B0); PG8_MMA(1, 1, At, B1); PG8_BAR; PG8_SCHED;
            PG8_LDB(B0, 1, 0); PG8_LDB(B1, 1, 1); PG8_SCHED; PG8_LDA(At, 1, 0); PG8_STAGE(PG8_SA(0, 1), a2 + hstep, voffA);
            PG8_WAIT_V(8); PG8_WAIT_L(0); PG8_BAR; PG8_MMA(0, 0, At, B0); PG8_MMA(0, 1, At, B1); PG8_BAR; PG8_SCHED;
            PG8_LDA(At, 1, 1); PG8_STAGE(PG8_SB(1, 0), b3, voffB); PG8_STAGE(PG8_SB(1, 1), b3 + hstep, voffB); PG8_STAGE(PG8_SA(1, 0), a3, voffA);
            PG8_WAIT_V(8); PG8_WAIT_L(0); PG8_BAR; PG8_MMA(1, 0, At, B0); PG8_MMA(1, 1, At, B1); PG8_BAR; PG8_SCHED;
            } else {
            PG8_LDB(B0, 0, 0); PG8_SCHED; PG8_LDA(At, 0, 0); PG8_STAGE(PG8_SA(1, 1), a1 + hstep, voffA);
            PG8_WAIT_L(8); PG8_BAR; PG8_WAIT_L(0); PG8_MMA(0, 0, At, B0); PG8_BAR; PG8_SCHED;
            PG8_LDB(B1, 0, 1); PG8_STAGE(PG8_SB(0, 0), b2, voffB);
            PG8_BAR; PG8_WAIT_L(0); PG8_MMA(0, 1, At, B1); PG8_BAR;
            PG8_LDA(At, 0, 1); PG8_STAGE(PG8_SA(0, 0), a2, voffA);
            PG8_BAR; PG8_WAIT_L(0); PG8_MMA(1, 0, At, B0); PG8_BAR; PG8_SCHED;
            PG8_STAGE(PG8_SB(0, 1), b2 + hstep, voffB);
            PG8_WAIT_V(6); PG8_BAR; PG8_MMA(1, 1, At, B1); PG8_BAR;
            PG8_LDB(B0, 1, 0); PG8_SCHED; PG8_LDA(At, 1, 0); PG8_STAGE(PG8_SA(0, 1), a2 + hstep, voffA);
            PG8_WAIT_L(8); PG8_BAR; PG8_WAIT_L(0); PG8_MMA(0, 0, At, B0); PG8_BAR; PG8_SCHED;
            PG8_LDB(B1, 1, 1); PG8_STAGE(PG8_SB(1, 0), b3, voffB);
            PG8_BAR; PG8_WAIT_L(0); PG8_MMA(0, 1, At, B1); PG8_BAR;
            PG8_LDA(At, 1, 1); PG8_STAGE(PG8_SA(1, 0), a3, voffA);
            PG8_BAR; PG8_WAIT_L(0); PG8_MMA(1, 0, At, B0); PG8_BAR; PG8_SCHED;
            PG8_STAGE(PG8_SB(1, 1), b3 + hstep, voffB);
            PG8_WAIT_V(6); PG8_BAR; PG8_MMA(1, 1, At, B1); PG8_BAR;
            }
        }
        if constexpr (ALIGN_EPI) { if (wr == 0) PG8_BAR; }
        if constexpr (!Epi::AFTER_DRAIN) { E(acc, cur, wr, wc, fr, fq, est); S.done(cur); }
        if (!has_next) break;
#pragma unroll
        for (int a = 0; a < 2; ++a)
#pragma unroll
            for (int b = 0; b < 2; ++b)
#pragma unroll
                for (int m = 0; m < 4; ++m)
#pragma unroll
                    for (int n = 0; n < 2; ++n) acc[a][b][m][n] = (f32x4){0.f, 0.f, 0.f, 0.f};
        cur = nxt; cA = nA; cB = nB; ++ui;
        if constexpr (ALIGN_EPI) { if (wr == 1) PG8_BAR; }
    }
    PG8_WAIT_V(0);
    if constexpr (!ALIGN_EPI) { if (wr == 0) PG8_BAR; }
    PG8_BAR;
    if constexpr (Epi::AFTER_DRAIN) { E.fused(acc, cur, wr, wc, fr, fq, lds, wid, lane); S.done(cur); }
#undef PG8_SA
#undef PG8_SB
#undef PG8_STAGE
#undef PG8_LDA
#undef PG8_LDB
#undef PG8_MMA
#undef PG8_WAIT_V
#undef PG8_WAIT_L
#undef PG8_BAR
#undef PG8_SCHED
}
}

constexpr int NWAVES = 8;
constexpr int SEQ = 8192, DM = 2048, DFF = 8192, EVEN_IN = 3584, ODD_IN = 6144;
constexpr int OFF_K = 1024, OFF_V = 1280, OFF_X = 1536, OFF_G = 2560;
#ifndef MK_N_LAUNCHES
#define MK_N_LAUNCHES 1
#endif
constexpr int N_PHASES = 13;
constexpr size_t MiB = 1u << 20;
constexpr size_t WS_CTL = 0, CTL_ZERO_BYTES = 64 * 1024;
constexpr size_t WS_SS = 1 * MiB;
constexpr size_t WS_BT = 1 * MiB + 512 * 1024;
constexpr size_t WS_GWT = 1 * MiB + 768 * 1024;
constexpr size_t WS_WIN0 = 2 * MiB, WS_WOUT0 = 16 * MiB, WS_WUP0 = 24 * MiB, WS_WDN0 = 56 * MiB, WS_WIN1 = 88 * MiB, WS_WOUT1 = 112 * MiB, WS_WUP1 = 120 * MiB, WS_WDN1 = 152 * MiB;
constexpr size_t WS_XN = 184 * MiB;
constexpr size_t WS_Y = 216 * MiB;
constexpr size_t WS_PROJ = 248 * MiB;
constexpr size_t WS_HL = 344 * MiB, WS_PA = 376 * MiB;
constexpr size_t WS_ACT = 248 * MiB;
constexpr size_t WS_END = 408 * MiB;
constexpr int CW_BAR = 1024;

constexpr int RING_OFF = 0, RING_BYTES = 131072;
constexpr int LDSCTL_OFF = RING_BYTES, MISC_OFF = LDSCTL_OFF + 320;
constexpr int LDS_BYTES = 147456;

#define GAS __attribute__((address_space(1)))
#define LAS __attribute__((address_space(3)))
typedef unsigned short bf16;
typedef unsigned v4u __attribute__((ext_vector_type(4)));
typedef unsigned v2u __attribute__((ext_vector_type(2)));
typedef float f32x4 __attribute__((ext_vector_type(4)));
#define LDS_WAIT() asm volatile("s_waitcnt lgkmcnt(0)" ::: "memory")
#define VM_WAIT() asm volatile("s_waitcnt vmcnt(0)" ::: "memory")
__device__ __forceinline__ unsigned f2bf(float f) { unsigned u = __builtin_bit_cast(unsigned, f); return (u + 0x7fffu + ((u >> 16) & 1u)) >> 16; }
__device__ __forceinline__ unsigned pk2(float lo, float hi) { return f2bf(lo) | (f2bf(hi) << 16); }
__device__ __forceinline__ float bflo(unsigned w) { return __builtin_bit_cast(float, w << 16); }
__device__ __forceinline__ float bfhi(unsigned w) { return __builtin_bit_cast(float, w & 0xffff0000u); }

#define XB_TMO      128
#define XB_XCNT(j)  (256  + 64 * (j))
#define XB_XSUB(j)  (1280 + 64 * (j))
#define XB_XGEN(j)  (2304 + 64 * (j))
#define XB_TOP      3328
#define XB_TOPGEN   3392
#define XCD_BAR_WORDS 3456
#define XB_SPIN_CAP (1u << 22)

__device__ __forceinline__ unsigned xb_ld(unsigned* p)              { return __hip_atomic_load(p, __ATOMIC_RELAXED, __HIP_MEMORY_SCOPE_AGENT); }
__device__ __forceinline__ unsigned xb_add(unsigned* p, unsigned v) { return __hip_atomic_fetch_add(p, v, __ATOMIC_RELAXED, __HIP_MEMORY_SCOPE_AGENT); }
__device__ __forceinline__ unsigned xb_xcc_id() { return (unsigned)__builtin_amdgcn_s_getreg((3 << 11) | 20) & 0xFu; }
#define XB_SPIN(cond, bar) do { unsigned _sp = 0; while (cond) { __builtin_amdgcn_s_sleep(1); \
    if ((++_sp & 255u) == 0u) { if (xb_ld(&(bar)[XB_TMO])) break; if (_sp > XB_SPIN_CAP) { atomicAdd(&(bar)[XB_TMO], 1u); break; } } } } while (0)

struct XcdBarrier {
    unsigned* bar; unsigned x;
    volatile LAS unsigned* st;
};

__device__ __forceinline__ XcdBarrier xcd_barrier_post(unsigned* bar, volatile LAS unsigned* st) {
    XcdBarrier b; b.bar = bar; b.x = xb_xcc_id(); b.st = st;
    if (threadIdx.x == 0) (void)xb_add(&bar[XB_XCNT(b.x)], 1u);
    return b;
}
__device__ __forceinline__ void xcd_barrier_complete(unsigned* bar, unsigned x, unsigned& nloc, unsigned& nx) {
    const unsigned G = gridDim.x * gridDim.y * gridDim.z;
    unsigned sum, cnt, mine, sp = 0u;
    for (;;) {
        sum = 0u; cnt = 0u; mine = 0u;
#pragma unroll
        for (unsigned j = 0; j < 16; ++j) { const unsigned c = xb_ld(&bar[XB_XCNT(j)]); sum += c; cnt += (c > 0u) ? 1u : 0u; mine = (j == x) ? c : mine; }
        if (sum == G) break;
        __builtin_amdgcn_s_sleep(1);
        if ((++sp & 255u) == 0u) { if (xb_ld(&bar[XB_TMO])) break; if (sp > XB_SPIN_CAP) { atomicAdd(&bar[XB_TMO], 1u); break; } }
    }
    nloc = mine > 0u ? mine : 1u; nx = cnt > 0u ? cnt : 1u;
}

__device__ __forceinline__ void xcd_barrier(const XcdBarrier& b) {
    asm volatile("s_waitcnt vmcnt(0)" ::: "memory");
    __syncthreads();
    if (threadIdx.x == 0) {
        unsigned* bar = b.bar;
        __builtin_amdgcn_s_waitcnt(0);
        unsigned nloc = b.st[0], nx = b.st[1];
        if (nloc == 0u) { xcd_barrier_complete(bar, b.x, nloc, nx); b.st[0] = nloc; b.st[1] = nx; }
        const unsigned old = xb_add(&bar[XB_XSUB(b.x)], 1u);
        const unsigned gen = old / nloc;
        if (old + 1u == (gen + 1u) * nloc) {
            __builtin_amdgcn_fence(__ATOMIC_RELEASE, "agent");
            asm volatile("s_waitcnt vmcnt(0)" ::: "memory");
            const unsigned og = xb_add(&bar[XB_TOP], 1u);
            const unsigned tg = og / nx;
            if (og + 1u == (tg + 1u) * nx) xb_add(&bar[XB_TOPGEN], 1u);
            else XB_SPIN(xb_ld(&bar[XB_TOPGEN]) == tg, bar);
            __builtin_amdgcn_fence(__ATOMIC_ACQUIRE, "agent");
            xb_add(&bar[XB_XGEN(b.x)], 1u);
            asm volatile("s_waitcnt vmcnt(0)" ::: "memory");
        } else {
            XB_SPIN(xb_ld(&bar[XB_XGEN(b.x)]) == gen, bar);
            __builtin_amdgcn_fence(__ATOMIC_ACQUIRE, "agent");
            asm volatile("s_waitcnt vmcnt(0)" ::: "memory");
        }
    }
    __syncthreads();
}
struct Frame {
    LAS unsigned char* lds;
    int tid, lane, wave, G;
    const float* in[19]; float* out; unsigned char* ws;
};
#define IN_X 0
#define IN_RELB 1
#define IN_NMIX 2
#define IN_EWIN 3
#define IN_CONVW 4
#define IN_CONVB 5
#define IN_GAW 6
#define IN_GAB 7
#define IN_GXW 8
#define IN_GXB 9
#define IN_LAMBDA 10
#define IN_SINKS 11
#define IN_EWOUT 12
#define IN_OWIN 13
#define IN_OWOUT 14
#define IN_NMLP 15
#define IN_WUP 16
#define IN_WDOWN 17
#define IN_FNORM 18

__device__ __forceinline__ float wave_sum(float v) {
#pragma unroll
    for (int o = 1; o < 64; o <<= 1) v += __shfl_xor(v, o);
    return v;
}
struct P0Tile { const float* W; const float* gain; bf16* WT; int K, N, k0, n0; };
__device__ __forceinline__ void p0_tile_load(const P0Tile& t, int lane, f32x4 (&v)[16]) {
    const GAS f32x4* p = (const GAS f32x4*)(t.W + (size_t)(t.k0 + (lane >> 4)) * t.N + t.n0 + 4 * (lane & 15));
#pragma unroll
    for (int i = 0; i < 16; ++i) v[i] = p[(size_t)i * t.N];
}
__device__ __forceinline__ void p0_tile_store(const P0Tile& t, int lane, const f32x4 (&v)[16], LAS float* scr) {
#pragma unroll
    for (int i = 0; i < 16; ++i) { const int kk = (lane >> 4) + 4 * i; *(LAS f32x4*)(scr + kk * 64 + ((4 * (lane & 15)) ^ (4 * ((kk >> 3) & 7)))) = v[i]; }
    LDS_WAIT(); asm volatile("" ::: "memory");
    const int kc = lane & 7;
    float g[8];
    if (t.gain) { const f32x4 a = *(const GAS f32x4*)(t.gain + t.k0 + 8 * kc), b = *(const GAS f32x4*)(t.gain + t.k0 + 8 * kc + 4); g[0] = a[0]; g[1] = a[1]; g[2] = a[2]; g[3] = a[3]; g[4] = b[0]; g[5] = b[1]; g[6] = b[2]; g[7] = b[3]; }
    else {
#pragma unroll
        for (int e = 0; e < 8; ++e) g[e] = 1.0f; }
#pragma unroll
    for (int j = 0; j < 8; ++j) { const int n = (lane >> 3) + 8 * j; const LAS float* s = scr + (8 * kc) * 64 + (n ^ (4 * kc));
        v4u o; o.x = pk2(s[0] * g[0], s[64] * g[1]); o.y = pk2(s[128] * g[2], s[192] * g[3]); o.z = pk2(s[256] * g[4], s[320] * g[5]); o.w = pk2(s[384] * g[6], s[448] * g[7]);
        *(GAS v4u*)(t.WT + (size_t)(t.n0 + n) * t.K + t.k0 + 8 * kc) = o; }
    LDS_WAIT(); asm volatile("" ::: "memory");
}
__device__ __forceinline__ int t5_bucket(int rel) {
    const int ret = rel > 0 ? 16 : 0, n = rel < 0 ? -rel : rel;
    if (n < 8) return ret + n;
    int large = 8 + (31 - __builtin_clz((unsigned)(n * n))) - 6; if (large > 15) large = 15;
    return ret + large;
}
__device__ __forceinline__ void p0_prologue(Frame& F) {
    LAS float* scr = (LAS float*)(F.lds + RING_OFF + F.wave * 16384);
    const int gw = blockIdx.x * NWAVES + F.wave, NGW = F.G * NWAVES;
    unsigned char* ws = F.ws;
    constexpr int T_IN0 = (DM / 64) * (EVEN_IN / 64), T_OUT = (DM / 64) * (DM / 64), T_UP = (DM / 64) * (DFF / 64), T_DN = (DFF / 64) * (DM / 64), T_IN1 = (DM / 64) * (ODD_IN / 64);
    constexpr int NTILES = T_IN0 + T_IN1 + 2 * T_OUT + 2 * T_UP + 2 * T_DN;
#define P0_DESC(it, t) do { int r_ = (it); \
        if (r_ < T_IN0) { t.W = F.in[IN_EWIN]; t.gain = F.in[IN_NMIX]; t.WT = (bf16*)(ws + WS_WIN0); t.K = DM; t.N = EVEN_IN; } else { r_ -= T_IN0; \
        if (r_ < T_OUT) { t.W = F.in[IN_EWOUT]; t.gain = nullptr; t.WT = (bf16*)(ws + WS_WOUT0); t.K = DM; t.N = DM; } else { r_ -= T_OUT; \
        if (r_ < T_UP) { t.W = F.in[IN_WUP]; t.gain = F.in[IN_NMLP]; t.WT = (bf16*)(ws + WS_WUP0); t.K = DM; t.N = DFF; } else { r_ -= T_UP; \
        if (r_ < T_DN) { t.W = F.in[IN_WDOWN]; t.gain = nullptr; t.WT = (bf16*)(ws + WS_WDN0); t.K = DFF; t.N = DM; } else { r_ -= T_DN; \
        if (r_ < T_IN1) { t.W = F.in[IN_OWIN]; t.gain = F.in[IN_NMIX] + DM; t.WT = (bf16*)(ws + WS_WIN1); t.K = DM; t.N = ODD_IN; } else { r_ -= T_IN1; \
        if (r_ < T_OUT) { t.W = F.in[IN_OWOUT]; t.gain = nullptr; t.WT = (bf16*)(ws + WS_WOUT1); t.K = DM; t.N = DM; } else { r_ -= T_OUT; \
        if (r_ < T_UP) { t.W = F.in[IN_WUP] + (size_t)DM * DFF; t.gain = F.in[IN_NMLP] + DM; t.WT = (bf16*)(ws + WS_WUP1); t.K = DM; t.N = DFF; } else { r_ -= T_UP; \
        t.W = F.in[IN_WDOWN] + (size_t)DFF * DM; t.gain = nullptr; t.WT = (bf16*)(ws + WS_WDN1); t.K = DFF; t.N = DM; } } } } } } } \
        const int nb_ = t.N / 64; t.k0 = 64 * (r_ / nb_); t.n0 = 64 * (r_ % nb_); } while (0)
    {
        f32x4 va[16], vb[16]; P0Tile ta, tb;
        int it = gw;
        if (it < NTILES) { P0_DESC(it, ta); p0_tile_load(ta, F.lane, va); }
        while (it < NTILES) {
            const int itn = it + NGW; const bool more = itn < NTILES;
            if (more) { P0_DESC(itn, tb); p0_tile_load(tb, F.lane, vb); }
            p0_tile_store(ta, F.lane, va, scr);
            if (more) { ta = tb;
#pragma unroll
                for (int i = 0; i < 16; ++i) va[i] = vb[i]; }
            it = itn;
        }
    }
#undef P0_DESC
    bf16* XN = (bf16*)(ws + WS_XN); float* SS = (float*)(ws + WS_SS);
    for (int m = gw; m < SEQ; m += NGW) {
        const GAS f32x4* xr = (const GAS f32x4*)(F.in[IN_X] + (size_t)m * DM) + F.lane;
        f32x4 v[8]; float s = 0.f;
#pragma unroll
        for (int j = 0; j < 8; ++j) { v[j] = xr[64 * j]; s += (v[j].x * v[j].x + v[j].y * v[j].y) + (v[j].z * v[j].z + v[j].w * v[j].w); }
        s = wave_sum(s);
        GAS v2u* o8 = (GAS v2u*)(XN + (size_t)m * DM) + F.lane;
#pragma unroll
        for (int j = 0; j < 8; ++j) { v2u w; w.x = pk2(v[j].x, v[j].y); w.y = pk2(v[j].z, v[j].w); o8[64 * j] = w; }
        if (F.lane < 8) SS[(size_t)m * 8 + F.lane] = F.lane == 0 ? s : 0.f;
    }
    float* BT = (float*)(ws + WS_BT);
    for (int i = blockIdx.x * 512 + F.tid; i < 16 * 256; i += F.G * 512) { const int head = i >> 8, rel = (i & 255) - 191; BT[i] = F.in[IN_RELB][t5_bucket(rel) * 16 + head]; }
    bf16* GWT = (bf16*)(ws + WS_GWT);
    for (int i = blockIdx.x * 512 + F.tid; i < 2 * 16 * 64 * 64; i += F.G * 512) { const int gate = i >> 16, hb = (i >> 12) & 15, jo = (i >> 6) & 63, ii = i & 63;
        GWT[i] = (bf16)f2bf(F.in[gate ? IN_GXW : IN_GAW][(size_t)(hb * 64 + ii) * 64 + jo]); }
}

__device__ __forceinline__ void ld8(const bf16* p, float (&o)[8]) { const v4u w = *(const GAS v4u*)p; o[0] = bflo(w.x); o[1] = bfhi(w.x); o[2] = bflo(w.y); o[3] = bfhi(w.y); o[4] = bflo(w.z); o[5] = bfhi(w.z); o[6] = bflo(w.w); o[7] = bfhi(w.w); }
__device__ __forceinline__ void swa_naive(Frame& F) {
    const bf16* PROJ = (const bf16*)(F.ws + WS_PROJ); bf16* Y = (bf16*)(F.ws + WS_Y); const float* BT = (const float*)(F.ws + WS_BT);
    for (int idx = blockIdx.x * 512 + F.tid; idx < SEQ * 16; idx += F.G * 512) {
        const int head = idx >> 13, tok = idx & (SEQ - 1), kvh = head >> 2, c = tok >> 6;
        float q[64], acc[64];
#pragma unroll
        for (int i = 0; i < 8; ++i) { float t[8]; ld8(PROJ + (size_t)tok * EVEN_IN + head * 64 + 8 * i, t);
#pragma unroll
            for (int j = 0; j < 8; ++j) { q[8 * i + j] = t[j] * 0.125f; acc[8 * i + j] = 0.f; } }
        float m = F.in[IN_SINKS][head], l = 1.0f;
        const int k0 = c >= 2 ? (c - 2) * 64 : 0, k1 = (c + 1) * 64;
        const float* bt = BT + head * 256;
        for (int j = k0; j < k1; ++j) {
            const bf16* kp = PROJ + (size_t)j * EVEN_IN + OFF_K + kvh * 64; float s = 0.f;
#pragma unroll
            for (int i = 0; i < 8; ++i) { float t[8]; ld8(kp + 8 * i, t);
#pragma unroll
                for (int e = 0; e < 8; ++e) s += q[8 * i + e] * t[e]; }
            s += bt[j - tok + 191];
            const float mn = fmaxf(m, s), corr = expf(m - mn), p = expf(s - mn);
            l = l * corr + p; m = mn;
            const bf16* vp = PROJ + (size_t)j * EVEN_IN + OFF_V + kvh * 64;
#pragma unroll
            for (int i = 0; i < 8; ++i) { float t[8]; ld8(vp + 8 * i, t);
#pragma unroll
                for (int e = 0; e < 8; ++e) acc[8 * i + e] = acc[8 * i + e] * corr + p * t[e]; }
        }
        const float inv = 1.0f / l;
#pragma unroll
        for (int i = 0; i < 8; ++i) { v4u w; w.x = pk2(acc[8 * i] * inv, acc[8 * i + 1] * inv); w.y = pk2(acc[8 * i + 2] * inv, acc[8 * i + 3] * inv); w.z = pk2(acc[8 * i + 4] * inv, acc[8 * i + 5] * inv); w.w = pk2(acc[8 * i + 6] * inv, acc[8 * i + 7] * inv);
            *(GAS v4u*)(Y + (size_t)tok * DM + head * 64 + 8 * i) = w; }
    }
}
__device__ __forceinline__ float softplusf(float z) { return fmaxf(z, 0.f) + log1pf(expf(-fabsf(z))); }
__device__ __forceinline__ float sigmoidf_(float z) { return 1.0f / (1.0f + expf(-z)); }
__device__ __forceinline__ float gelu_tanh(float x) { const float u = 0.7978845608028654f * (x + 0.044715f * x * x * x); return 0.5f * x * (1.0f + tanhf(u)); }
__device__ __forceinline__ void lru_naive(Frame& F) {
    if (blockIdx.x >= 16 || F.wave != 0) return;
    const bf16* PROJ = (const bf16*)(F.ws + WS_PROJ); bf16* Y = (bf16*)(F.ws + WS_Y);
    const int hb = blockIdx.x, lane = F.lane, c = hb * 64 + lane;
    float Wa[64], Wx[64];
#pragma unroll
    for (int i = 0; i < 64; ++i) { Wa[i] = F.in[IN_GAW][(size_t)(hb * 64 + i) * 64 + lane]; Wx[i] = F.in[IN_GXW][(size_t)(hb * 64 + i) * 64 + lane]; }
    const float ba = F.in[IN_GAB][c], bx = F.in[IN_GXB][c], cb = F.in[IN_CONVB][c];
    const float cw0 = F.in[IN_CONVW][c], cw1 = F.in[IN_CONVW][1024 + c], cw2 = F.in[IN_CONVW][2048 + c], cw3 = F.in[IN_CONVW][3072 + c];
    const float sp8 = 8.0f * softplusf(-F.in[IN_LAMBDA][c]);
    float x1 = 0.f, x2 = 0.f, x3 = 0.f, h = 0.f;
    for (int t0 = 0; t0 < SEQ; t0 += 8) {
        float xb[8], g[8];
#pragma unroll
        for (int u = 0; u < 8; ++u) { xb[u] = bflo((unsigned)PROJ[(size_t)(t0 + u) * EVEN_IN + OFF_X + c]); g[u] = bflo((unsigned)PROJ[(size_t)(t0 + u) * EVEN_IN + OFF_G + c]); }
#pragma unroll
        for (int u = 0; u < 8; ++u) {
            const float xt = xb[u], xc = cb + cw0 * x3 + cw1 * x2 + cw2 * x1 + cw3 * xt; x3 = x2; x2 = x1; x1 = xt;
            float ra = ba, rx = bx; const int xci = __builtin_bit_cast(int, xc);
#pragma unroll
            for (int i = 0; i < 64; ++i) { const float xi = __builtin_bit_cast(float, __builtin_amdgcn_readlane(xci, i)); ra += xi * Wa[i]; rx += xi * Wx[i]; }
            const float r = sigmoidf_(ra), ig = sigmoidf_(rx), log_a = -r * sp8, a = expf(log_a), mult = sqrtf(-expm1f(2.0f * log_a));
            h = a * h + mult * (ig * xc);
            Y[(size_t)(t0 + u) * DM + 1024 + c] = (bf16)f2bf(gelu_tanh(g[u]) * h);
        }
    }
}
__device__ __forceinline__ void sb_naive(Frame& F) {
    const bf16* PROJ = (const bf16*)(F.ws + WS_PROJ); bf16* Y = (bf16*)(F.ws + WS_Y);
    const int gt = blockIdx.x * 512 + F.tid, half = gt & 1;
    for (int pidx = gt >> 1; pidx < SEQ * 16; pidx += (F.G * 512) >> 1) {
        const int head = pidx >> 13, tok = pidx & (SEQ - 1);
        float q[64], acc[64];
#pragma unroll
        for (int i = 0; i < 8; ++i) { float t[8]; ld8(PROJ + (size_t)tok * ODD_IN + head * 128 + half * 64 + 8 * i, t);
#pragma unroll
            for (int j = 0; j < 8; ++j) { q[8 * i + j] = t[j] * 0.08838834764831845f; acc[8 * i + j] = 0.f; } }
        float stick = 0.f;
        for (int j = tok - 1; j >= 0; --j) {
            const bf16* kp = PROJ + (size_t)j * ODD_IN + 2048 + head * 128 + half * 64; float s = 0.f;
#pragma unroll
            for (int i = 0; i < 8; ++i) { float t[8]; ld8(kp + 8 * i, t);
#pragma unroll
                for (int e = 0; e < 8; ++e) s += q[8 * i + e] * t[e]; }
            const float z = s + __shfl_xor(s, 1);
            const float lk = -softplusf(z), w = expf(z + lk + stick);
            const bf16* vp = PROJ + (size_t)j * ODD_IN + 4096 + head * 128 + half * 64;
#pragma unroll
            for (int i = 0; i < 8; ++i) { float t[8]; ld8(vp + 8 * i, t);
#pragma unroll
                for (int e = 0; e < 8; ++e) acc[8 * i + e] += w * t[e]; }
            stick += lk;
            if (stick < -104.0f) break;
        }
#pragma unroll
        for (int i = 0; i < 8; ++i) { v4u w; w.x = pk2(acc[8 * i], acc[8 * i + 1]); w.y = pk2(acc[8 * i + 2], acc[8 * i + 3]); w.z = pk2(acc[8 * i + 4], acc[8 * i + 5]); w.w = pk2(acc[8 * i + 6], acc[8 * i + 7]);
            *(GAS v4u*)(Y + (size_t)tok * DM + head * 128 + half * 64 + 8 * i) = w; }
    }
}
__device__ __forceinline__ void final_norm(Frame& F) {
    const int gw = blockIdx.x * NWAVES + F.wave, NGW = F.G * NWAVES;
    const bf16* XN = (const bf16*)(F.ws + WS_XN); const float* SS = (const float*)(F.ws + WS_SS);
    const GAS f32x4* gp = (const GAS f32x4*)F.in[IN_FNORM] + 2 * F.lane;
    for (int m = gw; m < SEQ; m += NGW) {
        const GAS v4u* xr = (const GAS v4u*)(XN + (size_t)m * DM) + F.lane;
        GAS f32x4* orow = (GAS f32x4*)(F.out + (size_t)m * DM) + 2 * F.lane;
        const f32x4 sa = *(const GAS f32x4*)(SS + (size_t)m * 8), sb = *(const GAS f32x4*)(SS + (size_t)m * 8 + 4);
        const float rstd = 1.0f / sqrtf((((sa[0] + sa[1]) + (sa[2] + sa[3])) + ((sb[0] + sb[1]) + (sb[2] + sb[3]))) * (1.0f / DM) + 1e-6f);
        v4u v[4];
#pragma unroll
        for (int j = 0; j < 4; ++j) v[j] = xr[64 * j];
#pragma unroll
        for (int j = 0; j < 4; ++j) { const f32x4 g0 = gp[128 * j], g1 = gp[128 * j + 1];
            orow[128 * j] = (f32x4){bflo(v[j].x) * rstd * g0[0], bfhi(v[j].x) * rstd * g0[1], bflo(v[j].y) * rstd * g0[2], bfhi(v[j].y) * rstd * g0[3]};
            orow[128 * j + 1] = (f32x4){bflo(v[j].z) * rstd * g1[0], bfhi(v[j].z) * rstd * g1[1], bflo(v[j].w) * rstd * g1[2], bfhi(v[j].w) * rstd * g1[3]}; }
    }
}
typedef float f32x16 __attribute__((ext_vector_type(16)));
typedef short s16x8 __attribute__((ext_vector_type(8)));
typedef short s16x4 __attribute__((ext_vector_type(4)));
typedef __bf16 bf16x2v __attribute__((ext_vector_type(2)));
#define MFMA32(a, b, c) __builtin_amdgcn_mfma_f32_32x32x16_bf16((a), (b), (c), 0, 0, 0)
__device__ __forceinline__ int crow(int i, int h) { return (i & 3) + 8 * (i >> 2) + 4 * h; }
__device__ __forceinline__ unsigned pkbf(float a, float b) { bf16x2v v; v.x = (__bf16)a; v.y = (__bf16)b; return __builtin_bit_cast(unsigned, v); }
__device__ __forceinline__ s16x8 pack8(const float (&p)[16], int s) {
    v4u w; w.x = pkbf(p[8 * s], p[8 * s + 1]); w.y = pkbf(p[8 * s + 2], p[8 * s + 3]); w.z = pkbf(p[8 * s + 4], p[8 * s + 5]); w.w = pkbf(p[8 * s + 6], p[8 * s + 7]);
    return __builtin_bit_cast(s16x8, w);
}
__device__ __forceinline__ s16x8 tr_frag(const LAS unsigned char* p0, const LAS unsigned char* p1) {
    const s16x4 lo = __builtin_amdgcn_ds_read_tr16_b64_v4i16((LAS s16x4*)p0), hi = __builtin_amdgcn_ds_read_tr16_b64_v4i16((LAS s16x4*)p1);
    return __builtin_shufflevector(lo, hi, 0, 1, 2, 3, 4, 5, 6, 7);
}
__device__ __forceinline__ float ex2(float x) { return __builtin_amdgcn_exp2f(x); }
__device__ __forceinline__ float lg2(float x) { return __builtin_amdgcn_logf(x); }
__device__ __forceinline__ float fast_exp(float x) { return ex2(x * 1.4426950408889634f); }
__device__ __forceinline__ float fast_softplus(float z) { return fmaxf(z, 0.f) + 0.6931471805599453f * lg2(1.0f + ex2(-1.4426950408889634f * fabsf(z))); }
__device__ __forceinline__ float fast_sigmoid(float z) { return __builtin_amdgcn_rcpf(1.0f + ex2(-1.4426950408889634f * z)); }
#define G0(g, tok) (PROJ + ((size_t)(g) * SEQ + (tok)) * 64)
#define G1(g, tok) (PROJ + ((size_t)(g) * SEQ + (tok)) * 128)

__device__ __forceinline__ float neg_expm1(float x) {
    const float p = -x * (1.0f + x * (0.5f + x * (0.16666667f + x * (0.041666668f + x * (0.0083333338f + x * 0.0013888889f)))));
    return x > -0.25f ? p : 1.0f - fast_exp(x);
}
__device__ __forceinline__ void lru_local(Frame& F) {
    const bf16* PROJ = (const bf16*)(F.ws + WS_PROJ); float* HL = (float*)(F.ws + WS_HL); float* PA = (float*)(F.ws + WS_PA); const bf16* GWT = (const bf16*)(F.ws + WS_GWT);
    LAS unsigned char* xc16 = F.lds;
    LAS float* xc32 = (LAS float*)(F.lds + 18432);
    LAS float* comp = (LAS float*)(F.lds + 18432 + 34816);
    const int tid = F.tid, lane = F.lane, w = F.wave, ts = w & 3, ch = w >> 2, r = lane & 31, h = lane >> 5;
    const int hb = blockIdx.x & 15;
    const int tp = tid >> 3, cg = tid & 7, cb8 = hb * 64 + cg * 8;
    float cw[4][8], cbias[8];
#pragma unroll
    for (int d = 0; d < 4; ++d) { const f32x4 a = *(const GAS f32x4*)(F.in[IN_CONVW] + d * 1024 + cb8), b = *(const GAS f32x4*)(F.in[IN_CONVW] + d * 1024 + cb8 + 4);
        cw[d][0] = a[0]; cw[d][1] = a[1]; cw[d][2] = a[2]; cw[d][3] = a[3]; cw[d][4] = b[0]; cw[d][5] = b[1]; cw[d][6] = b[2]; cw[d][7] = b[3]; }
    { const f32x4 a = *(const GAS f32x4*)(F.in[IN_CONVB] + cb8), b = *(const GAS f32x4*)(F.in[IN_CONVB] + cb8 + 4);
      cbias[0] = a[0]; cbias[1] = a[1]; cbias[2] = a[2]; cbias[3] = a[3]; cbias[4] = b[0]; cbias[5] = b[1]; cbias[6] = b[2]; cbias[7] = b[3]; }
    s16x8 wa[4], wx[4];
#pragma unroll
    for (int s = 0; s < 4; ++s) { wa[s] = *(const GAS s16x8*)(GWT + (size_t)((0 * 16 + hb) * 64 + ch * 32 + r) * 64 + 16 * s + 8 * h); wx[s] = *(const GAS s16x8*)(GWT + (size_t)((1 * 16 + hb) * 64 + ch * 32 + r) * 64 + 16 * s + 8 * h); }
    const int c = hb * 64 + ch * 32 + r;
    const float gab = F.in[IN_GAB][c], gxb = F.in[IN_GXB][c], sp8 = 8.0f * softplusf(-F.in[IN_LAMBDA][c]);
    const int nun = (1024 - (int)blockIdx.x + F.G - 1) / F.G;
    v4u xin[5];
#define LRU_LOAD(kk) do { const int t_ = (kk) * 128 + 2 * tp; _Pragma("unroll") for (int d = 0; d < 5; ++d) { const int row_ = t_ - 3 + d; xin[d] = *(const GAS v4u*)(G0(24 + hb, row_ < 0 ? 0 : row_) + cg * 8); if (row_ < 0) xin[d] = (v4u){0u, 0u, 0u, 0u}; } } while (0)
    LRU_LOAD((int)blockIdx.x >> 4);
    for (int ui = 0; ui < nun; ++ui) {
        const int k = ((int)blockIdx.x + ui * F.G) >> 4, t0 = k * 128;
        {
            float xv[5][8];
#pragma unroll
            for (int d = 0; d < 5; ++d) { xv[d][0] = bflo(xin[d].x); xv[d][1] = bfhi(xin[d].x); xv[d][2] = bflo(xin[d].y); xv[d][3] = bfhi(xin[d].y); xv[d][4] = bflo(xin[d].z); xv[d][5] = bfhi(xin[d].z); xv[d][6] = bflo(xin[d].w); xv[d][7] = bfhi(xin[d].w); }
#pragma unroll
            for (int tk = 0; tk < 2; ++tk) { float xc[8];
#pragma unroll
                for (int e = 0; e < 8; ++e) xc[e] = cbias[e] + cw[0][e] * xv[tk][e] + cw[1][e] * xv[tk + 1][e] + cw[2][e] * xv[tk + 2][e] + cw[3][e] * xv[tk + 3][e];
                const int tt = 2 * tp + tk;
                *(LAS f32x4*)(xc32 + tt * 68 + cg * 8) = (f32x4){xc[0], xc[1], xc[2], xc[3]}; *(LAS f32x4*)(xc32 + tt * 68 + cg * 8 + 4) = (f32x4){xc[4], xc[5], xc[6], xc[7]};
                v4u o; o.x = pkbf(xc[0], xc[1]); o.y = pkbf(xc[2], xc[3]); o.z = pkbf(xc[4], xc[5]); o.w = pkbf(xc[6], xc[7]);
                *(LAS v4u*)(xc16 + tt * 144 + cg * 16) = o; }
        }
        __syncthreads();
        if (ui + 1 < nun) LRU_LOAD(((int)blockIdx.x + (ui + 1) * F.G) >> 4);
        __builtin_amdgcn_sched_barrier(0);
        f32x16 acc_a, acc_x;
#pragma unroll
        for (int i = 0; i < 16; ++i) { acc_a[i] = 0.f; acc_x[i] = 0.f; }
#pragma unroll
        for (int s = 0; s < 4; ++s) { const s16x8 af = *(const LAS s16x8*)(xc16 + (ts * 32 + r) * 144 + (16 * s + 8 * h) * 2); acc_a = MFMA32(af, wa[s], acc_a); acc_x = MFMA32(af, wx[s], acc_x); }
        float pa[16], hl[16], gA[4], gU[4];
#pragma unroll
        for (int g = 0; g < 4; ++g) { float A = 1.f, U = 0.f;
#pragma unroll
            for (int e = 0; e < 4; ++e) { const int i = 4 * g + e; const float xcv = xc32[(ts * 32 + crow(i, h)) * 68 + ch * 32 + r];
                const float rg = fast_sigmoid(acc_a[i] + gab), ig = fast_sigmoid(acc_x[i] + gxb), log_a = -rg * sp8, a = fast_exp(log_a), mult = sqrtf(neg_expm1(2.0f * log_a));
                U = a * U + mult * (ig * xcv); A *= a; pa[i] = A; hl[i] = U; }
            gA[g] = A; gU[g] = U; }
        float PAc = 1.f, Hc = 0.f;
#pragma unroll
        for (int g = 0; g < 4; ++g) { const float oA = __shfl_xor(gA[g], 32), oU = __shfl_xor(gU[g], 32);
            const float fA = h ? oA : gA[g], fU = h ? oU : gU[g], sA = h ? gA[g] : oA, sU = h ? gU[g] : oU;
            const float c0P = PAc, c0H = Hc; Hc = fA * Hc + fU; PAc *= fA; const float c1P = PAc, c1H = Hc; Hc = sA * Hc + sU; PAc *= sA;
            const float ciP = h ? c1P : c0P, ciH = h ? c1H : c0H;
#pragma unroll
            for (int e = 0; e < 4; ++e) { const int i = 4 * g + e; hl[i] += pa[i] * ciH; pa[i] *= ciP; } }
        if (h == 0) { comp[(ts * 64 + ch * 32 + r) * 2] = PAc; comp[(ts * 64 + ch * 32 + r) * 2 + 1] = Hc; }
        __syncthreads();
        float PAin = 1.f, Hin = 0.f;
        for (int t2 = 0; t2 < ts; ++t2) { const float A2 = comp[(t2 * 64 + ch * 32 + r) * 2], U2 = comp[(t2 * 64 + ch * 32 + r) * 2 + 1]; Hin = A2 * Hin + U2; PAin *= A2; }
#pragma unroll
        for (int i = 0; i < 16; ++i) { const size_t o = ((size_t)hb * SEQ + t0 + ts * 32 + crow(i, h)) * 64 + ch * 32 + r; HL[o] = hl[i] + pa[i] * Hin; PA[o] = pa[i] * PAin; }
        __syncthreads();
    }
#undef LRU_LOAD
}
__device__ __forceinline__ void lru_fix(Frame& F) {
    const bf16* PROJ = (const bf16*)(F.ws + WS_PROJ); const float* HL = (const float*)(F.ws + WS_HL); const float* PA = (const float*)(F.ws + WS_PA); bf16* Y = (bf16*)(F.ws + WS_Y);
    const int gw = blockIdx.x * NWAVES + F.wave, NGW = F.G * NWAVES;
    for (int it = gw; it < 2048; it += NGW) {
        const int cgp = it & 15, sub = (it >> 4) & 1, k = it >> 5, c = cgp * 64 + F.lane;
        float H = 0.f;
        for (int kb = 0; kb < k; kb += 16) {
            float a[16], u[16];
#pragma unroll
            for (int j = 0; j < 16; ++j) { const int kk = (kb + j < k) ? kb + j : 0; const size_t row = ((size_t)cgp * SEQ + kk * 128 + 127) * 64 + F.lane; a[j] = PA[row]; u[j] = HL[row]; }
#pragma unroll
            for (int j = 0; j < 16; ++j) { const bool on = kb + j < k; H = on ? a[j] * H + u[j] : H; }
        }
#pragma unroll
        for (int tb = 0; tb < 64; tb += 32) {
            float hv[32], pv[32], gv[32];
#pragma unroll
            for (int tt = 0; tt < 32; ++tt) { const int t = k * 128 + sub * 64 + tb + tt; const size_t o = ((size_t)cgp * SEQ + t) * 64 + F.lane; hv[tt] = HL[o]; pv[tt] = PA[o]; gv[tt] = bflo((unsigned)G0(40 + cgp, t)[F.lane]); }
#pragma unroll
            for (int tt = 0; tt < 32; ++tt) { const int t = k * 128 + sub * 64 + tb + tt; const float g = gv[tt], u2 = 1.5957691216057308f * (g + 0.044715f * g * g * g), ge = g * fast_sigmoid(u2);
                Y[(size_t)t * DM + 1024 + c] = (bf16)f2bf(ge * (hv[tt] + pv[tt] * H)); }
        }
    }
}
template <bool DIAG> __device__ __forceinline__ void sb_tile(const f32x16& sacc, int r, int h, float& run, float (&pw)[16]) {
    float q[16], sp[16], G[4];
#pragma unroll
    for (int g = 0; g < 4; ++g) { float gs = 0.f;
#pragma unroll
        for (int e = 0; e < 4; ++e) { const int i = 4 * g + e; const float y = sacc[i] * 0.12751743082459868f;
            const float lg = lg2(1.0f + ex2(-fabsf(y))); float s_ = fmaxf(y, 0.f) + lg, q_ = fminf(y, 0.f) - lg;
            if (DIAG) { const bool valid = crow(i, h) < r; s_ = valid ? s_ : 0.f; q_ = valid ? q_ : -1e30f; }
            sp[i] = s_; q[i] = q_; gs += s_; }
        G[g] = gs; }
#pragma unroll
    for (int g = 3; g >= 0; --g) { const float og = __shfl_xor(G[g], 32);
        const float s1 = run; run += h ? G[g] : og;
        const float s0 = run; run += h ? og : G[g];
        float ex = h ? s1 : s0;
#pragma unroll
        for (int e = 3; e >= 0; --e) { const int i = 4 * g + e; pw[i] = ex2(q[i] - ex); ex += sp[i]; } }
}
__device__ __forceinline__ void sb_attn(Frame& F) {
    const bf16* PROJ = (const bf16*)(F.ws + WS_PROJ); bf16* Y = (bf16*)(F.ws + WS_Y);
    LAS unsigned char* vl = F.lds + F.wave * 16384;
    const int lane = F.lane, r = lane & 31, h = lane >> 5;
    const int gw = blockIdx.x * NWAVES + F.wave;
    const int troff = (4 * h + ((lane & 15) >> 2)) * 256 + (16 * ((lane >> 4) & 1) + 4 * (lane & 3)) * 2;
    unsigned* qctr = (unsigned*)(F.ws + WS_CTL) + 8192;
    int cj = blockIdx.x & 7, tries = 0;
#define FRAG(g, tile, s) (PROJ + (size_t)(g) * SEQ * 128 + ((size_t)((((tile) * 8 + (s)) * 2 + h) * 32 + r)) * 8)
    for (int it = gw; ; ) {
        const int head = (it >> 3) & 15, qb = ((it >> 7) << 3) + (it & 7), q0 = qb * 32;
        s16x8 qf[8], kf[8];
#pragma unroll
        for (int s = 0; s < 8; ++s) { qf[s] = *(const GAS s16x8*)FRAG(head, qb, s); kf[s] = *(const GAS s16x8*)FRAG(16 + head, qb, s); }
        f32x16 o[4];
#pragma unroll
        for (int db = 0; db < 4; ++db)
#pragma unroll
            for (int i = 0; i < 16; ++i) o[db][i] = 0.f;
        float carry = 0.f;
        v4u vreg[8];
#pragma unroll
        for (int i = 0; i < 8; ++i) vreg[i] = *(const GAS v4u*)(G1(32 + head, q0) + (lane + 64 * i) * 8);
#pragma unroll
        for (int i = 0; i < 8; ++i) *(LAS v4u*)(vl + (lane + 64 * i) * 16) = vreg[i];
        LDS_WAIT();
        for (int kt = qb; kt >= 0; --kt) {
            const int ktn = kt > 0 ? kt - 1 : 0;
            f32x16 sacc;
#pragma unroll
            for (int i = 0; i < 16; ++i) sacc[i] = 0.f;
#pragma unroll
            for (int s = 0; s < 8; ++s) sacc = MFMA32(kf[s], qf[s], sacc);
#pragma unroll
            for (int s = 0; s < 8; ++s) kf[s] = *(const GAS s16x8*)FRAG(16 + head, ktn, s);
#pragma unroll
            for (int i = 0; i < 8; ++i) vreg[i] = *(const GAS v4u*)(G1(32 + head, ktn * 32) + (lane + 64 * i) * 8);
            __builtin_amdgcn_sched_barrier(0);
            float pw[16];
            if (kt == qb) sb_tile<true>(sacc, r, h, carry, pw); else sb_tile<false>(sacc, r, h, carry, pw);
            const s16x8 p0 = pack8(pw, 0), p1 = pack8(pw, 1);
            const LAS unsigned char* trb = vl + troff;
#pragma unroll
            for (int db = 0; db < 4; ++db) {
                const s16x8 v0 = tr_frag(trb + db * 64, trb + 8 * 256 + db * 64);
                const s16x8 v1 = tr_frag(trb + 16 * 256 + db * 64, trb + 24 * 256 + db * 64);
                o[db] = MFMA32(v0, p0, o[db]); o[db] = MFMA32(v1, p1, o[db]); }
#pragma unroll
            for (int i = 0; i < 8; ++i) *(LAS v4u*)(vl + (lane + 64 * i) * 16) = vreg[i];
            LDS_WAIT();
            if (__all(carry > 150.04f)) break;
        }
#pragma unroll
        for (int db = 0; db < 4; ++db)
#pragma unroll
            for (int g = 0; g < 4; ++g) { v2u w; w.x = pkbf(o[db][4 * g], o[db][4 * g + 1]); w.y = pkbf(o[db][4 * g + 2], o[db][4 * g + 3]);
                *(GAS v2u*)(Y + (size_t)(q0 + r) * DM + head * 128 + db * 32 + 8 * g + 4 * h) = w; }
        bool got = false;
        while (tries < 8) {
            unsigned n = 0u; if (lane == 0) n = __hip_atomic_fetch_add(qctr + 64 * cj, 1u, __ATOMIC_RELAXED, __HIP_MEMORY_SCOPE_AGENT);
            n = (unsigned)__builtin_amdgcn_readfirstlane((int)n);
            if (n < 256u) { it = 2048 + cj * 256 + (int)n; got = true; break; }
            cj = (cj + 1) & 7; ++tries; }
        if (!got) break;
    }
#undef FRAG
}
__device__ __forceinline__ void swa_attn(Frame& F) {
    const bf16* PROJ = (const bf16*)(F.ws + WS_PROJ); bf16* Y = (bf16*)(F.ws + WS_Y); const float* BT = (const float*)(F.ws + WS_BT);
    LAS unsigned char* KL = F.lds + 57344;
    LAS unsigned char* VL = KL + 27648;
    LAS float* btl = (LAS float*)(VL + 36864);
    const int tid = F.tid, lane = F.lane, w = F.wave, r = lane & 31, h = lane >> 5;
    const int kvh = blockIdx.x & 3;
    btl[tid] = BT[kvh * 1024 + tid]; btl[tid + 512] = BT[kvh * 1024 + 512 + tid];
    const int head = kvh * 4 + (w & 3);
    const float sink = F.in[IN_SINKS][head];
    const LAS float* bth = btl + (w & 3) * 256;
    const LAS unsigned char* trb = VL + (4 * h + ((lane & 15) >> 2)) * 192 + (16 * ((lane >> 4) & 1) + 4 * (lane & 3)) * 2;
    v4u kreg[3], vreg[3];
    const int nun = (512 - (int)blockIdx.x + F.G - 1) / F.G;
    {   const int c = blockIdx.x >> 2, kbase = (c - 2) * 64;
#pragma unroll
        for (int i = 0; i < 3; ++i) { const int j = tid + 512 * i; int row = kbase + (j >> 3); row = row < 0 ? 0 : row;
            kreg[i] = *(const GAS v4u*)(G0(16 + kvh, row) + (j & 7) * 8); vreg[i] = *(const GAS v4u*)(G0(20 + kvh, row) + (j & 7) * 8); } }
    for (int ui = 0; ui < nun; ++ui) {
        const int wu = blockIdx.x + ui * F.G, c = wu >> 2, q0 = c * 64 + (w >> 2) * 32, kbase = (c - 2) * 64, kt0 = c >= 2 ? 0 : (2 - c) * 2;
#pragma unroll
        for (int i = 0; i < 3; ++i) { const int j = tid + 512 * i; *(LAS v4u*)(KL + (j >> 3) * 144 + (j & 7) * 16) = kreg[i]; *(LAS v4u*)(VL + (j >> 3) * 192 + (j & 7) * 16) = vreg[i]; }
        __syncthreads();
        if (ui + 1 < nun) { const int c2 = (wu + F.G) >> 2, kb2 = (c2 - 2) * 64;
#pragma unroll
            for (int i = 0; i < 3; ++i) { const int j = tid + 512 * i; int row = kb2 + (j >> 3); row = row < 0 ? 0 : row;
                kreg[i] = *(const GAS v4u*)(G0(16 + kvh, row) + (j & 7) * 8); vreg[i] = *(const GAS v4u*)(G0(20 + kvh, row) + (j & 7) * 8); } }
        s16x8 qf[4];
#pragma unroll
        for (int s = 0; s < 4; ++s) qf[s] = *(const GAS s16x8*)(G0(head, q0 + r) + 16 * s + 8 * h);
        __builtin_amdgcn_sched_barrier(0);
        float sc[6][16]; float m = sink;
#pragma unroll
        for (int kt = 0; kt < 6; ++kt) {
            f32x16 sacc;
#pragma unroll
            for (int i = 0; i < 16; ++i) sacc[i] = 0.f;
#pragma unroll
            for (int s = 0; s < 4; ++s) { const s16x8 kf = *(const LAS s16x8*)(KL + (kt * 32 + r) * 144 + (16 * s + 8 * h) * 2); sacc = MFMA32(kf, qf[s], sacc); }
            const bool on = kt >= kt0;
#pragma unroll
            for (int i = 0; i < 16; ++i) { const float v = sacc[i] * 0.125f + bth[kt * 32 + crow(i, h) - 128 - (w >> 2) * 32 - r + 191]; sc[kt][i] = on ? v : -1e30f; m = fmaxf(m, sc[kt][i]); }
        }
        m = fmaxf(m, __shfl_xor(m, 32));
        float l = 0.f;
#pragma unroll
        for (int kt = 0; kt < 6; ++kt)
#pragma unroll
            for (int i = 0; i < 16; ++i) { const float p = fast_exp(sc[kt][i] - m); sc[kt][i] = p; l += p; }
        l += __shfl_xor(l, 32); l += fast_exp(sink - m);
        f32x16 o[2];
#pragma unroll
        for (int db = 0; db < 2; ++db)
#pragma unroll
            for (int i = 0; i < 16; ++i) o[db][i] = 0.f;
#pragma unroll
        for (int kt = 0; kt < 6; ++kt) {
            const s16x8 p0 = pack8(sc[kt], 0), p1 = pack8(sc[kt], 1);
#pragma unroll
            for (int db = 0; db < 2; ++db) {
                const LAS unsigned char* tb = trb + kt * 32 * 192 + db * 64;
                const s16x8 v0 = tr_frag(tb, tb + 8 * 192);
                const s16x8 v1 = tr_frag(tb + 16 * 192, tb + 24 * 192);
                o[db] = MFMA32(v0, p0, o[db]); o[db] = MFMA32(v1, p1, o[db]); }
        }
        const float inv = 1.0f / l;
#pragma unroll
        for (int db = 0; db < 2; ++db)
#pragma unroll
            for (int g = 0; g < 4; ++g) { v2u wv; wv.x = pkbf(o[db][4 * g] * inv, o[db][4 * g + 1] * inv); wv.y = pkbf(o[db][4 * g + 2] * inv, o[db][4 * g + 3] * inv);
                *(GAS v2u*)(Y + (size_t)(q0 + r) * DM + head * 64 + db * 32 + 8 * g + 4 * h) = wv; }
        __syncthreads();
    }
}

#ifndef REP_P0
#define REP_P0 1
#endif
#define REP_LRU 1
#define REP_SWA 1
#define REP_FIX 1
#define REP_SB 1
struct Args { const float* in[19]; float* out; unsigned char* ws; int ph_lo, ph_hi; };
__global__ void __launch_bounds__(NWAVES * 64, 2) hybrid_fwd(Args args) {
    extern __shared__ __attribute__((aligned(16))) unsigned char lds[];
    Frame F;
    F.lds = (LAS unsigned char*)lds;
    F.tid = threadIdx.x; F.lane = F.tid & 63; F.wave = __builtin_amdgcn_readfirstlane(F.tid >> 6);
    F.G = gridDim.x;
#pragma unroll
    for (int i = 0; i < 19; ++i) F.in[i] = args.in[i];
    F.out = args.out; F.ws = args.ws;
    unsigned char* ws = args.ws;
    for (int u = F.tid; u < (LDS_BYTES - LDSCTL_OFF) / 4; u += NWAVES * 64) ((LAS unsigned*)(F.lds + LDSCTL_OFF))[u] = 0u;
    __syncthreads();
    const int lo = args.ph_lo, hi = args.ph_hi;
    XcdBarrier bar; bar.bar = (unsigned*)(ws + WS_CTL) + CW_BAR; bar.x = 0; bar.st = nullptr;
    if (hi - lo > 1) bar = xcd_barrier_post((unsigned*)(ws + WS_CTL) + CW_BAR, (volatile LAS unsigned*)(F.lds + MISC_OFF) + 8);
#define IN(k) (lo <= (k) && (k) < hi)
#define SEAM(k) do { if (IN(k) && IN((k) + 1)) xcd_barrier(bar); } while (0)
    bf16* XN = (bf16*)(ws + WS_XN); bf16* Yb = (bf16*)(ws + WS_Y); bf16* PROJ = (bf16*)(ws + WS_PROJ); bf16* ACT = (bf16*)(ws + WS_ACT); float* SS = (float*)(ws + WS_SS);

    if (IN(0)) { for (int rep = 0; rep < REP_P0; ++rep) { p0_prologue(F); if (rep + 1 < REP_P0) xcd_barrier(bar); } } SEAM(0);
    if (IN(1)) { pg8::Gemm g{XN, (const bf16*)(ws + WS_WIN0), SEQ, EVEN_IN, DM}; pg8::StaticOrder S; S.init(SEQ, EVEN_IN, F.G, (int)blockIdx.x);
        pg8::EpiBf16<0> E{PROJ, EVEN_IN, SS, 64, SEQ, 0}; pg8::gemm_phase<pg8::EpiBf16<0>, pg8::StaticOrder, true, true>(F.lds + RING_OFF, g, S, E); } SEAM(1);
    if (IN(2)) { for (int rep = 0; rep < REP_LRU; ++rep) { lru_local(F); if (rep + 1 < REP_LRU) xcd_barrier(bar); } for (int rep = 0; rep < REP_SWA; ++rep) { swa_attn(F); if (rep + 1 < REP_SWA) xcd_barrier(bar); } } SEAM(2);
    if (IN(3)) { for (int rep = 0; rep < REP_FIX; ++rep) { lru_fix(F); if (rep + 1 < REP_FIX) xcd_barrier(bar); } } SEAM(3);
    if (IN(4)) { pg8::Gemm g{Yb, (const bf16*)(ws + WS_WOUT0), SEQ, DM, DM}; pg8::StaticOrder S; S.init(SEQ, DM, F.G, (int)blockIdx.x);
        pg8::EpiRes<true> E{F.in[IN_X], XN, SS, DM}; pg8::gemm_phase<pg8::EpiRes<true>, pg8::StaticOrder, false, true>(F.lds + RING_OFF, g, S, E); } SEAM(4);
    if (IN(5)) { pg8::Gemm g{XN, (const bf16*)(ws + WS_WUP0), SEQ, DFF, DM}; pg8::StaticOrder S; S.init(SEQ, DFF, F.G, (int)blockIdx.x);
        pg8::EpiBf16<1> E{ACT, DFF, SS, 0, 0, 0}; pg8::gemm_phase<pg8::EpiBf16<1>, pg8::StaticOrder, true, true>(F.lds + RING_OFF, g, S, E); } SEAM(5);
    if (IN(6)) { pg8::Gemm g{ACT, (const bf16*)(ws + WS_WDN0), SEQ, DM, DFF}; pg8::StaticOrder S; S.init(SEQ, DM, F.G, (int)blockIdx.x);
        pg8::EpiRes<false> E{nullptr, XN, SS, DM}; pg8::gemm_phase<pg8::EpiRes<false>, pg8::StaticOrder, false, true>(F.lds + RING_OFF, g, S, E); } SEAM(6);
    if (IN(7)) { pg8::Gemm g{XN, (const bf16*)(ws + WS_WIN1), SEQ, ODD_IN, DM}; pg8::StaticOrder S; S.init(SEQ, ODD_IN, F.G, (int)blockIdx.x);
        pg8::EpiBf16<0> E{PROJ, ODD_IN, SS, 128, SEQ, 32}; pg8::gemm_phase<pg8::EpiBf16<0>, pg8::StaticOrder, true, true>(F.lds + RING_OFF, g, S, E); } SEAM(7);
    if (IN(8)) { for (int rep = 0; rep < REP_SB; ++rep) { sb_attn(F); if (rep + 1 < REP_SB) xcd_barrier(bar); } } SEAM(8);
    if (IN(9)) { pg8::Gemm g{Yb, (const bf16*)(ws + WS_WOUT1), SEQ, DM, DM}; pg8::StaticOrder S; S.init(SEQ, DM, F.G, (int)blockIdx.x);
        pg8::EpiRes<false> E{nullptr, XN, SS, DM}; pg8::gemm_phase<pg8::EpiRes<false>, pg8::StaticOrder, false, true>(F.lds + RING_OFF, g, S, E); } SEAM(9);
    if (IN(10)) { pg8::Gemm g{XN, (const bf16*)(ws + WS_WUP1), SEQ, DFF, DM}; pg8::StaticOrder S; S.init(SEQ, DFF, F.G, (int)blockIdx.x);
        pg8::EpiBf16<1> E{ACT, DFF, SS, 0, 0, 0}; pg8::gemm_phase<pg8::EpiBf16<1>, pg8::StaticOrder, true, true>(F.lds + RING_OFF, g, S, E); } SEAM(10);
    if (IN(11)) { pg8::Gemm g{ACT, (const bf16*)(ws + WS_WDN1), SEQ, DM, DFF}; pg8::StaticOrder S; S.init(SEQ, DM, F.G, (int)blockIdx.x);
        pg8::EpiRes<false> E{nullptr, XN, SS, DM}; pg8::gemm_phase<pg8::EpiRes<false>, pg8::StaticOrder, false, true>(F.lds + RING_OFF, g, S, E); } SEAM(11);
    if (IN(12)) { final_norm(F); }
#undef IN
#undef SEAM
}

extern "C" void kernel_launch(void* const* d_in, const int* in_sizes, int n_in, void* d_out, int out_size, void* d_ws, size_t ws_size, hipStream_t stream) {
    static int grid = 0;
    if (grid == 0) {
        if (n_in != 19 || in_sizes[0] != SEQ * DM || out_size != SEQ * DM || ws_size < WS_END) { fprintf(stderr, "kernel_launch: unexpected shapes (n_in %d, in0 %d, out %d, ws %zu); nothing launched\n", n_in, n_in > 0 ? in_sizes[0] : -1, out_size, ws_size); grid = -1; return; }
        int dev = 0, cus = 0, per_cu = 0;
        if (hipGetDevice(&dev) != hipSuccess || hipDeviceGetAttribute(&cus, hipDeviceAttributeMultiprocessorCount, dev) != hipSuccess) { fprintf(stderr, "kernel_launch: device query failed\n"); grid = -1; return; }
        if (hipFuncSetAttribute((const void*)hybrid_fwd, hipFuncAttributeMaxDynamicSharedMemorySize, LDS_BYTES) != hipSuccess) { fprintf(stderr, "kernel_launch: hipFuncSetAttribute failed\n"); grid = -1; return; }
        if (hipOccupancyMaxActiveBlocksPerMultiprocessor(&per_cu, (const void*)hybrid_fwd, NWAVES * 64, LDS_BYTES) != hipSuccess || per_cu < 1) { fprintf(stderr, "kernel_launch: occupancy query reports %d workgroups per CU\n", per_cu); per_cu = 1; }
        (void)hipGetLastError();
        grid = cus;
        if (grid != 256) fprintf(stderr, "kernel_launch: %d CUs; the residual GEMM phases need exactly 256 workgroups\n", grid);
    }
    if (grid < 0) return;
    (void)hipMemsetAsync((char*)d_ws + WS_CTL, 0, CTL_ZERO_BYTES, stream);
    Args a{};
    for (int i = 0; i < 19; ++i) a.in[i] = (const float*)d_in[i];
    a.out = (float*)d_out; a.ws = (unsigned char*)d_ws;
#if MK_N_LAUNCHES == 1
    a.ph_lo = 0; a.ph_hi = N_PHASES;
    hipLaunchKernelGGL(hybrid_fwd, dim3(grid), dim3(NWAVES * 64), LDS_BYTES, stream, a);
#else
    for (int p = 0; p < N_PHASES; ++p) { a.ph_lo = p; a.ph_hi = p + 1; hipLaunchKernelGGL(hybrid_fwd, dim3(grid), dim3(NWAVES * 64), LDS_BYTES, stream, a); }
#endif
}
```
